# Optimizing an MI355X kernel written in HIP

```python
import math
import jax, jax.numpy as jnp
from jax import lax
import numpy as np

D_MODEL = 2048
BATCH = 4
SEQ = 2048
DEPTH = 2
DEC_BATCH = 128
DEC_SEQ = 4
PAST_LEN = 16384
PAGE_SIZE = 128

N_MIXERS = 2
N_A_LAYERS = (DEPTH + 1) // 2
N_B_LAYERS = DEPTH // 2
A_HEADS = 8
A_DV = D_MODEL // A_HEADS
A_DK = A_DV // 2
A_CHUNK = 64
A_PROJ = 2 * A_HEADS * A_DK + A_HEADS * A_DV + D_MODEL + 2 * A_HEADS
B_CHUNK = 128
B_GROUPS = 8
B_HALF = 3 * D_MODEL
B_GROUP_DIM = B_HALF // B_GROUPS
P_HEADS = 8
P_NKEYS = 128
P_EXPERTS = P_NKEYS * P_NKEYS
P_TOPK = 16
P_DKEY = 256
P_BLOCK = 128
ALPHA = float((2 * DEPTH) ** 0.25)
BETA = float((8 * DEPTH) ** -0.25)
LN_EPS = 1e-5

kernel_name = 'hybrid_mlstm_chunkgmlp_peer_step'


def layer_norm(x, g, b):
    xf = x.astype(jnp.float32)
    mu = jnp.mean(xf, axis=-1, keepdims=True)
    var = jnp.mean(jnp.square(xf - mu), axis=-1, keepdims=True)
    return ((xf - mu) * lax.rsqrt(var + LN_EPS) * g + b).astype(x.dtype)


def mlstm_chunkwise(q, k, v, it, lf, C0, n0, m0, chunk):
    B, T, H, _ = q.shape
    nc = T // chunk
    f32 = jnp.float32

    def to_chunks(a):
        a = a.astype(f32).reshape((B, nc, chunk, H) + a.shape[3:])
        return jnp.moveaxis(a, (1, 3), (0, 2))

    causal = jnp.tril(jnp.ones((chunk, chunk), dtype=bool))

    def step(carry, xs):
        C, n, m = carry
        qc, kc, vc, ic, fc = xs
        b = jnp.cumsum(fc, axis=-1)
        dlog = jnp.where(causal, b[..., :, None] - b[..., None, :] + ic[..., None, :], -jnp.inf)
        inter = b + m[..., None]
        m_t = jnp.maximum(inter, jnp.max(dlog, axis=-1))
        s = jnp.einsum('bhtd,bhsd->bhts', qc, kc) * jnp.exp(dlog - m_t[..., None])
        w_inter = jnp.exp(inter - m_t)
        num = jnp.einsum('bhts,bhse->bhte', s, vc) + w_inter[..., None] * jnp.einsum('bhtd,bhde->bhte', qc, C)
        den = jnp.sum(s, axis=-1) + w_inter * jnp.einsum('bhtd,bhd->bht', qc, n)
        h = num / jnp.maximum(jnp.abs(den), jnp.exp(-m_t))[..., None]
        b_end = b[..., -1]
        g_log = b_end[..., None] - b + ic
        m_new = jnp.maximum(b_end + m, jnp.max(g_log, axis=-1))
        w_k = jnp.exp(g_log - m_new[..., None])
        decay = jnp.exp(b_end + m - m_new)
        C_new = decay[..., None, None] * C + jnp.einsum('bhs,bhsd,bhse->bhde', w_k, kc, vc)
        n_new = decay[..., None] * n + jnp.einsum('bhs,bhsd->bhd', w_k, kc)
        return (C_new, n_new, m_new), h

    xs = (to_chunks(q), to_chunks(k), to_chunks(v), to_chunks(it), to_chunks(lf))
    init = (C0.astype(f32), n0.astype(f32), m0.astype(f32))
    (C, n, m), h = lax.scan(step, init, xs)
    h = jnp.moveaxis(h, (0, 2), (1, 3)).reshape(B, T, H, A_DV)
    return h, C, n, m


def mlstm_mixer(x, C0, n0, m0, w_in, b_gate, hn_gain, w_out):
    B, T, _ = x.shape
    HK, HV = A_HEADS * A_DK, A_HEADS * A_DV
    p = x @ w_in
    q = p[..., :HK].reshape(B, T, A_HEADS, A_DK)
    k = p[..., HK:2 * HK].reshape(B, T, A_HEADS, A_DK) * (A_DK ** -0.5)
    v = p[..., 2 * HK:2 * HK + HV].reshape(B, T, A_HEADS, A_DV)
    o = p[..., 2 * HK + HV:2 * HK + HV + D_MODEL]
    gates = p[..., 2 * HK + HV + D_MODEL:].astype(jnp.float32) + b_gate
    it = gates[..., :A_HEADS]
    lf = jax.nn.log_sigmoid(gates[..., A_HEADS:])
    chunk = math.gcd(A_CHUNK, T)
    h, C, n, m = mlstm_chunkwise(q, k, v, it, lf, C0, n0, m0, chunk)
    h = h * jax.nn.sigmoid(o.astype(jnp.float32)).reshape(B, T, A_HEADS, A_DV)
    mu = jnp.mean(h, axis=-1, keepdims=True)
    var = jnp.mean(jnp.square(h - mu), axis=-1, keepdims=True)
    h = (h - mu) * lax.rsqrt(var + LN_EPS) * hn_gain
    y = h.reshape(B, T, D_MODEL).astype(x.dtype) @ w_out
    return y, C, n, m


def chunk_gmlp_mixer(x, w_in, b_in, lnv_g, lnv_b, w_s, b_s, w_out):
    B, T, _ = x.shape
    z = jax.nn.gelu(x @ w_in + b_in)
    u, v = z[..., :B_HALF], z[..., B_HALF:]
    v = layer_norm(v, lnv_g, lnv_b)
    pad = (-T) % B_CHUNK
    nc = (T + pad) // B_CHUNK
    vc = jnp.pad(v, ((0, 0), (0, pad), (0, 0))).reshape(B, nc, B_CHUNK, B_GROUPS, B_GROUP_DIM)
    ws = jnp.where(jnp.tril(jnp.ones((B_CHUNK, B_CHUNK), dtype=bool)), w_s, jnp.zeros_like(w_s))
    mixed = jnp.einsum('gts,bcsgd->bctgd', ws, vc) + b_s.T[None, None, :, :, None]
    mixed = mixed.reshape(B, T + pad, B_HALF)[:, :T]
    y = (u * mixed) @ w_out
    return y, v


def peer_ffn(x, w_q, sub_keys, exp_u, exp_v):
    B, T, D = x.shape
    N = B * T
    pad = (-N) % P_BLOCK
    xb = jnp.pad(x.reshape(N, D), ((0, pad), (0, 0))).reshape(-1, P_BLOCK, D)
    sk = sub_keys.astype(jnp.float32)

    def block(xt):
        q = (xt @ w_q).astype(jnp.float32).reshape(P_BLOCK, P_HEADS, 2, P_DKEY // 2)
        s = jnp.einsum('bhpd,hpnd->bhpn', q, sk)
        sv, si = lax.top_k(s, P_TOPK)
        cand = (sv[:, :, 0, :, None] + sv[:, :, 1, None, :]).reshape(P_BLOCK, P_HEADS, P_TOPK * P_TOPK)
        cidx = (si[:, :, 0, :, None] * P_NKEYS + si[:, :, 1, None, :]).reshape(P_BLOCK, P_HEADS, P_TOPK * P_TOPK)
        top_s, top_pos = lax.top_k(cand, P_TOPK)
        idx = jnp.take_along_axis(cidx, top_pos, axis=-1)
        g = jax.nn.softmax(top_s, axis=-1)
        a = jnp.einsum('bhkd,bd->bhk', exp_u[idx], xt)
        w = (jax.nn.gelu(a.astype(jnp.float32)) * g).astype(x.dtype)
        return jnp.einsum('bhk,bhkd->bd', w, exp_v[idx])

    out = lax.map(block, xb).reshape(-1, D)[:N]
    return out.reshape(B, T, D)


def trunk(x, C0, n0, m0, w_in_a, b_gate_a, hn_gain_a, w_out_a, w_in_b, b_in_b, lnv_g_b, lnv_b_b,
          w_s_b, b_s_b, w_out_b, ln_mix_g, ln_mix_b, ln_ffn_g, ln_ffn_b,
          peer_w_q, peer_sub_keys, peer_u, peer_v):
    Cs, ns, ms, vs = [], [], [], []
    for i in range(DEPTH):
        j = i // N_MIXERS
        if i % N_MIXERS == 0:
            mix, C, n, m = mlstm_mixer(x, C0[j], n0[j], m0[j], w_in_a[j], b_gate_a[j], hn_gain_a[j], w_out_a[j])
            Cs.append(C)
            ns.append(n)
            ms.append(m)
        else:
            mix, v = chunk_gmlp_mixer(x, w_in_b[j], b_in_b[j], lnv_g_b[j], lnv_b_b[j], w_s_b[j], b_s_b[j], w_out_b[j])
            vs.append(v)
        x = layer_norm(ALPHA * x + mix, ln_mix_g[i], ln_mix_b[i])
        ffn = peer_ffn(x, peer_w_q[i], peer_sub_keys[i], peer_u[i], peer_v[i])
        x = layer_norm(ALPHA * x + ffn, ln_ffn_g[i], ln_ffn_b[i])
    return x, jnp.stack(Cs), jnp.stack(ns), jnp.stack(ms), jnp.stack(vs)


def setup_inputs(seed: int = 0) -> dict:
    key = jax.random.key(seed)
    ks = jax.random.split(key, 28)
    f32 = jnp.float32

    def nrm(k, shape, s):
        return s * jax.random.normal(k, shape, f32)

    b_gate_a = jnp.concatenate([
        nrm(ks[6], (N_A_LAYERS, A_HEADS), 0.1),
        jnp.linspace(3.0, 6.0, A_HEADS, dtype=f32)[None] + nrm(ks[7], (N_A_LAYERS, A_HEADS), 0.1)], axis=-1)
    return {
        'x_prompt': nrm(ks[0], (BATCH, SEQ, D_MODEL), 1.0),
        'x_sample': nrm(ks[1], (DEC_BATCH, DEC_SEQ, D_MODEL), 1.0),
        'state_mlstm_C': nrm(ks[2], (N_A_LAYERS, DEC_BATCH, A_HEADS, A_DK, A_DV), 0.3),
        'state_mlstm_n': nrm(ks[3], (N_A_LAYERS, DEC_BATCH, A_HEADS, A_DK), 0.3),
        'state_mlstm_m': nrm(ks[4], (N_A_LAYERS, DEC_BATCH, A_HEADS), 0.5),
        'w_in_a': nrm(ks[5], (N_A_LAYERS, D_MODEL, A_PROJ), D_MODEL ** -0.5),
        'b_gate_a': b_gate_a,
        'hn_gain_a': 1.0 + nrm(ks[8], (N_A_LAYERS, A_HEADS, A_DV), 0.02),
        'w_out_a': nrm(ks[9], (N_A_LAYERS, D_MODEL, D_MODEL), BETA * D_MODEL ** -0.5),
        'w_in_b': nrm(ks[10], (N_B_LAYERS, D_MODEL, 2 * B_HALF), D_MODEL ** -0.5),
        'b_in_b': nrm(ks[11], (N_B_LAYERS, 2 * B_HALF), 0.02),
        'lnv_g_b': 1.0 + nrm(ks[12], (N_B_LAYERS, B_HALF), 0.02),
        'lnv_b_b': nrm(ks[13], (N_B_LAYERS, B_HALF), 0.02),
        'w_s_b': nrm(ks[14], (N_B_LAYERS, B_GROUPS, B_CHUNK, B_CHUNK), B_CHUNK ** -0.5),
        'b_s_b': 1.0 + nrm(ks[15], (N_B_LAYERS, B_GROUPS, B_CHUNK), 0.02),
        'w_out_b': nrm(ks[16], (N_B_LAYERS, B_HALF, D_MODEL), BETA * B_HALF ** -0.5),
        'ln_mix_g': 1.0 + nrm(ks[17], (DEPTH, D_MODEL), 0.02),
        'ln_mix_b': nrm(ks[18], (DEPTH, D_MODEL), 0.02),
        'ln_ffn_g': 1.0 + nrm(ks[19], (DEPTH, D_MODEL), 0.02),
        'ln_ffn_b': nrm(ks[20], (DEPTH, D_MODEL), 0.02),
        'peer_w_q': nrm(ks[21], (DEPTH, D_MODEL, P_HEADS * P_DKEY), D_MODEL ** -0.5),
        'peer_sub_keys': nrm(ks[22], (DEPTH, P_HEADS, 2, P_NKEYS, P_DKEY // 2), (P_DKEY // 2) ** -0.5),
        'peer_u': nrm(ks[23], (DEPTH, P_EXPERTS, D_MODEL), D_MODEL ** -0.5),
        'peer_v': nrm(ks[24], (DEPTH, P_EXPERTS, D_MODEL), BETA * P_HEADS ** -0.5),
    }


def reference(x_prompt, x_sample, state_mlstm_C, state_mlstm_n, state_mlstm_m,
              w_in_a, b_gate_a, hn_gain_a, w_out_a, w_in_b, b_in_b, lnv_g_b, lnv_b_b,
              w_s_b, b_s_b, w_out_b, ln_mix_g, ln_mix_b, ln_ffn_g, ln_ffn_b,
              peer_w_q, peer_sub_keys, peer_u, peer_v):
    bp = x_prompt.shape[0]
    C0 = jnp.zeros((N_A_LAYERS, bp, A_HEADS, A_DK, A_DV), jnp.float32)
    n0 = jnp.zeros((N_A_LAYERS, bp, A_HEADS, A_DK), jnp.float32)
    m0 = jnp.zeros((N_A_LAYERS, bp, A_HEADS), jnp.float32)
    y_prompt, C_p, n_p, m_p, _ = trunk(
        x_prompt, C0, n0, m0, w_in_a, b_gate_a, hn_gain_a, w_out_a, w_in_b, b_in_b, lnv_g_b, lnv_b_b,
        w_s_b, b_s_b, w_out_b, ln_mix_g, ln_mix_b, ln_ffn_g, ln_ffn_b,
        peer_w_q, peer_sub_keys, peer_u, peer_v)
    y_sample, C_s, n_s, m_s, v_s = trunk(
        x_sample, state_mlstm_C, state_mlstm_n, state_mlstm_m, w_in_a, b_gate_a, hn_gain_a, w_out_a,
        w_in_b, b_in_b, lnv_g_b, lnv_b_b, w_s_b, b_s_b, w_out_b, ln_mix_g, ln_mix_b, ln_ffn_g, ln_ffn_b,
        peer_w_q, peer_sub_keys, peer_u, peer_v)
    return (y_prompt, y_sample, C_p, n_p, m_p, C_s, n_s, m_s, v_s)
```

```cpp
#include <hip/hip_runtime.h>
#include <stdint.h>
#include <math.h>
namespace nv {
__device__ __forceinline__ float gelu_tanh(float x) { return 0.5f * x * (1.f + tanhf(0.7978845608028654f * (x + 0.044715f * x * x * x))); }
__device__ __forceinline__ float wave_sum(float v) {
#pragma unroll
    for (int o = 32; o > 0; o >>= 1) v += __shfl_xor(v, o);
    return v;
}
__device__ __forceinline__ float block_sum256(float v, float* red) {
    v = wave_sum(v);
    __syncthreads();
    if ((threadIdx.x & 63) == 0) red[threadIdx.x >> 6] = v;
    __syncthreads();
    return (red[0] + red[1]) + (red[2] + red[3]);
}

template <int EPI>
__global__ __launch_bounds__(256) void gemm(const float* __restrict__ A, int lda, const float* __restrict__ B, int ldb, float* __restrict__ C, int ldc, int M, int N, int K, const float* __restrict__ bias) {
    __shared__ float As[16][68];
    __shared__ float Bs[16][68];
    const int tid = threadIdx.x, tx = tid & 15, ty = tid >> 4;
    const int m0 = blockIdx.y * 64, n0 = blockIdx.x * 64;
    float acc[4][4];
#pragma unroll
    for (int i = 0; i < 4; ++i)
#pragma unroll
        for (int j = 0; j < 4; ++j) acc[i][j] = 0.f;
    for (int k0 = 0; k0 < K; k0 += 16) {
        { const int r = tid >> 2, c = (tid & 3) * 4;
          const float4 v = *(const float4*)(A + (size_t)(m0 + r) * lda + k0 + c);
          As[c][r] = v.x; As[c + 1][r] = v.y; As[c + 2][r] = v.z; As[c + 3][r] = v.w; }
        { const int r = tid >> 4, c = (tid & 15) * 4;
          float4 v = make_float4(0.f, 0.f, 0.f, 0.f);
          if (n0 + c < N) v = *(const float4*)(B + (size_t)(k0 + r) * ldb + n0 + c);
          *(float4*)&Bs[r][c] = v; }
        __syncthreads();
#pragma unroll
        for (int k = 0; k < 16; ++k) {
            const float4 a = *(const float4*)&As[k][ty * 4]; const float4 b = *(const float4*)&Bs[k][tx * 4];
            const float av[4] = {a.x, a.y, a.z, a.w}; const float bv[4] = {b.x, b.y, b.z, b.w};
#pragma unroll
            for (int i = 0; i < 4; ++i)
#pragma unroll
                for (int j = 0; j < 4; ++j) acc[i][j] += av[i] * bv[j];
        }
        __syncthreads();
    }
    const int col = n0 + tx * 4;
    if (col < N) {
        float4 bz = make_float4(0.f, 0.f, 0.f, 0.f);
        if (EPI == 1) bz = *(const float4*)(bias + col);
#pragma unroll
        for (int i = 0; i < 4; ++i) {
            const int row = m0 + ty * 4 + i;
            float4 o = make_float4(acc[i][0], acc[i][1], acc[i][2], acc[i][3]);
            if (EPI == 1) { o.x = gelu_tanh(o.x + bz.x); o.y = gelu_tanh(o.y + bz.y); o.z = gelu_tanh(o.z + bz.z); o.w = gelu_tanh(o.w + bz.w); }
            *(float4*)(C + (size_t)row * ldc + col) = o;
        }
    }
}

template <int L>
__global__ __launch_bounds__(256) void mlstm(const float* __restrict__ P, const float* __restrict__ b_gate, const float* __restrict__ hn_gain,
                                             const float* __restrict__ C0, const float* __restrict__ n0, const float* __restrict__ m0,
                                             float* __restrict__ Cout, float* __restrict__ nout, float* __restrict__ mout, float* __restrict__ H, int row0, int T) {
    extern __shared__ float sm[];
    float* q = sm;
    float* k = q + L * 128;
    float* S = k + L * 128;
    float* bb = S + L * L; float* ii = bb + L; float* lf = ii + L; float* mt = lf + L; float* wint = mt + L; float* den = wint + L; float* wk = den + L;
    float* nS = wk + L;
    float* red = nS + 128;
    float* vv = red + 16;
    const int tid = threadIdx.x, seq = blockIdx.x >> 3, h = blockIdx.x & 7;
    float* C = Cout + (size_t)blockIdx.x * 32768;
    for (int d = 0; d < 128; ++d) C[d * 256 + tid] = C0 ? C0[(size_t)blockIdx.x * 32768 + d * 256 + tid] : 0.f;
    if (tid < 128) nS[tid] = n0 ? n0[blockIdx.x * 128 + tid] : 0.f;
    float m = m0 ? m0[blockIdx.x] : 0.f;
    __syncthreads();
    for (int c0 = 0; c0 < T; c0 += L) {
        const size_t rb = (size_t)row0 + (size_t)seq * T + c0;
        for (int idx = tid; idx < L * 128; idx += 256) { const int t = idx >> 7, d = idx & 127; const float* pr = P + (rb + t) * 6160; q[idx] = pr[h * 128 + d]; k[idx] = pr[1024 + h * 128 + d] * 0.08838834764831845f; }
        if (tid < L) { const float* pr = P + (rb + tid) * 6160 + 6144; ii[tid] = pr[h] + b_gate[h]; const float gf = pr[8 + h] + b_gate[8 + h]; lf[tid] = fminf(gf, 0.f) - log1pf(expf(-fabsf(gf))); }
        __syncthreads();
        if (tid == 0) { float s = 0.f; for (int t = 0; t < L; ++t) { s += lf[t]; bb[t] = s; } }
        __syncthreads();
        if (tid < L) { const float bt = bb[tid]; float mx = bt + m; for (int s = 0; s <= tid; ++s) mx = fmaxf(mx, bt - bb[s] + ii[s]); mt[tid] = mx; wint[tid] = expf(bt + m - mx); }
        __syncthreads();
        for (int idx = tid; idx < L * L; idx += 256) { const int t = idx / L, s = idx % L; float v = 0.f;
            if (s <= t) { float dot = 0.f; for (int d = 0; d < 128; ++d) dot += q[t * 128 + d] * k[s * 128 + d]; v = dot * expf(bb[t] - bb[s] + ii[s] - mt[t]); }
            S[idx] = v; }
        __syncthreads();
        if (tid < L) { float dsum = 0.f; for (int s = 0; s <= tid; ++s) dsum += S[tid * L + s]; float qn = 0.f; for (int d = 0; d < 128; ++d) qn += q[tid * 128 + d] * nS[d];
            dsum += wint[tid] * qn; den[tid] = fmaxf(fabsf(dsum), expf(-mt[tid])); }
        for (int s = 0; s < L; ++s) vv[s * 256 + tid] = P[(rb + s) * 6160 + 2048 + h * 256 + tid];
        __syncthreads();
        for (int t = 0; t < L; ++t) {
            float a = 0.f;
            for (int s = 0; s <= t; ++s) a += S[t * L + s] * vv[s * 256 + tid];
            float qc = 0.f;
            for (int d = 0; d < 128; ++d) qc += q[t * 128 + d] * C[d * 256 + tid];
            float hv = (a + wint[t] * qc) / den[t];
            const float o = P[(rb + t) * 6160 + 4096 + h * 256 + tid];
            hv *= 1.f / (1.f + expf(-o));
            const float mu = block_sum256(hv, red) * (1.f / 256.f);
            const float dv = hv - mu;
            const float var = block_sum256(dv * dv, red) * (1.f / 256.f);
            H[(rb + t) * 2048 + h * 256 + tid] = dv * rsqrtf(var + 1e-5f) * hn_gain[h * 256 + tid];
        }
        const float bend = bb[L - 1];
        if (tid == 0) { float mx = bend + m; for (int s = 0; s < L; ++s) mx = fmaxf(mx, bend - bb[s] + ii[s]); red[8] = mx; }
        __syncthreads();
        const float mnew = red[8]; const float decay = expf(bend + m - mnew);
        if (tid < L) wk[tid] = expf(bend - bb[tid] + ii[tid] - mnew);
        __syncthreads();
        for (int idx = tid; idx < L * 128; idx += 256) k[idx] *= wk[idx >> 7];
        __syncthreads();
        for (int d = 0; d < 128; ++d) { float a = decay * C[d * 256 + tid];
#pragma unroll
            for (int s = 0; s < L; ++s) a += k[s * 128 + d] * vv[s * 256 + tid];
            C[d * 256 + tid] = a; }
        if (tid < 128) { float a = decay * nS[tid]; for (int s = 0; s < L; ++s) a += k[s * 128 + tid]; nS[tid] = a; }
        m = mnew;
        __syncthreads();
    }
    if (tid < 128) nout[blockIdx.x * 128 + tid] = nS[tid];
    if (tid == 0) mout[blockIdx.x] = m;
}

__global__ __launch_bounds__(256) void ln2048(const float* __restrict__ a, float alpha, const float* __restrict__ y, const float* __restrict__ g, const float* __restrict__ b, float* __restrict__ out) {
    __shared__ float red[4];
    const int tid = threadIdx.x; const size_t r = blockIdx.x;
    float v[8];
#pragma unroll
    for (int i = 0; i < 2; ++i) { const float4 av = *(const float4*)(a + r * 2048 + i * 1024 + tid * 4); const float4 yv = *(const float4*)(y + r * 2048 + i * 1024 + tid * 4);
        v[i * 4 + 0] = alpha * av.x + yv.x; v[i * 4 + 1] = alpha * av.y + yv.y; v[i * 4 + 2] = alpha * av.z + yv.z; v[i * 4 + 3] = alpha * av.w + yv.w; }
    float s = 0.f;
#pragma unroll
    for (int i = 0; i < 8; ++i) s += v[i];
    const float mu = block_sum256(s, red) * (1.f / 2048.f);
    float s2 = 0.f;
#pragma unroll
    for (int i = 0; i < 8; ++i) { v[i] -= mu; s2 += v[i] * v[i]; }
    const float rstd = rsqrtf(block_sum256(s2, red) * (1.f / 2048.f) + 1e-5f);
#pragma unroll
    for (int i = 0; i < 2; ++i) { const int c = i * 1024 + tid * 4; const float4 gv = *(const float4*)(g + c); const float4 bv = *(const float4*)(b + c);
        float4 o; o.x = v[i * 4 + 0] * rstd * gv.x + bv.x; o.y = v[i * 4 + 1] * rstd * gv.y + bv.y; o.z = v[i * 4 + 2] * rstd * gv.z + bv.z; o.w = v[i * 4 + 3] * rstd * gv.w + bv.w;
        *(float4*)(out + r * 2048 + c) = o; }
}
__global__ __launch_bounds__(256) void lnv(const float* __restrict__ Z, const float* __restrict__ g, const float* __restrict__ b, float* __restrict__ VN) {
    __shared__ float red[4];
    const int tid = threadIdx.x; const size_t r = blockIdx.x;
    float v[24];
    float s = 0.f;
#pragma unroll
    for (int i = 0; i < 24; ++i) { v[i] = Z[r * 12288 + 6144 + i * 256 + tid]; s += v[i]; }
    const float mu = block_sum256(s, red) * (1.f / 6144.f);
    float s2 = 0.f;
#pragma unroll
    for (int i = 0; i < 24; ++i) { v[i] -= mu; s2 += v[i] * v[i]; }
    const float rstd = rsqrtf(block_sum256(s2, red) * (1.f / 6144.f) + 1e-5f);
#pragma unroll
    for (int i = 0; i < 24; ++i) { const int c = i * 256 + tid; VN[r * 6144 + c] = v[i] * rstd * g[c] + b[c]; }
}
__global__ __launch_bounds__(256) void spatial(const float* __restrict__ Zc, const float* __restrict__ VNc, const float* __restrict__ ws, const float* __restrict__ bs, float* __restrict__ UMc, int r0) {
    const int c = blockIdx.x * 256 + threadIdx.x; const int lr = blockIdx.y; const int gr = r0 + lr;
    const int t = (gr < 8192) ? (gr & 127) : ((gr - 8192) & 3);
    const int base = lr - t; const int g = c / 768;
    const float* w = ws + ((size_t)g * 128 + t) * 128;
    float acc = bs[g * 128 + t];
    for (int s = 0; s <= t; ++s) acc += w[s] * VNc[(size_t)(base + s) * 6144 + c];
    UMc[(size_t)lr * 6144 + c] = Zc[(size_t)lr * 12288 + c] * acc;
}
__global__ __launch_bounds__(256) void peer(const float* __restrict__ X, const float* __restrict__ QP, const float* __restrict__ sk, const float* __restrict__ U, const float* __restrict__ V, float* __restrict__ F) {
    __shared__ float xt[2048]; __shared__ float qv[2048]; __shared__ float sc[2048];
    __shared__ float sv[16][16]; __shared__ int si[16][16];
    __shared__ float cand[8][256];
    __shared__ float tw[128]; __shared__ int tix[128];
    const int tid = threadIdx.x; const size_t tok = blockIdx.x;
    for (int i = 0; i < 8; ++i) { xt[tid + 256 * i] = X[tok * 2048 + tid + 256 * i]; qv[tid + 256 * i] = QP[tok * 2048 + tid + 256 * i]; }
    __syncthreads();
    for (int r = 0; r < 8; ++r) { const int j = tid + 256 * r, l = j >> 7; const float* kk = sk + (size_t)j * 128; const float* qq = qv + l * 128; float dot = 0.f;
        for (int d = 0; d < 128; ++d) dot += qq[d] * kk[d];
        sc[j] = dot; }
    __syncthreads();
    if (tid < 16) { const int l = tid;
        for (int r = 0; r < 16; ++r) { float best = -INFINITY; int bi = 0; for (int n = 0; n < 128; ++n) { const float v = sc[l * 128 + n]; if (v > best) { best = v; bi = n; } }
            sv[l][r] = best; si[l][r] = bi; sc[l * 128 + bi] = -INFINITY; } }
    __syncthreads();
    for (int r = 0; r < 8; ++r) { const int j = tid + 256 * r, h = j >> 8, c = j & 255; cand[h][c] = sv[2 * h][c >> 4] + sv[2 * h + 1][c & 15]; }
    __syncthreads();
    if (tid < 8) { const int h = tid;
        for (int r = 0; r < 16; ++r) { float best = -INFINITY; int bi = 0; for (int n = 0; n < 256; ++n) { const float v = cand[h][n]; if (v > best) { best = v; bi = n; } }
            tw[h * 16 + r] = best; tix[h * 16 + r] = si[2 * h][bi >> 4] * 128 + si[2 * h + 1][bi & 15]; cand[h][bi] = -INFINITY; }
        const float mx = tw[h * 16]; float sum = 0.f;
        for (int r = 0; r < 16; ++r) { const float e = expf(tw[h * 16 + r] - mx); tw[h * 16 + r] = e; sum += e; }
        const float inv = 1.f / sum;
        for (int r = 0; r < 16; ++r) tw[h * 16 + r] *= inv; }
    __syncthreads();
    { const int wave = tid >> 6, lane = tid & 63;
      for (int e = wave * 32; e < wave * 32 + 32; ++e) { const float* ur = U + (size_t)tix[e] * 2048; float dot = 0.f;
          for (int i = 0; i < 8; ++i) { const float4 u4 = *(const float4*)(ur + i * 256 + lane * 4); const float* xp = xt + i * 256 + lane * 4; dot += u4.x * xp[0] + u4.y * xp[1] + u4.z * xp[2] + u4.w * xp[3]; }
          dot = wave_sum(dot);
          if (lane == 0) tw[e] = gelu_tanh(dot) * tw[e]; } }
    __syncthreads();
    float4 o0 = make_float4(0.f, 0.f, 0.f, 0.f), o1 = o0;
    for (int e = 0; e < 128; ++e) { const float w = tw[e]; const float* vr = V + (size_t)tix[e] * 2048; const float4 a = *(const float4*)(vr + tid * 4); const float4 b = *(const float4*)(vr + 1024 + tid * 4);
        o0.x += w * a.x; o0.y += w * a.y; o0.z += w * a.z; o0.w += w * a.w; o1.x += w * b.x; o1.y += w * b.y; o1.z += w * b.z; o1.w += w * b.w; }
    *(float4*)(F + tok * 2048 + tid * 4) = o0; *(float4*)(F + tok * 2048 + 1024 + tid * 4) = o1;
}
}
constexpr size_t MiB = 1u << 20;
constexpr int NTOK = 8704, NPROMPT = 8192;
constexpr float ALPHA = 1.4142135623730951f;
constexpr size_t O_Y = 0, O_CP = 17825792, O_NP = O_CP + 1048576, O_MP = O_NP + 4096, O_CS = O_MP + 32, O_NS = O_CS + 33554432, O_MS = O_NS + 131072, O_VS = O_MS + 1024;
static_assert(O_VS + 3145728 == 55710752, "out size");

static void naive_forward(void* const* d_in, float* out, unsigned char* ws, hipStream_t st) {
    const float* x_prompt = (const float*)d_in[0]; const float* x_sample = (const float*)d_in[1];
    const float* sC = (const float*)d_in[2]; const float* sn = (const float*)d_in[3]; const float* smm = (const float*)d_in[4];
    const float* w_in_a = (const float*)d_in[5]; const float* b_gate = (const float*)d_in[6]; const float* hn_gain = (const float*)d_in[7]; const float* w_out_a = (const float*)d_in[8];
    const float* w_in_b = (const float*)d_in[9]; const float* b_in_b = (const float*)d_in[10]; const float* lnv_g = (const float*)d_in[11]; const float* lnv_b = (const float*)d_in[12];
    const float* w_s = (const float*)d_in[13]; const float* b_s = (const float*)d_in[14]; const float* w_out_b = (const float*)d_in[15];
    const float* ln_mix_g = (const float*)d_in[16]; const float* ln_mix_b = (const float*)d_in[17]; const float* ln_ffn_g = (const float*)d_in[18]; const float* ln_ffn_b = (const float*)d_in[19];
    const float* w_q = (const float*)d_in[20]; const float* sk = (const float*)d_in[21]; const float* pu = (const float*)d_in[22]; const float* pv = (const float*)d_in[23];
    float* XA = (float*)(ws + 0 * MiB); float* XB = (float*)(ws + 68 * MiB); float* XC = (float*)(ws + 136 * MiB);
    float* T0 = (float*)(ws + 204 * MiB); float* T1 = (float*)(ws + 272 * MiB); float* BIG = (float*)(ws + 340 * MiB);
    static bool init = false;
    if (!init) { init = true; (void)hipFuncSetAttribute((const void*)nv::mlstm<64>, hipFuncAttributeMaxDynamicSharedMemorySize, (21072 + 64 * 256) * 4); }
    (void)hipMemcpyAsync(XA, x_prompt, (size_t)NPROMPT * 2048 * 4, hipMemcpyDeviceToDevice, st);
    (void)hipMemcpyAsync(XA + (size_t)NPROMPT * 2048, x_sample, (size_t)512 * 2048 * 4, hipMemcpyDeviceToDevice, st);
    float* P = BIG;
    nv::gemm<0><<<dim3(97, NTOK / 64), 256, 0, st>>>(XA, 2048, w_in_a, 6160, P, 6160, NTOK, 6160, 2048, nullptr);
    nv::mlstm<64><<<32, 256, (21072 + 64 * 256) * 4, st>>>(P, b_gate, hn_gain, nullptr, nullptr, nullptr, out + O_CP, out + O_NP, out + O_MP, T0, 0, 2048);
    nv::mlstm<4><<<1024, 256, (2 * 4 * 128 + 16 + 7 * 4 + 128 + 16 + 4 * 256) * 4, st>>>(P, b_gate, hn_gain, sC, sn, smm, out + O_CS, out + O_NS, out + O_MS, T0, NPROMPT, 4);
    nv::gemm<0><<<dim3(32, NTOK / 64), 256, 0, st>>>(T0, 2048, w_out_a, 2048, T1, 2048, NTOK, 2048, 2048, nullptr);
    nv::ln2048<<<NTOK, 256, 0, st>>>(XA, ALPHA, T1, ln_mix_g, ln_mix_b, XB);
    nv::gemm<0><<<dim3(32, NTOK / 64), 256, 0, st>>>(XB, 2048, w_q, 2048, T0, 2048, NTOK, 2048, 2048, nullptr);
    nv::peer<<<NTOK, 256, 0, st>>>(XB, T0, sk, pu, pv, T1);
    nv::ln2048<<<NTOK, 256, 0, st>>>(XB, ALPHA, T1, ln_ffn_g, ln_ffn_b, XC);
    float* Zc = BIG; float* VNc = BIG + (size_t)2176 * 12288; float* UMc = VNc + (size_t)2176 * 6144;
    for (int rc = 0; rc < 4; ++rc) {
        const int r0 = rc * 2176;
        nv::gemm<1><<<dim3(192, 2176 / 64), 256, 0, st>>>(XC + (size_t)r0 * 2048, 2048, w_in_b, 12288, Zc, 12288, 2176, 12288, 2048, b_in_b);
        nv::lnv<<<2176, 256, 0, st>>>(Zc, lnv_g, lnv_b, VNc);
        if (rc == 3) (void)hipMemcpyAsync(out + O_VS, VNc + (size_t)(NPROMPT - r0) * 6144, (size_t)512 * 6144 * 4, hipMemcpyDeviceToDevice, st);
        nv::spatial<<<dim3(24, 2176), 256, 0, st>>>(Zc, VNc, w_s, b_s, UMc, r0);
        nv::gemm<0><<<dim3(32, 2176 / 64), 256, 0, st>>>(UMc, 6144, w_out_b, 2048, T1 + (size_t)r0 * 2048, 2048, 2176, 2048, 6144, nullptr);
    }
    nv::ln2048<<<NTOK, 256, 0, st>>>(XC, ALPHA, T1, ln_mix_g + 2048, ln_mix_b + 2048, XA);
    nv::gemm<0><<<dim3(32, NTOK / 64), 256, 0, st>>>(XA, 2048, w_q + (size_t)2048 * 2048, 2048, T0, 2048, NTOK, 2048, 2048, nullptr);
    nv::peer<<<NTOK, 256, 0, st>>>(XA, T0, sk + (size_t)8 * 2 * 128 * 128, pu + (size_t)16384 * 2048, pv + (size_t)16384 * 2048, T1);
    nv::ln2048<<<NTOK, 256, 0, st>>>(XA, ALPHA, T1, ln_ffn_g + 2048, ln_ffn_b + 2048, out + O_Y);
}
extern "C" void kernel_launch(void* const* d_in, const int* in_sizes, int n_in, void* d_out, int out_size, void* d_ws, size_t ws_size, hipStream_t stream) {
    naive_forward(d_in, (float*)d_out, (unsigned char*)d_ws, stream);
}
```

```cpp
#include <hip/hip_runtime.h>
#include <stdint.h>
#include <math.h>
#define DUPMASK 0u
#define MLSTM_DUPSEL 7
#define GAS __attribute__((address_space(1)))
#define LAS __attribute__((address_space(3)))
typedef unsigned short bf16;
typedef unsigned v4u __attribute__((ext_vector_type(4)));
typedef float f32x4 __attribute__((ext_vector_type(4)));
typedef short bf16x8 __attribute__((ext_vector_type(8)));
typedef GAS unsigned gu32;
typedef GAS unsigned long long gu64;
#define RLX_AGENT __ATOMIC_RELAXED, __HIP_MEMORY_SCOPE_AGENT
#define LDS_WAIT() asm volatile("s_waitcnt lgkmcnt(0)" ::: "memory")
#define VM_WAIT() asm volatile("s_waitcnt vmcnt(0)" ::: "memory")
__device__ __forceinline__ unsigned long long rt() { return __builtin_amdgcn_s_memrealtime(); }
__device__ __forceinline__ unsigned f2bf(float f) { unsigned u = __builtin_bit_cast(unsigned, f); return (u + 0x7fffu + ((u >> 16) & 1u)) >> 16; }
__device__ __forceinline__ unsigned pk2(float lo, float hi) { unsigned r; asm("v_cvt_pk_bf16_f32 %0, %1, %2" : "=v"(r) : "v"(lo), "v"(hi)); return r; }

#define XB_TMO      128
#define XB_XCNT(j)  (256  + 64 * (j))
#define XB_XSUB(j)  (1280 + 64 * (j))
#define XB_XGEN(j)  (2304 + 64 * (j))
#define XB_TOP      3328
#define XB_TOPGEN   3392
#define XCD_BAR_WORDS 3456
#define XB_SPIN_CAP (1u << 22)

__device__ __forceinline__ unsigned xb_ld(unsigned* p)              { return __hip_atomic_load(p, __ATOMIC_RELAXED, __HIP_MEMORY_SCOPE_AGENT); }
__device__ __forceinline__ unsigned xb_add(unsigned* p, unsigned v) { return __hip_atomic_fetch_add(p, v, __ATOMIC_RELAXED, __HIP_MEMORY_SCOPE_AGENT); }
__device__ __forceinline__ unsigned xb_xcc_id() { return (unsigned)__builtin_amdgcn_s_getreg((3 << 11) | 20) & 0xFu; }
#define XB_SPIN(cond, bar) do { unsigned _sp = 0; while (cond) { __builtin_amdgcn_s_sleep(1); \
    if ((++_sp & 255u) == 0u) { if (xb_ld(&(bar)[XB_TMO])) break; if (_sp > XB_SPIN_CAP) { atomicAdd(&(bar)[XB_TMO], 1u); break; } } } } while (0)

struct XcdBarrier {
    unsigned* bar; unsigned x;
    volatile LAS unsigned* st;
};

__device__ __forceinline__ XcdBarrier xcd_barrier_post(unsigned* bar, volatile LAS unsigned* st) {
    XcdBarrier b; b.bar = bar; b.x = xb_xcc_id(); b.st = st;
    if (threadIdx.x == 0) st[2] = xb_add(&bar[XB_XCNT(b.x)], 1u);
    return b;
}
__device__ __forceinline__ void xcd_barrier_complete(unsigned* bar, unsigned x, unsigned& nloc, unsigned& nx) {
    const unsigned G = gridDim.x * gridDim.y * gridDim.z;
    unsigned sum, cnt, mine, sp = 0u;
    for (;;) {
        sum = 0u; cnt = 0u; mine = 0u;
#pragma unroll
        for (unsigned j = 0; j < 16; ++j) { const unsigned c = xb_ld(&bar[XB_XCNT(j)]); sum += c; cnt += (c > 0u) ? 1u : 0u; mine = (j == x) ? c : mine; }
        if (sum == G) break;
        __builtin_amdgcn_s_sleep(1);
        if ((++sp & 255u) == 0u) { if (xb_ld(&bar[XB_TMO])) break; if (sp > XB_SPIN_CAP) { atomicAdd(&bar[XB_TMO], 1u); break; } }
    }
    nloc = mine > 0u ? mine : 1u; nx = cnt > 0u ? cnt : 1u;
}

__device__ __forceinline__ void xcd_barrier(const XcdBarrier& b) {
    asm volatile("s_waitcnt vmcnt(0)" ::: "memory");
    __syncthreads();
    if (threadIdx.x == 0) {
        unsigned* bar = b.bar;
        __builtin_amdgcn_s_waitcnt(0);
        unsigned nloc = b.st[0], nx = b.st[1];
        if (nloc == 0u) { xcd_barrier_complete(bar, b.x, nloc, nx); b.st[0] = nloc; b.st[1] = nx; }
        const unsigned old = xb_add(&bar[XB_XSUB(b.x)], 1u);
        const unsigned gen = old / nloc;
        if (old + 1u == (gen + 1u) * nloc) {
            __builtin_amdgcn_fence(__ATOMIC_RELEASE, "agent");
            asm volatile("s_waitcnt vmcnt(0)" ::: "memory");
            const unsigned og = xb_add(&bar[XB_TOP], 1u);
            const unsigned tg = og / nx;
            if (og + 1u == (tg + 1u) * nx) xb_add(&bar[XB_TOPGEN], 1u);
            else XB_SPIN(xb_ld(&bar[XB_TOPGEN]) == tg, bar);
            __builtin_amdgcn_fence(__ATOMIC_ACQUIRE, "agent");
            xb_add(&bar[XB_XGEN(b.x)], 1u);
            asm volatile("s_waitcnt vmcnt(0)" ::: "memory");
        } else {
            XB_SPIN(xb_ld(&bar[XB_XGEN(b.x)]) == gen, bar);
            __builtin_amdgcn_fence(__ATOMIC_ACQUIRE, "agent");
            asm volatile("s_waitcnt vmcnt(0)" ::: "memory");
        }
    }
    __syncthreads();
}

namespace pg8 {
#define PG8_LAS __attribute__((address_space(3)))
typedef unsigned short bf16_t;
typedef short bf16x8 __attribute__((ext_vector_type(8)));
typedef float f32x4 __attribute__((ext_vector_type(4)));
typedef unsigned u32x4 __attribute__((ext_vector_type(4)));
constexpr int BM = 256, BK = 64, HALF = 128, HTB = HALF * BK * 2  , STAGE_BYTES = 8 * HTB, NXCD = 8, WGM = 8;

__host__ __device__ __forceinline__ int lds_byte(int r, int c) { const int st = (r >> 4) * 2 + (c >> 5), rr = r & 15, cc = c & 31, ob = rr * 64 + cc * 2; return st * 1024 + (ob ^ (((ob >> 9) & 1) << 5)); }
__host__ __device__ __forceinline__ void stage_rc(int b, int& R, int& C) { const int st = b / 1024, sb = b % 1024, swz = sb ^ (((sb >> 9) & 1) << 5); R = (st >> 1) * 16 + swz / 64; C = (st & 1) * 32 + (swz % 64) / 2; }
__host__ __device__ __forceinline__ int perm32(int rho) { const int n = rho >> 4, i = rho & 15; return 8 * (i >> 2) + 4 * n + (i & 3); }

struct Unit { int pm, pn; };
struct Gemm { const bf16_t* A; const bf16_t* Bt; int M, N, K; };

struct StaticOrder {
    int nM, nN, nwg, G, c;
    __host__ __device__ void init(int M, int N, int G_, int c_) { nM = M / BM; nN = N / BM; nwg = nM * nN; G = G_; c = c_; }
    __host__ __device__ bool next(int i, Unit& u) const {
        const long L = (long)i * G + c; if (L >= nwg) return false;
        int wgid = (int)L; { const int q = nwg / NXCD, r = nwg % NXCD, xcd = wgid % NXCD, off = wgid / NXCD; wgid = (xcd < r ? xcd * (q + 1) : r * (q + 1) + (xcd - r) * q) + off; }
        const int nig = WGM * nN, gid = wgid / nig, fm = gid * WGM, gsz = (nM - fm) < WGM ? (nM - fm) : WGM;
        u.pm = fm + ((wgid % nig) % gsz); u.pn = (wgid % nig) / gsz; return true;
    }
    __device__ __forceinline__ void a_ready(const Unit&) const {}
    __device__ __forceinline__ void done(const Unit&) const {}
};


__device__ __forceinline__ unsigned cvt_pk_bf16(float lo, float hi) { unsigned r; asm volatile("v_cvt_pk_bf16_f32 %0, %1, %2" : "=v"(r) : "v"(lo), "v"(hi)); return r; }
__device__ __forceinline__ float gelu_tanh_f(float x) { const float u = x + 0.044715f * x * x * x; const float e = __builtin_amdgcn_exp2f(u * -2.302208198f); return x * __builtin_amdgcn_rcpf(1.0f + e); }
struct EpiBf16S {
    static constexpr bool PERM = true, AFTER_DRAIN = false;
    bf16_t* O; int ldc; int sc_lo, sc_hi; float sc;
    __device__ __forceinline__ void operator()(const f32x4 (&acc)[2][2][4][2], const Unit& u, int wr, int wc, int fr, int fq) const {
        const int row0 = u.pm * BM + wr * 64 + fr; const int colt = u.pn * BM;
        const float s = (colt >= sc_lo && colt < sc_hi) ? sc : 1.f;
        const int col0 = colt + wc * 32 + 8 * fq;
#pragma unroll
        for (int ai = 0; ai < 2; ++ai)
#pragma unroll
            for (int m = 0; m < 4; ++m) { bf16_t* rowp = O + (size_t)(row0 + ai * HALF + m * 16) * ldc + col0;
#pragma unroll
                for (int bj = 0; bj < 2; ++bj) { const f32x4 v0 = acc[ai][bj][m][0] * s, v1 = acc[ai][bj][m][1] * s;
                    u32x4 w; w.x = cvt_pk_bf16(v0[0], v0[1]); w.y = cvt_pk_bf16(v0[2], v0[3]); w.z = cvt_pk_bf16(v1[0], v1[1]); w.w = cvt_pk_bf16(v1[2], v1[3]);
                    *(u32x4*)(rowp + bj * HALF) = w; } }
    }
};
struct EpiRes {
    static constexpr bool PERM = false, AFTER_DRAIN = false;
    const float* res0; const float* res1; float* Z; float alpha;
    __device__ __forceinline__ void operator()(const f32x4 (&acc)[2][2][4][2], const Unit& u, int wr, int wc, int fr, int fq) const {
        const int col0 = u.pn * BM + wc * 32 + 4 * fq;
#pragma unroll
        for (int ai = 0; ai < 2; ++ai)
#pragma unroll
            for (int m = 0; m < 4; ++m) { const int r = u.pm * BM + ai * HALF + wr * 64 + m * 16 + fr;
                const float* rp = (r < 8192) ? res0 + (size_t)r * 2048 : res1 + (size_t)(r - 8192) * 2048; float* zp = Z + (size_t)r * 2048;
#pragma unroll
                for (int bj = 0; bj < 2; ++bj)
#pragma unroll
                    for (int n = 0; n < 2; ++n) { const int c = col0 + bj * HALF + n * 16; const f32x4 x = *(const f32x4*)(rp + c); *(f32x4*)(zp + c) = x * alpha + acc[ai][bj][m][n]; } }
    }
};
struct EpiGelu {
    static constexpr bool PERM = true, AFTER_DRAIN = false;
    bf16_t* U; bf16_t* V; const float* bias; float* VST;
    __device__ __forceinline__ void operator()(const f32x4 (&acc)[2][2][4][2], const Unit& u, int wr, int wc, int fr, int fq) const {
        const int row0 = u.pm * BM + wr * 64 + fr; const bool isv = u.pn >= 24; const int colt = (isv ? u.pn - 24 : u.pn) * BM;
        bf16_t* base = isv ? V : U;
        const int col0 = colt + wc * 32 + 8 * fq, bcol0 = u.pn * BM + wc * 32 + 8 * fq;
        f32x4 bv[2][2];
#pragma unroll
        for (int bj = 0; bj < 2; ++bj)
#pragma unroll
            for (int n = 0; n < 2; ++n) bv[bj][n] = *(const f32x4*)(bias + bcol0 + bj * HALF + 4 * n);
#pragma unroll
        for (int ai = 0; ai < 2; ++ai)
#pragma unroll
            for (int m = 0; m < 4; ++m) { const int r = row0 + ai * HALF + m * 16; bf16_t* rowp = base + (size_t)r * 6144 + col0; float s1 = 0.f, s2 = 0.f;
#pragma unroll
                for (int bj = 0; bj < 2; ++bj) { f32x4 v0 = acc[ai][bj][m][0] + bv[bj][0], v1 = acc[ai][bj][m][1] + bv[bj][1];
#pragma unroll
                    for (int e = 0; e < 4; ++e) { v0[e] = gelu_tanh_f(v0[e]); v1[e] = gelu_tanh_f(v1[e]); s1 += v0[e] + v1[e]; s2 += v0[e] * v0[e] + v1[e] * v1[e]; }
                    u32x4 w; w.x = cvt_pk_bf16(v0[0], v0[1]); w.y = cvt_pk_bf16(v0[2], v0[3]); w.z = cvt_pk_bf16(v1[0], v1[1]); w.w = cvt_pk_bf16(v1[2], v1[3]);
                    *(u32x4*)(rowp + bj * HALF) = w; }
                if (isv) { s1 += __shfl_xor(s1, 16); s1 += __shfl_xor(s1, 32); s2 += __shfl_xor(s2, 16); s2 += __shfl_xor(s2, 32);
                    if (fq == 0) { atomicAdd(VST + 2 * r, s1); atomicAdd(VST + 2 * r + 1, s2); } } }
    }
};
template <class Epi, class Sched, bool ALIGN_EPI = false, bool SP2 = false>
__device__ __forceinline__ void gemm_phase(PG8_LAS unsigned char* lds, const Gemm g, const Sched& S, const Epi& E) {
    int tid_l = threadIdx.x; asm volatile("" : "+v"(tid_l));
    const int tid = tid_l, wid = __builtin_amdgcn_readfirstlane(tid >> 6), lane = tid & 63, wr = wid >> 2, wc = wid & 3, fr = lane & 15, fq = lane >> 4;
    const int K = g.K, nt = K / BK;
    unsigned voffA[2], voffB[2];
#pragma unroll
    for (int i = 0; i < 2; ++i) { int R, C; stage_rc(tid * 16 + i * 8192, R, C); const int Rb = Epi::PERM ? ((R & ~31) + perm32(R & 31)) : R;
        voffA[i] = (unsigned)(R * K + C) * 2u; voffB[i] = (unsigned)(Rb * K + C) * 2u; }
    const size_t kstep = (size_t)(BK * 2);
    const size_t hstep = (size_t)HALF * K * 2;
    const size_t tstep = 2 * hstep;
    const unsigned ldsw = (unsigned)wid * 1024u;
    const int aoff = lds_byte(wr * 64 + fr, fq * 8), boff = lds_byte(wc * 32 + fr, fq * 8);
#define PG8_SA(b, h) (((b) * 2 + (h)) * HTB)
#define PG8_SB(b, h) ((4 + (b) * 2 + (h)) * HTB)
#define PG8_STAGE(bufoff, gbase, voff) do { _Pragma("unroll") for (int _i = 0; _i < 2; ++_i) \
        __builtin_amdgcn_global_load_lds((const unsigned*)((const char*)(gbase) + (voff)[_i]), (PG8_LAS unsigned*)(lds + (bufoff) + ldsw + _i * 8192), 16, 0, 0); } while (0)
#define PG8_LDA(dst, b, h) do { _Pragma("unroll") for (int m = 0; m < 4; ++m) _Pragma("unroll") for (int k = 0; k < 2; ++k) dst[m][k] = *(const PG8_LAS bf16x8*)(lds + PG8_SA(b, h) + aoff + m * 2048 + k * 1024); } while (0)
#define PG8_LDB(dst, b, h) do { _Pragma("unroll") for (int n = 0; n < 2; ++n) _Pragma("unroll") for (int k = 0; k < 2; ++k) dst[n][k] = *(const PG8_LAS bf16x8*)(lds + PG8_SB(b, h) + boff + n * 2048 + k * 1024); } while (0)
#define PG8_MMA(ai, bj, At, Bt) do { __builtin_amdgcn_s_setprio(1); _Pragma("unroll") for (int m = 0; m < 4; ++m) _Pragma("unroll") for (int n = 0; n < 2; ++n) _Pragma("unroll") for (int k = 0; k < 2; ++k) \
        acc[ai][bj][m][n] = __builtin_amdgcn_mfma_f32_16x16x32_bf16(Bt[n][k], At[m][k], acc[ai][bj][m][n], 0, 0, 0); __builtin_amdgcn_s_setprio(0); } while (0)
#define PG8_WAIT_V(n) asm volatile("s_waitcnt vmcnt(" #n ")" ::: "memory")
#define PG8_WAIT_L(n) asm volatile("s_waitcnt lgkmcnt(" #n ")" ::: "memory")
#define PG8_BAR __builtin_amdgcn_s_barrier()
#define PG8_SCHED __builtin_amdgcn_sched_barrier(0)
    Unit cur, nxt; int ui = 0;
    if (!S.next(0, cur)) return;
    f32x4 acc[2][2][4][2];
#pragma unroll
    for (int a = 0; a < 2; ++a)
#pragma unroll
        for (int b = 0; b < 2; ++b)
#pragma unroll
            for (int m = 0; m < 4; ++m)
#pragma unroll
                for (int n = 0; n < 2; ++n) acc[a][b][m][n] = (f32x4){0.f, 0.f, 0.f, 0.f};
    bf16x8 At[4][2], B0[2][2], B1[2][2];
    const char* cA = (const char*)g.A + (size_t)cur.pm * tstep; const char* cB = (const char*)g.Bt + (size_t)cur.pn * tstep;
    S.a_ready(cur);
    if constexpr (SP2) {
        PG8_STAGE(PG8_SB(0, 0), cB, voffB); PG8_STAGE(PG8_SB(0, 1), cB + hstep, voffB); PG8_STAGE(PG8_SA(0, 0), cA, voffA); PG8_STAGE(PG8_SA(0, 1), cA + hstep, voffA);
        if (wr == 1) PG8_BAR;
        PG8_WAIT_V(2); PG8_BAR;
        PG8_STAGE(PG8_SB(1, 0), cB + kstep, voffB); PG8_STAGE(PG8_SA(1, 0), cA + kstep, voffA); PG8_STAGE(PG8_SB(1, 1), cB + hstep + kstep, voffB);
        PG8_WAIT_V(6); PG8_BAR;
    } else {
        PG8_STAGE(PG8_SB(0, 0), cB, voffB); PG8_STAGE(PG8_SA(0, 0), cA, voffA); PG8_STAGE(PG8_SB(0, 1), cB + hstep, voffB); PG8_STAGE(PG8_SA(0, 1), cA + hstep, voffA);
        if (wr == 1) PG8_BAR;
        PG8_WAIT_V(4); PG8_BAR;
        PG8_STAGE(PG8_SB(1, 0), cB + kstep, voffB); PG8_STAGE(PG8_SA(1, 0), cA + kstep, voffA); PG8_STAGE(PG8_SB(1, 1), cB + hstep + kstep, voffB);
        PG8_WAIT_V(6); PG8_BAR;
    }
    for (;;) {
        const bool has_next = S.next(ui + 1, nxt);
        const char* nA = has_next ? (const char*)g.A + (size_t)nxt.pm * tstep : cA; const char* nB = has_next ? (const char*)g.Bt + (size_t)nxt.pn * tstep : cB;
        for (int t = 0; t < nt; t += 2) {
            const bool last = (t == nt - 2);
            const char* a1 = cA + (size_t)(t + 1) * kstep;
            const char* a2 = last ? nA : cA + (size_t)(t + 2) * kstep; const char* b2 = last ? nB : cB + (size_t)(t + 2) * kstep;
            const char* a3 = a2 + kstep; const char* b3 = b2 + kstep;
            if (last && has_next) S.a_ready(nxt);
            if constexpr (SP2) {
            PG8_LDB(B0, 0, 0); PG8_LDB(B1, 0, 1); PG8_SCHED; PG8_LDA(At, 0, 0); PG8_STAGE(PG8_SA(1, 1), a1 + hstep, voffA);
            PG8_WAIT_V(8); PG8_WAIT_L(0); PG8_BAR; PG8_MMA(0, 0, At, B0); PG8_MMA(0, 1, At, B1); PG8_BAR; PG8_SCHED;
            PG8_LDA(At, 0, 1); PG8_STAGE(PG8_SB(0, 0), b2, voffB); PG8_STAGE(PG8_SB(0, 1), b2 + hstep, voffB); PG8_STAGE(PG8_SA(0, 0), a2, voffA);
            PG8_WAIT_V(8); PG8_WAIT_L(0); PG8_BAR; PG8_MMA(1, 0, At, B0); PG8_MMA(1, 1, At, B1); PG8_BAR; PG8_SCHED;
            PG8_LDB(B0, 1, 0); PG8_LDB(B1, 1, 1); PG8_SCHED; PG8_LDA(At, 1, 0); PG8_STAGE(PG8_SA(0, 1), a2 + hstep, voffA);
            PG8_WAIT_V(8); PG8_WAIT_L(0); PG8_BAR; PG8_MMA(0, 0, At, B0); PG8_MMA(0, 1, At, B1); PG8_BAR; PG8_SCHED;
            PG8_LDA(At, 1, 1); PG8_STAGE(PG8_SB(1, 0), b3, voffB); PG8_STAGE(PG8_SB(1, 1), b3 + hstep, voffB); PG8_STAGE(PG8_SA(1, 0), a3, voffA);
            PG8_WAIT_V(8); PG8_WAIT_L(0); PG8_BAR; PG8_MMA(1, 0, At, B0); PG8_MMA(1, 1, At, B1); PG8_BAR; PG8_SCHED;
            } else {
            PG8_LDB(B0, 0, 0); PG8_SCHED; PG8_LDA(At, 0, 0); PG8_STAGE(PG8_SA(1, 1), a1 + hstep, voffA);
            PG8_WAIT_L(8); PG8_BAR; PG8_WAIT_L(0); PG8_MMA(0, 0, At, B0); PG8_BAR; PG8_SCHED;
            PG8_LDB(B1, 0, 1); PG8_STAGE(PG8_SB(0, 0), b2, voffB);
            PG8_BAR; PG8_WAIT_L(0); PG8_MMA(0, 1, At, B1); PG8_BAR;
            PG8_LDA(At, 0, 1); PG8_STAGE(PG8_SA(0, 0), a2, voffA);
            PG8_BAR; PG8_WAIT_L(0); PG8_MMA(1, 0, At, B0); PG8_BAR; PG8_SCHED;
            PG8_STAGE(PG8_SB(0, 1), b2 + hstep, voffB);
            PG8_WAIT_V(6); PG8_BAR; PG8_MMA(1, 1, At, B1); PG8_BAR;
            PG8_LDB(B0, 1, 0); PG8_SCHED; PG8_LDA(At, 1, 0); PG8_STAGE(PG8_SA(0, 1), a2 + hstep, voffA);
            PG8_WAIT_L(8); PG8_BAR; PG8_WAIT_L(0); PG8_MMA(0, 0, At, B0); PG8_BAR; PG8_SCHED;
            PG8_LDB(B1, 1, 1); PG8_STAGE(PG8_SB(1, 0), b3, voffB);
            PG8_BAR; PG8_WAIT_L(0); PG8_MMA(0, 1, At, B1); PG8_BAR;
            PG8_LDA(At, 1, 1); PG8_STAGE(PG8_SA(1, 0), a3, voffA);
            PG8_BAR; PG8_WAIT_L(0); PG8_MMA(1, 0, At, B0); PG8_BAR; PG8_SCHED;
            PG8_STAGE(PG8_SB(1, 1), b3 + hstep, voffB);
            PG8_WAIT_V(6); PG8_BAR; PG8_MMA(1, 1, At, B1); PG8_BAR;
            }
        }
        if constexpr (ALIGN_EPI) { if (wr == 0) PG8_BAR; }
        if constexpr (!Epi::AFTER_DRAIN) { E(acc, cur, wr, wc, fr, fq); S.done(cur); }
        if (!has_next) break;
#pragma unroll
        for (int a = 0; a < 2; ++a)
#pragma unroll
            for (int b = 0; b < 2; ++b)
#pragma unroll
                for (int m = 0; m < 4; ++m)
#pragma unroll
                    for (int n = 0; n < 2; ++n) acc[a][b][m][n] = (f32x4){0.f, 0.f, 0.f, 0.f};
        cur = nxt; cA = nA; cB = nB; ++ui;
        if constexpr (ALIGN_EPI) { if (wr == 1) PG8_BAR; }
    }
    PG8_WAIT_V(0);
    if constexpr (!ALIGN_EPI) { if (wr == 0) PG8_BAR; }
    PG8_BAR;
    if constexpr (Epi::AFTER_DRAIN) { E.fused(acc, cur, wr, wc, fr, fq, lds, wid, lane); S.done(cur); }
#undef PG8_SA
#undef PG8_SB
#undef PG8_STAGE
#undef PG8_LDA
#undef PG8_LDB
#undef PG8_MMA
#undef PG8_WAIT_V
#undef PG8_WAIT_L
#undef PG8_BAR
#undef PG8_SCHED
}
}
constexpr int NWAVES = 8;
constexpr int LDS_BYTES = 147456;
constexpr int RING_BYTES = 131072;
constexpr int MISC_OFF = RING_BYTES + 320;
constexpr int NTOKF = 8704;
constexpr float ALPHA_F = 1.4142135623730951f;
constexpr size_t OUT_VS = 52565024;

struct Lay {
    unsigned long long ctl, wina, wouta, winb, woutb, wq, sk, gates, vst, idx, gt, ww, ptu, ptv, xf0, xf1, z, xb, qp, qkvo, ub, vb, um, wsb, ptu1, ptv1, rinv, su, xq, sx;
};
struct Args { const float* in[24]; float* out; unsigned char* ws; Lay L; int ph_lo, ph_hi, li, pad; };

__device__ __forceinline__ float wave_sum_f(float v) {
#pragma unroll
    for (int o = 1; o < 64; o <<= 1) v += __shfl_xor(v, o);
    return v;
}
__device__ __forceinline__ void p0_transpose_item(const float* W, int K, int ldw, int Nuse, bf16* WT, LAS float* scr, int item, int lane) {
    const int nblk = Nuse / 32, kb = item / nblk, nb = item % nblk, k0 = 64 * kb, n0 = 32 * nb;
    f32x4 ld[8];
#pragma unroll
    for (int i = 0; i < 8; ++i) ld[i] = __builtin_nontemporal_load((const GAS f32x4*)(W + (size_t)(k0 + 8 * i + (lane >> 3)) * ldw + n0 + (lane & 7) * 4));
#pragma unroll
    for (int i = 0; i < 8; ++i) { LAS float* d = scr + (8 * i + (lane >> 3)) * 33 + (lane & 7) * 4; d[0] = ld[i].x; d[1] = ld[i].y; d[2] = ld[i].z; d[3] = ld[i].w; }
    LDS_WAIT(); asm volatile("" ::: "memory");
    const int c = lane & 7;
#pragma unroll
    for (int j = 0; j < 4; ++j) { const int n = (lane >> 3) + 8 * j; const LAS float* s = scr + (8 * c) * 33 + n;
        v4u o; o.x = pk2(s[0 * 33], s[1 * 33]); o.y = pk2(s[2 * 33], s[3 * 33]); o.z = pk2(s[4 * 33], s[5 * 33]); o.w = pk2(s[6 * 33], s[7 * 33]);
        *(GAS v4u*)(WT + (size_t)(n0 + n) * K + k0 + 8 * c) = o; }
    LDS_WAIT(); asm volatile("" ::: "memory");
}
__device__ __forceinline__ void cvt_stream(const float* src, bf16* dst, size_t n8, int gw, int NGW, int lane) {
    for (size_t i = (size_t)gw * 64 + lane; i < n8; i += (size_t)NGW * 64) {
        const f32x4 a = *(const GAS f32x4*)(src + i * 8), b = *(const GAS f32x4*)(src + i * 8 + 4);
        v4u o; o.x = pk2(a.x, a.y); o.y = pk2(a.z, a.w); o.z = pk2(b.x, b.y); o.w = pk2(b.z, b.w);
        *(GAS v4u*)(dst + i * 8) = o;
    }
}
__device__ __forceinline__ void cvt_peer_table(const float* src, bf16* dst, int gw, int NGW, int lane) {
    const size_t n8 = (size_t)16384 * 2048 / 8;
    for (size_t i = (size_t)gw * 64 + lane; i < n8; i += (size_t)NGW * 64) {
        const f32x4 a = __builtin_nontemporal_load((const GAS f32x4*)(src + i * 8)), b = __builtin_nontemporal_load((const GAS f32x4*)(src + i * 8 + 4));
        v4u o; o.x = pk2(a.x, a.y); o.y = pk2(a.z, a.w); o.z = pk2(b.x, b.y); o.w = pk2(b.z, b.w);
        const size_t e = i >> 8; const int c8 = (int)(i & 255) * 8;
        *(GAS v4u*)(dst + ((size_t)(c8 >> 6) * 16384 + e) * 64 + (c8 & 63)) = o;
    }
}
__device__ __forceinline__ void cvt_peer_table_fp8(const float* src, unsigned char* dst, float* rinv, int gw, int NGW, int lane) {
    f32x4 nx[8];
    if (gw < 16384) {
#pragma unroll
        for (int j = 0; j < 8; ++j) nx[j] = __builtin_nontemporal_load((const GAS f32x4*)(src + (size_t)gw * 2048 + j * 256 + lane * 4)); }
    for (int e = gw; e < 16384; e += NGW) {
        f32x4 v[8]; float am = 0.f;
#pragma unroll
        for (int j = 0; j < 8; ++j) { v[j] = nx[j]; am = fmaxf(am, fmaxf(fmaxf(fabsf(v[j].x), fabsf(v[j].y)), fmaxf(fabsf(v[j].z), fabsf(v[j].w)))); }
        if (e + NGW < 16384) {
#pragma unroll
            for (int j = 0; j < 8; ++j) nx[j] = __builtin_nontemporal_load((const GAS f32x4*)(src + (size_t)(e + NGW) * 2048 + j * 256 + lane * 4)); }
#pragma unroll
        for (int o = 1; o < 64; o <<= 1) am = fmaxf(am, __shfl_xor(am, o));
        const float sc = (am > 0.f) ? exp2f(floorf(log2f(224.f / am))) : 1.f;
        if (lane == 0) rinv[e] = 1.f / sc;
#pragma unroll
        for (int j = 0; j < 8; ++j) { unsigned p = __builtin_amdgcn_cvt_pk_fp8_f32(v[j].x * sc, v[j].y * sc, 0u, false); p = __builtin_amdgcn_cvt_pk_fp8_f32(v[j].z * sc, v[j].w * sc, p, true);
            const int w = lane & 31, pw = ((((w >> 2) & 1) * 4 + (w & 3)) << 2) + ((w >> 4) & 1) * 2 + ((w >> 3) & 1);
            *(GAS unsigned*)(dst + ((size_t)(2 * j + (lane >> 5)) * 16384 + e) * 128 + pw * 4) = p; }
    }
}
__device__ __forceinline__ unsigned pack_i8x4(f32x4 v, float sc) { const int a = __float2int_rn(v.x * sc), b = __float2int_rn(v.y * sc), c = __float2int_rn(v.z * sc), d = __float2int_rn(v.w * sc);
    return (unsigned)(a & 0xFF) | ((unsigned)(b & 0xFF) << 8) | ((unsigned)(c & 0xFF) << 16) | ((unsigned)d << 24); }
__device__ __forceinline__ void cvt_peer_table_i8(const float* src, unsigned char* dst, float* rinv, int gw, int NGW, int lane) {
    f32x4 nx[8];
    if (gw < 16384) {
#pragma unroll
        for (int j = 0; j < 8; ++j) nx[j] = __builtin_nontemporal_load((const GAS f32x4*)(src + (size_t)gw * 2048 + j * 256 + lane * 4)); }
    for (int e = gw; e < 16384; e += NGW) {
        f32x4 v[8]; float am = 0.f;
#pragma unroll
        for (int j = 0; j < 8; ++j) { v[j] = nx[j]; am = fmaxf(am, fmaxf(fmaxf(fabsf(v[j].x), fabsf(v[j].y)), fmaxf(fabsf(v[j].z), fabsf(v[j].w)))); }
        if (e + NGW < 16384) {
#pragma unroll
            for (int j = 0; j < 8; ++j) nx[j] = __builtin_nontemporal_load((const GAS f32x4*)(src + (size_t)(e + NGW) * 2048 + j * 256 + lane * 4)); }
#pragma unroll
        for (int o = 1; o < 64; o <<= 1) am = fmaxf(am, __shfl_xor(am, o));
        const float sc = (am > 0.f) ? 127.f / am : 0.f;
        if (lane == 0) rinv[e] = am * (1.f / 127.f);
#pragma unroll
        for (int j = 0; j < 8; ++j) *(GAS unsigned*)(dst + ((size_t)(2 * j + (lane >> 5)) * 16384 + e) * 128 + (lane & 31) * 4) = pack_i8x4(v[j], sc);
    }
}
__device__ __forceinline__ const float* xrow_in(const Args& a, int r) { return r < 8192 ? a.in[0] + (size_t)r * 2048 : a.in[1] + (size_t)(r - 8192) * 2048; }

__device__ __forceinline__ void phase_prologue(const Args& a, LAS unsigned char* lds, int vcu, int G, int wave, int lane) {
    unsigned char* ws = a.ws;
    LAS float* scr = (LAS float*)(lds + wave * 16384);
    const int gw = vcu * NWAVES + wave, NGW = G * NWAVES;
    for (int it = gw; it < 32 * 192; it += NGW) p0_transpose_item(a.in[5], 2048, 6160, 6144, (bf16*)(ws + a.L.wina), scr, it, lane);
    __syncthreads();
    { LAS f32x4* wg = (LAS f32x4*)lds; const float* w = a.in[5];
      for (int i = threadIdx.x; i < 2048 * 4; i += NWAVES * 64) { const int k = i >> 2, q4 = i & 3; wg[(k >> 2) * 16 + ((((k & 3) * 4 + q4)) ^ ((k >> 2) & 15))] = *(const GAS f32x4*)(w + (size_t)k * 6160 + 6144 + q4 * 4); } }
    __syncthreads();
    const float* bg = a.in[6];
    for (int r = gw; r < NTOKF; r += NGW) {
        const float* xr = xrow_in(a, r);
        GAS unsigned long long* o8 = (GAS unsigned long long*)((bf16*)(ws + a.L.xb) + (size_t)r * 2048) + lane;
        float g[16];
#pragma unroll
        for (int q = 0; q < 16; ++q) g[q] = 0.f;
#pragma unroll 1
        for (int j = 0; j < 8; ++j) {
            const f32x4 xv = *(const GAS f32x4*)(xr + j * 256 + lane * 4);
            o8[64 * j] = (unsigned long long)pk2(xv.x, xv.y) | ((unsigned long long)pk2(xv.z, xv.w) << 32);
            const int kq = j * 64 + lane;
#pragma unroll
            for (int e = 0; e < 4; ++e) { const float x = xv[e];
#pragma unroll
                for (int q4 = 0; q4 < 4; ++q4) { const f32x4 w4 = ((const LAS f32x4*)lds)[kq * 16 + ((e * 4 + q4) ^ (kq & 15))]; g[q4 * 4 + 0] += x * w4.x; g[q4 * 4 + 1] += x * w4.y; g[q4 * 4 + 2] += x * w4.z; g[q4 * 4 + 3] += x * w4.w; } }
        }
        float mine = 0.f;
#pragma unroll
        for (int q = 0; q < 16; ++q) { const float s = wave_sum_f(g[q]); if (lane == q) mine = s; }
        if (lane < 16) { float v = mine + bg[lane]; if (lane >= 8) v = fminf(v, 0.f) - log1pf(expf(-fabsf(v))); ((float*)(ws + a.L.gates))[(size_t)r * 16 + lane] = v; }
    }
    __syncthreads();
}

__device__ __forceinline__ void side_convert(const Args& a, LAS unsigned char* lds, int gw, int NGW, int wave, int lane, int parts) {
    unsigned char* ws = a.ws;
    LAS float* scr = (LAS float*)(lds + wave * 16384);
    constexpr int I_OA = 32 * 64, I_B = 32 * 384, I_OB = 96 * 64, I_Q = 32 * 64;
    constexpr int NITEMS = I_OA + I_B + I_OB + 2 * I_Q;
    if (parts & 1) for (int it = gw; it < NITEMS; it += NGW) {
        int r = it;
        if (r < I_OA) { p0_transpose_item(a.in[8], 2048, 2048, 2048, (bf16*)(ws + a.L.wouta), scr, r, lane); continue; } r -= I_OA;
        if (r < I_B) { p0_transpose_item(a.in[9], 2048, 12288, 12288, (bf16*)(ws + a.L.winb), scr, r, lane); continue; } r -= I_B;
        if (r < I_OB) { p0_transpose_item(a.in[15], 6144, 2048, 2048, (bf16*)(ws + a.L.woutb), scr, r, lane); continue; } r -= I_OB;
        if (r < I_Q) { p0_transpose_item(a.in[20], 2048, 2048, 2048, (bf16*)(ws + a.L.wq), scr, r, lane); continue; } r -= I_Q;
        p0_transpose_item(a.in[20] + (size_t)2048 * 2048, 2048, 2048, 2048, (bf16*)(ws + a.L.wq) + (size_t)2048 * 2048, scr, r, lane);
    }
    if (parts & 2) { float* ri = (float*)(ws + a.L.rinv);
      cvt_peer_table_i8(a.in[22], ws + a.L.ptu, ri, gw, NGW, lane);
      cvt_peer_table_fp8(a.in[23], ws + a.L.ptv, ri + 16384, gw, NGW, lane);
      cvt_peer_table_i8(a.in[22] + (size_t)16384 * 2048, ws + a.L.ptu1, ri + 32768, gw, NGW, lane);
      cvt_peer_table_fp8(a.in[23] + (size_t)16384 * 2048, ws + a.L.ptv1, ri + 49152, gw, NGW, lane); }
    cvt_stream(a.in[21], (bf16*)(ws + a.L.sk), (size_t)2 * 16 * 128 * 128 / 8, gw, NGW, lane);
    { bf16* wsb = (bf16*)(ws + a.L.wsb); const float* wsf = a.in[13]; for (int i = gw * 64 + lane; i < 8 * 128 * 128; i += NGW * 64) { const int t = (i >> 7) & 127, s = i & 127; wsb[i] = (bf16)(s <= t ? f2bf(wsf[i]) : 0u); } }
    { float* vst = (float*)(ws + a.L.vst); for (int i = gw * 64 + lane; i < NTOKF * 2; i += NGW * 64) vst[i] = 0.f; }
}

__device__ __forceinline__ void phase_ln(const float* Z, const float* g, const float* b, float* Xf, bf16* Xb, unsigned char* Xq, float* sx, int vcu, int G, int wave, int lane) {
    const int gw = vcu * NWAVES + wave, NGW = G * NWAVES;
    f32x4 gv[8], bv[8];
#pragma unroll
    for (int j = 0; j < 8; ++j) { gv[j] = *(const GAS f32x4*)(g + j * 256 + lane * 4); bv[j] = *(const GAS f32x4*)(b + j * 256 + lane * 4); }
    for (int r = gw; r < NTOKF; r += NGW) {
        const float* zr = Z + (size_t)r * 2048;
        f32x4 v[8]; float s = 0.f;
#pragma unroll
        for (int j = 0; j < 8; ++j) { v[j] = *(const GAS f32x4*)(zr + j * 256 + lane * 4); s += (v[j].x + v[j].y) + (v[j].z + v[j].w); }
        const float mean = wave_sum_f(s) * (1.f / 2048.f); float s2 = 0.f;
#pragma unroll
        for (int j = 0; j < 8; ++j) { v[j] = v[j] - mean; s2 += (v[j].x * v[j].x + v[j].y * v[j].y) + (v[j].z * v[j].z + v[j].w * v[j].w); }
        const float rstd = 1.f / sqrtf(wave_sum_f(s2) * (1.f / 2048.f) + 1e-5f);
#pragma unroll
        for (int j = 0; j < 8; ++j) { v[j] = v[j] * rstd * gv[j] + bv[j]; *(GAS f32x4*)(Xf + (size_t)r * 2048 + j * 256 + lane * 4) = v[j]; }
        if (Xq) {
            float am = 0.f;
#pragma unroll
            for (int j = 0; j < 8; ++j) am = fmaxf(am, fmaxf(fmaxf(fabsf(v[j].x), fabsf(v[j].y)), fmaxf(fabsf(v[j].z), fabsf(v[j].w))));
#pragma unroll
            for (int o = 1; o < 64; o <<= 1) am = fmaxf(am, __shfl_xor(am, o));
            const float sc = (am > 0.f) ? 127.f / am : 0.f;
            if (lane == 0) sx[r] = am * (1.f / 127.f);
#pragma unroll
            for (int j = 0; j < 8; ++j) *(GAS unsigned*)(Xq + (size_t)r * 2048 + j * 256 + lane * 4) = pack_i8x4(v[j], sc);
        }
        if (Xb) { GAS unsigned long long* o8 = (GAS unsigned long long*)(Xb + (size_t)r * 2048) + lane;
#pragma unroll
            for (int j = 0; j < 8; ++j) o8[64 * j] = (unsigned long long)pk2(v[j].x, v[j].y) | ((unsigned long long)pk2(v[j].z, v[j].w) << 32); }
    }
}
typedef __bf16 bf16x2_t __attribute__((ext_vector_type(2)));
typedef int i32x4 __attribute__((ext_vector_type(4)));
__device__ __forceinline__ unsigned fkey(float f) { const unsigned u = __builtin_bit_cast(unsigned, f); return (u & 0x80000000u) ? ~u : (u | 0x80000000u); }
__device__ __forceinline__ float keyf(unsigned k) { const unsigned u = (k & 0x80000000u) ? (k & 0x7fffffffu) : ~k; return __builtin_bit_cast(float, u); }
__device__ __forceinline__ float dot2bf(unsigned a, unsigned b, float c) { return __builtin_amdgcn_fdot2_f32_bf16(__builtin_bit_cast(bf16x2_t, a), __builtin_bit_cast(bf16x2_t, b), c, false); }
__device__ __forceinline__ float bflo(unsigned w) { return __builtin_bit_cast(float, w << 16); }
__device__ __forceinline__ float bfhi(unsigned w) { return __builtin_bit_cast(float, w & 0xffff0000u); }
__device__ __forceinline__ float gelu_tanh_g(float x) { const float u = x + 0.044715f * x * x * x; const float e = __builtin_amdgcn_exp2f(u * -2.302208198f); return x * __builtin_amdgcn_rcpf(1.0f + e); }
#define INS16(v, x) do { unsigned nw_ = (x); _Pragma("unroll") for (int k_ = 0; k_ < 16; ++k_) { const unsigned hi_ = max(v[k_], nw_); nw_ = min(v[k_], nw_); v[k_] = hi_; } } while (0)


#define CE_DESC(a, b) do { const unsigned hi_ = max(a, b), lo_ = min(a, b); a = hi_; b = lo_; } while (0)
__device__ __forceinline__ void sort16_desc(unsigned (&v)[16]) {
#pragma unroll
    for (int k = 2; k <= 16; k <<= 1)
#pragma unroll
        for (int j = k >> 1; j > 0; j >>= 1)
#pragma unroll
            for (int i = 0; i < 16; ++i) { const int l = i ^ j; if (l > i) { if ((i & k) == 0) CE_DESC(v[i], v[l]); else CE_DESC(v[l], v[i]); } }
}
__device__ __forceinline__ void merge_top16(unsigned (&a)[16], const unsigned (&b)[16]) {
#pragma unroll
    for (int i = 0; i < 16; ++i) a[i] = max(a[i], b[15 - i]);
#pragma unroll
    for (int sd = 8; sd >= 1; sd >>= 1)
#pragma unroll
        for (int i = 0; i < 16; ++i) if ((i & sd) == 0) CE_DESC(a[i], a[i + sd]);
}
static __device__ const unsigned char CAND_TAB[52] = {
    0, 1, 2, 3, 4, 5, 6, 7, 8, 9, 10, 11, 12, 13, 14, 15,
    16, 17, 18, 19, 20, 21, 22, 23,
    32, 33, 34, 35, 36,
    48, 49, 50, 51,
    64, 65, 66,
    80, 81,
    96, 97,
    112, 113,
    128, 144, 160, 176, 192, 208, 224, 240,
    255, 255 };

template <int MODE>
__device__ __forceinline__ void phase_topk(const bf16* QP, const bf16* SK, int* IDX, float* GT, float* AACC, float* SU, const float* rinvU, const float* rinvV, LAS unsigned char* lds, int vcu, int G, int wave, int lane) {
    LAS float* S = (LAS float*)lds;
    LAS unsigned char* NL = lds + 2 * 64 * 132 * 4;
    LAS float* FL = (LAS float*)(NL + 512 * 32);
    const int tid = wave * 64 + lane;
    for (int u = vcu; u < 136 * 8; u += G) {
        const int tt = u >> 3, h = u & 7;
        if (MODE != 1) {
            const int p = wave >> 2, rt = wave & 3, fr = lane & 15, fq = lane >> 4;
            const bf16* qrow = QP + (size_t)(tt * 64 + rt * 16 + fr) * 2048 + h * 256 + p * 128 + 8 * fq;
            bf16x8 af[4];
#pragma unroll
            for (int ks = 0; ks < 4; ++ks) af[ks] = *(const GAS bf16x8*)(qrow + ks * 32);
            const bf16* kbase = SK + (size_t)((h * 2 + p) * 128 + fr) * 128 + 8 * fq;
#pragma unroll 4
            for (int nt = 0; nt < 8; ++nt) {
                bf16x8 bfr[4];
#pragma unroll
                for (int ks = 0; ks < 4; ++ks) bfr[ks] = *(const GAS bf16x8*)(kbase + (size_t)nt * 16 * 128 + ks * 32);
                f32x4 acc = (f32x4){0.f, 0.f, 0.f, 0.f};
#pragma unroll
                for (int ks = 0; ks < 4; ++ks) acc = __builtin_amdgcn_mfma_f32_16x16x32_bf16(af[ks], bfr[ks], acc, 0, 0, 0);
                LAS float* sp = S + (size_t)(p * 64 + rt * 16 + fq * 4) * 132 + nt * 16 + fr;
                sp[0] = acc[0]; sp[132] = acc[1]; sp[264] = acc[2]; sp[396] = acc[3];
            }
        }
        __syncthreads();
        if (MODE != 2) {
            const int tl = lane >> 3, p = (lane >> 2) & 1, qr = lane & 3, t = wave * 8 + tl;
            unsigned own[16], oth_[16];
            const LAS f32x4* sp = (const LAS f32x4*)(S + (size_t)(p * 64 + t) * 132 + qr * 32);
#pragma unroll
            for (int c = 0; c < 4; ++c) { const f32x4 v = sp[c], w = sp[4 + c];
#pragma unroll
                for (int e = 0; e < 4; ++e) { own[c * 4 + e] = (fkey(v[e]) & ~127u) | (unsigned)(127 - (qr * 32 + c * 4 + e)); oth_[c * 4 + e] = (fkey(w[e]) & ~127u) | (unsigned)(127 - (qr * 32 + 16 + c * 4 + e)); } }
            sort16_desc(own); sort16_desc(oth_); merge_top16(own, oth_);
#pragma unroll
            for (int st = 1; st <= 2; st <<= 1) {
#pragma unroll
                for (int i = 0; i < 16; ++i) oth_[i] = (unsigned)__shfl_xor((int)own[i], st);
                merge_top16(own, oth_);
            }
            LAS unsigned char* nl = NL + tid * 32;
            LAS float* fl = FL + (tid >> 2) * 32;
#pragma unroll
            for (int i = 0; i < 16; ++i) { const unsigned oth = (unsigned)__shfl_xor((int)own[i], 4); const unsigned a0 = p ? oth : own[i], a1 = p ? own[i] : oth;
                if (qr == 0) { fl[i] = keyf(a0 & ~127u); fl[16 + i] = keyf(a1 & ~127u); }
                nl[i] = (unsigned char)(127u - (a0 & 127u)); nl[16 + i] = (unsigned char)(127u - (a1 & 127u)); }
            unsigned tv[16];
#pragma unroll
            for (int k = 0; k < 16; ++k) tv[k] = 0u;
#pragma unroll
            for (int m = 0; m < 13; ++m) { const unsigned c = CAND_TAB[m * 4 + qr]; unsigned key = 0u;
                if (c != 255u) { const float s = fl[c >> 4] + fl[16 + (c & 15u)]; key = (fkey(s) & ~255u) | (255u - c); }
                INS16(tv, key); }
#pragma unroll
            for (int st = 1; st <= 2; st <<= 1) {
#pragma unroll
                for (int i = 0; i < 16; ++i) oth_[i] = (unsigned)__shfl_xor((int)tv[i], st);
                merge_top16(tv, oth_);
            }
            float ev[16]; int ex[16]; float sum = 0.f; const float mx = keyf(tv[0] & ~255u);
#pragma unroll
            for (int k = 0; k < 16; ++k) { const unsigned c = 255u - (tv[k] & 255u); const int i = (int)(c >> 4), j = (int)(c & 15u);
                ex[k] = (int)nl[i] * 128 + (int)nl[16 + j]; ev[k] = __expf(keyf(tv[k] & ~255u) - mx); sum += ev[k]; }
            const float inv = 1.f / sum;
            if (MODE == 3) { if (ex[0] == 0x7fffffff) IDX[0] = (int)inv; }
            else if (p == 0 && qr == 0) {
                const size_t o = (size_t)(tt * 64 + t) * 128 + h * 16;
#pragma unroll
                for (int k4 = 0; k4 < 4; ++k4) { *(GAS i32x4*)(IDX + o + k4 * 4) = (i32x4){ex[k4 * 4], ex[k4 * 4 + 1], ex[k4 * 4 + 2], ex[k4 * 4 + 3]};
                    *(GAS f32x4*)(GT + o + k4 * 4) = (f32x4){ev[k4 * 4] * inv, ev[k4 * 4 + 1] * inv, ev[k4 * 4 + 2] * inv, ev[k4 * 4 + 3] * inv};
                    *(GAS f32x4*)(AACC + o + k4 * 4) = (f32x4){0.f, 0.f, 0.f, 0.f}; }
            }
        }
        __syncthreads();
    }
}

__device__ __forceinline__ void phase_upass(const bf16* U, const bf16* XBt, const int* IDX, const float* GT, float* WW, int vcu, int G, int wave, int lane) {
    const int gw = vcu * NWAVES + wave, NGW = G * NWAVES;
    for (int t = gw; t < NTOKF; t += NGW) {
        v4u xq[4];
#pragma unroll
        for (int j = 0; j < 4; ++j) xq[j] = *(const GAS v4u*)(XBt + (size_t)t * 2048 + j * 512 + lane * 8);
        const int ilo = IDX[(size_t)t * 128 + lane], ihi = IDX[(size_t)t * 128 + 64 + lane];
        float wlo = 0.f, whi = 0.f;
#pragma unroll 1
        for (int e0 = 0; e0 < 128; e0 += 4) {
            v4u uq[4][4];
#pragma unroll
            for (int ee = 0; ee < 4; ++ee) { const int e = e0 + ee; const int id = __builtin_amdgcn_readlane(e0 < 64 ? ilo : ihi, e & 63);
                const bf16* ur = U + (size_t)id * 2048 + lane * 8;
#pragma unroll
                for (int j = 0; j < 4; ++j) uq[ee][j] = *(const GAS v4u*)(ur + j * 512); }
#pragma unroll
            for (int ee = 0; ee < 4; ++ee) { float acc = 0.f;
#pragma unroll
                for (int j = 0; j < 4; ++j) { acc = dot2bf(uq[ee][j].x, xq[j].x, acc); acc = dot2bf(uq[ee][j].y, xq[j].y, acc); acc = dot2bf(uq[ee][j].z, xq[j].z, acc); acc = dot2bf(uq[ee][j].w, xq[j].w, acc); }
                acc = wave_sum_f(acc);
                const int e = e0 + ee;
                if (lane == (e & 63)) { if (e0 < 64) wlo = acc; else whi = acc; } }
        }
        WW[(size_t)t * 128 + lane] = gelu_tanh_g(wlo) * GT[(size_t)t * 128 + lane];
        WW[(size_t)t * 128 + 64 + lane] = gelu_tanh_g(whi) * GT[(size_t)t * 128 + 64 + lane];
    }
}

__device__ __forceinline__ void phase_vpass(const bf16* V, const float* Xf, const int* IDX, const float* WW, float* Z, float alpha, int vcu, int G, int wave, int lane) {
    const int gw = vcu * NWAVES + wave, NGW = G * NWAVES;
    for (int t = gw; t < NTOKF; t += NGW) {
        f32x4 acc[4][2];
#pragma unroll
        for (int j = 0; j < 4; ++j)
#pragma unroll
            for (int q = 0; q < 2; ++q) acc[j][q] = *(const GAS f32x4*)(Xf + (size_t)t * 2048 + j * 512 + lane * 8 + q * 4) * alpha;
        const int ilo = IDX[(size_t)t * 128 + lane], ihi = IDX[(size_t)t * 128 + 64 + lane];
        const float wlo = WW[(size_t)t * 128 + lane], whi = WW[(size_t)t * 128 + 64 + lane];
#pragma unroll 1
        for (int e0 = 0; e0 < 128; e0 += 4) {
            v4u vq[4][4]; float wv[4];
#pragma unroll
            for (int ee = 0; ee < 4; ++ee) { const int e = e0 + ee; const int id = __builtin_amdgcn_readlane(e0 < 64 ? ilo : ihi, e & 63);
                wv[ee] = __builtin_bit_cast(float, __builtin_amdgcn_readlane(__builtin_bit_cast(int, e0 < 64 ? wlo : whi), e & 63));
                const bf16* vr = V + (size_t)id * 2048 + lane * 8;
#pragma unroll
                for (int j = 0; j < 4; ++j) vq[ee][j] = *(const GAS v4u*)(vr + j * 512); }
#pragma unroll
            for (int ee = 0; ee < 4; ++ee)
#pragma unroll
                for (int j = 0; j < 4; ++j) { const v4u q = vq[ee][j]; const float w = wv[ee];
                    acc[j][0].x += w * bflo(q.x); acc[j][0].y += w * bfhi(q.x); acc[j][0].z += w * bflo(q.y); acc[j][0].w += w * bfhi(q.y);
                    acc[j][1].x += w * bflo(q.z); acc[j][1].y += w * bfhi(q.z); acc[j][1].z += w * bflo(q.w); acc[j][1].w += w * bfhi(q.w); }
        }
#pragma unroll
        for (int j = 0; j < 4; ++j)
#pragma unroll
            for (int q = 0; q < 2; ++q) *(GAS f32x4*)(Z + (size_t)t * 2048 + j * 512 + lane * 8 + q * 4) = acc[j][q];
    }
}

struct XTopo { int xi, nx, wq, nwq; };
__device__ __forceinline__ XTopo xcd_topology(unsigned* bar, unsigned x, unsigned rank, int wave) {
    XTopo t; int xi = 0, nx = 0, nloc = 1;
#pragma unroll
    for (unsigned j = 0; j < 16; ++j) { const unsigned c = xb_ld(&bar[XB_XCNT(j)]); if (c > 0u) { if (j < x) ++xi; ++nx; } if (j == x) nloc = (int)c; }
    if (nloc < 1) nloc = 1; if (nx < 1) nx = 1;
    t.xi = __builtin_amdgcn_readfirstlane(xi); t.nx = __builtin_amdgcn_readfirstlane(nx); t.wq = __builtin_amdgcn_readfirstlane((int)rank * NWAVES + wave); t.nwq = __builtin_amdgcn_readfirstlane(nloc * NWAVES); return t;
}
typedef float f32x2 __attribute__((ext_vector_type(2)));
template <int MODE>
__device__ __forceinline__ void upass_reduce_add(float (&acc)[16], float* ap, int lane) {
    const bool b2 = (lane & 4) != 0, b1 = (lane & 2) != 0, b0 = (lane & 1) != 0;
    float r8[8], r4[4], r2[2];
#pragma unroll
    for (int j = 0; j < 8; ++j) { const float keep = b2 ? acc[8 + j] : acc[j], send = b2 ? acc[j] : acc[8 + j]; r8[j] = keep + __shfl_xor(send, 4); }
#pragma unroll
    for (int j = 0; j < 4; ++j) { const float keep = b1 ? r8[4 + j] : r8[j], send = b1 ? r8[j] : r8[4 + j]; r4[j] = keep + __shfl_xor(send, 2); }
#pragma unroll
    for (int j = 0; j < 2; ++j) { const float keep = b0 ? r4[2 + j] : r4[j], send = b0 ? r4[j] : r4[2 + j]; r2[j] = keep + __shfl_xor(send, 1); }
    if (MODE == 1) { ap[0] = r2[0]; ap[64] = r2[1]; } else { unsafeAtomicAdd(ap, r2[0]); unsafeAtomicAdd(ap + 64, r2[1]); }
}
__device__ __forceinline__ float dot16_i8(const v4u q, const v4u x) {
    int a = __builtin_amdgcn_sdot4((int)q.x, (int)x.x, 0, false); a = __builtin_amdgcn_sdot4((int)q.y, (int)x.y, a, false);
    a = __builtin_amdgcn_sdot4((int)q.z, (int)x.z, a, false); a = __builtin_amdgcn_sdot4((int)q.w, (int)x.w, a, false);
    return (float)a;
}
__device__ __forceinline__ void unpack16bf(const v4u a, const v4u b, float (&xf)[16]) {
    xf[0] = bflo(a.x); xf[1] = bfhi(a.x); xf[2] = bflo(a.y); xf[3] = bfhi(a.y); xf[4] = bflo(a.z); xf[5] = bfhi(a.z); xf[6] = bflo(a.w); xf[7] = bfhi(a.w);
    xf[8] = bflo(b.x); xf[9] = bfhi(b.x); xf[10] = bflo(b.y); xf[11] = bfhi(b.y); xf[12] = bflo(b.z); xf[13] = bfhi(b.z); xf[14] = bflo(b.w); xf[15] = bfhi(b.w);
}
template <int MODE>
__device__ __forceinline__ void phase_upass_sl(const unsigned char* U, const unsigned char* XQ, const float* SX, const int* IDX, float* AACC, float* GT, float* SU, const float* rinvU, const float* rinvV, const XTopo tp, int lane0) {
#define UP_IDX(dst, tt) do { const int t_ = min((tt), NTOKF - 1); const int* ip_ = IDX + (size_t)t_ * 128 + (lane >> 3) * 8; dst[0] = *(const GAS i32x4*)ip_; dst[1] = *(const GAS i32x4*)(ip_ + 4); dst[2] = *(const GAS i32x4*)(ip_ + 64); dst[3] = *(const GAS i32x4*)(ip_ + 68); } while (0)
#define UP_SEL(id, s_) id[2 * ((s_) & 1) + ((s_) >> 3)][((s_) >> 1) & 3]
#define UP_GATHER8(dst, id, h) do { _Pragma("unroll") for (int j_ = 0; j_ < 8; ++j_) { if (MODE == 2) dst[j_] = (v4u){(unsigned)UP_SEL(id, 8 * (h) + j_), 0x38383838u, 0x38383838u, 0x38383838u}; else dst[j_] = __builtin_bit_cast(v4u, __builtin_amdgcn_raw_buffer_load_b128(urs, (UP_SEL(id, 8 * (h) + j_) << 7) + i * 16, 0, 0)); } } while (0)
#define UP_X(xa, xb, tt) do { const int t_ = min((tt), NTOKF - 1); xa = *(const GAS v4u*)(XQ + (size_t)t_ * 2048 + sl * 128 + (lane & 7) * 16); xb.x = __builtin_bit_cast(unsigned, SX[t_]); } while (0)
    for (int sl = tp.xi; sl < 16; sl += tp.nx) {
        int lane = lane0; asm volatile("" : "+v"(lane));
        const int g = lane >> 3, i = lane & 7;
        const __amdgpu_buffer_rsrc_t urs = __builtin_amdgcn_make_buffer_rsrc((void*)(U + (size_t)sl * 16384 * 128), 0, 16384 * 128, 0x00020000);
        i32x4 idn[4]; v4u qa[8], qb[8], xa, xb;
        UP_IDX(idn, tp.wq); UP_GATHER8(qa, idn, 0); UP_GATHER8(qb, idn, 1); UP_X(xa, xb, tp.wq); UP_IDX(idn, tp.wq + tp.nwq);
#pragma unroll 1
        for (int t = tp.wq; t < NTOKF; t += tp.nwq) {
            float acc[16]; const v4u xq_ = xa; const float sx_ = __builtin_bit_cast(float, xb.x);
#pragma unroll
            for (int j = 0; j < 8; ++j) acc[j] = dot16_i8(qa[j], xq_) * sx_;
            UP_GATHER8(qa, idn, 0);
#pragma unroll
            for (int j = 0; j < 8; ++j) acc[8 + j] = dot16_i8(qb[j], xq_) * sx_;
            UP_GATHER8(qb, idn, 1);
            UP_X(xa, xb, t + tp.nwq); UP_IDX(idn, t + 2 * tp.nwq);
            upass_reduce_add<MODE>(acc, AACC + (size_t)t * 128 + lane, lane);
            if (MODE == 0 && sl == tp.xi && ((t >> 8) % tp.nx) == tp.xi) {
                const size_t o_ = (size_t)t * 128 + lane; const int e0_ = IDX[o_], e1_ = IDX[o_ + 64];
                SU[o_] = rinvU[e0_]; SU[o_ + 64] = rinvU[e1_]; GT[o_] *= rinvV[e0_]; GT[o_ + 64] *= rinvV[e1_]; }
        }
    }
#undef UP_IDX
#undef UP_SEL
#undef UP_GATHER8
#undef UP_X
}
__device__ __forceinline__ void vpass_finish(const v4u (&vq)[16], const LAS float* wl, const float* Xf, float* Z, float alpha, int t, int sl, int lane) {
    const int g = lane >> 3, i = lane & 7;
    f32x4 w4[4];
#pragma unroll
    for (int q = 0; q < 4; ++q) w4[q] = *(const LAS f32x4*)(wl + g * 16 + q * 4);
    float acc[16];
#pragma unroll
    for (int c = 0; c < 16; ++c) acc[c] = 0.f;
#pragma unroll
    for (int j = 0; j < 16; ++j) { const float w = w4[j >> 2][j & 3]; const unsigned wd[4] = {vq[j].x, vq[j].y, vq[j].z, vq[j].w};
#pragma unroll
        for (int d = 0; d < 4; ++d) { const f32x2 lo = __builtin_amdgcn_cvt_pk_f32_fp8(wd[d], false), hi = __builtin_amdgcn_cvt_pk_f32_fp8(wd[d], true);
            acc[d * 4 + 0] += w * lo.x; acc[d * 4 + 1] += w * lo.y; acc[d * 4 + 2] += w * hi.x; acc[d * 4 + 3] += w * hi.y; } }
    const bool b3 = (lane & 8) != 0, b4 = (lane & 16) != 0, b5 = (lane & 32) != 0;
    float r8[8], r4[4], r2[2];
#pragma unroll
    for (int c = 0; c < 8; ++c) { const float keep = b3 ? acc[8 + c] : acc[c], send = b3 ? acc[c] : acc[8 + c]; r8[c] = keep + __shfl_xor(send, 8); }
#pragma unroll
    for (int c = 0; c < 4; ++c) { const float keep = b4 ? r8[4 + c] : r8[c], send = b4 ? r8[c] : r8[4 + c]; r4[c] = keep + __shfl_xor(send, 16); }
#pragma unroll
    for (int c = 0; c < 2; ++c) { const float keep = b5 ? r4[2 + c] : r4[c], send = b5 ? r4[c] : r4[2 + c]; r2[c] = keep + __shfl_xor(send, 32); }
    const int col = sl * 128 + i * 16 + (b3 ? 8 : 0) + (b4 ? 4 : 0) + (b5 ? 2 : 0);
    const f32x2 xr = *(const GAS f32x2*)(Xf + (size_t)t * 2048 + col);
    *(GAS f32x2*)(Z + (size_t)t * 2048 + col) = (f32x2){alpha * xr.x + r2[0], alpha * xr.y + r2[1]};
}
__device__ __forceinline__ int wave_max_bits(int x) {
    x = max(x, __builtin_amdgcn_update_dpp(x, x, 0x111, 0xf, 0xf, false));
    x = max(x, __builtin_amdgcn_update_dpp(x, x, 0x112, 0xf, 0xf, false));
    x = max(x, __builtin_amdgcn_update_dpp(x, x, 0x114, 0xf, 0xf, false));
    x = max(x, __builtin_amdgcn_update_dpp(x, x, 0x118, 0xf, 0xf, false));
    x = max(x, __builtin_amdgcn_update_dpp(x, x, 0x142, 0xa, 0xf, false));
    x = max(x, __builtin_amdgcn_update_dpp(x, x, 0x143, 0xc, 0xf, false));
    return __builtin_amdgcn_readlane(x, 63);
}
template <int MODE>
__device__ __forceinline__ void vpass_step(const v4u (&cur)[16], v4u (&nxt)[16], const i32x4 (&idin)[4], i32x4 (&idout)[4], const float (&scc)[6], float (&scn)[6], const f32x4 xr, f32x4& xrn, const __amdgpu_buffer_rsrc_t vrs,
                                           const float* Xf, const int* IDX, const float* AACC, const float* SU, const float* GT, float* Z, float alpha, LAS float* wl, int t, int tn, int tnn, int sl, int lane0, bool live = true) {
    int lane = lane0; asm volatile("" : "+v"(lane));
    const int g = lane >> 3, i = lane & 7;
#pragma unroll
    for (int q = 0; q < 4; ++q) idout[q] = *(const GAS i32x4*)(IDX + (size_t)tnn * 128 + g * 16 + q * 4);
    { const size_t o0 = (size_t)tn * 128 + lane; scn[0] = AACC[o0]; scn[1] = AACC[o0 + 64]; scn[2] = SU[o0]; scn[3] = SU[o0 + 64]; scn[4] = GT[o0]; scn[5] = GT[o0 + 64]; }
    const bool hv = (lane & 32) != 0, valid = (((lane >> 5) ^ (lane >> 3)) & 1) == 0;
    const int col = sl * 128 + (hv ? 64 : 0) + ((lane >> 4) & 1) * 32 + (i >> 2) * 16 + (i & 3) * 4;
    if (MODE != 3) xrn = *(const GAS f32x4*)(Xf + (size_t)tn * 2048 + col);
    __builtin_amdgcn_sched_barrier(0);
#pragma unroll
    for (int j = 0; j < 16; ++j) { if (MODE == 1) nxt[j] = (v4u){(unsigned)idin[j >> 2][j & 3], 0x38383838u, 0x38383838u, 0x38383838u}; else nxt[j] = __builtin_bit_cast(v4u, __builtin_amdgcn_raw_buffer_load_b128(vrs, (idin[j >> 2][j & 3] << 7) + i * 16, 0, 0)); }
    __builtin_amdgcn_sched_barrier(0);
    const float w0 = gelu_tanh_g(scc[0] * scc[2]) * scc[4], w1 = gelu_tanh_g(scc[1] * scc[3]) * scc[5];
    const int e8 = max(wave_max_bits(__builtin_bit_cast(int, fmaxf(fabsf(w0), fabsf(w1)))) >> 23, 8);
    const float S = __builtin_bit_cast(float, (261 - e8) << 23), invS = __builtin_bit_cast(float, (e8 - 7) << 23);
    wl[lane] = w0 * S; wl[64 + lane] = w1 * S;
    if (MODE == 2) { unsigned s_ = 0u;
#pragma unroll
        for (int j = 0; j < 16; ++j) s_ += cur[j].x ^ cur[j].y ^ cur[j].z ^ cur[j].w;
        if (s_ == 0x12345u) Z[(size_t)t * 2048 + sl * 128 + lane] = 1.f; }
    else {
        f32x4 w4[4];
#pragma unroll
        for (int q = 0; q < 4; ++q) w4[q] = *(const LAS f32x4*)(wl + g * 16 + q * 4);
        const int p8 = (lane & 3) * 8;
        const unsigned selp = 0x0c0c0c0cu & ~(0xffu << p8);
        const unsigned selLo = (lane & 4) ? 0x0c0c0c0cu : selp, selHi = (lane & 4) ? selp : 0x0c0c0c0cu;
        f32x4 D1 = {0.f, 0.f, 0.f, 0.f}, D2 = {0.f, 0.f, 0.f, 0.f};
#pragma unroll
        for (int j = 0; j < 16; ++j) {
            const unsigned tb = (unsigned)__builtin_amdgcn_cvt_pk_fp8_f32(w4[j >> 2][j & 3], 0.f, 0, false);
            const unsigned alo = __builtin_amdgcn_perm(0u, tb, selLo), ahi = __builtin_amdgcn_perm(0u, tb, selHi);
            const long A = (long)(((unsigned long)ahi << 32) | (unsigned long)alo);
            const long B1 = (long)(((unsigned long)cur[j].y << 32) | (unsigned long)cur[j].x), B2 = (long)(((unsigned long)cur[j].w << 32) | (unsigned long)cur[j].z);
            D1 = __builtin_amdgcn_mfma_f32_16x16x32_fp8_fp8(A, B1, D1, 0, 0, 0);
            D2 = __builtin_amdgcn_mfma_f32_16x16x32_fp8_fp8(A, B2, D2, 0, 0, 0);
        }
        f32x4 o;
#pragma unroll
        for (int r = 0; r < 4; ++r) { const float snd = hv ? D1[r] : D2[r], own = hv ? D2[r] : D1[r]; o[r] = alpha * xr[r] + (own + __shfl_xor(snd, 40)) * invS; }
        if (MODE == 3 || MODE == 4) { if (o[0] + o[1] + o[2] + o[3] == 1.2345f) *(GAS f32x4*)(Z + (size_t)t * 2048 + col) = o; } else
        if (MODE == 6) { if (valid && live) *(GAS f32x4*)(Z + (size_t)(t & 127) * 2048 + col) = o; } else
        if (valid && live) { float* zp = Z + (size_t)t * 2048 + col; asm volatile("global_store_dwordx4 %0, %1, off sc0 sc1" :: "v"(zp), "v"(o) : "memory"); }
    }
}
template <int MODE>
__device__ __forceinline__ void phase_vpass_sl(const unsigned char* V, const float* Xf, const int* IDX, const float* AACC, const float* SU, const float* GT, float* Z, float alpha, const XTopo tp, LAS unsigned char* lds, int wave, int lane_in) {
    const int lane0 = lane_in;
    LAS float* wl = (LAS float*)lds + wave * 128;
    for (int sl = tp.xi; sl < 16; sl += tp.nx) {
        const __amdgpu_buffer_rsrc_t vrs = __builtin_amdgcn_make_buffer_rsrc((void*)(V + (size_t)sl * 16384 * 128), 0, 16384 * 128, 0x00020000);
        v4u vqA[16], vqB[16]; i32x4 idA[4], idB[4]; float scA[6], scB[6]; f32x4 xrA = {0.f, 0.f, 0.f, 0.f}, xrB = {0.f, 0.f, 0.f, 0.f};
        {   int lane = lane0; asm volatile("" : "+v"(lane));
            const int g = lane >> 3, i = lane & 7, t0 = tp.wq, t1 = min(tp.wq + tp.nwq, NTOKF - 1);
#pragma unroll
            for (int q = 0; q < 4; ++q) { idA[q] = *(const GAS i32x4*)(IDX + (size_t)t0 * 128 + g * 16 + q * 4); idB[q] = *(const GAS i32x4*)(IDX + (size_t)t1 * 128 + g * 16 + q * 4); }
            const size_t o0 = (size_t)t0 * 128 + lane; scA[0] = AACC[o0]; scA[1] = AACC[o0 + 64]; scA[2] = SU[o0]; scA[3] = SU[o0 + 64]; scA[4] = GT[o0]; scA[5] = GT[o0 + 64];
            if (MODE != 3) xrA = *(const GAS f32x4*)(Xf + (size_t)t0 * 2048 + sl * 128 + ((lane & 32) ? 64 : 0) + ((lane >> 4) & 1) * 32 + (i >> 2) * 16 + (i & 3) * 4);
            __builtin_amdgcn_sched_barrier(0);
#pragma unroll
            for (int j = 0; j < 16; ++j) { if (MODE == 1) vqA[j] = (v4u){(unsigned)idA[j >> 2][j & 3], 0x38383838u, 0x38383838u, 0x38383838u}; else vqA[j] = __builtin_bit_cast(v4u, __builtin_amdgcn_raw_buffer_load_b128(vrs, (idA[j >> 2][j & 3] << 7) + i * 16, 0, 0)); }
        }
#pragma unroll 1
        for (int t = tp.wq; t < NTOKF; t += 2 * tp.nwq) {
            const int t1 = min(t + tp.nwq, NTOKF - 1), t2 = min(t + 2 * tp.nwq, NTOKF - 1), t3 = min(t + 3 * tp.nwq, NTOKF - 1);
            vpass_step<MODE>(vqA, vqB, idB, idA, scA, scB, xrA, xrB, vrs, Xf, IDX, AACC, SU, GT, Z, alpha, wl, t, t1, t2, sl, lane0);
            vpass_step<MODE>(vqB, vqA, idA, idB, scB, scA, xrB, xrA, vrs, Xf, IDX, AACC, SU, GT, Z, alpha, wl, t1, t2, t3, sl, lane0, t + tp.nwq < NTOKF);
        }
    }
}
typedef short s16x4 __attribute__((ext_vector_type(4)));
typedef unsigned u32x2 __attribute__((ext_vector_type(2)));
template <int MODE>
__device__ __forceinline__ void phase_spatial(const bf16* UB, const bf16* VB, const float* VST, const float* lng, const float* lnb, const bf16* WSB, const float* wsf, const float* bs,
                                              bf16* UM, float* vs_out, LAS unsigned char* lds, int vcu, int G, int wave, int lane) {
    constexpr int PITCH = 136;
    LAS bf16* T = (LAS bf16*)lds;
    LAS bf16* WS = (LAS bf16*)(lds + 128 * PITCH * 2);
    const int tid = wave * 64 + lane;
    const int nbg = G >> 3, g = (nbg > 0) ? vcu / nbg : 0, jb = (nbg > 0) ? vcu % nbg : 0;
    if (MODE != 1 && nbg > 0 && g < 8) {
        for (int i = tid; i < 128 * 16; i += 512) { const int t = i >> 4, ch = i & 15; *(LAS v4u*)(WS + t * 128 + ((ch ^ (t & 15)) << 3)) = *(const GAS v4u*)(WSB + (size_t)(g * 128 + t) * 128 + ch * 8); }
        const int s_ = tid >> 2, cq_ = (tid & 3) * 32;
        v4u pvq[4]; float ps1 = 1.f, ps2 = 2.f;
        if (MODE == 2) pvq[0] = pvq[1] = pvq[2] = pvq[3] = (v4u){0x3f803f80u, 0x3f803f80u, 0x3f803f80u, 0x3f803f80u};
        else if (jb < 384) { const int ck = jb / 6, cb = g * 6 + jb % 6; const size_t r = (size_t)ck * 128 + s_;
            ps1 = VST[r * 2]; ps2 = VST[r * 2 + 1];
#pragma unroll
            for (int i = 0; i < 4; ++i) pvq[i] = *(const GAS v4u*)(VB + r * 6144 + cb * 128 + cq_ + i * 8); }
        for (int u = jb; u < 384; u += nbg) {
            const int ck = u / 6, cb = g * 6 + u % 6;
            const size_t row0 = (size_t)ck * 128; const int col0 = cb * 128;
            u32x2 uq[8]; float bsv[8];
            { const int fr = lane & 15, fq = lane >> 4, c0 = 16 * wave;
#pragma unroll
              for (int jt = 0; jt < 8; ++jt) { const int t = jt * 16 + fr; if (MODE == 3) uq[jt] = (u32x2){0x3f803f80u, 0x3f803f80u}; else uq[jt] = *(const GAS u32x2*)(UB + (row0 + t) * 6144 + col0 + c0 + 4 * fq); bsv[jt] = bs[g * 128 + t]; } }
            {
                const float mu = ps1 * (1.f / 6144.f); const float rstd = rsqrtf(ps2 * (1.f / 6144.f) - mu * mu + 1e-5f);
#pragma unroll
                for (int i = 0; i < 4; ++i) { const v4u q = pvq[i];
                    const float* gp = lng + col0 + cq_ + i * 8; const float* bp = lnb + col0 + cq_ + i * 8;
                    const f32x4 g0 = *(const GAS f32x4*)gp, g1 = *(const GAS f32x4*)(gp + 4), b0 = *(const GAS f32x4*)bp, b1 = *(const GAS f32x4*)(bp + 4);
                    v4u o;
                    o.x = pk2((bflo(q.x) - mu) * rstd * g0.x + b0.x, (bfhi(q.x) - mu) * rstd * g0.y + b0.y);
                    o.y = pk2((bflo(q.y) - mu) * rstd * g0.z + b0.z, (bfhi(q.y) - mu) * rstd * g0.w + b0.w);
                    o.z = pk2((bflo(q.z) - mu) * rstd * g1.x + b1.x, (bfhi(q.z) - mu) * rstd * g1.y + b1.y);
                    o.w = pk2((bflo(q.w) - mu) * rstd * g1.z + b1.z, (bfhi(q.w) - mu) * rstd * g1.w + b1.w);
                    *(LAS v4u*)(T + s_ * PITCH + cq_ + i * 8) = o; }
            }
            __syncthreads();
            {
                const int fr = lane & 15, fq = lane >> 4, qq = fr >> 2, pp = fr & 3, c0 = 16 * wave;
                if (MODE != 2 && u + nbg < 384) { const int un = u + nbg, ckn = un / 6, cbn = g * 6 + un % 6; const size_t r = (size_t)ckn * 128 + s_;
                    ps1 = VST[r * 2]; ps2 = VST[r * 2 + 1];
#pragma unroll
                    for (int i = 0; i < 4; ++i) pvq[i] = *(const GAS v4u*)(VB + r * 6144 + cbn * 128 + cq_ + i * 8); }
                bf16x8 af[4];
#pragma unroll
                for (int ks = 0; ks < 4; ++ks) {
                    const s16x4 r0 = __builtin_amdgcn_ds_read_tr16_b64_v4i16((LAS s16x4*)(T + (32 * ks + 8 * fq + qq) * PITCH + c0 + 4 * pp));
                    const s16x4 r1 = __builtin_amdgcn_ds_read_tr16_b64_v4i16((LAS s16x4*)(T + (32 * ks + 8 * fq + 4 + qq) * PITCH + c0 + 4 * pp));
                    af[ks] = (bf16x8){r0.x, r0.y, r0.z, r0.w, r1.x, r1.y, r1.z, r1.w};
                }
                f32x4 acc[8];
#pragma unroll
                for (int jt = 0; jt < 8; ++jt) {
                    acc[jt] = (f32x4){0.f, 0.f, 0.f, 0.f};
#pragma unroll
                    for (int ks = 0; ks < 4; ++ks) if (ks <= (jt >> 1)) { const bf16x8 bfr = *(const LAS bf16x8*)(WS + (jt * 16 + fr) * 128 + (((ks * 4 + fq) ^ fr) << 3)); acc[jt] = __builtin_amdgcn_mfma_f32_16x16x32_bf16(af[ks], bfr, acc[jt], 0, 0, 0); }
                }
#pragma unroll
                for (int jt = 0; jt < 8; ++jt) {
                    const int t = jt * 16 + fr; const size_t off = (row0 + t) * 6144 + col0 + c0 + 4 * fq;
                    u32x2 o; o.x = pk2(bflo(uq[jt].x) * (acc[jt][0] + bsv[jt]), bfhi(uq[jt].x) * (acc[jt][1] + bsv[jt])); o.y = pk2(bflo(uq[jt].y) * (acc[jt][2] + bsv[jt]), bfhi(uq[jt].y) * (acc[jt][3] + bsv[jt]));
                    if (MODE == 3) { if (o.x == 0x12345u) *(GAS u32x2*)(UM + off) = o; } else *(GAS u32x2*)(UM + off) = o;
                }
            }
            __syncthreads();
        }
    }
    if (MODE == 0 || MODE == 1) for (int it = vcu * 512 + tid; it < 128 * 768; it += G * 512) {
        const int sq = it / 768, c8 = (it % 768) * 8, gg = c8 / 768;
        const size_t r0 = 8192 + (size_t)sq * 4;
        const f32x4 g0 = *(const GAS f32x4*)(lng + c8), g1 = *(const GAS f32x4*)(lng + c8 + 4), b0 = *(const GAS f32x4*)(lnb + c8), b1 = *(const GAS f32x4*)(lnb + c8 + 4);
        v4u vq4[4], uq4[4]; float st1[4], st2[4], bsv4[4], wv[4][4];
#pragma unroll
        for (int s = 0; s < 4; ++s) { st1[s] = VST[(r0 + s) * 2]; st2[s] = VST[(r0 + s) * 2 + 1]; vq4[s] = *(const GAS v4u*)(VB + (r0 + s) * 6144 + c8); uq4[s] = *(const GAS v4u*)(UB + (r0 + s) * 6144 + c8); bsv4[s] = bs[gg * 128 + s];
#pragma unroll
            for (int s2 = 0; s2 < 4; ++s2) wv[s][s2] = (s2 <= s) ? wsf[(size_t)(gg * 128 + s) * 128 + s2] : 0.f; }
        float vn[4][8];
#pragma unroll
        for (int s = 0; s < 4; ++s) {
            const float mu = st1[s] * (1.f / 6144.f); const float rstd = rsqrtf(st2[s] * (1.f / 6144.f) - mu * mu + 1e-5f); const v4u q = vq4[s];
            vn[s][0] = (bflo(q.x) - mu) * rstd * g0.x + b0.x; vn[s][1] = (bfhi(q.x) - mu) * rstd * g0.y + b0.y; vn[s][2] = (bflo(q.y) - mu) * rstd * g0.z + b0.z; vn[s][3] = (bfhi(q.y) - mu) * rstd * g0.w + b0.w;
            vn[s][4] = (bflo(q.z) - mu) * rstd * g1.x + b1.x; vn[s][5] = (bfhi(q.z) - mu) * rstd * g1.y + b1.y; vn[s][6] = (bflo(q.w) - mu) * rstd * g1.z + b1.z; vn[s][7] = (bfhi(q.w) - mu) * rstd * g1.w + b1.w;
        }
#pragma unroll
        for (int s = 0; s < 4; ++s) { float* vo = vs_out + ((size_t)sq * 4 + s) * 6144 + c8;
            *(GAS f32x4*)vo = (f32x4){vn[s][0], vn[s][1], vn[s][2], vn[s][3]}; *(GAS f32x4*)(vo + 4) = (f32x4){vn[s][4], vn[s][5], vn[s][6], vn[s][7]}; }
#pragma unroll
        for (int t = 0; t < 4; ++t) {
            float mx[8];
#pragma unroll
            for (int e = 0; e < 8; ++e) mx[e] = bsv4[t];
#pragma unroll
            for (int s = 0; s < 4; ++s) if (s <= t) {
#pragma unroll
                for (int e = 0; e < 8; ++e) mx[e] += wv[t][s] * vn[s][e]; }
            const v4u uq = uq4[t];
            v4u o; o.x = pk2(bflo(uq.x) * mx[0], bfhi(uq.x) * mx[1]); o.y = pk2(bflo(uq.y) * mx[2], bfhi(uq.y) * mx[3]); o.z = pk2(bflo(uq.z) * mx[4], bfhi(uq.z) * mx[5]); o.w = pk2(bflo(uq.w) * mx[6], bfhi(uq.w) * mx[7]);
            *(GAS v4u*)(UM + (r0 + t) * 6144 + c8) = o;
        }
    }
}
__device__ __forceinline__ float wave_scan_add(float v, int lane) {
#pragma unroll
    for (int o = 1; o < 64; o <<= 1) { const float t = __shfl_up(v, o); if (lane >= o) v += t; }
    return v;
}
__device__ __forceinline__ float wave_scan_max(float v, int lane) {
#pragma unroll
    for (int o = 1; o < 64; o <<= 1) { const float t = __shfl_up(v, o); if (lane >= o) v = fmaxf(v, t); }
    return v;
}
__device__ __forceinline__ bf16x8 tr_frag2(const LAS bf16* p0, const LAS bf16* p1) {
    const s16x4 r0 = __builtin_amdgcn_ds_read_tr16_b64_v4i16((LAS s16x4*)p0);
    const s16x4 r1 = __builtin_amdgcn_ds_read_tr16_b64_v4i16((LAS s16x4*)p1);
    return (bf16x8){r0.x, r0.y, r0.z, r0.w, r1.x, r1.y, r1.z, r1.w};
}
__device__ __forceinline__ bf16x8 tr_frag(const LAS bf16* p0, int rowstep4) { return tr_frag2(p0, p0 + rowstep4); }
__device__ __forceinline__ int qk_off(int row, int chunk) { return row * 128 + ((chunk ^ (row & 15)) << 3); }
__device__ __forceinline__ int v_off(int row, int chunk) { return row * 256 + ((chunk ^ (row & 7)) << 3); }
__device__ __forceinline__ int p_off(int row, int chunk) { return row * 64 + ((chunk ^ ((row >> 1) & 7)) << 3); }

__device__ __forceinline__ void mlstm_prompt_seq(const bf16* QKVO, const float* GATES, const float* hn_gain, bf16* HN, float* Cp, float* np_, float* mp, int seq, int h, LAS unsigned char* lds, int wave, int lane) {
    LAS bf16* Qs = (LAS bf16*)lds;
    LAS bf16* Ks = (LAS bf16*)(lds + 16384);
    LAS bf16* Vs = (LAS bf16*)(lds + 32768);
    LAS bf16* Cd = (LAS bf16*)(lds + 65536) + wave * 4096;
    LAS unsigned char* hi = lds + RING_BYTES + 512;
    LAS bf16* Ps = (LAS bf16*)hi;
    LAS float* A_ = (LAS float*)(hi + 8192);
    LAS float* M_ = A_ + 64;
    LAS float* B_ = M_ + 64;
    LAS float* SC = B_ + 64;
    LAS float* X_ = SC + 4;
    LAS bf16* nd = (LAS bf16*)(X_ + 1024);
    LAS float* GN = X_ + 1024 + 64;
    const int tid = wave * 64 + lane, fr = lane & 15, fq = lane >> 4;
    const size_t row0 = (size_t)seq * 2048;
    for (int i = tid; i < 65536 / 16; i += 512) ((LAS v4u*)(lds + 65536))[i] = (v4u){0u, 0u, 0u, 0u};
    if (tid < 16) ((LAS v4u*)nd)[tid] = (v4u){0u, 0u, 0u, 0u};
    if (tid < 256) GN[tid] = hn_gain[h * 256 + tid];
    float nreg = 0.f;
    f32x4 Cacc[2][8];
#pragma unroll
    for (int it = 0; it < 2; ++it)
#pragma unroll
        for (int jd = 0; jd < 8; ++jd) Cacc[it][jd] = (f32x4){0.f, 0.f, 0.f, 0.f};
    float m = 0.f;
    const bf16x8 ones = (fr == 0) ? (bf16x8){0x3F80, 0x3F80, 0x3F80, 0x3F80, 0x3F80, 0x3F80, 0x3F80, 0x3F80} : (bf16x8){0, 0, 0, 0, 0, 0, 0, 0};
    const int srow = tid >> 3, sc16 = (tid & 7) * 16, sc32 = (tid & 7) * 32;
    v4u pq[2], pk[2], pv[4];
    {   const bf16* r = QKVO + (row0 + srow) * 6144;
#pragma unroll
        for (int i = 0; i < 2; ++i) { pq[i] = *(const GAS v4u*)(r + h * 128 + sc16 + i * 8); pk[i] = *(const GAS v4u*)(r + 1024 + h * 128 + sc16 + i * 8); }
#pragma unroll
        for (int i = 0; i < 4; ++i) pv[i] = *(const GAS v4u*)(r + 2048 + h * 256 + sc32 + i * 8); }
    float ig_n = 0.f, lf_n = 0.f;
    if (wave == 0) { ig_n = GATES[(row0 + lane) * 16 + h]; lf_n = GATES[(row0 + lane) * 16 + 8 + h]; }
    __syncthreads();
#pragma unroll 1
    for (int c = 0; c < 32; ++c) {
        const size_t rb = row0 + (size_t)c * 64;
        int fr_l = lane & 15, fq_l = lane >> 4; asm volatile("" : "+v"(fr_l), "+v"(fq_l));
        const int fr = fr_l, fq = fq_l;
#pragma unroll
        for (int i = 0; i < 2; ++i) { *(LAS v4u*)(Qs + qk_off(srow, (sc16 >> 3) + i)) = pq[i]; *(LAS v4u*)(Ks + qk_off(srow, (sc16 >> 3) + i)) = pk[i]; }
#pragma unroll
        for (int i = 0; i < 4; ++i) *(LAS v4u*)(Vs + v_off(srow, (sc32 >> 3) + i)) = pv[i];
        if (c + 1 < 32) { const bf16* r = QKVO + (rb + 64 + srow) * 6144;
#pragma unroll
            for (int i = 0; i < 2; ++i) { pq[i] = *(const GAS v4u*)(r + h * 128 + sc16 + i * 8); pk[i] = *(const GAS v4u*)(r + 1024 + h * 128 + sc16 + i * 8); }
#pragma unroll
            for (int i = 0; i < 4; ++i) pv[i] = *(const GAS v4u*)(r + 2048 + h * 256 + sc32 + i * 8); }
        if (wave == 0) {
            const float ig = ig_n, lf = lf_n;
            if (c + 1 < 32) { ig_n = GATES[(rb + 64 + lane) * 16 + h]; lf_n = GATES[(rb + 64 + lane) * 16 + 8 + h]; }
            const float b = wave_scan_add(lf, lane); const float a = ig - b; const float pm = wave_scan_max(a, lane);
            const float Mt = fmaxf(m, pm);
            A_[lane] = a; M_[lane] = Mt; B_[lane] = b;
            const float M63 = __shfl(Mt, 63), b63 = __shfl(b, 63);
            if (lane == 0) { SC[0] = __expf(m - M63); SC[1] = b63 + M63; SC[2] = m; }
            m = b63 + M63;
        }
        __syncthreads();
        f32x4 nacc[3][4];
#pragma unroll
        for (int it = 0; it < 3; ++it)
#pragma unroll
            for (int jt = 0; jt < 4; ++jt) nacc[it][jt] = (f32x4){0.f, 0.f, 0.f, 0.f};
#pragma unroll 1
        for (int ks = 0; ks < 4; ++ks) {
            bf16x8 ca[3];
#pragma unroll
            for (int it = 0; it < 2; ++it) ca[it] = tr_frag(Cd + (32 * ks + 8 * fq + (fr >> 2)) * 32 + 16 * it + 4 * (fr & 3), 4 * 32);
            ca[2] = (fr == 0) ? *(const LAS bf16x8*)(nd + 32 * ks + 8 * fq) : (bf16x8){0, 0, 0, 0, 0, 0, 0, 0};
#pragma unroll
            for (int jt = 0; jt < 4; ++jt) { const bf16x8 qb = *(const LAS bf16x8*)(Qs + qk_off(16 * jt + fr, 4 * ks + fq));
#pragma unroll
                for (int it = 0; it < 3; ++it) nacc[it][jt] = __builtin_amdgcn_mfma_f32_16x16x32_bf16(ca[it], qb, nacc[it][jt], 0, 0, 0); }
        }
#pragma unroll
        for (int jt = 0; jt < 4; ++jt) { const float mt = M_[16 * jt + fr]; const float wi = __expf(SC[2] - mt);
#pragma unroll
            for (int it = 0; it < 3; ++it) nacc[it][jt] = nacc[it][jt] * wi; }
        {
#pragma unroll 1
            for (int ti = wave; ti < 16; ti += 8) {
                int tt, st;
                if (ti < 10) { tt = (ti >= 6) ? 3 : (ti >= 3) ? 2 : (ti >= 1) ? 1 : 0; st = ti - (tt * (tt + 1)) / 2; }
                else { const int z = ti - 10; tt = (z >= 5) ? 2 : (z >= 3) ? 1 : 0; st = (z >= 5) ? 3 : (z >= 3) ? (z - 3 + 2) : (z + 1); }
                u32x2 o = (u32x2){0u, 0u};
                if (ti < 10) {
                    f32x4 sa = (f32x4){0.f, 0.f, 0.f, 0.f};
#pragma unroll
                    for (int ks = 0; ks < 4; ++ks) { const bf16x8 ka = *(const LAS bf16x8*)(Ks + qk_off(16 * st + fr, 4 * ks + fq)); const bf16x8 qb = *(const LAS bf16x8*)(Qs + qk_off(16 * tt + fr, 4 * ks + fq));
                        sa = __builtin_amdgcn_mfma_f32_16x16x32_bf16(ka, qb, sa, 0, 0, 0); }
                    const int t = 16 * tt + fr, s0 = 16 * st + 4 * fq; const float mt = M_[t];
                    float pvv[4];
#pragma unroll
                    for (int r = 0; r < 4; ++r) pvv[r] = (s0 + r <= t) ? sa[r] * __expf(A_[s0 + r] - mt) : 0.f;
                    o.x = pk2(pvv[0], pvv[1]); o.y = pk2(pvv[2], pvv[3]);
                }
                *(LAS u32x2*)(Ps + p_off(16 * tt + fr, 2 * st + (fq >> 1)) + 4 * (fq & 1)) = o;
            }
        }
        __syncthreads();
        {   const float M63 = M_[63]; const float wk = __expf(A_[srow] - M63);
#pragma unroll
            for (int i = 0; i < 2; ++i) { v4u q = *(LAS v4u*)(Ks + qk_off(srow, (sc16 >> 3) + i));
                q.x = pk2(bflo(q.x) * wk, bfhi(q.x) * wk); q.y = pk2(bflo(q.y) * wk, bfhi(q.y) * wk); q.z = pk2(bflo(q.z) * wk, bfhi(q.z) * wk); q.w = pk2(bflo(q.w) * wk, bfhi(q.w) * wk);
                *(LAS v4u*)(Ks + qk_off(srow, (sc16 >> 3) + i)) = q; } }
        bf16x8 va[2][2];
#pragma unroll
        for (int ks = 0; ks < 2; ++ks)
#pragma unroll
            for (int it = 0; it < 2; ++it) { const int r_ = 32 * ks + 8 * fq + (fr >> 2), ch_ = 4 * wave + 2 * it + ((fr & 3) >> 1), w_ = 4 * (fr & 1); va[ks][it] = tr_frag2(Vs + v_off(r_, ch_) + w_, Vs + v_off(r_ + 4, ch_) + w_); }
#pragma unroll
        for (int ks = 0; ks < 2; ++ks)
#pragma unroll
            for (int jt = 0; jt < 4; ++jt) { const bf16x8 pb = *(const LAS bf16x8*)(Ps + p_off(16 * jt + fr, 4 * ks + fq));
                nacc[0][jt] = __builtin_amdgcn_mfma_f32_16x16x32_bf16(va[ks][0], pb, nacc[0][jt], 0, 0, 0);
                nacc[1][jt] = __builtin_amdgcn_mfma_f32_16x16x32_bf16(va[ks][1], pb, nacc[1][jt], 0, 0, 0);
                nacc[2][jt] = __builtin_amdgcn_mfma_f32_16x16x32_bf16(ones, pb, nacc[2][jt], 0, 0, 0); }
        u32x2 oq[4][2];
#pragma unroll
        for (int jt = 0; jt < 4; ++jt)
#pragma unroll
            for (int it = 0; it < 2; ++it) oq[jt][it] = *(const GAS u32x2*)(QKVO + (rb + 16 * jt + fr) * 6144 + 4096 + h * 256 + 32 * wave + 16 * it + 4 * fq);
        float s1[4], s2[4];
#pragma unroll
        for (int jt = 0; jt < 4; ++jt) {
            const int t = 16 * jt + fr;
            const float den = __shfl(nacc[2][jt][0], fr);
            const float dd = fmaxf(fabsf(den), __expf(-(B_[t] + M_[t]))); const float inv = 1.f / dd;
            s1[jt] = 0.f; s2[jt] = 0.f;
#pragma unroll
            for (int it = 0; it < 2; ++it) { const u32x2 oq_ = oq[jt][it];
                const float og[4] = {bflo(oq_.x), bfhi(oq_.x), bflo(oq_.y), bfhi(oq_.y)};
#pragma unroll
                for (int r = 0; r < 4; ++r) { const float hv = nacc[it][jt][r] * inv * __builtin_amdgcn_rcpf(1.f + __expf(-og[r])); nacc[it][jt][r] = hv; s1[jt] += hv; s2[jt] += hv * hv; } }
            s1[jt] += __shfl_xor(s1[jt], 16); s1[jt] += __shfl_xor(s1[jt], 32); s2[jt] += __shfl_xor(s2[jt], 16); s2[jt] += __shfl_xor(s2[jt], 32);
            if (fq == 0) { X_[(wave * 64 + t) * 2] = s1[jt]; X_[(wave * 64 + t) * 2 + 1] = s2[jt]; }
        }
        __syncthreads();
#pragma unroll
        for (int jt = 0; jt < 4; ++jt) {
            const int t = 16 * jt + fr; float a1 = 0.f, a2 = 0.f;
#pragma unroll
            for (int w = 0; w < 8; ++w) { a1 += X_[(w * 64 + t) * 2]; a2 += X_[(w * 64 + t) * 2 + 1]; }
            const float mu = a1 * (1.f / 256.f); const float rstd = rsqrtf(a2 * (1.f / 256.f) - mu * mu + 1e-5f);
#pragma unroll
            for (int it = 0; it < 2; ++it) { const int e = 32 * wave + 16 * it + 4 * fq; const f32x4 gn = *(const LAS f32x4*)(GN + e);
                u32x2 o; o.x = pk2((nacc[it][jt][0] - mu) * rstd * gn.x, (nacc[it][jt][1] - mu) * rstd * gn.y); o.y = pk2((nacc[it][jt][2] - mu) * rstd * gn.z, (nacc[it][jt][3] - mu) * rstd * gn.w);
                *(GAS u32x2*)(HN + (rb + t) * 2048 + h * 256 + e) = o; }
        }
        {   const float decay = SC[0];
#pragma unroll
            for (int it = 0; it < 2; ++it)
#pragma unroll
                for (int jd = 0; jd < 8; ++jd) Cacc[it][jd] = Cacc[it][jd] * decay;
            if (tid < 128) { float sum = 0.f;
#pragma unroll 8
                for (int s2_ = 0; s2_ < 64; ++s2_) sum += bflo((unsigned)Ks[qk_off(s2_, tid >> 3) + (tid & 7)]);
                nreg = decay * nreg + sum; nd[tid] = (bf16)f2bf(nreg); }
#pragma unroll
            for (int ks = 0; ks < 2; ++ks)
#pragma unroll
                for (int jd = 0; jd < 8; ++jd) { asm volatile("" ::: "memory"); const int r_ = 32 * ks + 8 * fq + (fr >> 2), ch_ = 2 * jd + ((fr & 3) >> 1), w_ = 4 * (fr & 1); const bf16x8 kb = tr_frag2(Ks + qk_off(r_, ch_) + w_, Ks + qk_off(r_ + 4, ch_) + w_);
                    Cacc[0][jd] = __builtin_amdgcn_mfma_f32_16x16x32_bf16(va[ks][0], kb, Cacc[0][jd], 0, 0, 0);
                    Cacc[1][jd] = __builtin_amdgcn_mfma_f32_16x16x32_bf16(va[ks][1], kb, Cacc[1][jd], 0, 0, 0);
                }
#pragma unroll
            for (int jd = 0; jd < 8; ++jd) {
#pragma unroll
                for (int it = 0; it < 2; ++it) { u32x2 o; o.x = pk2(Cacc[it][jd][0], Cacc[it][jd][1]); o.y = pk2(Cacc[it][jd][2], Cacc[it][jd][3]); *(LAS u32x2*)(Cd + (16 * jd + fr) * 32 + 16 * it + 4 * fq) = o; }
            }
        }
        __syncthreads();
    }
    float* Co = Cp + (size_t)(seq * 8 + h) * 32768;
#pragma unroll
    for (int jd = 0; jd < 8; ++jd) {
#pragma unroll
        for (int it = 0; it < 2; ++it) *(GAS f32x4*)(Co + (size_t)(16 * jd + fr) * 256 + 32 * wave + 16 * it + 4 * fq) = Cacc[it][jd];
    }
    if (tid < 128) np_[(seq * 8 + h) * 128 + tid] = nreg;
    if (wave == 0 && lane == 0) mp[seq * 8 + h] = m;
}

__device__ __forceinline__ void mlstm_sample_unit(const bf16* QKVO, const float* GATES, const float* hn_gain, const float* C0, const float* n0, const float* m0,
                                                  bf16* HN, float* Cs, float* ns, float* ms, int u, LAS unsigned char* lds, int wave, int lane) {
    const int h = u & 7, tid = wave * 64 + lane; const size_t r0 = 8192 + (size_t)(u >> 3) * 4;
    LAS float* q = (LAS float*)lds;
    LAS float* k = q + 512;
    LAS float* v = k + 512;
    LAS float* Sm = v + 1024;
    LAS float* gv = Sm + 16;
    LAS float* nn = gv + 32;
    LAS float* part = nn + 128;
    LAS float* red = part + 8192;
    { const int t = tid >> 7, d = tid & 127; const bf16* r = QKVO + (r0 + t) * 6144; q[tid] = bflo((unsigned)r[h * 128 + d]); k[tid] = bflo((unsigned)r[1024 + h * 128 + d]);
#pragma unroll
      for (int i = 0; i < 2; ++i) { const int idx = tid + 512 * i, tv = idx >> 8, e = idx & 255; v[idx] = bflo((unsigned)QKVO[(r0 + tv) * 6144 + 2048 + h * 256 + e]); } }
    if (tid < 128) nn[tid] = n0[(size_t)u * 128 + tid];
    if (tid == 0) {
        const float mprev = m0[u]; float b = 0.f, pm = -INFINITY;
        for (int t = 0; t < 4; ++t) { const float ig = GATES[(r0 + t) * 16 + h], lf = GATES[(r0 + t) * 16 + 8 + h]; b += lf; const float a = ig - b; pm = fmaxf(pm, a); const float Mt = fmaxf(mprev, pm);
            gv[t] = a; gv[4 + t] = Mt; gv[8 + t] = b; gv[12 + t] = __expf(mprev - Mt); }
        const float M3 = gv[7], b3 = gv[11];
        gv[28] = __expf(mprev - M3); gv[29] = b3 + M3;
        for (int s = 0; s < 4; ++s) gv[20 + s] = __expf(gv[s] - M3);
    }
    __syncthreads();
    if (tid < 16) { const int t = tid >> 2, s = tid & 3; float r = 0.f; if (s <= t) { float dot = 0.f; for (int d = 0; d < 128; ++d) dot += q[t * 128 + d] * k[s * 128 + d]; r = dot * __expf(gv[s] - gv[4 + t]); } Sm[tid] = r; }
    else if (tid < 20) { const int t = tid - 16; float dot = 0.f; for (int d = 0; d < 128; ++d) dot += q[t * 128 + d] * nn[d]; gv[24 + t] = dot; }
    __syncthreads();
    if (tid < 4) { float den = gv[12 + tid] * gv[24 + tid]; for (int s = 0; s <= tid; ++s) den += Sm[tid * 4 + s]; gv[16 + tid] = fmaxf(fabsf(den), __expf(-(gv[8 + tid] + gv[4 + tid]))); }
    k[tid] *= gv[20 + (tid >> 7)];
    __syncthreads();
    {
        const int eq = tid & 63, dg = tid >> 6; const float decay = gv[28];
        f32x4 v4[4];
#pragma unroll
        for (int s = 0; s < 4; ++s) v4[s] = *(const LAS f32x4*)(v + s * 256 + 4 * eq);
        f32x4 acc[4];
#pragma unroll
        for (int t = 0; t < 4; ++t) acc[t] = (f32x4){0.f, 0.f, 0.f, 0.f};
        const float* cin = C0 + (size_t)u * 32768 + (size_t)(dg * 16) * 256 + 4 * eq; float* cout = Cs + (size_t)u * 32768 + (size_t)(dg * 16) * 256 + 4 * eq;
#pragma unroll
        for (int hb = 0; hb < 2; ++hb) {
            f32x4 cr[8];
#pragma unroll
            for (int dd = 0; dd < 8; ++dd) cr[dd] = __builtin_nontemporal_load((const GAS f32x4*)(cin + (hb * 8 + dd) * 256));
#pragma unroll
            for (int dd = 0; dd < 8; ++dd) { const int d = dg * 16 + hb * 8 + dd; const f32x4 c = cr[dd];
#pragma unroll
                for (int t = 0; t < 4; ++t) acc[t] += c * q[t * 128 + d];
                f32x4 cn = c * decay;
#pragma unroll
                for (int s = 0; s < 4; ++s) cn += v4[s] * k[s * 128 + d];
                __builtin_nontemporal_store(cn, (GAS f32x4*)(cout + (hb * 8 + dd) * 256)); }
        }
#pragma unroll
        for (int t = 0; t < 4; ++t) *(LAS f32x4*)(part + (dg * 4 + t) * 256 + 4 * eq) = acc[t];
    }
    __syncthreads();
    float hv[2];
    {   const int t = tid >> 7, e2 = (tid & 127) * 2;
        float s1 = 0.f, s2 = 0.f;
#pragma unroll
        for (int i = 0; i < 2; ++i) { const int e = e2 + i; float num2 = 0.f;
#pragma unroll
            for (int dg = 0; dg < 8; ++dg) num2 += part[(dg * 4 + t) * 256 + e];
            float num1 = 0.f; for (int s = 0; s <= t; ++s) num1 += Sm[t * 4 + s] * v[s * 256 + e];
            float x = (num1 + gv[12 + t] * num2) / gv[16 + t];
            const float o = bflo((unsigned)QKVO[(r0 + t) * 6144 + 4096 + h * 256 + e]);
            x *= 1.f / (1.f + __expf(-o)); hv[i] = x; s1 += x; s2 += x * x; }
        s1 = wave_sum_f(s1); s2 = wave_sum_f(s2);
        if (lane == 0) { red[wave * 2] = s1; red[wave * 2 + 1] = s2; }
    }
    __syncthreads();
    {   const int t = tid >> 7, e2 = (tid & 127) * 2;
        const float a1 = red[(2 * t) * 2] + red[(2 * t + 1) * 2], a2 = red[(2 * t) * 2 + 1] + red[(2 * t + 1) * 2 + 1];
        const float mu = a1 * (1.f / 256.f); const float rstd = rsqrtf(a2 * (1.f / 256.f) - mu * mu + 1e-5f);
        const unsigned o = pk2((hv[0] - mu) * rstd * hn_gain[h * 256 + e2], (hv[1] - mu) * rstd * hn_gain[h * 256 + e2 + 1]);
        *(GAS unsigned*)(HN + (r0 + t) * 2048 + h * 256 + e2) = o;
        if (tid < 128) { float a = gv[28] * nn[tid]; for (int s = 0; s < 4; ++s) a += k[s * 128 + tid]; ns[(size_t)u * 128 + tid] = a; }
        if (tid == 0) ms[u] = gv[29];
    }
    __syncthreads();
}

__device__ __forceinline__ void phase_mlstm(const Args& a, LAS unsigned char* lds, int G, int wave, int lane, int which) {
    const bf16* QKVO = (const bf16*)(a.ws + a.L.qkvo); const float* GATES = (const float*)(a.ws + a.L.gates); bf16* HN = (bf16*)(a.ws + a.L.qp);
    const int bx = blockIdx.x;
    constexpr size_t O_CP = 17825792, O_NP = O_CP + 1048576, O_MP = O_NP + 4096, O_CS = O_MP + 32, O_NS = O_CS + 33554432, O_MS = O_NS + 131072;
    if (bx < 32) { if (which & 1) mlstm_prompt_seq(QKVO, GATES, a.in[7], HN, a.out + O_CP, a.out + O_NP, a.out + O_MP, bx >> 3, bx & 7, lds, wave, lane); }
    else {
        if (which & 2) for (int u = bx - 32; u < 1024; u += G - 32) mlstm_sample_unit(QKVO, GATES, a.in[7], a.in[2], a.in[3], a.in[4], HN, a.out + O_CS, a.out + O_NS, a.out + O_MS, u, lds, wave, lane);
        if (which & 28) { __syncthreads(); side_convert(a, lds, (bx - 32) * NWAVES + wave, (G - 32) * NWAVES, wave, lane, (which & 4) ? 3 : ((which >> 3) & 3)); }
    }
}
struct MiniBf16S { bf16* O; int ldc, sclo, schi; __device__ __forceinline__ void operator()(int row, int col, f32x4 a) const { const float s = (col >= sclo && col < schi) ? 0.08838834764831845f : 1.f;
    u32x2 o; o.x = pk2(a[0] * s, a[1] * s); o.y = pk2(a[2] * s, a[3] * s); *(GAS u32x2*)(O + (size_t)row * ldc + col) = o; } };
struct MiniBf16 { bf16* O; int ldc; __device__ __forceinline__ void operator()(int row, int col, f32x4 a) const { u32x2 o; o.x = pk2(a[0], a[1]); o.y = pk2(a[2], a[3]); *(GAS u32x2*)(O + (size_t)row * ldc + col) = o; } };
struct MiniRes { const float* res0; const float* res1; float* Z; float alpha; __device__ __forceinline__ void operator()(int row, int col, f32x4 a) const {
    const float* rp = (row < 8192) ? res0 + (size_t)row * 2048 : res1 + (size_t)(row - 8192) * 2048; const f32x4 x = *(const GAS f32x4*)(rp + col); *(GAS f32x4*)(Z + (size_t)row * 2048 + col) = x * alpha + a; } };
struct MiniGelu { bf16* U; bf16* V; const float* bias; float* VST; __device__ __forceinline__ void operator()(int row, int col, f32x4 a) const {
    const bool isv = col >= 6144; const f32x4 bv = *(const GAS f32x4*)(bias + col); float s1 = 0.f, s2 = 0.f;
#pragma unroll
    for (int e = 0; e < 4; ++e) { a[e] = pg8::gelu_tanh_f(a[e] + bv[e]); s1 += a[e]; s2 += a[e] * a[e]; }
    u32x2 o; o.x = pk2(a[0], a[1]); o.y = pk2(a[2], a[3]);
    *(GAS u32x2*)((isv ? V + (size_t)row * 6144 + (col - 6144) : U + (size_t)row * 6144 + col)) = o;
    if (isv) { s1 += __shfl_xor(s1, 16); s1 += __shfl_xor(s1, 32); s2 += __shfl_xor(s2, 16); s2 += __shfl_xor(s2, 32);
        if ((threadIdx.x & 48) == 0) { atomicAdd(VST + 2 * row, s1); atomicAdd(VST + 2 * row + 1, s2); } } } };
template <class Epi>
__device__ __forceinline__ void mini_gemm(const bf16* A, const bf16* Bt, int N, int K, const Epi& E, LAS unsigned char* lds, int vcu, int G, int wave, int lane) {
    const int tid = wave * 64 + lane, fr = lane & 15, fq = lane >> 4;
    const int srow = tid >> 4, sch = tid & 15;
    const int nct = N / 128, nunits = 16 * nct, nch = K / 128;
    const int wofs = srow * 256 + ((sch ^ (srow & 15)) << 4);
    const size_t bstep = (size_t)32 * K;
#define MG_LOAD(r, c) do { r[0] = *(const GAS v4u*)(ag + (size_t)(c) * 128); _Pragma("unroll") for (int p_ = 0; p_ < 4; ++p_) r[1 + p_] = *(const GAS v4u*)(bg + p_ * bstep + (size_t)(c) * 128); } while (0)
#define MG_STORE(r, b) do { *(LAS v4u*)(lds + (b) * 40960 + wofs) = r[0]; _Pragma("unroll") for (int p_ = 0; p_ < 4; ++p_) *(LAS v4u*)(lds + (b) * 40960 + 8192 + p_ * 8192 + wofs) = r[1 + p_]; } while (0)
#define MG_COMPUTE(b) do { _Pragma("unroll") for (int ks_ = 0; ks_ < 4; ++ks_) { const int co_ = ((ks_ * 4 + fq) ^ fr) << 4; \
        const bf16x8 a0_ = *(const LAS bf16x8*)(lds + (b) * 40960 + fr * 256 + co_), a1_ = *(const LAS bf16x8*)(lds + (b) * 40960 + (16 + fr) * 256 + co_); \
        const bf16x8 b_ = *(const LAS bf16x8*)(lds + (b) * 40960 + 8192 + (wave * 16 + fr) * 256 + co_); \
        acc0 = __builtin_amdgcn_mfma_f32_16x16x32_bf16(b_, a0_, acc0, 0, 0, 0); acc1 = __builtin_amdgcn_mfma_f32_16x16x32_bf16(b_, a1_, acc1, 0, 0, 0); } } while (0)
    for (int u = vcu; u < nunits; u += G) {
        const int rt = u & 15, ct = u >> 4;
        const int row0 = 8192 + rt * 32, colB0 = ct * 128;
        const bf16* ag = A + (size_t)(row0 + srow) * K + sch * 8;
        const bf16* bg = Bt + (size_t)(colB0 + srow) * K + sch * 8;
        f32x4 acc0 = (f32x4){0.f, 0.f, 0.f, 0.f}, acc1 = acc0;
        v4u r0[5], r1[5];
        MG_LOAD(r0, 0); MG_LOAD(r1, 1);
        MG_STORE(r0, 0); __syncthreads();
#pragma unroll 1
        for (int c = 0; c < nch; c += 2) {
            if (c + 2 < nch) MG_LOAD(r0, c + 2);
            MG_COMPUTE(0);
            MG_STORE(r1, 1); __syncthreads();
            if (c + 3 < nch) MG_LOAD(r1, c + 3);
            MG_COMPUTE(1);
            if (c + 2 < nch) MG_STORE(r0, 0);
            __syncthreads();
        }
        E(row0 + fr, colB0 + wave * 16 + 4 * fq, acc0); E(row0 + 16 + fr, colB0 + wave * 16 + 4 * fq, acc1);
    }
#undef MG_LOAD
#undef MG_STORE
#undef MG_COMPUTE
}
__global__ void __launch_bounds__(NWAVES * 64, 2) mk(Args args) {
    extern __shared__ __attribute__((aligned(16))) unsigned char lds_raw[];
    LAS unsigned char* lds = (LAS unsigned char*)lds_raw;
    volatile LAS unsigned* MISC = (volatile LAS unsigned*)(lds + MISC_OFF);
    const int tid = threadIdx.x, lane = tid & 63, wave = __builtin_amdgcn_readfirstlane(tid >> 6);
    const int G = gridDim.x, bx = blockIdx.x; const int vcu = (G % 8 == 0) ? (bx % 8) * (G / 8) + bx / 8 : bx;
    for (int u = tid; u < (LDS_BYTES - RING_BYTES) / 4; u += NWAVES * 64) ((LAS unsigned*)(lds + RING_BYTES))[u] = 0u;
    __syncthreads();
    unsigned char* ws = args.ws; const Lay& L = args.L;
    unsigned* ctl = (unsigned*)(ws + L.ctl);
    XcdBarrier bar = xcd_barrier_post(ctl + 4096 + args.li * XCD_BAR_WORDS, MISC + 8);
    const int lo = args.ph_lo, hi = args.ph_hi;
#ifndef PHMASK
#define PHMASK 0xFFFFFFFFu
#endif
#define IN(k) (((PHMASK >> (k)) & 1u) && lo <= (k) && (k) < hi)
#ifndef MLSTM_DUPSEL
#define MLSTM_DUPSEL 3
#endif
#ifndef TK_ABL
#define TK_ABL 0
#endif
#ifndef SP_ABL
#define SP_ABL 0
#endif
#ifndef UP_ABL
#define UP_ABL 0
#endif
#ifndef VP_ABL
#define VP_ABL 0
#endif
#ifndef DUPMASK
#define DUPMASK 0u
#endif
#define DUP(k) ((DUPMASK >> (k)) & 1u)
#define LANE() ({ int l_ = lane; asm volatile("" : "+v"(l_)); l_; })
#define SEAM(k) do { if (IN(k) && IN((k) + 1)) xcd_barrier(bar); } while (0)
#define GEMM_PHASE_FULL(EPI_T, E, Aptr, Btptr, Nn, Kk) do { pg8::Gemm g_{(const pg8::bf16_t*)(Aptr), (const pg8::bf16_t*)(Btptr), NTOKF, (Nn), (Kk)}; pg8::StaticOrder S_; S_.init(NTOKF, (Nn), G, bx); \
        pg8::gemm_phase<EPI_T, pg8::StaticOrder, true, true>(lds, g_, S_, E); } while (0)
#define GEMM_PHASE(EPI_T, E, Aptr, Btptr, Nn, Kk, MINI_E) do { pg8::Gemm g_{(const pg8::bf16_t*)(Aptr), (const pg8::bf16_t*)(Btptr), 8192, (Nn), (Kk)}; pg8::StaticOrder S_; S_.init(8192, (Nn), G, bx); \
        pg8::gemm_phase<EPI_T, pg8::StaticOrder, true, true>(lds, g_, S_, E); \
        mini_gemm((const bf16*)(Aptr), (const bf16*)(Btptr), (Nn), (Kk), MINI_E, lds, vcu, G, wave, LANE()); } while (0)

    if (IN(0)) { { phase_prologue(args, lds, vcu, G, wave, LANE()); } if (DUP(0)) { xcd_barrier(bar); { phase_prologue(args, lds, vcu, G, wave, LANE()); } } } SEAM(0);
    if (IN(1)) { { pg8::EpiBf16S E{(pg8::bf16_t*)(ws + L.qkvo), 6144, 1024, 2048, 0.08838834764831845f}; GEMM_PHASE_FULL(pg8::EpiBf16S, E, ws + L.xb, ws + L.wina, 6144, 2048); } if (DUP(1)) { xcd_barrier(bar); { pg8::EpiBf16S E{(pg8::bf16_t*)(ws + L.qkvo), 6144, 1024, 2048, 0.08838834764831845f}; GEMM_PHASE_FULL(pg8::EpiBf16S, E, ws + L.xb, ws + L.wina, 6144, 2048); } } } SEAM(1);
    if (IN(2)) { { phase_mlstm(args, lds, G, wave, lane, 7); } if (DUP(2)) { xcd_barrier(bar); { phase_mlstm(args, lds, G, wave, lane, MLSTM_DUPSEL); } } } SEAM(2);
    if (IN(3)) { { pg8::EpiRes E{args.in[0], args.in[1], (float*)(ws + L.z), ALPHA_F}; GEMM_PHASE(pg8::EpiRes, E, ws + L.qp, ws + L.wouta, 2048, 2048, (MiniRes{args.in[0], args.in[1], (float*)(ws + L.z), ALPHA_F})); } if (DUP(3)) { xcd_barrier(bar); { pg8::EpiRes E{args.in[0], args.in[1], (float*)(ws + L.z), ALPHA_F}; GEMM_PHASE(pg8::EpiRes, E, ws + L.qp, ws + L.wouta, 2048, 2048, (MiniRes{args.in[0], args.in[1], (float*)(ws + L.z), ALPHA_F})); } } } SEAM(3);
    if (IN(4)) { { phase_ln((const float*)(ws + L.z), args.in[16], args.in[17], (float*)(ws + L.xf0), (bf16*)(ws + L.xb), ws + L.xq, (float*)(ws + L.sx), vcu, G, wave, LANE()); } if (DUP(4)) { xcd_barrier(bar); { phase_ln((const float*)(ws + L.z), args.in[16], args.in[17], (float*)(ws + L.xf0), (bf16*)(ws + L.xb), ws + L.xq, (float*)(ws + L.sx), vcu, G, wave, LANE()); } } } SEAM(4);
    if (IN(5)) { { pg8::EpiBf16S E{(pg8::bf16_t*)(ws + L.qp), 2048, 0, 0, 1.f}; GEMM_PHASE(pg8::EpiBf16S, E, ws + L.xb, ws + L.wq, 2048, 2048, (MiniBf16S{(bf16*)(ws + L.qp), 2048, 0, 0})); } if (DUP(5)) { xcd_barrier(bar); { pg8::EpiBf16S E{(pg8::bf16_t*)(ws + L.qp), 2048, 0, 0, 1.f}; GEMM_PHASE(pg8::EpiBf16S, E, ws + L.xb, ws + L.wq, 2048, 2048, (MiniBf16S{(bf16*)(ws + L.qp), 2048, 0, 0})); } } } SEAM(5);
#define RINV_U ((const float*)(ws + L.rinv))
#define RINV_V ((const float*)(ws + L.rinv) + 16384)
    if (IN(6)) { { phase_topk<0>((const bf16*)(ws + L.qp), (const bf16*)(ws + L.sk), (int*)(ws + L.idx), (float*)(ws + L.gt), (float*)(ws + L.ww), (float*)(ws + L.su), RINV_U, RINV_V, lds, vcu, G, wave, LANE()); } if (DUP(6)) { xcd_barrier(bar); { phase_topk<TK_ABL>((const bf16*)(ws + L.qp), (const bf16*)(ws + L.sk), (int*)(ws + L.um), (float*)(ws + L.um + 8388608), (float*)(ws + L.um + 16777216), (float*)(ws + L.um + 25165824), RINV_U, RINV_V, lds, vcu, G, wave, LANE()); } } } SEAM(6);
    if (IN(7)) { { phase_upass_sl<0>((const unsigned char*)(ws + L.ptu), (const unsigned char*)(ws + L.xq), (const float*)(ws + L.sx), (const int*)(ws + L.idx), (float*)(ws + L.ww), (float*)(ws + L.gt), (float*)(ws + L.su), RINV_U, RINV_V, xcd_topology(bar.bar, bar.x, MISC[10], wave), LANE()); } if (DUP(7)) { xcd_barrier(bar); { phase_upass_sl<UP_ABL>((const unsigned char*)(ws + L.ptu), (const unsigned char*)(ws + L.xq), (const float*)(ws + L.sx), (const int*)(ws + L.idx), (float*)(ws + L.um), (float*)(ws + L.gt), (float*)(ws + L.su), RINV_U, RINV_V, xcd_topology(bar.bar, bar.x, MISC[10], wave), LANE()); } } } SEAM(7);
    if (IN(8)) { { phase_vpass_sl<0>((const unsigned char*)(ws + L.ptv), (const float*)(ws + L.xf0), (const int*)(ws + L.idx), (const float*)(ws + L.ww), (const float*)(ws + L.su), (const float*)(ws + L.gt), (float*)(ws + L.z), ALPHA_F, xcd_topology(bar.bar, bar.x, MISC[10], wave), lds, wave, LANE()); } if (DUP(8)) { xcd_barrier(bar); { phase_vpass_sl<VP_ABL>((const unsigned char*)(ws + L.ptv), (const float*)(ws + L.xf0), (const int*)(ws + L.idx), (const float*)(ws + L.ww), (const float*)(ws + L.su), (const float*)(ws + L.gt), (float*)(ws + L.um), ALPHA_F, xcd_topology(bar.bar, bar.x, MISC[10], wave), lds, wave, LANE()); } } } SEAM(8);
    if (IN(9)) { { phase_ln((const float*)(ws + L.z), args.in[18], args.in[19], (float*)(ws + L.xf1), (bf16*)(ws + L.xb), (unsigned char*)nullptr, (float*)nullptr, vcu, G, wave, LANE()); } if (DUP(9)) { xcd_barrier(bar); { phase_ln((const float*)(ws + L.z), args.in[18], args.in[19], (float*)(ws + L.xf1), (bf16*)(ws + L.xb), (unsigned char*)nullptr, (float*)nullptr, vcu, G, wave, LANE()); } } } SEAM(9);
    if (IN(10)) { { pg8::EpiGelu E{(pg8::bf16_t*)(ws + L.ub), (pg8::bf16_t*)(ws + L.vb), args.in[10], (float*)(ws + L.vst)}; GEMM_PHASE_FULL(pg8::EpiGelu, E, ws + L.xb, ws + L.winb, 12288, 2048); } if (DUP(10)) { xcd_barrier(bar); { pg8::EpiGelu E{(pg8::bf16_t*)(ws + L.ub), (pg8::bf16_t*)(ws + L.vb), args.in[10], (float*)(ws + L.vst)}; GEMM_PHASE_FULL(pg8::EpiGelu, E, ws + L.xb, ws + L.winb, 12288, 2048); } } } SEAM(10);
    if (IN(11)) { { phase_spatial<0>((const bf16*)(ws + L.ub), (const bf16*)(ws + L.vb), (const float*)(ws + L.vst), args.in[11], args.in[12], (const bf16*)(ws + L.wsb), args.in[13], args.in[14],
                                (bf16*)(ws + L.um), args.out + OUT_VS, lds, vcu, G, wave, LANE()); } if (DUP(11)) { xcd_barrier(bar); { phase_spatial<SP_ABL>((const bf16*)(ws + L.ub), (const bf16*)(ws + L.vb), (const float*)(ws + L.vst), args.in[11], args.in[12], (const bf16*)(ws + L.wsb), args.in[13], args.in[14],
                                (bf16*)(ws + L.ptu), (float*)(ws + L.ptu1), lds, vcu, G, wave, LANE()); } } } SEAM(11);
    if (IN(12)) { { pg8::EpiRes E{(const float*)(ws + L.xf1), (const float*)(ws + L.xf1) + (size_t)8192 * 2048, (float*)(ws + L.z), ALPHA_F}; GEMM_PHASE(pg8::EpiRes, E, ws + L.um, ws + L.woutb, 2048, 6144, (MiniRes{(const float*)(ws + L.xf1), (const float*)(ws + L.xf1) + (size_t)8192 * 2048, (float*)(ws + L.z), ALPHA_F})); } if (DUP(12)) { xcd_barrier(bar); { pg8::EpiRes E{(const float*)(ws + L.xf1), (const float*)(ws + L.xf1) + (size_t)8192 * 2048, (float*)(ws + L.z), ALPHA_F}; GEMM_PHASE(pg8::EpiRes, E, ws + L.um, ws + L.woutb, 2048, 6144, (MiniRes{(const float*)(ws + L.xf1), (const float*)(ws + L.xf1) + (size_t)8192 * 2048, (float*)(ws + L.z), ALPHA_F})); } } } SEAM(12);
    if (IN(13)) { { phase_ln((const float*)(ws + L.z), args.in[16] + 2048, args.in[17] + 2048, (float*)(ws + L.xf0), (bf16*)(ws + L.xb), ws + L.xq, (float*)(ws + L.sx), vcu, G, wave, LANE()); } if (DUP(13)) { xcd_barrier(bar); { phase_ln((const float*)(ws + L.z), args.in[16] + 2048, args.in[17] + 2048, (float*)(ws + L.xf0), (bf16*)(ws + L.xb), ws + L.xq, (float*)(ws + L.sx), vcu, G, wave, LANE()); } } } SEAM(13);
    if (IN(14)) { { pg8::EpiBf16S E{(pg8::bf16_t*)(ws + L.qp), 2048, 0, 0, 1.f}; GEMM_PHASE(pg8::EpiBf16S, E, ws + L.xb, (bf16*)(ws + L.wq) + (size_t)2048 * 2048, 2048, 2048, (MiniBf16S{(bf16*)(ws + L.qp), 2048, 0, 0})); } if (DUP(14)) { xcd_barrier(bar); { pg8::EpiBf16S E{(pg8::bf16_t*)(ws + L.qp), 2048, 0, 0, 1.f}; GEMM_PHASE(pg8::EpiBf16S, E, ws + L.xb, (bf16*)(ws + L.wq) + (size_t)2048 * 2048, 2048, 2048, (MiniBf16S{(bf16*)(ws + L.qp), 2048, 0, 0})); } } } SEAM(14);
#undef RINV_U
#undef RINV_V
#define RINV_U ((const float*)(ws + L.rinv) + 32768)
#define RINV_V ((const float*)(ws + L.rinv) + 49152)
    if (IN(15)) { { phase_topk<0>((const bf16*)(ws + L.qp), (const bf16*)(ws + L.sk) + (size_t)16 * 128 * 128, (int*)(ws + L.idx), (float*)(ws + L.gt), (float*)(ws + L.ww), (float*)(ws + L.su), RINV_U, RINV_V, lds, vcu, G, wave, LANE()); } if (DUP(15)) { xcd_barrier(bar); { phase_topk<TK_ABL>((const bf16*)(ws + L.qp), (const bf16*)(ws + L.sk) + (size_t)16 * 128 * 128, (int*)(ws + L.um), (float*)(ws + L.um + 8388608), (float*)(ws + L.um + 16777216), (float*)(ws + L.um + 25165824), RINV_U, RINV_V, lds, vcu, G, wave, LANE()); } } } SEAM(15);
    if (IN(16)) { { phase_upass_sl<0>((const unsigned char*)(ws + L.ptu1), (const unsigned char*)(ws + L.xq), (const float*)(ws + L.sx), (const int*)(ws + L.idx), (float*)(ws + L.ww), (float*)(ws + L.gt), (float*)(ws + L.su), RINV_U, RINV_V, xcd_topology(bar.bar, bar.x, MISC[10], wave), LANE()); } if (DUP(16)) { xcd_barrier(bar); { phase_upass_sl<UP_ABL>((const unsigned char*)(ws + L.ptu1), (const unsigned char*)(ws + L.xq), (const float*)(ws + L.sx), (const int*)(ws + L.idx), (float*)(ws + L.um), (float*)(ws + L.gt), (float*)(ws + L.su), RINV_U, RINV_V, xcd_topology(bar.bar, bar.x, MISC[10], wave), LANE()); } } } SEAM(16);
    if (IN(17)) { { phase_vpass_sl<0>((const unsigned char*)(ws + L.ptv1), (const float*)(ws + L.xf0), (const int*)(ws + L.idx), (const float*)(ws + L.ww), (const float*)(ws + L.su), (const float*)(ws + L.gt), (float*)(ws + L.z), ALPHA_F, xcd_topology(bar.bar, bar.x, MISC[10], wave), lds, wave, LANE()); } if (DUP(17)) { xcd_barrier(bar); { phase_vpass_sl<VP_ABL>((const unsigned char*)(ws + L.ptv1), (const float*)(ws + L.xf0), (const int*)(ws + L.idx), (const float*)(ws + L.ww), (const float*)(ws + L.su), (const float*)(ws + L.gt), (float*)(ws + L.um), ALPHA_F, xcd_topology(bar.bar, bar.x, MISC[10], wave), lds, wave, LANE()); } } } SEAM(17);
#ifdef XBAR_EXTRA
    if (IN(17) && IN(18)) { for (int e_ = 0; e_ < XBAR_EXTRA; ++e_) xcd_barrier(bar); }
#endif
    if (IN(18)) { phase_ln((const float*)(ws + L.z), args.in[18] + 2048, args.in[19] + 2048, args.out, nullptr, (unsigned char*)nullptr, (float*)nullptr, vcu, G, wave, LANE()); }
#undef IN
#undef SEAM
#undef GEMM_PHASE
}

static int g_grid = 0;
static bool mk_init() {
    if (g_grid == 0) {
        int dev = 0, cus = 0;
        if (hipGetDevice(&dev) != hipSuccess || hipDeviceGetAttribute(&cus, hipDeviceAttributeMultiprocessorCount, dev) != hipSuccess) { g_grid = -1; return false; }
        if (hipFuncSetAttribute((const void*)mk, hipFuncAttributeMaxDynamicSharedMemorySize, LDS_BYTES) != hipSuccess) { g_grid = -1; return false; }
        (void)hipGetLastError();
        g_grid = cus;
    }
    return g_grid > 0;
}
static void mk_launch(const Args& a0, int lo, int hi, int li, hipStream_t st) {
    Args a = a0; a.ph_lo = lo; a.ph_hi = hi; a.li = li;
    hipLaunchKernelGGL(mk, dim3(g_grid), dim3(NWAVES * 64), LDS_BYTES, st, a);
}
extern "C" void kernel_launch(void* const* d_in, const int* in_sizes, int n_in, void* d_out, int out_size, void* d_ws, size_t ws_size, hipStream_t stream) {
    if (!mk_init()) return;
    constexpr unsigned long long MiB = 1ull << 20;
    Args a{};
    for (int i = 0; i < 24; ++i) a.in[i] = (const float*)d_in[i];
    a.out = (float*)d_out; a.ws = (unsigned char*)d_ws;
    Lay& L = a.L;
    L.ctl = 0; L.wina = 1 * MiB; L.wouta = 25 * MiB; L.winb = 33 * MiB; L.woutb = 81 * MiB; L.wq = 105 * MiB; L.sk = 121 * MiB; L.gates = 122 * MiB; L.vst = 123 * MiB; L.wsb = 124 * MiB;
    L.idx = 125 * MiB; L.gt = 130 * MiB; L.ww = 135 * MiB; L.ptu = 140 * MiB; L.ptv = 204 * MiB; L.xf0 = 268 * MiB; L.xf1 = 336 * MiB; L.z = 404 * MiB; L.xb = 472 * MiB; L.qp = 506 * MiB;
    L.qkvo = 540 * MiB; L.ub = 540 * MiB; L.vb = 642 * MiB; L.um = 744 * MiB; L.ptu1 = 846 * MiB; L.ptv1 = 910 * MiB; L.rinv = 974 * MiB; L.su = 975 * MiB; L.xq = 980 * MiB; L.sx = 997 * MiB;
    (void)hipMemsetAsync((unsigned char*)d_ws + L.ctl, 0, MiB, stream);
    mk_launch(a, 0, 19, 0, stream);
}
```

```cpp
#include <hip/hip_runtime.h>
#include <stdint.h>
#include <math.h>
#define DUPMASK 0u
#define MLSTM_DUPSEL 7
#define GAS __attribute__((address_space(1)))
#define LAS __attribute__((address_space(3)))
typedef unsigned short bf16;
typedef unsigned v4u __attribute__((ext_vector_type(4)));
typedef float f32x4 __attribute__((ext_vector_type(4)));
typedef short bf16x8 __attribute__((ext_vector_type(8)));
typedef GAS unsigned gu32;
typedef GAS unsigned long long gu64;
#define RLX_AGENT __ATOMIC_RELAXED, __HIP_MEMORY_SCOPE_AGENT
#define LDS_WAIT() asm volatile("s_waitcnt lgkmcnt(0)" ::: "memory")
#define VM_WAIT() asm volatile("s_waitcnt vmcnt(0)" ::: "memory")
__device__ __forceinline__ unsigned long long rt() { return __builtin_amdgcn_s_memrealtime(); }
__device__ __forceinline__ unsigned f2bf(float f) { unsigned u = __builtin_bit_cast(unsigned, f); return (u + 0x7fffu + ((u >> 16) & 1u)) >> 16; }
__device__ __forceinline__ unsigned pk2(float lo, float hi) { unsigned r; asm("v_cvt_pk_bf16_f32 %0, %1, %2" : "=v"(r) : "v"(lo), "v"(hi)); return r; }

#define XB_TMO      128
#define XB_XCNT(j)  (256  + 64 * (j))
#define XB_XSUB(j)  (1280 + 64 * (j))
#define XB_XGEN(j)  (2304 + 64 * (j))
#define XB_TOP      3328
#define XB_TOPGEN   3392
#define XCD_BAR_WORDS 3456
#define XB_SPIN_CAP (1u << 22)

__device__ __forceinline__ unsigned xb_ld(unsigned* p)              { return __hip_atomic_load(p, __ATOMIC_RELAXED, __HIP_MEMORY_SCOPE_AGENT); }
__device__ __forceinline__ unsigned xb_add(unsigned* p, unsigned v) { return __hip_atomic_fetch_add(p, v, __ATOMIC_RELAXED, __HIP_MEMORY_SCOPE_AGENT); }
__device__ __forceinline__ unsigned xb_xcc_id() { return (unsigned)__builtin_amdgcn_s_getreg((3 << 11) | 20) & 0xFu; }
#define XB_SPIN(cond, bar) do { unsigned _sp = 0; while (cond) { __builtin_amdgcn_s_sleep(1); \
    if ((++_sp & 255u) == 0u) { if (xb_ld(&(bar)[XB_TMO])) break; if (_sp > XB_SPIN_CAP) { atomicAdd(&(bar)[XB_TMO], 1u); break; } } } } while (0)

struct XcdBarrier {
    unsigned* bar; unsigned x;
    volatile LAS unsigned* st;
};

__device__ __forceinline__ XcdBarrier xcd_barrier_post(unsigned* bar, volatile LAS unsigned* st) {
    XcdBarrier b; b.bar = bar; b.x = xb_xcc_id(); b.st = st;
    if (threadIdx.x == 0) st[2] = xb_add(&bar[XB_XCNT(b.x)], 1u);
    return b;
}
__device__ __forceinline__ void xcd_barrier_complete(unsigned* bar, unsigned x, unsigned& nloc, unsigned& nx) {
    const unsigned G = gridDim.x * gridDim.y * gridDim.z;
    unsigned sum, cnt, mine, sp = 0u;
    for (;;) {
        sum = 0u; cnt = 0u; mine = 0u;
#pragma unroll
        for (unsigned j = 0; j < 16; ++j) { const unsigned c = xb_ld(&bar[XB_XCNT(j)]); sum += c; cnt += (c > 0u) ? 1u : 0u; mine = (j == x) ? c : mine; }
        if (sum == G) break;
        __builtin_amdgcn_s_sleep(1);
        if ((++sp & 255u) == 0u) { if (xb_ld(&bar[XB_TMO])) break; if (sp > XB_SPIN_CAP) { atomicAdd(&bar[XB_TMO], 1u); break; } }
    }
    nloc = mine > 0u ? mine : 1u; nx = cnt > 0u ? cnt : 1u;
}

__device__ __forceinline__ void xcd_barrier(const XcdBarrier& b) {
    asm volatile("s_waitcnt vmcnt(0)" ::: "memory");
    __syncthreads();
    if (threadIdx.x == 0) {
        unsigned* bar = b.bar;
        __builtin_amdgcn_s_waitcnt(0);
        unsigned nloc = b.st[0], nx = b.st[1];
        if (nloc == 0u) { xcd_barrier_complete(bar, b.x, nloc, nx); b.st[0] = nloc; b.st[1] = nx; }
        const unsigned old = xb_add(&bar[XB_XSUB(b.x)], 1u);
        const unsigned gen = old / nloc;
        if (old + 1u == (gen + 1u) * nloc) {
            __builtin_amdgcn_fence(__ATOMIC_RELEASE, "agent");
            asm volatile("s_waitcnt vmcnt(0)" ::: "memory");
            const unsigned og = xb_add(&bar[XB_TOP], 1u);
            const unsigned tg = og / nx;
            if (og + 1u == (tg + 1u) * nx) xb_add(&bar[XB_TOPGEN], 1u);
            else XB_SPIN(xb_ld(&bar[XB_TOPGEN]) == tg, bar);
            __builtin_amdgcn_fence(__ATOMIC_ACQUIRE, "agent");
            xb_add(&bar[XB_XGEN(b.x)], 1u);
            asm volatile("s_waitcnt vmcnt(0)" ::: "memory");
        } else {
            XB_SPIN(xb_ld(&bar[XB_XGEN(b.x)]) == gen, bar);
            __builtin_amdgcn_fence(__ATOMIC_ACQUIRE, "agent");
            asm volatile("s_waitcnt vmcnt(0)" ::: "memory");
        }
    }
    __syncthreads();
}

namespace pg8 {
#define PG8_LAS __attribute__((address_space(3)))
typedef unsigned short bf16_t;
typedef short bf16x8 __attribute__((ext_vector_type(8)));
typedef float f32x4 __attribute__((ext_vector_type(4)));
typedef unsigned u32x4 __attribute__((ext_vector_type(4)));
constexpr int BM = 256, BK = 64, HALF = 128, HTB = HALF * BK * 2  , STAGE_BYTES = 8 * HTB, NXCD = 8, WGM = 8;

__host__ __device__ __forceinline__ int lds_byte(int r, int c) { const int st = (r >> 4) * 2 + (c >> 5), rr = r & 15, cc = c & 31, ob = rr * 64 + cc * 2; return st * 1024 + (ob ^ (((ob >> 9) & 1) << 5)); }
__host__ __device__ __forceinline__ void stage_rc(int b, int& R, int& C) { const int st = b / 1024, sb = b % 1024, swz = sb ^ (((sb >> 9) & 1) << 5); R = (st >> 1) * 16 + swz / 64; C = (st & 1) * 32 + (swz % 64) / 2; }
__host__ __device__ __forceinline__ int perm32(int rho) { const int n = rho >> 4, i = rho & 15; return 8 * (i >> 2) + 4 * n + (i & 3); }

struct Unit { int pm, pn; };
struct Gemm { const bf16_t* A; const bf16_t* Bt; int M, N, K; };

struct StaticOrder {
    int nM, nN, nwg, G, c;
    __host__ __device__ void init(int M, int N, int G_, int c_) { nM = M / BM; nN = N / BM; nwg = nM * nN; G = G_; c = c_; }
    __host__ __device__ bool next(int i, Unit& u) const {
        const long L = (long)i * G + c; if (L >= nwg) return false;
        int wgid = (int)L; { const int q = nwg / NXCD, r = nwg % NXCD, xcd = wgid % NXCD, off = wgid / NXCD; wgid = (xcd < r ? xcd * (q + 1) : r * (q + 1) + (xcd - r) * q) + off; }
        const int nig = WGM * nN, gid = wgid / nig, fm = gid * WGM, gsz = (nM - fm) < WGM ? (nM - fm) : WGM;
        u.pm = fm + ((wgid % nig) % gsz); u.pn = (wgid % nig) / gsz; return true;
    }
    __device__ __forceinline__ void a_ready(const Unit&) const {}
    __device__ __forceinline__ void done(const Unit&) const {}
};


__device__ __forceinline__ unsigned cvt_pk_bf16(float lo, float hi) { unsigned r; asm volatile("v_cvt_pk_bf16_f32 %0, %1, %2" : "=v"(r) : "v"(lo), "v"(hi)); return r; }
__device__ __forceinline__ float gelu_tanh_f(float x) { const float u = x + 0.044715f * x * x * x; const float e = __builtin_amdgcn_exp2f(u * -2.302208198f); return x * __builtin_amdgcn_rcpf(1.0f + e); }
struct EpiBf16S {
    static constexpr bool PERM = true, AFTER_DRAIN = false;
    bf16_t* O; int ldc; int sc_lo, sc_hi; float sc;
    __device__ __forceinline__ void operator()(const f32x4 (&acc)[2][2][4][2], const Unit& u, int wr, int wc, int fr, int fq) const {
        const int row0 = u.pm * BM + wr * 64 + fr; const int colt = u.pn * BM;
        const float s = (colt >= sc_lo && colt < sc_hi) ? sc : 1.f;
        const int col0 = colt + wc * 32 + 8 * fq;
#pragma unroll
        for (int ai = 0; ai < 2; ++ai)
#pragma unroll
            for (int m = 0; m < 4; ++m) { bf16_t* rowp = O + (size_t)(row0 + ai * HALF + m * 16) * ldc + col0;
#pragma unroll
                for (int bj = 0; bj < 2; ++bj) { const f32x4 v0 = acc[ai][bj][m][0] * s, v1 = acc[ai][bj][m][1] * s;
                    u32x4 w; w.x = cvt_pk_bf16(v0[0], v0[1]); w.y = cvt_pk_bf16(v0[2], v0[3]); w.z = cvt_pk_bf16(v1[0], v1[1]); w.w = cvt_pk_bf16(v1[2], v1[3]);
                    *(u32x4*)(rowp + bj * HALF) = w; } }
    }
};
struct EpiRes {
    static constexpr bool PERM = false, AFTER_DRAIN = false;
    const float* res0; const float* res1; float* Z; float alpha;
    __device__ __forceinline__ void operator()(const f32x4 (&acc)[2][2][4][2], const Unit& u, int wr, int wc, int fr, int fq) const {
        const int col0 = u.pn * BM + wc * 32 + 4 * fq;
#pragma unroll
        for (int ai = 0; ai < 2; ++ai)
#pragma unroll
            for (int m = 0; m < 4; ++m) { const int r = u.pm * BM + ai * HALF + wr * 64 + m * 16 + fr;
                const float* rp = (r < 8192) ? res0 + (size_t)r * 2048 : res1 + (size_t)(r - 8192) * 2048; float* zp = Z + (size_t)r * 2048;
#pragma unroll
                for (int bj = 0; bj < 2; ++bj)
#pragma unroll
                    for (int n = 0; n < 2; ++n) { const int c = col0 + bj * HALF + n * 16; const f32x4 x = *(const f32x4*)(rp + c); *(f32x4*)(zp + c) = x * alpha + acc[ai][bj][m][n]; } }
    }
};
struct EpiGelu {
    static constexpr bool PERM = true, AFTER_DRAIN = false;
    bf16_t* U; bf16_t* V; const float* bias; float* VST;
    __device__ __forceinline__ void operator()(const f32x4 (&acc)[2][2][4][2], const Unit& u, int wr, int wc, int fr, int fq) const {
        const int row0 = u.pm * BM + wr * 64 + fr; const bool isv = u.pn >= 24; const int colt = (isv ? u.pn - 24 : u.pn) * BM;
        bf16_t* base = isv ? V : U;
        const int col0 = colt + wc * 32 + 8 * fq, bcol0 = u.pn * BM + wc * 32 + 8 * fq;
        f32x4 bv[2][2];
#pragma unroll
        for (int bj = 0; bj < 2; ++bj)
#pragma unroll
            for (int n = 0; n < 2; ++n) bv[bj][n] = *(const f32x4*)(bias + bcol0 + bj * HALF + 4 * n);
#pragma unroll
        for (int ai = 0; ai < 2; ++ai)
#pragma unroll
            for (int m = 0; m < 4; ++m) { const int r = row0 + ai * HALF + m * 16; bf16_t* rowp = base + (size_t)r * 6144 + col0; float s1 = 0.f, s2 = 0.f;
#pragma unroll
                for (int bj = 0; bj < 2; ++bj) { f32x4 v0 = acc[ai][bj][m][0] + bv[bj][0], v1 = acc[ai][bj][m][1] + bv[bj][1];
#pragma unroll
                    for (int e = 0; e < 4; ++e) { v0[e] = gelu_tanh_f(v0[e]); v1[e] = gelu_tanh_f(v1[e]); s1 += v0[e] + v1[e]; s2 += v0[e] * v0[e] + v1[e] * v1[e]; }
                    u32x4 w; w.x = cvt_pk_bf16(v0[0], v0[1]); w.y = cvt_pk_bf16(v0[2], v0[3]); w.z = cvt_pk_bf16(v1[0], v1[1]); w.w = cvt_pk_bf16(v1[2], v1[3]);
                    *(u32x4*)(rowp + bj * HALF) = w; }
                if (isv) { s1 += __shfl_xor(s1, 16); s1 += __shfl_xor(s1, 32); s2 += __shfl_xor(s2, 16); s2 += __shfl_xor(s2, 32);
                    if (fq == 0) { atomicAdd(VST + 2 * r, s1); atomicAdd(VST + 2 * r + 1, s2); } } }
    }
};
template <class Epi, class Sched, bool ALIGN_EPI = false, bool SP2 = false>
__device__ __forceinline__ void gemm_phase(PG8_LAS unsigned char* lds, const Gemm g, const Sched& S, const Epi& E) {
    int tid_l = threadIdx.x; asm volatile("" : "+v"(tid_l));
    const int tid = tid_l, wid = __builtin_amdgcn_readfirstlane(tid >> 6), lane = tid & 63, wr = wid >> 2, wc = wid & 3, fr = lane & 15, fq = lane >> 4;
    const int K = g.K, nt = K / BK;
    unsigned voffA[2], voffB[2];
#pragma unroll
    for (int i = 0; i < 2; ++i) { int R, C; stage_rc(tid * 16 + i * 8192, R, C); const int Rb = Epi::PERM ? ((R & ~31) + perm32(R & 31)) : R;
        voffA[i] = (unsigned)(R * K + C) * 2u; voffB[i] = (unsigned)(Rb * K + C) * 2u; }
    const size_t kstep = (size_t)(BK * 2);
    const size_t hstep = (size_t)HALF * K * 2;
    const size_t tstep = 2 * hstep;
    const unsigned ldsw = (unsigned)wid * 1024u;
    const int aoff = lds_byte(wr * 64 + fr, fq * 8), boff = lds_byte(wc * 32 + fr, fq * 8);
#define PG8_SA(b, h) (((b) * 2 + (h)) * HTB)
#define PG8_SB(b, h) ((4 + (b) * 2 + (h)) * HTB)
#define PG8_STAGE(bufoff, gbase, voff) do { _Pragma("unroll") for (int _i = 0; _i < 2; ++_i) \
        __builtin_amdgcn_global_load_lds((const unsigned*)((const char*)(gbase) + (voff)[_i]), (PG8_LAS unsigned*)(lds + (bufoff) + ldsw + _i * 8192), 16, 0, 0); } while (0)
#define PG8_LDA(dst, b, h) do { _Pragma("unroll") for (int m = 0; m < 4; ++m) _Pragma("unroll") for (int k = 0; k < 2; ++k) dst[m][k] = *(const PG8_LAS bf16x8*)(lds + PG8_SA(b, h) + aoff + m * 2048 + k * 1024); } while (0)
#define PG8_LDB(dst, b, h) do { _Pragma("unroll") for (int n = 0; n < 2; ++n) _Pragma("unroll") for (int k = 0; k < 2; ++k) dst[n][k] = *(const PG8_LAS bf16x8*)(lds + PG8_SB(b, h) + boff + n * 2048 + k * 1024); } while (0)
#define PG8_MMA(ai, bj, At, Bt) do { __builtin_amdgcn_s_setprio(1); _Pragma("unroll") for (int m = 0; m < 4; ++m) _Pragma("unroll") for (int n = 0; n < 2; ++n) _Pragma("unroll") for (int k = 0; k < 2; ++k) \
        acc[ai][bj][m][n] = __builtin_amdgcn_mfma_f32_16x16x32_bf16(Bt[n][k], At[m][k], acc[ai][bj][m][n], 0, 0, 0); __builtin_amdgcn_s_setprio(0); } while (0)
#define PG8_WAIT_V(n) asm volatile("s_waitcnt vmcnt(" #n ")" ::: "memory")
#define PG8_WAIT_L(n) asm volatile("s_waitcnt lgkmcnt(" #n ")" ::: "memory")
#define PG8_BAR __builtin_amdgcn_s_barrier()
#define PG8_SCHED __builtin_amdgcn_sched_barrier(0)
    Unit cur, nxt; int ui = 0;
    if (!S.next(0, cur)) return;
    f32x4 acc[2][2][4][2];
#pragma unroll
    for (int a = 0; a < 2; ++a)
#pragma unroll
        for (int b = 0; b < 2; ++b)
#pragma unroll
            for (int m = 0; m < 4; ++m)
#pragma unroll
                for (int n = 0; n < 2; ++n) acc[a][b][m][n] = (f32x4){0.f, 0.f, 0.f, 0.f};
    bf16x8 At[4][2], B0[2][2], B1[2][2];
    const char* cA = (const char*)g.A + (size_t)cur.pm * tstep; const char* cB = (const char*)g.Bt + (size_t)cur.pn * tstep;
    S.a_ready(cur);
    if constexpr (SP2) {
        PG8_STAGE(PG8_SB(0, 0), cB, voffB); PG8_STAGE(PG8_SB(0, 1), cB + hstep, voffB); PG8_STAGE(PG8_SA(0, 0), cA, voffA); PG8_STAGE(PG8_SA(0, 1), cA + hstep, voffA);
        if (wr == 1) PG8_BAR;
        PG8_WAIT_V(2); PG8_BAR;
        PG8_STAGE(PG8_SB(1, 0), cB + kstep, voffB); PG8_STAGE(PG8_SA(1, 0), cA + kstep, voffA); PG8_STAGE(PG8_SB(1, 1), cB + hstep + kstep, voffB);
        PG8_WAIT_V(6); PG8_BAR;
    } else {
        PG8_STAGE(PG8_SB(0, 0), cB, voffB); PG8_STAGE(PG8_SA(0, 0), cA, voffA); PG8_STAGE(PG8_SB(0, 1), cB + hstep, voffB); PG8_STAGE(PG8_SA(0, 1), cA + hstep, voffA);
        if (wr == 1) PG8_BAR;
        PG8_WAIT_V(4); PG8_BAR;
        PG8_STAGE(PG8_SB(1, 0), cB + kstep, voffB); PG8_STAGE(PG8_SA(1, 0), cA + kstep, voffA); PG8_STAGE(PG8_SB(1, 1), cB + hstep + kstep, voffB);
        PG8_WAIT_V(6); PG8_BAR;
    }
    for (;;) {
        const bool has_next = S.next(ui + 1, nxt);
        const char* nA = has_next ? (const char*)g.A + (size_t)nxt.pm * tstep : cA; const char* nB = has_next ? (const char*)g.Bt + (size_t)nxt.pn * tstep : cB;
        for (int t = 0; t < nt; t += 2) {
            const bool last = (t == nt - 2);
            const char* a1 = cA + (size_t)(t + 1) * kstep;
            const char* a2 = last ? nA : cA + (size_t)(t + 2) * kstep; const char* b2 = last ? nB : cB + (size_t)(t + 2) * kstep;
            const char* a3 = a2 + kstep; const char* b3 = b2 + kstep;
            if (last && has_next) S.a_ready(nxt);
            if constexpr (SP2) {
            PG8_LDB(B0, 0, 0); PG8_LDB(B1, 0, 1); PG8_SCHED; PG8_LDA(At, 0, 0); PG8_STAGE(PG8_SA(1, 1), a1 + hstep, voffA);
            PG8_WAIT_V(8); PG8_WAIT_L(0); PG8_BAR; PG8_MMA(0, 0, At, B0); PG8_MMA(0, 1, At, B1); PG8_BAR; PG8_SCHED;
            PG8_LDA(At, 0, 1); PG8_STAGE(PG8_SB(0, 0), b2, voffB); PG8_STAGE(PG8_SB(0, 1), b2 + hstep, voffB); PG8_STAGE(PG8_SA(0, 0), a2, voffA);
            PG8_WAIT_V(8); PG8_WAIT_L(0); PG8_BAR; PG8_MMA(1, 0, At, B0); PG8_MMA(1, 1, At, B1); PG8_BAR; PG8_SCHED;
            PG8_LDB(B0, 1, 0); PG8_LDB(B1, 1, 1); PG8_SCHED; PG8_LDA(At, 1, 0); PG8_STAGE(PG8_SA(0, 1), a2 + hstep, voffA);
            PG8_WAIT_V(8); PG8_WAIT_L(0); PG8_BAR; PG8_MMA(0, 0, At, B0); PG8_MMA(0, 1, At, B1); PG8_BAR; PG8_SCHED;
            PG8_LDA(At, 1, 1); PG8_STAGE(PG8_SB(1, 0), b3, voffB); PG8_STAGE(PG8_SB(1, 1), b3 + hstep, voffB); PG8_STAGE(PG8_SA(1, 0), a3, voffA);
            PG8_WAIT_V(8); PG8_WAIT_L(0); PG8_BAR; PG8_MMA(1, 0, At, B0); PG8_MMA(1, 1, At, B1); PG8_BAR; PG8_SCHED;
            } else {
            PG8_LDB(B0, 0, 0); PG8_SCHED; PG8_LDA(At, 0, 0); PG8_STAGE(PG8_SA(1, 1), a1 + hstep, voffA);
            PG8_WAIT_L(8); PG8_BAR; PG8_WAIT_L(0); PG8_MMA(0, 0, At, B0); PG8_BAR; PG8_SCHED;
            PG8_LDB(B1, 0, 1); PG8_STAGE(PG8_SB(0, 0), b2, voffB);
            PG8_BAR; PG8_WAIT_L(0); PG8_MMA(0, 1, At, B1); PG8_BAR;
            PG8_LDA(At, 0, 1); PG8_STAGE(PG8_SA(0, 0), a2, voffA);
            PG8_BAR; PG8_WAIT_L(0); PG8_MMA(1, 0, At, B0); PG8_BAR; PG8_SCHED;
            PG8_STAGE(PG8_SB(0, 1), b2 + hstep, voffB);
            PG8_WAIT_V(6); PG8_BAR; PG8_MMA(1, 1, At, B1); PG8_BAR;
            PG8_LDB(B0, 1, 0); PG8_SCHED; PG8_LDA(At, 1, 0); PG8_STAGE(PG8_SA(0, 1), a2 + hstep, voffA);
            PG8_WAIT_L(8); PG8_BAR; PG8_WAIT_L(0); PG8_MMA(0, 0, At, B0); PG8_BAR; PG8_SCHED;
            PG8_LDB(B1, 1, 1); PG8_STAGE(PG8_SB(1, 0), b3, voffB);
            PG8_BAR; PG8_WAIT_L(0); PG8_MMA(0, 1, At, B1); PG8_BAR;
            PG8_LDA(At, 1, 1); PG8_STAGE(PG8_SA(1, 0), a3, voffA);
            PG8_BAR; PG8_WAIT_L(0); PG8_MMA(1, 0, At, B0); PG8_BAR; PG8_SCHED;
            PG8_STAGE(PG8_SB(1, 1), b3 + hstep, voffB);
            PG8_WAIT_V(6); PG8_BAR; PG8_MMA(1, 1, At, B1); PG8_BAR;
            }
        }
        if constexpr (ALIGN_EPI) { if (wr == 0) PG8_BAR; }
        if constexpr (!Epi::AFTER_DRAIN) { E(acc, cur, wr, wc, fr, fq); S.done(cur); }
        if (!has_next) break;
#pragma unroll
        for (int a = 0; a < 2; ++a)
#pragma unroll
            for (int b = 0; b < 2; ++b)
#pragma unroll
                for (int m = 0; m < 4; ++m)
#pragma unroll
                    for (int n = 0; n < 2; ++n) acc[a][b][m][n] = (f32x4){0.f, 0.f, 0.f, 0.f};
        cur = nxt; cA = nA; cB = nB; ++ui;
        if constexpr (ALIGN_EPI) { if (wr == 1) PG8_BAR; }
    }
    PG8_WAIT_V(0);
    if constexpr (!ALIGN_EPI) { if (wr == 0) PG8_BAR; }
    PG8_BAR;
    if constexpr (Epi::AFTER_DRAIN) { E.fused(acc, cur, wr, wc, fr, fq, lds, wid, lane); S.done(cur); }
#undef PG8_SA
#undef PG8_SB
#undef PG8_STAGE
#undef PG8_LDA
#undef PG8_LDB
#undef PG8_MMA
#undef PG8_WAIT_V
#undef PG8_WAIT_L
#undef PG8_BAR
#undef PG8_SCHED
}
}
constexpr int NWAVES = 8;
constexpr int LDS_BYTES = 147456;
constexpr int RING_BYTES = 131072;
constexpr int MISC_OFF = RING_BYTES + 320;
constexpr int NTOKF = 8704;
constexpr float ALPHA_F = 1.4142135623730951f;
constexpr size_t OUT_VS = 52565024;

struct Lay {
    unsigned long long ctl, wina, wouta, winb, woutb, wq, sk, gates, vst, idx, gt, ww, ptu, ptv, xf0, xf1, z, xb, qp, qkvo, ub, vb, um, wsb, ptu1, ptv1, rinv, su, xq, sx;
};
struct Args { const float* in[24]; float* out; unsigned char* ws; Lay L; int ph_lo, ph_hi, li, pad; };

__device__ __forceinline__ float wave_sum_f(float v) {
#pragma unroll
    for (int o = 1; o < 64; o <<= 1) v += __shfl_xor(v, o);
    return v;
}
__device__ __forceinline__ void p0_transpose_item(const float* W, int K, int ldw, int Nuse, bf16* WT, LAS float* scr, int item, int lane) {
    const int nblk = Nuse / 32, kb = item / nblk, nb = item % nblk, k0 = 64 * kb, n0 = 32 * nb;
    f32x4 ld[8];
#pragma unroll
    for (int i = 0; i < 8; ++i) ld[i] = __builtin_nontemporal_load((const GAS f32x4*)(W + (size_t)(k0 + 8 * i + (lane >> 3)) * ldw + n0 + (lane & 7) * 4));
#pragma unroll
    for (int i = 0; i < 8; ++i) { LAS float* d = scr + (8 * i + (lane >> 3)) * 33 + (lane & 7) * 4; d[0] = ld[i].x; d[1] = ld[i].y; d[2] = ld[i].z; d[3] = ld[i].w; }
    LDS_WAIT(); asm volatile("" ::: "memory");
    const int c = lane & 7;
#pragma unroll
    for (int j = 0; j < 4; ++j) { const int n = (lane >> 3) + 8 * j; const LAS float* s = scr + (8 * c) * 33 + n;
        v4u o; o.x = pk2(s[0 * 33], s[1 * 33]); o.y = pk2(s[2 * 33], s[3 * 33]); o.z = pk2(s[4 * 33], s[5 * 33]); o.w = pk2(s[6 * 33], s[7 * 33]);
        *(GAS v4u*)(WT + (size_t)(n0 + n) * K + k0 + 8 * c) = o; }
    LDS_WAIT(); asm volatile("" ::: "memory");
}
__device__ __forceinline__ void cvt_stream(const float* src, bf16* dst, size_t n8, int gw, int NGW, int lane) {
    for (size_t i = (size_t)gw * 64 + lane; i < n8; i += (size_t)NGW * 64) {
        const f32x4 a = *(const GAS f32x4*)(src + i * 8), b = *(const GAS f32x4*)(src + i * 8 + 4);
        v4u o; o.x = pk2(a.x, a.y); o.y = pk2(a.z, a.w); o.z = pk2(b.x, b.y); o.w = pk2(b.z, b.w);
        *(GAS v4u*)(dst + i * 8) = o;
    }
}
__device__ __forceinline__ void cvt_peer_table(const float* src, bf16* dst, int gw, int NGW, int lane) {
    const size_t n8 = (size_t)16384 * 2048 / 8;
    for (size_t i = (size_t)gw * 64 + lane; i < n8; i += (size_t)NGW * 64) {
        const f32x4 a = __builtin_nontemporal_load((const GAS f32x4*)(src + i * 8)), b = __builtin_nontemporal_load((const GAS f32x4*)(src + i * 8 + 4));
        v4u o; o.x = pk2(a.x, a.y); o.y = pk2(a.z, a.w); o.z = pk2(b.x, b.y); o.w = pk2(b.z, b.w);
        const size_t e = i >> 8; const int c8 = (int)(i & 255) * 8;
        *(GAS v4u*)(dst + ((size_t)(c8 >> 6) * 16384 + e) * 64 + (c8 & 63)) = o;
    }
}
__device__ __forceinline__ void cvt_peer_table_fp8(const float* src, unsigned char* dst, float* rinv, int gw, int NGW, int lane) {
    f32x4 nx[8];
    if (gw < 16384) {
#pragma unroll
        for (int j = 0; j < 8; ++j) nx[j] = __builtin_nontemporal_load((const GAS f32x4*)(src + (size_t)gw * 2048 + j * 256 + lane * 4)); }
    for (int e = gw; e < 16384; e += NGW) {
        f32x4 v[8]; float am = 0.f;
#pragma unroll
        for (int j = 0; j < 8; ++j) { v[j] = nx[j]; am = fmaxf(am, fmaxf(fmaxf(fabsf(v[j].x), fabsf(v[j].y)), fmaxf(fabsf(v[j].z), fabsf(v[j].w)))); }
        if (e + NGW < 16384) {
#pragma unroll
            for (int j = 0; j < 8; ++j) nx[j] = __builtin_nontemporal_load((const GAS f32x4*)(src + (size_t)(e + NGW) * 2048 + j * 256 + lane * 4)); }
#pragma unroll
        for (int o = 1; o < 64; o <<= 1) am = fmaxf(am, __shfl_xor(am, o));
        const float sc = (am > 0.f) ? exp2f(floorf(log2f(224.f / am))) : 1.f;
        if (lane == 0) rinv[e] = 1.f / sc;
#pragma unroll
        for (int j = 0; j < 8; ++j) { unsigned p = __builtin_amdgcn_cvt_pk_fp8_f32(v[j].x * sc, v[j].y * sc, 0u, false); p = __builtin_amdgcn_cvt_pk_fp8_f32(v[j].z * sc, v[j].w * sc, p, true);
            const int w = lane & 31, pw = ((((w >> 2) & 1) * 4 + (w & 3)) << 2) + ((w >> 4) & 1) * 2 + ((w >> 3) & 1);
            *(GAS unsigned*)(dst + ((size_t)(2 * j + (lane >> 5)) * 16384 + e) * 128 + pw * 4) = p; }
    }
}
__device__ __forceinline__ unsigned pack_i8x4(f32x4 v, float sc) { const int a = __float2int_rn(v.x * sc), b = __float2int_rn(v.y * sc), c = __float2int_rn(v.z * sc), d = __float2int_rn(v.w * sc);
    return (unsigned)(a & 0xFF) | ((unsigned)(b & 0xFF) << 8) | ((unsigned)(c & 0xFF) << 16) | ((unsigned)d << 24); }
__device__ __forceinline__ void cvt_peer_table_i8(const float* src, unsigned char* dst, float* rinv, int gw, int NGW, int lane) {
    f32x4 nx[8];
    if (gw < 16384) {
#pragma unroll
        for (int j = 0; j < 8; ++j) nx[j] = __builtin_nontemporal_load((const GAS f32x4*)(src + (size_t)gw * 2048 + j * 256 + lane * 4)); }
    for (int e = gw; e < 16384; e += NGW) {
        f32x4 v[8]; float am = 0.f;
#pragma unroll
        for (int j = 0; j < 8; ++j) { v[j] = nx[j]; am = fmaxf(am, fmaxf(fmaxf(fabsf(v[j].x), fabsf(v[j].y)), fmaxf(fabsf(v[j].z), fabsf(v[j].w)))); }
        if (e + NGW < 16384) {
#pragma unroll
            for (int j = 0; j < 8; ++j) nx[j] = __builtin_nontemporal_load((const GAS f32x4*)(src + (size_t)(e + NGW) * 2048 + j * 256 + lane * 4)); }
#pragma unroll
        for (int o = 1; o < 64; o <<= 1) am = fmaxf(am, __shfl_xor(am, o));
        const float sc = (am > 0.f) ? 127.f / am : 0.f;
        if (lane == 0) rinv[e] = am * (1.f / 127.f);
#pragma unroll
        for (int j = 0; j < 8; ++j) *(GAS unsigned*)(dst + ((size_t)(2 * j + (lane >> 5)) * 16384 + e) * 128 + (lane & 31) * 4) = pack_i8x4(v[j], sc);
    }
}
__device__ __forceinline__ const float* xrow_in(const Args& a, int r) { return r < 8192 ? a.in[0] + (size_t)r * 2048 : a.in[1] + (size_t)(r - 8192) * 2048; }

__device__ __forceinline__ void phase_prologue(const Args& a, LAS unsigned char* lds, int vcu, int G, int wave, int lane) {
    unsigned char* ws = a.ws;
    LAS float* scr = (LAS float*)(lds + wave * 16384);
    const int gw = vcu * NWAVES + wave, NGW = G * NWAVES;
    for (int it = gw; it < 32 * 192; it += NGW) p0_transpose_item(a.in[5], 2048, 6160, 6144, (bf16*)(ws + a.L.wina), scr, it, lane);
    __syncthreads();
    { LAS f32x4* wg = (LAS f32x4*)lds; const float* w = a.in[5];
      for (int i = threadIdx.x; i < 2048 * 4; i += NWAVES * 64) { const int k = i >> 2, q4 = i & 3; wg[(k >> 2) * 16 + ((((k & 3) * 4 + q4)) ^ ((k >> 2) & 15))] = *(const GAS f32x4*)(w + (size_t)k * 6160 + 6144 + q4 * 4); } }
    __syncthreads();
    const float* bg = a.in[6];
    for (int r = gw; r < NTOKF; r += NGW) {
        const float* xr = xrow_in(a, r);
        GAS unsigned long long* o8 = (GAS unsigned long long*)((bf16*)(ws + a.L.xb) + (size_t)r * 2048) + lane;
        float g[16];
#pragma unroll
        for (int q = 0; q < 16; ++q) g[q] = 0.f;
#pragma unroll 1
        for (int j = 0; j < 8; ++j) {
            const f32x4 xv = *(const GAS f32x4*)(xr + j * 256 + lane * 4);
            o8[64 * j] = (unsigned long long)pk2(xv.x, xv.y) | ((unsigned long long)pk2(xv.z, xv.w) << 32);
            const int kq = j * 64 + lane;
#pragma unroll
            for (int e = 0; e < 4; ++e) { const float x = xv[e];
#pragma unroll
                for (int q4 = 0; q4 < 4; ++q4) { const f32x4 w4 = ((const LAS f32x4*)lds)[kq * 16 + ((e * 4 + q4) ^ (kq & 15))]; g[q4 * 4 + 0] += x * w4.x; g[q4 * 4 + 1] += x * w4.y; g[q4 * 4 + 2] += x * w4.z; g[q4 * 4 + 3] += x * w4.w; } }
        }
        float mine = 0.f;
#pragma unroll
        for (int q = 0; q < 16; ++q) { const float s = wave_sum_f(g[q]); if (lane == q) mine = s; }
        if (lane < 16) { float v = mine + bg[lane]; if (lane >= 8) v = fminf(v, 0.f) - log1pf(expf(-fabsf(v))); ((float*)(ws + a.L.gates))[(size_t)r * 16 + lane] = v; }
    }
    __syncthreads();
}

__device__ __forceinline__ void side_convert(const Args& a, LAS unsigned char* lds, int gw, int NGW, int wave, int lane, int parts) {
    unsigned char* ws = a.ws;
    LAS float* scr = (LAS float*)(lds + wave * 16384);
    constexpr int I_OA = 32 * 64, I_B = 32 * 384, I_OB = 96 * 64, I_Q = 32 * 64;
    constexpr int NITEMS = I_OA + I_B + I_OB + 2 * I_Q;
    if (parts & 1) for (int it = gw; it < NITEMS; it += NGW) {
        int r = it;
        if (r < I_OA) { p0_transpose_item(a.in[8], 2048, 2048, 2048, (bf16*)(ws + a.L.wouta), scr, r, lane); continue; } r -= I_OA;
        if (r < I_B) { p0_transpose_item(a.in[9], 2048, 12288, 12288, (bf16*)(ws + a.L.winb), scr, r, lane); continue; } r -= I_B;
        if (r < I_OB) { p0_transpose_item(a.in[15], 6144, 2048, 2048, (bf16*)(ws + a.L.woutb), scr, r, lane); continue; } r -= I_OB;
        if (r < I_Q) { p0_transpose_item(a.in[20], 2048, 2048, 2048, (bf16*)(ws + a.L.wq), scr, r, lane); continue; } r -= I_Q;
        p0_transpose_item(a.in[20] + (size_t)2048 * 2048, 2048, 2048, 2048, (bf16*)(ws + a.L.wq) + (size_t)2048 * 2048, scr, r, lane);
    }
    if (parts & 2) { float* ri = (float*)(ws + a.L.rinv);
      cvt_peer_table_i8(a.in[22], ws + a.L.ptu, ri, gw, NGW, lane);
      cvt_peer_table_fp8(a.in[23], ws + a.L.ptv, ri + 16384, gw, NGW, lane);
      cvt_peer_table_i8(a.in[22] + (size_t)16384 * 2048, ws + a.L.ptu1, ri + 32768, gw, NGW, lane);
      cvt_peer_table_fp8(a.in[23] + (size_t)16384 * 2048, ws + a.L.ptv1, ri + 49152, gw, NGW, lane); }
    cvt_stream(a.in[21], (bf16*)(ws + a.L.sk), (size_t)2 * 16 * 128 * 128 / 8, gw, NGW, lane);
    { bf16* wsb = (bf16*)(ws + a.L.wsb); const float* wsf = a.in[13]; for (int i = gw * 64 + lane; i < 8 * 128 * 128; i += NGW * 64) { const int t = (i >> 7) & 127, s = i & 127; wsb[i] = (bf16)(s <= t ? f2bf(wsf[i]) : 0u); } }
    { float* vst = (float*)(ws + a.L.vst); for (int i = gw * 64 + lane; i < NTOKF * 2; i += NGW * 64) vst[i] = 0.f; }
}

template <bool ZBF>
__device__ __forceinline__ void phase_ln(const float* Z, const float* g, const float* b, float* Xf, bf16* Xb, unsigned char* Xq, float* sx, int vcu, int G, int wave, int lane) {
    const int gw = vcu * NWAVES + wave, NGW = G * NWAVES;
    f32x4 gv[8], bv[8];
#pragma unroll
    for (int j = 0; j < 8; ++j) { gv[j] = *(const GAS f32x4*)(g + j * 256 + lane * 4); bv[j] = *(const GAS f32x4*)(b + j * 256 + lane * 4); }
    for (int r = gw; r < NTOKF; r += NGW) {
        const float* zr = Z + (size_t)r * 2048;
        f32x4 v[8]; float s = 0.f;
#pragma unroll
        for (int j = 0; j < 8; ++j) {
            if (ZBF) { const unsigned long long q = *((const GAS unsigned long long*)((const bf16*)Z + (size_t)r * 2048) + 64 * j + lane); const unsigned lo = (unsigned)q, hi = (unsigned)(q >> 32);
                v[j] = (f32x4){__builtin_bit_cast(float, lo << 16), __builtin_bit_cast(float, lo & 0xffff0000u), __builtin_bit_cast(float, hi << 16), __builtin_bit_cast(float, hi & 0xffff0000u)}; }
            else v[j] = *(const GAS f32x4*)(zr + j * 256 + lane * 4);
            s += (v[j].x + v[j].y) + (v[j].z + v[j].w); }
        const float mean = wave_sum_f(s) * (1.f / 2048.f); float s2 = 0.f;
#pragma unroll
        for (int j = 0; j < 8; ++j) { v[j] = v[j] - mean; s2 += (v[j].x * v[j].x + v[j].y * v[j].y) + (v[j].z * v[j].z + v[j].w * v[j].w); }
        const float rstd = 1.f / sqrtf(wave_sum_f(s2) * (1.f / 2048.f) + 1e-5f);
#pragma unroll
        for (int j = 0; j < 8; ++j) { v[j] = v[j] * rstd * gv[j] + bv[j]; if (Xf) *(GAS f32x4*)(Xf + (size_t)r * 2048 + j * 256 + lane * 4) = v[j]; }
        if (Xq) {
            float am = 0.f;
#pragma unroll
            for (int j = 0; j < 8; ++j) am = fmaxf(am, fmaxf(fmaxf(fabsf(v[j].x), fabsf(v[j].y)), fmaxf(fabsf(v[j].z), fabsf(v[j].w))));
#pragma unroll
            for (int o = 1; o < 64; o <<= 1) am = fmaxf(am, __shfl_xor(am, o));
            const float sc = (am > 0.f) ? 127.f / am : 0.f;
            if (lane == 0) sx[r] = am * (1.f / 127.f);
#pragma unroll
            for (int j = 0; j < 8; ++j) *(GAS unsigned*)(Xq + (size_t)r * 2048 + j * 256 + lane * 4) = pack_i8x4(v[j], sc);
        }
        if (Xb) { GAS unsigned long long* o8 = (GAS unsigned long long*)(Xb + (size_t)r * 2048) + lane;
#pragma unroll
            for (int j = 0; j < 8; ++j) o8[64 * j] = (unsigned long long)pk2(v[j].x, v[j].y) | ((unsigned long long)pk2(v[j].z, v[j].w) << 32); }
    }
}
typedef __bf16 bf16x2_t __attribute__((ext_vector_type(2)));
typedef int i32x4 __attribute__((ext_vector_type(4)));
__device__ __forceinline__ unsigned fkey(float f) { const unsigned u = __builtin_bit_cast(unsigned, f); return (u & 0x80000000u) ? ~u : (u | 0x80000000u); }
__device__ __forceinline__ float keyf(unsigned k) { const unsigned u = (k & 0x80000000u) ? (k & 0x7fffffffu) : ~k; return __builtin_bit_cast(float, u); }
__device__ __forceinline__ float dot2bf(unsigned a, unsigned b, float c) { return __builtin_amdgcn_fdot2_f32_bf16(__builtin_bit_cast(bf16x2_t, a), __builtin_bit_cast(bf16x2_t, b), c, false); }
__device__ __forceinline__ float bflo(unsigned w) { return __builtin_bit_cast(float, w << 16); }
__device__ __forceinline__ float bfhi(unsigned w) { return __builtin_bit_cast(float, w & 0xffff0000u); }
__device__ __forceinline__ float gelu_tanh_g(float x) { const float u = x + 0.044715f * x * x * x; const float e = __builtin_amdgcn_exp2f(u * -2.302208198f); return x * __builtin_amdgcn_rcpf(1.0f + e); }
#define INS16(v, x) do { unsigned nw_ = (x); _Pragma("unroll") for (int k_ = 0; k_ < 16; ++k_) { const unsigned hi_ = max(v[k_], nw_); nw_ = min(v[k_], nw_); v[k_] = hi_; } } while (0)


#define CE_DESC(a, b) do { const unsigned hi_ = max(a, b), lo_ = min(a, b); a = hi_; b = lo_; } while (0)
__device__ __forceinline__ void sort16_desc(unsigned (&v)[16]) {
#pragma unroll
    for (int k = 2; k <= 16; k <<= 1)
#pragma unroll
        for (int j = k >> 1; j > 0; j >>= 1)
#pragma unroll
            for (int i = 0; i < 16; ++i) { const int l = i ^ j; if (l > i) { if ((i & k) == 0) CE_DESC(v[i], v[l]); else CE_DESC(v[l], v[i]); } }
}
__device__ __forceinline__ void merge_top16(unsigned (&a)[16], const unsigned (&b)[16]) {
#pragma unroll
    for (int i = 0; i < 16; ++i) a[i] = max(a[i], b[15 - i]);
#pragma unroll
    for (int sd = 8; sd >= 1; sd >>= 1)
#pragma unroll
        for (int i = 0; i < 16; ++i) if ((i & sd) == 0) CE_DESC(a[i], a[i + sd]);
}
static __device__ const unsigned char CAND_TAB[52] = {
    0, 1, 2, 3, 4, 5, 6, 7, 8, 9, 10, 11, 12, 13, 14, 15,
    16, 17, 18, 19, 20, 21, 22, 23,
    32, 33, 34, 35, 36,
    48, 49, 50, 51,
    64, 65, 66,
    80, 81,
    96, 97,
    112, 113,
    128, 144, 160, 176, 192, 208, 224, 240,
    255, 255 };

template <int MODE>
__device__ __forceinline__ void phase_topk(const bf16* QP, const bf16* SK, int* IDX, float* GT, float* AACC, float* SU, const float* rinvU, const float* rinvV, LAS unsigned char* lds, int vcu, int G, int wave, int lane) {
    LAS float* S = (LAS float*)lds;
    LAS unsigned char* NL = lds + 2 * 64 * 132 * 4;
    LAS float* FL = (LAS float*)(NL + 512 * 32);
    const int tid = wave * 64 + lane;
    for (int u = vcu; u < 136 * 8; u += G) {
        const int tt = u >> 3, h = u & 7;
        if (MODE != 1) {
            const int p = wave >> 2, rt = wave & 3, fr = lane & 15, fq = lane >> 4;
            const bf16* qrow = QP + (size_t)(tt * 64 + rt * 16 + fr) * 2048 + h * 256 + p * 128 + 8 * fq;
            bf16x8 af[4];
#pragma unroll
            for (int ks = 0; ks < 4; ++ks) af[ks] = *(const GAS bf16x8*)(qrow + ks * 32);
            const bf16* kbase = SK + (size_t)((h * 2 + p) * 128 + fr) * 128 + 8 * fq;
#pragma unroll 4
            for (int nt = 0; nt < 8; ++nt) {
                bf16x8 bfr[4];
#pragma unroll
                for (int ks = 0; ks < 4; ++ks) bfr[ks] = *(const GAS bf16x8*)(kbase + (size_t)nt * 16 * 128 + ks * 32);
                f32x4 acc = (f32x4){0.f, 0.f, 0.f, 0.f};
#pragma unroll
                for (int ks = 0; ks < 4; ++ks) acc = __builtin_amdgcn_mfma_f32_16x16x32_bf16(af[ks], bfr[ks], acc, 0, 0, 0);
                LAS float* sp = S + (size_t)(p * 64 + rt * 16 + fq * 4) * 132 + nt * 16 + fr;
                sp[0] = acc[0]; sp[132] = acc[1]; sp[264] = acc[2]; sp[396] = acc[3];
            }
        }
        __syncthreads();
        if (MODE != 2) {
            const int tl = lane >> 3, p = (lane >> 2) & 1, qr = lane & 3, t = wave * 8 + tl;
            unsigned own[16], oth_[16];
            const LAS f32x4* sp = (const LAS f32x4*)(S + (size_t)(p * 64 + t) * 132 + qr * 32);
#pragma unroll
            for (int c = 0; c < 4; ++c) { const f32x4 v = sp[c], w = sp[4 + c];
#pragma unroll
                for (int e = 0; e < 4; ++e) { own[c * 4 + e] = (fkey(v[e]) & ~127u) | (unsigned)(127 - (qr * 32 + c * 4 + e)); oth_[c * 4 + e] = (fkey(w[e]) & ~127u) | (unsigned)(127 - (qr * 32 + 16 + c * 4 + e)); } }
            sort16_desc(own); sort16_desc(oth_); merge_top16(own, oth_);
#pragma unroll
            for (int st = 1; st <= 2; st <<= 1) {
#pragma unroll
                for (int i = 0; i < 16; ++i) oth_[i] = (unsigned)__shfl_xor((int)own[i], st);
                merge_top16(own, oth_);
            }
            LAS unsigned char* nl = NL + tid * 32;
            LAS float* fl = FL + (tid >> 2) * 32;
#pragma unroll
            for (int i = 0; i < 16; ++i) { const unsigned oth = (unsigned)__shfl_xor((int)own[i], 4); const unsigned a0 = p ? oth : own[i], a1 = p ? own[i] : oth;
                if (qr == 0) { fl[i] = keyf(a0 & ~127u); fl[16 + i] = keyf(a1 & ~127u); }
                nl[i] = (unsigned char)(127u - (a0 & 127u)); nl[16 + i] = (unsigned char)(127u - (a1 & 127u)); }
            unsigned tv[16];
#pragma unroll
            for (int k = 0; k < 16; ++k) tv[k] = 0u;
#pragma unroll
            for (int m = 0; m < 13; ++m) { const unsigned c = CAND_TAB[m * 4 + qr]; unsigned key = 0u;
                if (c != 255u) { const float s = fl[c >> 4] + fl[16 + (c & 15u)]; key = (fkey(s) & ~255u) | (255u - c); }
                INS16(tv, key); }
#pragma unroll
            for (int st = 1; st <= 2; st <<= 1) {
#pragma unroll
                for (int i = 0; i < 16; ++i) oth_[i] = (unsigned)__shfl_xor((int)tv[i], st);
                merge_top16(tv, oth_);
            }
            float ev[16]; int ex[16]; float sum = 0.f; const float mx = keyf(tv[0] & ~255u);
#pragma unroll
            for (int k = 0; k < 16; ++k) { const unsigned c = 255u - (tv[k] & 255u); const int i = (int)(c >> 4), j = (int)(c & 15u);
                ex[k] = (int)nl[i] * 128 + (int)nl[16 + j]; ev[k] = __expf(keyf(tv[k] & ~255u) - mx); sum += ev[k]; }
            const float inv = 1.f / sum;
            if (MODE == 3) { if (ex[0] == 0x7fffffff) IDX[0] = (int)inv; }
            else if (p == 0 && qr == 0) {
                const size_t o = (size_t)(tt * 64 + t) * 128 + h * 16;
#pragma unroll
                for (int k4 = 0; k4 < 4; ++k4) { *(GAS i32x4*)(IDX + o + k4 * 4) = (i32x4){ex[k4 * 4], ex[k4 * 4 + 1], ex[k4 * 4 + 2], ex[k4 * 4 + 3]};
                    *(GAS f32x4*)(GT + o + k4 * 4) = (f32x4){ev[k4 * 4] * inv, ev[k4 * 4 + 1] * inv, ev[k4 * 4 + 2] * inv, ev[k4 * 4 + 3] * inv};
                    *(GAS f32x4*)(AACC + o + k4 * 4) = (f32x4){0.f, 0.f, 0.f, 0.f}; }
            }
        }
        __syncthreads();
    }
}

__device__ __forceinline__ void phase_upass(const bf16* U, const bf16* XBt, const int* IDX, const float* GT, float* WW, int vcu, int G, int wave, int lane) {
    const int gw = vcu * NWAVES + wave, NGW = G * NWAVES;
    for (int t = gw; t < NTOKF; t += NGW) {
        v4u xq[4];
#pragma unroll
        for (int j = 0; j < 4; ++j) xq[j] = *(const GAS v4u*)(XBt + (size_t)t * 2048 + j * 512 + lane * 8);
        const int ilo = IDX[(size_t)t * 128 + lane], ihi = IDX[(size_t)t * 128 + 64 + lane];
        float wlo = 0.f, whi = 0.f;
#pragma unroll 1
        for (int e0 = 0; e0 < 128; e0 += 4) {
            v4u uq[4][4];
#pragma unroll
            for (int ee = 0; ee < 4; ++ee) { const int e = e0 + ee; const int id = __builtin_amdgcn_readlane(e0 < 64 ? ilo : ihi, e & 63);
                const bf16* ur = U + (size_t)id * 2048 + lane * 8;
#pragma unroll
                for (int j = 0; j < 4; ++j) uq[ee][j] = *(const GAS v4u*)(ur + j * 512); }
#pragma unroll
            for (int ee = 0; ee < 4; ++ee) { float acc = 0.f;
#pragma unroll
                for (int j = 0; j < 4; ++j) { acc = dot2bf(uq[ee][j].x, xq[j].x, acc); acc = dot2bf(uq[ee][j].y, xq[j].y, acc); acc = dot2bf(uq[ee][j].z, xq[j].z, acc); acc = dot2bf(uq[ee][j].w, xq[j].w, acc); }
                acc = wave_sum_f(acc);
                const int e = e0 + ee;
                if (lane == (e & 63)) { if (e0 < 64) wlo = acc; else whi = acc; } }
        }
        WW[(size_t)t * 128 + lane] = gelu_tanh_g(wlo) * GT[(size_t)t * 128 + lane];
        WW[(size_t)t * 128 + 64 + lane] = gelu_tanh_g(whi) * GT[(size_t)t * 128 + 64 + lane];
    }
}

__device__ __forceinline__ void phase_vpass(const bf16* V, const float* Xf, const int* IDX, const float* WW, float* Z, float alpha, int vcu, int G, int wave, int lane) {
    const int gw = vcu * NWAVES + wave, NGW = G * NWAVES;
    for (int t = gw; t < NTOKF; t += NGW) {
        f32x4 acc[4][2];
#pragma unroll
        for (int j = 0; j < 4; ++j)
#pragma unroll
            for (int q = 0; q < 2; ++q) acc[j][q] = *(const GAS f32x4*)(Xf + (size_t)t * 2048 + j * 512 + lane * 8 + q * 4) * alpha;
        const int ilo = IDX[(size_t)t * 128 + lane], ihi = IDX[(size_t)t * 128 + 64 + lane];
        const float wlo = WW[(size_t)t * 128 + lane], whi = WW[(size_t)t * 128 + 64 + lane];
#pragma unroll 1
        for (int e0 = 0; e0 < 128; e0 += 4) {
            v4u vq[4][4]; float wv[4];
#pragma unroll
            for (int ee = 0; ee < 4; ++ee) { const int e = e0 + ee; const int id = __builtin_amdgcn_readlane(e0 < 64 ? ilo : ihi, e & 63);
                wv[ee] = __builtin_bit_cast(float, __builtin_amdgcn_readlane(__builtin_bit_cast(int, e0 < 64 ? wlo : whi), e & 63));
                const bf16* vr = V + (size_t)id * 2048 + lane * 8;
#pragma unroll
                for (int j = 0; j < 4; ++j) vq[ee][j] = *(const GAS v4u*)(vr + j * 512); }
#pragma unroll
            for (int ee = 0; ee < 4; ++ee)
#pragma unroll
                for (int j = 0; j < 4; ++j) { const v4u q = vq[ee][j]; const float w = wv[ee];
                    acc[j][0].x += w * bflo(q.x); acc[j][0].y += w * bfhi(q.x); acc[j][0].z += w * bflo(q.y); acc[j][0].w += w * bfhi(q.y);
                    acc[j][1].x += w * bflo(q.z); acc[j][1].y += w * bfhi(q.z); acc[j][1].z += w * bflo(q.w); acc[j][1].w += w * bfhi(q.w); }
        }
#pragma unroll
        for (int j = 0; j < 4; ++j)
#pragma unroll
            for (int q = 0; q < 2; ++q) *(GAS f32x4*)(Z + (size_t)t * 2048 + j * 512 + lane * 8 + q * 4) = acc[j][q];
    }
}

struct XTopo { int xi, nx, wq, nwq; };
__device__ __forceinline__ XTopo xcd_topology(unsigned* bar, unsigned x, unsigned rank, int wave) {
    XTopo t; int xi = 0, nx = 0, nloc = 1;
#pragma unroll
    for (unsigned j = 0; j < 16; ++j) { const unsigned c = xb_ld(&bar[XB_XCNT(j)]); if (c > 0u) { if (j < x) ++xi; ++nx; } if (j == x) nloc = (int)c; }
    if (nloc < 1) nloc = 1; if (nx < 1) nx = 1;
    t.xi = __builtin_amdgcn_readfirstlane(xi); t.nx = __builtin_amdgcn_readfirstlane(nx); t.wq = __builtin_amdgcn_readfirstlane((int)rank * NWAVES + wave); t.nwq = __builtin_amdgcn_readfirstlane(nloc * NWAVES); return t;
}
typedef float f32x2 __attribute__((ext_vector_type(2)));
template <int MODE>
__device__ __forceinline__ void upass_reduce_add(float (&acc)[16], float* ap, int lane) {
    const bool b2 = (lane & 4) != 0, b1 = (lane & 2) != 0, b0 = (lane & 1) != 0;
    float r8[8], r4[4], r2[2];
#pragma unroll
    for (int j = 0; j < 8; ++j) { const float keep = b2 ? acc[8 + j] : acc[j], send = b2 ? acc[j] : acc[8 + j]; r8[j] = keep + __shfl_xor(send, 4); }
#pragma unroll
    for (int j = 0; j < 4; ++j) { const float keep = b1 ? r8[4 + j] : r8[j], send = b1 ? r8[j] : r8[4 + j]; r4[j] = keep + __shfl_xor(send, 2); }
#pragma unroll
    for (int j = 0; j < 2; ++j) { const float keep = b0 ? r4[2 + j] : r4[j], send = b0 ? r4[j] : r4[2 + j]; r2[j] = keep + __shfl_xor(send, 1); }
    if (MODE == 1) { ap[0] = r2[0]; ap[64] = r2[1]; } else { unsafeAtomicAdd(ap, r2[0]); unsafeAtomicAdd(ap + 64, r2[1]); }
}
__device__ __forceinline__ float dot16_i8(const v4u q, const v4u x) {
    int a = __builtin_amdgcn_sdot4((int)q.x, (int)x.x, 0, false); a = __builtin_amdgcn_sdot4((int)q.y, (int)x.y, a, false);
    a = __builtin_amdgcn_sdot4((int)q.z, (int)x.z, a, false); a = __builtin_amdgcn_sdot4((int)q.w, (int)x.w, a, false);
    return (float)a;
}
__device__ __forceinline__ void unpack16bf(const v4u a, const v4u b, float (&xf)[16]) {
    xf[0] = bflo(a.x); xf[1] = bfhi(a.x); xf[2] = bflo(a.y); xf[3] = bfhi(a.y); xf[4] = bflo(a.z); xf[5] = bfhi(a.z); xf[6] = bflo(a.w); xf[7] = bfhi(a.w);
    xf[8] = bflo(b.x); xf[9] = bfhi(b.x); xf[10] = bflo(b.y); xf[11] = bfhi(b.y); xf[12] = bflo(b.z); xf[13] = bfhi(b.z); xf[14] = bflo(b.w); xf[15] = bfhi(b.w);
}
template <int MODE>
__device__ __forceinline__ void phase_upass_sl(const unsigned char* U, const unsigned char* XQ, const float* SX, const int* IDX, float* AACC, float* GT, float* SU, const float* rinvU, const float* rinvV, const XTopo tp, int lane0) {
#define UP_IDX(dst, tt) do { const int t_ = min((tt), NTOKF - 1); const int* ip_ = IDX + (size_t)t_ * 128 + (lane >> 3) * 8; dst[0] = *(const GAS i32x4*)ip_; dst[1] = *(const GAS i32x4*)(ip_ + 4); dst[2] = *(const GAS i32x4*)(ip_ + 64); dst[3] = *(const GAS i32x4*)(ip_ + 68); } while (0)
#define UP_SEL(id, s_) id[2 * ((s_) & 1) + ((s_) >> 3)][((s_) >> 1) & 3]
#define UP_GATHER8(dst, id, h) do { _Pragma("unroll") for (int j_ = 0; j_ < 8; ++j_) { if (MODE == 2) dst[j_] = (v4u){(unsigned)UP_SEL(id, 8 * (h) + j_), 0x38383838u, 0x38383838u, 0x38383838u}; else dst[j_] = __builtin_bit_cast(v4u, __builtin_amdgcn_raw_buffer_load_b128(urs, (UP_SEL(id, 8 * (h) + j_) << 7) + i * 16, 0, 0)); } } while (0)
#define UP_X(xa, xb, tt) do { const int t_ = min((tt), NTOKF - 1); xa = *(const GAS v4u*)(XQ + (size_t)t_ * 2048 + sl * 128 + (lane & 7) * 16); xb.x = __builtin_bit_cast(unsigned, SX[t_]); } while (0)
    for (int sl = tp.xi; sl < 16; sl += tp.nx) {
        int lane = lane0; asm volatile("" : "+v"(lane));
        const int g = lane >> 3, i = lane & 7;
        const __amdgpu_buffer_rsrc_t urs = __builtin_amdgcn_make_buffer_rsrc((void*)(U + (size_t)sl * 16384 * 128), 0, 16384 * 128, 0x00020000);
        i32x4 idn[4]; v4u qa[8], qb[8], xa, xb;
        UP_IDX(idn, tp.wq); UP_GATHER8(qa, idn, 0); UP_GATHER8(qb, idn, 1); UP_X(xa, xb, tp.wq); UP_IDX(idn, tp.wq + tp.nwq);
#pragma unroll 1
        for (int t = tp.wq; t < NTOKF; t += tp.nwq) {
            float acc[16]; const v4u xq_ = xa; const float sx_ = __builtin_bit_cast(float, xb.x);
#pragma unroll
            for (int j = 0; j < 8; ++j) acc[j] = dot16_i8(qa[j], xq_) * sx_;
            UP_GATHER8(qa, idn, 0);
#pragma unroll
            for (int j = 0; j < 8; ++j) acc[8 + j] = dot16_i8(qb[j], xq_) * sx_;
            UP_GATHER8(qb, idn, 1);
            UP_X(xa, xb, t + tp.nwq); UP_IDX(idn, t + 2 * tp.nwq);
            upass_reduce_add<MODE>(acc, AACC + (size_t)t * 128 + lane, lane);
            if (MODE == 0 && sl == tp.xi && ((t >> 8) % tp.nx) == tp.xi) {
                const size_t o_ = (size_t)t * 128 + lane; const int e0_ = IDX[o_], e1_ = IDX[o_ + 64];
                SU[o_] = rinvU[e0_]; SU[o_ + 64] = rinvU[e1_]; GT[o_] *= rinvV[e0_]; GT[o_ + 64] *= rinvV[e1_]; }
        }
    }
#undef UP_IDX
#undef UP_SEL
#undef UP_GATHER8
#undef UP_X
}
__device__ __forceinline__ void vpass_finish(const v4u (&vq)[16], const LAS float* wl, const float* Xf, float* Z, float alpha, int t, int sl, int lane) {
    const int g = lane >> 3, i = lane & 7;
    f32x4 w4[4];
#pragma unroll
    for (int q = 0; q < 4; ++q) w4[q] = *(const LAS f32x4*)(wl + g * 16 + q * 4);
    float acc[16];
#pragma unroll
    for (int c = 0; c < 16; ++c) acc[c] = 0.f;
#pragma unroll
    for (int j = 0; j < 16; ++j) { const float w = w4[j >> 2][j & 3]; const unsigned wd[4] = {vq[j].x, vq[j].y, vq[j].z, vq[j].w};
#pragma unroll
        for (int d = 0; d < 4; ++d) { const f32x2 lo = __builtin_amdgcn_cvt_pk_f32_fp8(wd[d], false), hi = __builtin_amdgcn_cvt_pk_f32_fp8(wd[d], true);
            acc[d * 4 + 0] += w * lo.x; acc[d * 4 + 1] += w * lo.y; acc[d * 4 + 2] += w * hi.x; acc[d * 4 + 3] += w * hi.y; } }
    const bool b3 = (lane & 8) != 0, b4 = (lane & 16) != 0, b5 = (lane & 32) != 0;
    float r8[8], r4[4], r2[2];
#pragma unroll
    for (int c = 0; c < 8; ++c) { const float keep = b3 ? acc[8 + c] : acc[c], send = b3 ? acc[c] : acc[8 + c]; r8[c] = keep + __shfl_xor(send, 8); }
#pragma unroll
    for (int c = 0; c < 4; ++c) { const float keep = b4 ? r8[4 + c] : r8[c], send = b4 ? r8[c] : r8[4 + c]; r4[c] = keep + __shfl_xor(send, 16); }
#pragma unroll
    for (int c = 0; c < 2; ++c) { const float keep = b5 ? r4[2 + c] : r4[c], send = b5 ? r4[c] : r4[2 + c]; r2[c] = keep + __shfl_xor(send, 32); }
    const int col = sl * 128 + i * 16 + (b3 ? 8 : 0) + (b4 ? 4 : 0) + (b5 ? 2 : 0);
    const f32x2 xr = *(const GAS f32x2*)(Xf + (size_t)t * 2048 + col);
    *(GAS f32x2*)(Z + (size_t)t * 2048 + col) = (f32x2){alpha * xr.x + r2[0], alpha * xr.y + r2[1]};
}
__device__ __forceinline__ int wave_max_bits(int x) {
    x = max(x, __builtin_amdgcn_update_dpp(x, x, 0x111, 0xf, 0xf, false));
    x = max(x, __builtin_amdgcn_update_dpp(x, x, 0x112, 0xf, 0xf, false));
    x = max(x, __builtin_amdgcn_update_dpp(x, x, 0x114, 0xf, 0xf, false));
    x = max(x, __builtin_amdgcn_update_dpp(x, x, 0x118, 0xf, 0xf, false));
    x = max(x, __builtin_amdgcn_update_dpp(x, x, 0x142, 0xa, 0xf, false));
    x = max(x, __builtin_amdgcn_update_dpp(x, x, 0x143, 0xc, 0xf, false));
    return __builtin_amdgcn_readlane(x, 63);
}
typedef unsigned u32x2v __attribute__((ext_vector_type(2)));
template <int MODE>
__device__ __forceinline__ void vpass_step(const v4u (&cur)[16], v4u (&nxt)[16], const i32x4 (&idin)[4], i32x4 (&idout)[4], const float (&scc)[6], float (&scn)[6], const u32x2v xr, u32x2v& xrn, const __amdgpu_buffer_rsrc_t vrs,
                                           const bf16* Xf, const int* IDX, const float* AACC, const float* SU, const float* GT, bf16* Z, float alpha, LAS float* wl, int t, int tn, int tnn, int sl, int lane0, bool live = true) {
    int lane = lane0; asm volatile("" : "+v"(lane));
    const int g = lane >> 3, i = lane & 7;
#pragma unroll
    for (int q = 0; q < 4; ++q) idout[q] = *(const GAS i32x4*)(IDX + (size_t)tnn * 128 + g * 16 + q * 4);
    { const size_t o0 = (size_t)tn * 128 + lane; scn[0] = AACC[o0]; scn[1] = AACC[o0 + 64]; scn[2] = SU[o0]; scn[3] = SU[o0 + 64]; scn[4] = GT[o0]; scn[5] = GT[o0 + 64]; }
    const bool hv = (lane & 32) != 0, valid = (((lane >> 5) ^ (lane >> 3)) & 1) == 0;
    const int col = sl * 128 + (hv ? 64 : 0) + ((lane >> 4) & 1) * 32 + (i >> 2) * 16 + (i & 3) * 4;
    if (MODE != 3) xrn = *(const GAS u32x2v*)(Xf + (size_t)tn * 2048 + col);
    __builtin_amdgcn_sched_barrier(0);
#pragma unroll
    for (int j = 0; j < 16; ++j) { if (MODE == 1) nxt[j] = (v4u){(unsigned)idin[j >> 2][j & 3], 0x38383838u, 0x38383838u, 0x38383838u}; else nxt[j] = __builtin_bit_cast(v4u, __builtin_amdgcn_raw_buffer_load_b128(vrs, (idin[j >> 2][j & 3] << 7) + i * 16, 0, 0)); }
    __builtin_amdgcn_sched_barrier(0);
    const float w0 = gelu_tanh_g(scc[0] * scc[2]) * scc[4], w1 = gelu_tanh_g(scc[1] * scc[3]) * scc[5];
    const int e8 = max(wave_max_bits(__builtin_bit_cast(int, fmaxf(fabsf(w0), fabsf(w1)))) >> 23, 8);
    const float S = __builtin_bit_cast(float, (261 - e8) << 23), invS = __builtin_bit_cast(float, (e8 - 7) << 23);
    wl[lane] = w0 * S; wl[64 + lane] = w1 * S;
    if (MODE == 2) { unsigned s_ = 0u;
#pragma unroll
        for (int j = 0; j < 16; ++j) s_ += cur[j].x ^ cur[j].y ^ cur[j].z ^ cur[j].w;
        if (s_ == 0x12345u) Z[(size_t)t * 2048 + sl * 128 + lane] = 1; }
    else {
        f32x4 w4[4];
#pragma unroll
        for (int q = 0; q < 4; ++q) w4[q] = *(const LAS f32x4*)(wl + g * 16 + q * 4);
        const int p8 = (lane & 3) * 8;
        const unsigned selp = 0x0c0c0c0cu & ~(0xffu << p8);
        const unsigned selLo = (lane & 4) ? 0x0c0c0c0cu : selp, selHi = (lane & 4) ? selp : 0x0c0c0c0cu;
        f32x4 D1 = {0.f, 0.f, 0.f, 0.f}, D2 = {0.f, 0.f, 0.f, 0.f};
#pragma unroll
        for (int j = 0; j < 16; ++j) {
            const unsigned tb = (unsigned)__builtin_amdgcn_cvt_pk_fp8_f32(w4[j >> 2][j & 3], 0.f, 0, false);
            const unsigned alo = __builtin_amdgcn_perm(0u, tb, selLo), ahi = __builtin_amdgcn_perm(0u, tb, selHi);
            const long A = (long)(((unsigned long)ahi << 32) | (unsigned long)alo);
            const long B1 = (long)(((unsigned long)cur[j].y << 32) | (unsigned long)cur[j].x), B2 = (long)(((unsigned long)cur[j].w << 32) | (unsigned long)cur[j].z);
            D1 = __builtin_amdgcn_mfma_f32_16x16x32_fp8_fp8(A, B1, D1, 0, 0, 0);
            D2 = __builtin_amdgcn_mfma_f32_16x16x32_fp8_fp8(A, B2, D2, 0, 0, 0);
        }
        f32x4 o;
#pragma unroll
        for (int r = 0; r < 4; ++r) { const float snd = hv ? D1[r] : D2[r], own = hv ? D2[r] : D1[r]; const unsigned xw = (r & 2) ? xr.y : xr.x; const float xv = (r & 1) ? bfhi(xw) : bflo(xw); o[r] = alpha * xv + (own + __shfl_xor(snd, 40)) * invS; }
        u32x2v ob; ob.x = pk2(o[0], o[1]); ob.y = pk2(o[2], o[3]);
        if (MODE == 3 || MODE == 4) { if (o[0] + o[1] + o[2] + o[3] == 1.2345f) *(GAS u32x2v*)(Z + (size_t)t * 2048 + col) = ob; } else
        if (MODE == 6) { if (valid && live) *(GAS u32x2v*)(Z + (size_t)(t & 127) * 2048 + col) = ob; } else
        if (valid && live) { bf16* zp = Z + (size_t)t * 2048 + col; asm volatile("global_store_dwordx2 %0, %1, off sc0 sc1" :: "v"(zp), "v"(ob) : "memory"); }
    }
}
template <int MODE>
__device__ __forceinline__ void phase_vpass_sl(const unsigned char* V, const bf16* Xf, const int* IDX, const float* AACC, const float* SU, const float* GT, bf16* Z, float alpha, const XTopo tp, LAS unsigned char* lds, int wave, int lane_in) {
    const int lane0 = lane_in;
    LAS float* wl = (LAS float*)lds + wave * 128;
    for (int sl = tp.xi; sl < 16; sl += tp.nx) {
        const __amdgpu_buffer_rsrc_t vrs = __builtin_amdgcn_make_buffer_rsrc((void*)(V + (size_t)sl * 16384 * 128), 0, 16384 * 128, 0x00020000);
        v4u vqA[16], vqB[16]; i32x4 idA[4], idB[4]; float scA[6], scB[6]; u32x2v xrA = {0u, 0u}, xrB = {0u, 0u};
        {   int lane = lane0; asm volatile("" : "+v"(lane));
            const int g = lane >> 3, i = lane & 7, t0 = tp.wq, t1 = min(tp.wq + tp.nwq, NTOKF - 1);
#pragma unroll
            for (int q = 0; q < 4; ++q) { idA[q] = *(const GAS i32x4*)(IDX + (size_t)t0 * 128 + g * 16 + q * 4); idB[q] = *(const GAS i32x4*)(IDX + (size_t)t1 * 128 + g * 16 + q * 4); }
            const size_t o0 = (size_t)t0 * 128 + lane; scA[0] = AACC[o0]; scA[1] = AACC[o0 + 64]; scA[2] = SU[o0]; scA[3] = SU[o0 + 64]; scA[4] = GT[o0]; scA[5] = GT[o0 + 64];
            if (MODE != 3) xrA = *(const GAS u32x2v*)(Xf + (size_t)t0 * 2048 + sl * 128 + ((lane & 32) ? 64 : 0) + ((lane >> 4) & 1) * 32 + (i >> 2) * 16 + (i & 3) * 4);
            __builtin_amdgcn_sched_barrier(0);
#pragma unroll
            for (int j = 0; j < 16; ++j) { if (MODE == 1) vqA[j] = (v4u){(unsigned)idA[j >> 2][j & 3], 0x38383838u, 0x38383838u, 0x38383838u}; else vqA[j] = __builtin_bit_cast(v4u, __builtin_amdgcn_raw_buffer_load_b128(vrs, (idA[j >> 2][j & 3] << 7) + i * 16, 0, 0)); }
        }
#pragma unroll 1
        for (int t = tp.wq; t < NTOKF; t += 2 * tp.nwq) {
            const int t1 = min(t + tp.nwq, NTOKF - 1), t2 = min(t + 2 * tp.nwq, NTOKF - 1), t3 = min(t + 3 * tp.nwq, NTOKF - 1);
            vpass_step<MODE>(vqA, vqB, idB, idA, scA, scB, xrA, xrB, vrs, Xf, IDX, AACC, SU, GT, Z, alpha, wl, t, t1, t2, sl, lane0);
            vpass_step<MODE>(vqB, vqA, idA, idB, scB, scA, xrB, xrA, vrs, Xf, IDX, AACC, SU, GT, Z, alpha, wl, t1, t2, t3, sl, lane0, t + tp.nwq < NTOKF);
        }
    }
}
typedef short s16x4 __attribute__((ext_vector_type(4)));
typedef unsigned u32x2 __attribute__((ext_vector_type(2)));
template <int MODE>
__device__ __forceinline__ void phase_spatial(const bf16* UB, const bf16* VB, const float* VST, const float* lng, const float* lnb, const bf16* WSB, const float* wsf, const float* bs,
                                              bf16* UM, float* vs_out, LAS unsigned char* lds, int vcu, int G, int wave, int lane) {
    constexpr int PITCH = 136;
    LAS bf16* T = (LAS bf16*)lds;
    LAS bf16* WS = (LAS bf16*)(lds + 128 * PITCH * 2);
    const int tid = wave * 64 + lane;
    const int nbg = G >> 3, g = (nbg > 0) ? vcu / nbg : 0, jb = (nbg > 0) ? vcu % nbg : 0;
    if (MODE != 1 && nbg > 0 && g < 8) {
        for (int i = tid; i < 128 * 16; i += 512) { const int t = i >> 4, ch = i & 15; *(LAS v4u*)(WS + t * 128 + ((ch ^ (t & 15)) << 3)) = *(const GAS v4u*)(WSB + (size_t)(g * 128 + t) * 128 + ch * 8); }
        const int s_ = tid >> 2, cq_ = (tid & 3) * 32;
        v4u pvq[4]; float ps1 = 1.f, ps2 = 2.f;
        if (MODE == 2) pvq[0] = pvq[1] = pvq[2] = pvq[3] = (v4u){0x3f803f80u, 0x3f803f80u, 0x3f803f80u, 0x3f803f80u};
        else if (jb < 384) { const int ck = jb / 6, cb = g * 6 + jb % 6; const size_t r = (size_t)ck * 128 + s_;
            ps1 = VST[r * 2]; ps2 = VST[r * 2 + 1];
#pragma unroll
            for (int i = 0; i < 4; ++i) pvq[i] = *(const GAS v4u*)(VB + r * 6144 + cb * 128 + cq_ + i * 8); }
        for (int u = jb; u < 384; u += nbg) {
            const int ck = u / 6, cb = g * 6 + u % 6;
            const size_t row0 = (size_t)ck * 128; const int col0 = cb * 128;
            u32x2 uq[8]; float bsv[8];
            { const int fr = lane & 15, fq = lane >> 4, c0 = 16 * wave;
#pragma unroll
              for (int jt = 0; jt < 8; ++jt) { const int t = jt * 16 + fr; if (MODE == 3) uq[jt] = (u32x2){0x3f803f80u, 0x3f803f80u}; else uq[jt] = *(const GAS u32x2*)(UB + (row0 + t) * 6144 + col0 + c0 + 4 * fq); bsv[jt] = bs[g * 128 + t]; } }
            {
                const float mu = ps1 * (1.f / 6144.f); const float rstd = rsqrtf(ps2 * (1.f / 6144.f) - mu * mu + 1e-5f);
#pragma unroll
                for (int i = 0; i < 4; ++i) { const v4u q = pvq[i];
                    const float* gp = lng + col0 + cq_ + i * 8; const float* bp = lnb + col0 + cq_ + i * 8;
                    const f32x4 g0 = *(const GAS f32x4*)gp, g1 = *(const GAS f32x4*)(gp + 4), b0 = *(const GAS f32x4*)bp, b1 = *(const GAS f32x4*)(bp + 4);
                    v4u o;
                    o.x = pk2((bflo(q.x) - mu) * rstd * g0.x + b0.x, (bfhi(q.x) - mu) * rstd * g0.y + b0.y);
                    o.y = pk2((bflo(q.y) - mu) * rstd * g0.z + b0.z, (bfhi(q.y) - mu) * rstd * g0.w + b0.w);
                    o.z = pk2((bflo(q.z) - mu) * rstd * g1.x + b1.x, (bfhi(q.z) - mu) * rstd * g1.y + b1.y);
                    o.w = pk2((bflo(q.w) - mu) * rstd * g1.z + b1.z, (bfhi(q.w) - mu) * rstd * g1.w + b1.w);
                    *(LAS v4u*)(T + s_ * PITCH + cq_ + i * 8) = o; }
            }
            __syncthreads();
            {
                const int fr = lane & 15, fq = lane >> 4, qq = fr >> 2, pp = fr & 3, c0 = 16 * wave;
                if (MODE != 2 && u + nbg < 384) { const int un = u + nbg, ckn = un / 6, cbn = g * 6 + un % 6; const size_t r = (size_t)ckn * 128 + s_;
                    ps1 = VST[r * 2]; ps2 = VST[r * 2 + 1];
#pragma unroll
                    for (int i = 0; i < 4; ++i) pvq[i] = *(const GAS v4u*)(VB + r * 6144 + cbn * 128 + cq_ + i * 8); }
                bf16x8 af[4];
#pragma unroll
                for (int ks = 0; ks < 4; ++ks) {
                    const s16x4 r0 = __builtin_amdgcn_ds_read_tr16_b64_v4i16((LAS s16x4*)(T + (32 * ks + 8 * fq + qq) * PITCH + c0 + 4 * pp));
                    const s16x4 r1 = __builtin_amdgcn_ds_read_tr16_b64_v4i16((LAS s16x4*)(T + (32 * ks + 8 * fq + 4 + qq) * PITCH + c0 + 4 * pp));
                    af[ks] = (bf16x8){r0.x, r0.y, r0.z, r0.w, r1.x, r1.y, r1.z, r1.w};
                }
                f32x4 acc[8];
#pragma unroll
                for (int jt = 0; jt < 8; ++jt) {
                    acc[jt] = (f32x4){0.f, 0.f, 0.f, 0.f};
#pragma unroll
                    for (int ks = 0; ks < 4; ++ks) if (ks <= (jt >> 1)) { const bf16x8 bfr = *(const LAS bf16x8*)(WS + (jt * 16 + fr) * 128 + (((ks * 4 + fq) ^ fr) << 3)); acc[jt] = __builtin_amdgcn_mfma_f32_16x16x32_bf16(af[ks], bfr, acc[jt], 0, 0, 0); }
                }
#pragma unroll
                for (int jt = 0; jt < 8; ++jt) {
                    const int t = jt * 16 + fr; const size_t off = (row0 + t) * 6144 + col0 + c0 + 4 * fq;
                    u32x2 o; o.x = pk2(bflo(uq[jt].x) * (acc[jt][0] + bsv[jt]), bfhi(uq[jt].x) * (acc[jt][1] + bsv[jt])); o.y = pk2(bflo(uq[jt].y) * (acc[jt][2] + bsv[jt]), bfhi(uq[jt].y) * (acc[jt][3] + bsv[jt]));
                    if (MODE == 3) { if (o.x == 0x12345u) *(GAS u32x2*)(UM + off) = o; } else *(GAS u32x2*)(UM + off) = o;
                }
            }
            __syncthreads();
        }
    }
    if (MODE == 0 || MODE == 1) for (int it = vcu * 512 + tid; it < 128 * 768; it += G * 512) {
        const int sq = it / 768, c8 = (it % 768) * 8, gg = c8 / 768;
        const size_t r0 = 8192 + (size_t)sq * 4;
        const f32x4 g0 = *(const GAS f32x4*)(lng + c8), g1 = *(const GAS f32x4*)(lng + c8 + 4), b0 = *(const GAS f32x4*)(lnb + c8), b1 = *(const GAS f32x4*)(lnb + c8 + 4);
        v4u vq4[4], uq4[4]; float st1[4], st2[4], bsv4[4], wv[4][4];
#pragma unroll
        for (int s = 0; s < 4; ++s) { st1[s] = VST[(r0 + s) * 2]; st2[s] = VST[(r0 + s) * 2 + 1]; vq4[s] = *(const GAS v4u*)(VB + (r0 + s) * 6144 + c8); uq4[s] = *(const GAS v4u*)(UB + (r0 + s) * 6144 + c8); bsv4[s] = bs[gg * 128 + s];
#pragma unroll
            for (int s2 = 0; s2 < 4; ++s2) wv[s][s2] = (s2 <= s) ? wsf[(size_t)(gg * 128 + s) * 128 + s2] : 0.f; }
        float vn[4][8];
#pragma unroll
        for (int s = 0; s < 4; ++s) {
            const float mu = st1[s] * (1.f / 6144.f); const float rstd = rsqrtf(st2[s] * (1.f / 6144.f) - mu * mu + 1e-5f); const v4u q = vq4[s];
            vn[s][0] = (bflo(q.x) - mu) * rstd * g0.x + b0.x; vn[s][1] = (bfhi(q.x) - mu) * rstd * g0.y + b0.y; vn[s][2] = (bflo(q.y) - mu) * rstd * g0.z + b0.z; vn[s][3] = (bfhi(q.y) - mu) * rstd * g0.w + b0.w;
            vn[s][4] = (bflo(q.z) - mu) * rstd * g1.x + b1.x; vn[s][5] = (bfhi(q.z) - mu) * rstd * g1.y + b1.y; vn[s][6] = (bflo(q.w) - mu) * rstd * g1.z + b1.z; vn[s][7] = (bfhi(q.w) - mu) * rstd * g1.w + b1.w;
        }
#pragma unroll
        for (int s = 0; s < 4; ++s) { float* vo = vs_out + ((size_t)sq * 4 + s) * 6144 + c8;
            *(GAS f32x4*)vo = (f32x4){vn[s][0], vn[s][1], vn[s][2], vn[s][3]}; *(GAS f32x4*)(vo + 4) = (f32x4){vn[s][4], vn[s][5], vn[s][6], vn[s][7]}; }
#pragma unroll
        for (int t = 0; t < 4; ++t) {
            float mx[8];
#pragma unroll
            for (int e = 0; e < 8; ++e) mx[e] = bsv4[t];
#pragma unroll
            for (int s = 0; s < 4; ++s) if (s <= t) {
#pragma unroll
                for (int e = 0; e < 8; ++e) mx[e] += wv[t][s] * vn[s][e]; }
            const v4u uq = uq4[t];
            v4u o; o.x = pk2(bflo(uq.x) * mx[0], bfhi(uq.x) * mx[1]); o.y = pk2(bflo(uq.y) * mx[2], bfhi(uq.y) * mx[3]); o.z = pk2(bflo(uq.z) * mx[4], bfhi(uq.z) * mx[5]); o.w = pk2(bflo(uq.w) * mx[6], bfhi(uq.w) * mx[7]);
            *(GAS v4u*)(UM + (r0 + t) * 6144 + c8) = o;
        }
    }
}
__device__ __forceinline__ float wave_scan_add(float v, int lane) {
#pragma unroll
    for (int o = 1; o < 64; o <<= 1) { const float t = __shfl_up(v, o); if (lane >= o) v += t; }
    return v;
}
__device__ __forceinline__ float wave_scan_max(float v, int lane) {
#pragma unroll
    for (int o = 1; o < 64; o <<= 1) { const float t = __shfl_up(v, o); if (lane >= o) v = fmaxf(v, t); }
    return v;
}
__device__ __forceinline__ bf16x8 tr_frag2(const LAS bf16* p0, const LAS bf16* p1) {
    const s16x4 r0 = __builtin_amdgcn_ds_read_tr16_b64_v4i16((LAS s16x4*)p0);
    const s16x4 r1 = __builtin_amdgcn_ds_read_tr16_b64_v4i16((LAS s16x4*)p1);
    return (bf16x8){r0.x, r0.y, r0.z, r0.w, r1.x, r1.y, r1.z, r1.w};
}
__device__ __forceinline__ bf16x8 tr_frag(const LAS bf16* p0, int rowstep4) { return tr_frag2(p0, p0 + rowstep4); }
__device__ __forceinline__ int qk_off(int row, int chunk) { return row * 128 + ((chunk ^ (row & 15)) << 3); }
__device__ __forceinline__ int v_off(int row, int chunk) { return row * 256 + ((chunk ^ (row & 7)) << 3); }
__device__ __forceinline__ int p_off(int row, int chunk) { return row * 64 + ((chunk ^ ((row >> 1) & 7)) << 3); }

__device__ __forceinline__ void mlstm_prompt_seq(const bf16* QKVO, const float* GATES, const float* hn_gain, bf16* HN, float* Cp, float* np_, float* mp, int seq, int h, LAS unsigned char* lds, int wave, int lane) {
    LAS bf16* Qs = (LAS bf16*)lds;
    LAS bf16* Ks = (LAS bf16*)(lds + 16384);
    LAS bf16* Vs = (LAS bf16*)(lds + 32768);
    LAS bf16* Cd = (LAS bf16*)(lds + 65536) + wave * 4096;
    LAS unsigned char* hi = lds + RING_BYTES + 512;
    LAS bf16* Ps = (LAS bf16*)hi;
    LAS float* A_ = (LAS float*)(hi + 8192);
    LAS float* M_ = A_ + 64;
    LAS float* B_ = M_ + 64;
    LAS float* SC = B_ + 64;
    LAS float* X_ = SC + 4;
    LAS bf16* nd = (LAS bf16*)(X_ + 1024);
    LAS float* GN = X_ + 1024 + 64;
    const int tid = wave * 64 + lane, fr = lane & 15, fq = lane >> 4;
    const size_t row0 = (size_t)seq * 2048;
    for (int i = tid; i < 65536 / 16; i += 512) ((LAS v4u*)(lds + 65536))[i] = (v4u){0u, 0u, 0u, 0u};
    if (tid < 16) ((LAS v4u*)nd)[tid] = (v4u){0u, 0u, 0u, 0u};
    if (tid < 256) GN[tid] = hn_gain[h * 256 + tid];
    float nreg = 0.f;
    f32x4 Cacc[2][8];
#pragma unroll
    for (int it = 0; it < 2; ++it)
#pragma unroll
        for (int jd = 0; jd < 8; ++jd) Cacc[it][jd] = (f32x4){0.f, 0.f, 0.f, 0.f};
    float m = 0.f;
    const bf16x8 ones = (fr == 0) ? (bf16x8){0x3F80, 0x3F80, 0x3F80, 0x3F80, 0x3F80, 0x3F80, 0x3F80, 0x3F80} : (bf16x8){0, 0, 0, 0, 0, 0, 0, 0};
    const int srow = tid >> 3, sc16 = (tid & 7) * 16, sc32 = (tid & 7) * 32;
    v4u pq[2], pk[2], pv[4];
    {   const bf16* r = QKVO + (row0 + srow) * 6144;
#pragma unroll
        for (int i = 0; i < 2; ++i) { pq[i] = *(const GAS v4u*)(r + h * 128 + sc16 + i * 8); pk[i] = *(const GAS v4u*)(r + 1024 + h * 128 + sc16 + i * 8); }
#pragma unroll
        for (int i = 0; i < 4; ++i) pv[i] = *(const GAS v4u*)(r + 2048 + h * 256 + sc32 + i * 8); }
    float ig_n = 0.f, lf_n = 0.f;
    if (wave == 0) { ig_n = GATES[(row0 + lane) * 16 + h]; lf_n = GATES[(row0 + lane) * 16 + 8 + h]; }
    __syncthreads();
#pragma unroll 1
    for (int c = 0; c < 32; ++c) {
        const size_t rb = row0 + (size_t)c * 64;
        int fr_l = lane & 15, fq_l = lane >> 4; asm volatile("" : "+v"(fr_l), "+v"(fq_l));
        const int fr = fr_l, fq = fq_l;
#pragma unroll
        for (int i = 0; i < 2; ++i) { *(LAS v4u*)(Qs + qk_off(srow, (sc16 >> 3) + i)) = pq[i]; *(LAS v4u*)(Ks + qk_off(srow, (sc16 >> 3) + i)) = pk[i]; }
#pragma unroll
        for (int i = 0; i < 4; ++i) *(LAS v4u*)(Vs + v_off(srow, (sc32 >> 3) + i)) = pv[i];
        if (c + 1 < 32) { const bf16* r = QKVO + (rb + 64 + srow) * 6144;
#pragma unroll
            for (int i = 0; i < 2; ++i) { pq[i] = *(const GAS v4u*)(r + h * 128 + sc16 + i * 8); pk[i] = *(const GAS v4u*)(r + 1024 + h * 128 + sc16 + i * 8); }
#pragma unroll
            for (int i = 0; i < 4; ++i) pv[i] = *(const GAS v4u*)(r + 2048 + h * 256 + sc32 + i * 8); }
        if (wave == 0) {
            const float ig = ig_n, lf = lf_n;
            if (c + 1 < 32) { ig_n = GATES[(rb + 64 + lane) * 16 + h]; lf_n = GATES[(rb + 64 + lane) * 16 + 8 + h]; }
            const float b = wave_scan_add(lf, lane); const float a = ig - b; const float pm = wave_scan_max(a, lane);
            const float Mt = fmaxf(m, pm);
            A_[lane] = a; M_[lane] = Mt; B_[lane] = b;
            const float M63 = __shfl(Mt, 63), b63 = __shfl(b, 63);
            if (lane == 0) { SC[0] = __expf(m - M63); SC[1] = b63 + M63; SC[2] = m; }
            m = b63 + M63;
        }
        __syncthreads();
        f32x4 nacc[3][4];
#pragma unroll
        for (int it = 0; it < 3; ++it)
#pragma unroll
            for (int jt = 0; jt < 4; ++jt) nacc[it][jt] = (f32x4){0.f, 0.f, 0.f, 0.f};
#pragma unroll 1
        for (int ks = 0; ks < 4; ++ks) {
            bf16x8 ca[3];
#pragma unroll
            for (int it = 0; it < 2; ++it) ca[it] = tr_frag(Cd + (32 * ks + 8 * fq + (fr >> 2)) * 32 + 16 * it + 4 * (fr & 3), 4 * 32);
            ca[2] = (fr == 0) ? *(const LAS bf16x8*)(nd + 32 * ks + 8 * fq) : (bf16x8){0, 0, 0, 0, 0, 0, 0, 0};
#pragma unroll
            for (int jt = 0; jt < 4; ++jt) { const bf16x8 qb = *(const LAS bf16x8*)(Qs + qk_off(16 * jt + fr, 4 * ks + fq));
#pragma unroll
                for (int it = 0; it < 3; ++it) nacc[it][jt] = __builtin_amdgcn_mfma_f32_16x16x32_bf16(ca[it], qb, nacc[it][jt], 0, 0, 0); }
        }
#pragma unroll
        for (int jt = 0; jt < 4; ++jt) { const float mt = M_[16 * jt + fr]; const float wi = __expf(SC[2] - mt);
#pragma unroll
            for (int it = 0; it < 3; ++it) nacc[it][jt] = nacc[it][jt] * wi; }
        {
#pragma unroll 1
            for (int ti = wave; ti < 16; ti += 8) {
                int tt, st;
                if (ti < 10) { tt = (ti >= 6) ? 3 : (ti >= 3) ? 2 : (ti >= 1) ? 1 : 0; st = ti - (tt * (tt + 1)) / 2; }
                else { const int z = ti - 10; tt = (z >= 5) ? 2 : (z >= 3) ? 1 : 0; st = (z >= 5) ? 3 : (z >= 3) ? (z - 3 + 2) : (z + 1); }
                u32x2 o = (u32x2){0u, 0u};
                if (ti < 10) {
                    f32x4 sa = (f32x4){0.f, 0.f, 0.f, 0.f};
#pragma unroll
                    for (int ks = 0; ks < 4; ++ks) { const bf16x8 ka = *(const LAS bf16x8*)(Ks + qk_off(16 * st + fr, 4 * ks + fq)); const bf16x8 qb = *(const LAS bf16x8*)(Qs + qk_off(16 * tt + fr, 4 * ks + fq));
                        sa = __builtin_amdgcn_mfma_f32_16x16x32_bf16(ka, qb, sa, 0, 0, 0); }
                    const int t = 16 * tt + fr, s0 = 16 * st + 4 * fq; const float mt = M_[t];
                    float pvv[4];
#pragma unroll
                    for (int r = 0; r < 4; ++r) pvv[r] = (s0 + r <= t) ? sa[r] * __expf(A_[s0 + r] - mt) : 0.f;
                    o.x = pk2(pvv[0], pvv[1]); o.y = pk2(pvv[2], pvv[3]);
                }
                *(LAS u32x2*)(Ps + p_off(16 * tt + fr, 2 * st + (fq >> 1)) + 4 * (fq & 1)) = o;
            }
        }
        __syncthreads();
        {   const float M63 = M_[63]; const float wk = __expf(A_[srow] - M63);
#pragma unroll
            for (int i = 0; i < 2; ++i) { v4u q = *(LAS v4u*)(Ks + qk_off(srow, (sc16 >> 3) + i));
                q.x = pk2(bflo(q.x) * wk, bfhi(q.x) * wk); q.y = pk2(bflo(q.y) * wk, bfhi(q.y) * wk); q.z = pk2(bflo(q.z) * wk, bfhi(q.z) * wk); q.w = pk2(bflo(q.w) * wk, bfhi(q.w) * wk);
                *(LAS v4u*)(Ks + qk_off(srow, (sc16 >> 3) + i)) = q; } }
        bf16x8 va[2][2];
#pragma unroll
        for (int ks = 0; ks < 2; ++ks)
#pragma unroll
            for (int it = 0; it < 2; ++it) { const int r_ = 32 * ks + 8 * fq + (fr >> 2), ch_ = 4 * wave + 2 * it + ((fr & 3) >> 1), w_ = 4 * (fr & 1); va[ks][it] = tr_frag2(Vs + v_off(r_, ch_) + w_, Vs + v_off(r_ + 4, ch_) + w_); }
#pragma unroll
        for (int ks = 0; ks < 2; ++ks)
#pragma unroll
            for (int jt = 0; jt < 4; ++jt) { const bf16x8 pb = *(const LAS bf16x8*)(Ps + p_off(16 * jt + fr, 4 * ks + fq));
                nacc[0][jt] = __builtin_amdgcn_mfma_f32_16x16x32_bf16(va[ks][0], pb, nacc[0][jt], 0, 0, 0);
                nacc[1][jt] = __builtin_amdgcn_mfma_f32_16x16x32_bf16(va[ks][1], pb, nacc[1][jt], 0, 0, 0);
                nacc[2][jt] = __builtin_amdgcn_mfma_f32_16x16x32_bf16(ones, pb, nacc[2][jt], 0, 0, 0); }
        u32x2 oq[4][2];
#pragma unroll
        for (int jt = 0; jt < 4; ++jt)
#pragma unroll
            for (int it = 0; it < 2; ++it) oq[jt][it] = *(const GAS u32x2*)(QKVO + (rb + 16 * jt + fr) * 6144 + 4096 + h * 256 + 32 * wave + 16 * it + 4 * fq);
        float s1[4], s2[4];
#pragma unroll
        for (int jt = 0; jt < 4; ++jt) {
            const int t = 16 * jt + fr;
            const float den = __shfl(nacc[2][jt][0], fr);
            const float dd = fmaxf(fabsf(den), __expf(-(B_[t] + M_[t]))); const float inv = 1.f / dd;
            s1[jt] = 0.f; s2[jt] = 0.f;
#pragma unroll
            for (int it = 0; it < 2; ++it) { const u32x2 oq_ = oq[jt][it];
                const float og[4] = {bflo(oq_.x), bfhi(oq_.x), bflo(oq_.y), bfhi(oq_.y)};
#pragma unroll
                for (int r = 0; r < 4; ++r) { const float hv = nacc[it][jt][r] * inv * __builtin_amdgcn_rcpf(1.f + __expf(-og[r])); nacc[it][jt][r] = hv; s1[jt] += hv; s2[jt] += hv * hv; } }
            s1[jt] += __shfl_xor(s1[jt], 16); s1[jt] += __shfl_xor(s1[jt], 32); s2[jt] += __shfl_xor(s2[jt], 16); s2[jt] += __shfl_xor(s2[jt], 32);
            if (fq == 0) { X_[(wave * 64 + t) * 2] = s1[jt]; X_[(wave * 64 + t) * 2 + 1] = s2[jt]; }
        }
        __syncthreads();
#pragma unroll
        for (int jt = 0; jt < 4; ++jt) {
            const int t = 16 * jt + fr; float a1 = 0.f, a2 = 0.f;
#pragma unroll
            for (int w = 0; w < 8; ++w) { a1 += X_[(w * 64 + t) * 2]; a2 += X_[(w * 64 + t) * 2 + 1]; }
            const float mu = a1 * (1.f / 256.f); const float rstd = rsqrtf(a2 * (1.f / 256.f) - mu * mu + 1e-5f);
#pragma unroll
            for (int it = 0; it < 2; ++it) { const int e = 32 * wave + 16 * it + 4 * fq; const f32x4 gn = *(const LAS f32x4*)(GN + e);
                u32x2 o; o.x = pk2((nacc[it][jt][0] - mu) * rstd * gn.x, (nacc[it][jt][1] - mu) * rstd * gn.y); o.y = pk2((nacc[it][jt][2] - mu) * rstd * gn.z, (nacc[it][jt][3] - mu) * rstd * gn.w);
                *(GAS u32x2*)(HN + (rb + t) * 2048 + h * 256 + e) = o; }
        }
        {   const float decay = SC[0];
#pragma unroll
            for (int it = 0; it < 2; ++it)
#pragma unroll
                for (int jd = 0; jd < 8; ++jd) Cacc[it][jd] = Cacc[it][jd] * decay;
            if (tid < 128) { float sum = 0.f;
#pragma unroll 8
                for (int s2_ = 0; s2_ < 64; ++s2_) sum += bflo((unsigned)Ks[qk_off(s2_, tid >> 3) + (tid & 7)]);
                nreg = decay * nreg + sum; nd[tid] = (bf16)f2bf(nreg); }
#pragma unroll
            for (int ks = 0; ks < 2; ++ks)
#pragma unroll
                for (int jd = 0; jd < 8; ++jd) { asm volatile("" ::: "memory"); const int r_ = 32 * ks + 8 * fq + (fr >> 2), ch_ = 2 * jd + ((fr & 3) >> 1), w_ = 4 * (fr & 1); const bf16x8 kb = tr_frag2(Ks + qk_off(r_, ch_) + w_, Ks + qk_off(r_ + 4, ch_) + w_);
                    Cacc[0][jd] = __builtin_amdgcn_mfma_f32_16x16x32_bf16(va[ks][0], kb, Cacc[0][jd], 0, 0, 0);
                    Cacc[1][jd] = __builtin_amdgcn_mfma_f32_16x16x32_bf16(va[ks][1], kb, Cacc[1][jd], 0, 0, 0);
                }
#pragma unroll
            for (int jd = 0; jd < 8; ++jd) {
#pragma unroll
                for (int it = 0; it < 2; ++it) { u32x2 o; o.x = pk2(Cacc[it][jd][0], Cacc[it][jd][1]); o.y = pk2(Cacc[it][jd][2], Cacc[it][jd][3]); *(LAS u32x2*)(Cd + (16 * jd + fr) * 32 + 16 * it + 4 * fq) = o; }
            }
        }
        __syncthreads();
    }
    float* Co = Cp + (size_t)(seq * 8 + h) * 32768;
#pragma unroll
    for (int jd = 0; jd < 8; ++jd) {
#pragma unroll
        for (int it = 0; it < 2; ++it) *(GAS f32x4*)(Co + (size_t)(16 * jd + fr) * 256 + 32 * wave + 16 * it + 4 * fq) = Cacc[it][jd];
    }
    if (tid < 128) np_[(seq * 8 + h) * 128 + tid] = nreg;
    if (wave == 0 && lane == 0) mp[seq * 8 + h] = m;
}

__device__ __forceinline__ void mlstm_sample_unit(const bf16* QKVO, const float* GATES, const float* hn_gain, const float* C0, const float* n0, const float* m0,
                                                  bf16* HN, float* Cs, float* ns, float* ms, int u, LAS unsigned char* lds, int wave, int lane) {
    const int h = u & 7, tid = wave * 64 + lane; const size_t r0 = 8192 + (size_t)(u >> 3) * 4;
    LAS float* q = (LAS float*)lds;
    LAS float* k = q + 512;
    LAS float* v = k + 512;
    LAS float* Sm = v + 1024;
    LAS float* gv = Sm + 16;
    LAS float* nn = gv + 32;
    LAS float* part = nn + 128;
    LAS float* red = part + 8192;
    { const int t = tid >> 7, d = tid & 127; const bf16* r = QKVO + (r0 + t) * 6144; q[tid] = bflo((unsigned)r[h * 128 + d]); k[tid] = bflo((unsigned)r[1024 + h * 128 + d]);
#pragma unroll
      for (int i = 0; i < 2; ++i) { const int idx = tid + 512 * i, tv = idx >> 8, e = idx & 255; v[idx] = bflo((unsigned)QKVO[(r0 + tv) * 6144 + 2048 + h * 256 + e]); } }
    if (tid < 128) nn[tid] = n0[(size_t)u * 128 + tid];
    if (tid == 0) {
        const float mprev = m0[u]; float b = 0.f, pm = -INFINITY;
        for (int t = 0; t < 4; ++t) { const float ig = GATES[(r0 + t) * 16 + h], lf = GATES[(r0 + t) * 16 + 8 + h]; b += lf; const float a = ig - b; pm = fmaxf(pm, a); const float Mt = fmaxf(mprev, pm);
            gv[t] = a; gv[4 + t] = Mt; gv[8 + t] = b; gv[12 + t] = __expf(mprev - Mt); }
        const float M3 = gv[7], b3 = gv[11];
        gv[28] = __expf(mprev - M3); gv[29] = b3 + M3;
        for (int s = 0; s < 4; ++s) gv[20 + s] = __expf(gv[s] - M3);
    }
    __syncthreads();
    if (tid < 16) { const int t = tid >> 2, s = tid & 3; float r = 0.f; if (s <= t) { float dot = 0.f; for (int d = 0; d < 128; ++d) dot += q[t * 128 + d] * k[s * 128 + d]; r = dot * __expf(gv[s] - gv[4 + t]); } Sm[tid] = r; }
    else if (tid < 20) { const int t = tid - 16; float dot = 0.f; for (int d = 0; d < 128; ++d) dot += q[t * 128 + d] * nn[d]; gv[24 + t] = dot; }
    __syncthreads();
    if (tid < 4) { float den = gv[12 + tid] * gv[24 + tid]; for (int s = 0; s <= tid; ++s) den += Sm[tid * 4 + s]; gv[16 + tid] = fmaxf(fabsf(den), __expf(-(gv[8 + tid] + gv[4 + tid]))); }
    k[tid] *= gv[20 + (tid >> 7)];
    __syncthreads();
    {
        const int eq = tid & 63, dg = tid >> 6; const float decay = gv[28];
        f32x4 v4[4];
#pragma unroll
        for (int s = 0; s < 4; ++s) v4[s] = *(const LAS f32x4*)(v + s * 256 + 4 * eq);
        f32x4 acc[4];
#pragma unroll
        for (int t = 0; t < 4; ++t) acc[t] = (f32x4){0.f, 0.f, 0.f, 0.f};
        const float* cin = C0 + (size_t)u * 32768 + (size_t)(dg * 16) * 256 + 4 * eq; float* cout = Cs + (size_t)u * 32768 + (size_t)(dg * 16) * 256 + 4 * eq;
#pragma unroll
        for (int hb = 0; hb < 2; ++hb) {
            f32x4 cr[8];
#pragma unroll
            for (int dd = 0; dd < 8; ++dd) cr[dd] = __builtin_nontemporal_load((const GAS f32x4*)(cin + (hb * 8 + dd) * 256));
#pragma unroll
            for (int dd = 0; dd < 8; ++dd) { const int d = dg * 16 + hb * 8 + dd; const f32x4 c = cr[dd];
#pragma unroll
                for (int t = 0; t < 4; ++t) acc[t] += c * q[t * 128 + d];
                f32x4 cn = c * decay;
#pragma unroll
                for (int s = 0; s < 4; ++s) cn += v4[s] * k[s * 128 + d];
                __builtin_nontemporal_store(cn, (GAS f32x4*)(cout + (hb * 8 + dd) * 256)); }
        }
#pragma unroll
        for (int t = 0; t < 4; ++t) *(LAS f32x4*)(part + (dg * 4 + t) * 256 + 4 * eq) = acc[t];
    }
    __syncthreads();
    float hv[2];
    {   const int t = tid >> 7, e2 = (tid & 127) * 2;
        float s1 = 0.f, s2 = 0.f;
#pragma unroll
        for (int i = 0; i < 2; ++i) { const int e = e2 + i; float num2 = 0.f;
#pragma unroll
            for (int dg = 0; dg < 8; ++dg) num2 += part[(dg * 4 + t) * 256 + e];
            float num1 = 0.f; for (int s = 0; s <= t; ++s) num1 += Sm[t * 4 + s] * v[s * 256 + e];
            float x = (num1 + gv[12 + t] * num2) / gv[16 + t];
            const float o = bflo((unsigned)QKVO[(r0 + t) * 6144 + 4096 + h * 256 + e]);
            x *= 1.f / (1.f + __expf(-o)); hv[i] = x; s1 += x; s2 += x * x; }
        s1 = wave_sum_f(s1); s2 = wave_sum_f(s2);
        if (lane == 0) { red[wave * 2] = s1; red[wave * 2 + 1] = s2; }
    }
    __syncthreads();
    {   const int t = tid >> 7, e2 = (tid & 127) * 2;
        const float a1 = red[(2 * t) * 2] + red[(2 * t + 1) * 2], a2 = red[(2 * t) * 2 + 1] + red[(2 * t + 1) * 2 + 1];
        const float mu = a1 * (1.f / 256.f); const float rstd = rsqrtf(a2 * (1.f / 256.f) - mu * mu + 1e-5f);
        const unsigned o = pk2((hv[0] - mu) * rstd * hn_gain[h * 256 + e2], (hv[1] - mu) * rstd * hn_gain[h * 256 + e2 + 1]);
        *(GAS unsigned*)(HN + (r0 + t) * 2048 + h * 256 + e2) = o;
        if (tid < 128) { float a = gv[28] * nn[tid]; for (int s = 0; s < 4; ++s) a += k[s * 128 + tid]; ns[(size_t)u * 128 + tid] = a; }
        if (tid == 0) ms[u] = gv[29];
    }
    __syncthreads();
}

__device__ __forceinline__ void phase_mlstm(const Args& a, LAS unsigned char* lds, int G, int wave, int lane, int which) {
    const bf16* QKVO = (const bf16*)(a.ws + a.L.qkvo); const float* GATES = (const float*)(a.ws + a.L.gates); bf16* HN = (bf16*)(a.ws + a.L.qp);
    const int bx = blockIdx.x;
    constexpr size_t O_CP = 17825792, O_NP = O_CP + 1048576, O_MP = O_NP + 4096, O_CS = O_MP + 32, O_NS = O_CS + 33554432, O_MS = O_NS + 131072;
    if (bx < 32) { if (which & 1) mlstm_prompt_seq(QKVO, GATES, a.in[7], HN, a.out + O_CP, a.out + O_NP, a.out + O_MP, bx >> 3, bx & 7, lds, wave, lane); }
    else {
        if (which & 2) for (int u = bx - 32; u < 1024; u += G - 32) mlstm_sample_unit(QKVO, GATES, a.in[7], a.in[2], a.in[3], a.in[4], HN, a.out + O_CS, a.out + O_NS, a.out + O_MS, u, lds, wave, lane);
        if (which & 28) { __syncthreads(); side_convert(a, lds, (bx - 32) * NWAVES + wave, (G - 32) * NWAVES, wave, lane, (which & 4) ? 3 : ((which >> 3) & 3)); }
    }
}
struct MiniBf16S { bf16* O; int ldc, sclo, schi; __device__ __forceinline__ void operator()(int row, int col, f32x4 a) const { const float s = (col >= sclo && col < schi) ? 0.08838834764831845f : 1.f;
    u32x2 o; o.x = pk2(a[0] * s, a[1] * s); o.y = pk2(a[2] * s, a[3] * s); *(GAS u32x2*)(O + (size_t)row * ldc + col) = o; } };
struct MiniBf16 { bf16* O; int ldc; __device__ __forceinline__ void operator()(int row, int col, f32x4 a) const { u32x2 o; o.x = pk2(a[0], a[1]); o.y = pk2(a[2], a[3]); *(GAS u32x2*)(O + (size_t)row * ldc + col) = o; } };
struct MiniRes { const float* res0; const float* res1; float* Z; float alpha; __device__ __forceinline__ void operator()(int row, int col, f32x4 a) const {
    const float* rp = (row < 8192) ? res0 + (size_t)row * 2048 : res1 + (size_t)(row - 8192) * 2048; const f32x4 x = *(const GAS f32x4*)(rp + col); *(GAS f32x4*)(Z + (size_t)row * 2048 + col) = x * alpha + a; } };
struct MiniGelu { bf16* U; bf16* V; const float* bias; float* VST; __device__ __forceinline__ void operator()(int row, int col, f32x4 a) const {
    const bool isv = col >= 6144; const f32x4 bv = *(const GAS f32x4*)(bias + col); float s1 = 0.f, s2 = 0.f;
#pragma unroll
    for (int e = 0; e < 4; ++e) { a[e] = pg8::gelu_tanh_f(a[e] + bv[e]); s1 += a[e]; s2 += a[e] * a[e]; }
    u32x2 o; o.x = pk2(a[0], a[1]); o.y = pk2(a[2], a[3]);
    *(GAS u32x2*)((isv ? V + (size_t)row * 6144 + (col - 6144) : U + (size_t)row * 6144 + col)) = o;
    if (isv) { s1 += __shfl_xor(s1, 16); s1 += __shfl_xor(s1, 32); s2 += __shfl_xor(s2, 16); s2 += __shfl_xor(s2, 32);
        if ((threadIdx.x & 48) == 0) { atomicAdd(VST + 2 * row, s1); atomicAdd(VST + 2 * row + 1, s2); } } } };
template <class Epi>
__device__ __forceinline__ void mini_gemm(const bf16* A, const bf16* Bt, int N, int K, const Epi& E, LAS unsigned char* lds, int vcu, int G, int wave, int lane) {
    const int tid = wave * 64 + lane, fr = lane & 15, fq = lane >> 4;
    const int srow = tid >> 4, sch = tid & 15;
    const int nct = N / 128, nunits = 16 * nct, nch = K / 128;
    const int wofs = srow * 256 + ((sch ^ (srow & 15)) << 4);
    const size_t bstep = (size_t)32 * K;
#define MG_LOAD(r, c) do { int cc_ = (c) + c0; if (cc_ >= nch) cc_ -= nch; r[0] = *(const GAS v4u*)(ag + (size_t)cc_ * 128); _Pragma("unroll") for (int p_ = 0; p_ < 4; ++p_) r[1 + p_] = *(const GAS v4u*)(bg + p_ * bstep + (size_t)cc_ * 128); } while (0)
#define MG_STORE(r, b) do { *(LAS v4u*)(lds + (b) * 40960 + wofs) = r[0]; _Pragma("unroll") for (int p_ = 0; p_ < 4; ++p_) *(LAS v4u*)(lds + (b) * 40960 + 8192 + p_ * 8192 + wofs) = r[1 + p_]; } while (0)
#define MG_COMPUTE(b) do { _Pragma("unroll") for (int ks_ = 0; ks_ < 4; ++ks_) { const int co_ = ((ks_ * 4 + fq) ^ fr) << 4; \
        const bf16x8 a0_ = *(const LAS bf16x8*)(lds + (b) * 40960 + fr * 256 + co_), a1_ = *(const LAS bf16x8*)(lds + (b) * 40960 + (16 + fr) * 256 + co_); \
        const bf16x8 b_ = *(const LAS bf16x8*)(lds + (b) * 40960 + 8192 + (wave * 16 + fr) * 256 + co_); \
        acc0 = __builtin_amdgcn_mfma_f32_16x16x32_bf16(b_, a0_, acc0, 0, 0, 0); acc1 = __builtin_amdgcn_mfma_f32_16x16x32_bf16(b_, a1_, acc1, 0, 0, 0); } } while (0)
    for (int u = vcu; u < nunits; u += G) {
        const int rt = u & 15, ct = u >> 4;
        const int row0 = 8192 + rt * 32, colB0 = ct * 128;
        const bf16* ag = A + (size_t)(row0 + srow) * K + sch * 8;
        const bf16* bg = Bt + (size_t)(colB0 + srow) * K + sch * 8;
        f32x4 acc0 = (f32x4){0.f, 0.f, 0.f, 0.f}, acc1 = acc0;
        const int c0 = (u * 5) % nch;
        v4u r0[5], r1[5], r2[5], r3[5];
        MG_LOAD(r0, 0); MG_LOAD(r1, 1); MG_LOAD(r2, 2); MG_LOAD(r3, 3);
        MG_STORE(r0, 0); __syncthreads();
#pragma unroll 1
        for (int c = 0; c < nch; c += 4) {
            MG_LOAD(r0, min(c + 4, nch - 1));
            MG_COMPUTE(0);
            MG_STORE(r1, 1); __syncthreads();
            MG_LOAD(r1, min(c + 5, nch - 1));
            MG_COMPUTE(1);
            MG_STORE(r2, 0); __syncthreads();
            MG_LOAD(r2, min(c + 6, nch - 1));
            MG_COMPUTE(0);
            MG_STORE(r3, 1); __syncthreads();
            MG_LOAD(r3, min(c + 7, nch - 1));
            MG_COMPUTE(1);
            MG_STORE(r0, 0);
            __syncthreads();
        }
        E(row0 + fr, colB0 + wave * 16 + 4 * fq, acc0); E(row0 + 16 + fr, colB0 + wave * 16 + 4 * fq, acc1);
    }
#undef MG_LOAD
#undef MG_STORE
#undef MG_COMPUTE
}
__global__ void __launch_bounds__(NWAVES * 64, 2) mk(Args args) {
    extern __shared__ __attribute__((aligned(16))) unsigned char lds_raw[];
    LAS unsigned char* lds = (LAS unsigned char*)lds_raw;
    volatile LAS unsigned* MISC = (volatile LAS unsigned*)(lds + MISC_OFF);
    const int tid = threadIdx.x, lane = tid & 63, wave = __builtin_amdgcn_readfirstlane(tid >> 6);
    const int G = gridDim.x, bx = blockIdx.x; const int vcu = (G % 8 == 0) ? (bx % 8) * (G / 8) + bx / 8 : bx;
    for (int u = tid; u < (LDS_BYTES - RING_BYTES) / 4; u += NWAVES * 64) ((LAS unsigned*)(lds + RING_BYTES))[u] = 0u;
    __syncthreads();
    unsigned char* ws = args.ws; const Lay& L = args.L;
    unsigned* ctl = (unsigned*)(ws + L.ctl);
    XcdBarrier bar = xcd_barrier_post(ctl + 4096 + args.li * XCD_BAR_WORDS, MISC + 8);
    const int lo = args.ph_lo, hi = args.ph_hi;
#ifndef PHMASK
#define PHMASK 0xFFFFFFFFu
#endif
#define IN(k) (((PHMASK >> (k)) & 1u) && lo <= (k) && (k) < hi)
#ifndef MLSTM_DUPSEL
#define MLSTM_DUPSEL 3
#endif
#ifndef TK_ABL
#define TK_ABL 0
#endif
#ifndef SP_ABL
#define SP_ABL 0
#endif
#ifndef UP_ABL
#define UP_ABL 0
#endif
#ifndef VP_ABL
#define VP_ABL 0
#endif
#ifndef DUPMASK
#define DUPMASK 0u
#endif
#define DUP(k) ((DUPMASK >> (k)) & 1u)
#define LANE() ({ int l_ = lane; asm volatile("" : "+v"(l_)); l_; })
#define SEAM(k) do { if (IN(k) && IN((k) + 1)) xcd_barrier(bar); } while (0)
#define GEMM_PHASE_FULL(EPI_T, E, Aptr, Btptr, Nn, Kk) do { pg8::Gemm g_{(const pg8::bf16_t*)(Aptr), (const pg8::bf16_t*)(Btptr), NTOKF, (Nn), (Kk)}; pg8::StaticOrder S_; S_.init(NTOKF, (Nn), G, bx); \
        pg8::gemm_phase<EPI_T, pg8::StaticOrder, true, true>(lds, g_, S_, E); } while (0)
#define GEMM_PHASE(EPI_T, E, Aptr, Btptr, Nn, Kk, MINI_E) do { pg8::Gemm g_{(const pg8::bf16_t*)(Aptr), (const pg8::bf16_t*)(Btptr), 8192, (Nn), (Kk)}; pg8::StaticOrder S_; S_.init(8192, (Nn), G, bx); \
        pg8::gemm_phase<EPI_T, pg8::StaticOrder, true, true>(lds, g_, S_, E); \
        mini_gemm((const bf16*)(Aptr), (const bf16*)(Btptr), (Nn), (Kk), MINI_E, lds, vcu, G, wave, LANE()); } while (0)

#define GEMM_PHASE_MINI(EPI_T, E, Aptr, Btptr, Nn, Kk, MINI_E) do { mini_gemm((const bf16*)(Aptr), (const bf16*)(Btptr), (Nn), (Kk), MINI_E, lds, vcu, G, wave, LANE()); } while (0)
#ifdef MINI_DUP
#define GEMM_PHASE_DUPSEL GEMM_PHASE_MINI
#else
#define GEMM_PHASE_DUPSEL GEMM_PHASE
#endif

    if (IN(0)) { { phase_prologue(args, lds, vcu, G, wave, LANE()); } if (DUP(0)) { xcd_barrier(bar); { phase_prologue(args, lds, vcu, G, wave, LANE()); } } } SEAM(0);
    if (IN(1)) { { pg8::EpiBf16S E{(pg8::bf16_t*)(ws + L.qkvo), 6144, 1024, 2048, 0.08838834764831845f}; GEMM_PHASE_FULL(pg8::EpiBf16S, E, ws + L.xb, ws + L.wina, 6144, 2048); } if (DUP(1)) { xcd_barrier(bar); { pg8::EpiBf16S E{(pg8::bf16_t*)(ws + L.qkvo), 6144, 1024, 2048, 0.08838834764831845f}; GEMM_PHASE_FULL(pg8::EpiBf16S, E, ws + L.xb, ws + L.wina, 6144, 2048); } } } SEAM(1);
    if (IN(2)) { { phase_mlstm(args, lds, G, wave, lane, 7); } if (DUP(2)) { xcd_barrier(bar); { phase_mlstm(args, lds, G, wave, lane, MLSTM_DUPSEL); } } } SEAM(2);
    if (IN(3)) { { pg8::EpiRes E{args.in[0], args.in[1], (float*)(ws + L.z), ALPHA_F}; GEMM_PHASE(pg8::EpiRes, E, ws + L.qp, ws + L.wouta, 2048, 2048, (MiniRes{args.in[0], args.in[1], (float*)(ws + L.z), ALPHA_F})); } if (DUP(3)) { xcd_barrier(bar); { pg8::EpiRes E{args.in[0], args.in[1], (float*)(ws + L.z), ALPHA_F}; GEMM_PHASE(pg8::EpiRes, E, ws + L.qp, ws + L.wouta, 2048, 2048, (MiniRes{args.in[0], args.in[1], (float*)(ws + L.z), ALPHA_F})); } } } SEAM(3);
    if (IN(4)) { { phase_ln<false>((const float*)(ws + L.z), args.in[16], args.in[17], (float*)nullptr, (bf16*)(ws + L.xb), ws + L.xq, (float*)(ws + L.sx), vcu, G, wave, LANE()); } if (DUP(4)) { xcd_barrier(bar); { phase_ln<false>((const float*)(ws + L.z), args.in[16], args.in[17], (float*)nullptr, (bf16*)(ws + L.xb), ws + L.xq, (float*)(ws + L.sx), vcu, G, wave, LANE()); } } } SEAM(4);
    if (IN(5)) { { pg8::EpiBf16S E{(pg8::bf16_t*)(ws + L.qp), 2048, 0, 0, 1.f}; GEMM_PHASE(pg8::EpiBf16S, E, ws + L.xb, ws + L.wq, 2048, 2048, (MiniBf16S{(bf16*)(ws + L.qp), 2048, 0, 0})); } if (DUP(5)) { xcd_barrier(bar); { pg8::EpiBf16S E{(pg8::bf16_t*)(ws + L.qp), 2048, 0, 0, 1.f}; GEMM_PHASE(pg8::EpiBf16S, E, ws + L.xb, ws + L.wq, 2048, 2048, (MiniBf16S{(bf16*)(ws + L.qp), 2048, 0, 0})); } } } SEAM(5);
#define RINV_U ((const float*)(ws + L.rinv))
#define RINV_V ((const float*)(ws + L.rinv) + 16384)
    if (IN(6)) { { phase_topk<0>((const bf16*)(ws + L.qp), (const bf16*)(ws + L.sk), (int*)(ws + L.idx), (float*)(ws + L.gt), (float*)(ws + L.ww), (float*)(ws + L.su), RINV_U, RINV_V, lds, vcu, G, wave, LANE()); } if (DUP(6)) { xcd_barrier(bar); { phase_topk<TK_ABL>((const bf16*)(ws + L.qp), (const bf16*)(ws + L.sk), (int*)(ws + L.um), (float*)(ws + L.um + 8388608), (float*)(ws + L.um + 16777216), (float*)(ws + L.um + 25165824), RINV_U, RINV_V, lds, vcu, G, wave, LANE()); } } } SEAM(6);
    if (IN(7)) { { phase_upass_sl<0>((const unsigned char*)(ws + L.ptu), (const unsigned char*)(ws + L.xq), (const float*)(ws + L.sx), (const int*)(ws + L.idx), (float*)(ws + L.ww), (float*)(ws + L.gt), (float*)(ws + L.su), RINV_U, RINV_V, xcd_topology(bar.bar, bar.x, MISC[10], wave), LANE()); } if (DUP(7)) { xcd_barrier(bar); { phase_upass_sl<UP_ABL>((const unsigned char*)(ws + L.ptu), (const unsigned char*)(ws + L.xq), (const float*)(ws + L.sx), (const int*)(ws + L.idx), (float*)(ws + L.um), (float*)(ws + L.gt), (float*)(ws + L.su), RINV_U, RINV_V, xcd_topology(bar.bar, bar.x, MISC[10], wave), LANE()); } } } SEAM(7);
    if (IN(8)) { { phase_vpass_sl<0>((const unsigned char*)(ws + L.ptv), (const bf16*)(ws + L.xb), (const int*)(ws + L.idx), (const float*)(ws + L.ww), (const float*)(ws + L.su), (const float*)(ws + L.gt), (bf16*)(ws + L.z), ALPHA_F, xcd_topology(bar.bar, bar.x, MISC[10], wave), lds, wave, LANE()); } if (DUP(8)) { xcd_barrier(bar); { phase_vpass_sl<VP_ABL>((const unsigned char*)(ws + L.ptv), (const bf16*)(ws + L.xb), (const int*)(ws + L.idx), (const float*)(ws + L.ww), (const float*)(ws + L.su), (const float*)(ws + L.gt), (bf16*)(ws + L.um), ALPHA_F, xcd_topology(bar.bar, bar.x, MISC[10], wave), lds, wave, LANE()); } } } SEAM(8);
    if (IN(9)) { { phase_ln<true>((const float*)(ws + L.z), args.in[18], args.in[19], (float*)(ws + L.xf1), (bf16*)(ws + L.xb), (unsigned char*)nullptr, (float*)nullptr, vcu, G, wave, LANE()); } if (DUP(9)) { xcd_barrier(bar); { phase_ln<true>((const float*)(ws + L.z), args.in[18], args.in[19], (float*)(ws + L.xf1), (bf16*)(ws + L.xb), (unsigned char*)nullptr, (float*)nullptr, vcu, G, wave, LANE()); } } } SEAM(9);
    if (IN(10)) { { pg8::EpiGelu E{(pg8::bf16_t*)(ws + L.ub), (pg8::bf16_t*)(ws + L.vb), args.in[10], (float*)(ws + L.vst)}; GEMM_PHASE_FULL(pg8::EpiGelu, E, ws + L.xb, ws + L.winb, 12288, 2048); } if (DUP(10)) { xcd_barrier(bar); { pg8::EpiGelu E{(pg8::bf16_t*)(ws + L.ub), (pg8::bf16_t*)(ws + L.vb), args.in[10], (float*)(ws + L.vst)}; GEMM_PHASE_FULL(pg8::EpiGelu, E, ws + L.xb, ws + L.winb, 12288, 2048); } } } SEAM(10);
    if (IN(11)) { { phase_spatial<0>((const bf16*)(ws + L.ub), (const bf16*)(ws + L.vb), (const float*)(ws + L.vst), args.in[11], args.in[12], (const bf16*)(ws + L.wsb), args.in[13], args.in[14],
                                (bf16*)(ws + L.um), args.out + OUT_VS, lds, vcu, G, wave, LANE()); } if (DUP(11)) { xcd_barrier(bar); { phase_spatial<SP_ABL>((const bf16*)(ws + L.ub), (const bf16*)(ws + L.vb), (const float*)(ws + L.vst), args.in[11], args.in[12], (const bf16*)(ws + L.wsb), args.in[13], args.in[14],
                                (bf16*)(ws + L.ptu), (float*)(ws + L.ptu1), lds, vcu, G, wave, LANE()); } } } SEAM(11);
    if (IN(12)) { { pg8::EpiRes E{(const float*)(ws + L.xf1), (const float*)(ws + L.xf1) + (size_t)8192 * 2048, (float*)(ws + L.z), ALPHA_F}; GEMM_PHASE(pg8::EpiRes, E, ws + L.um, ws + L.woutb, 2048, 6144, (MiniRes{(const float*)(ws + L.xf1), (const float*)(ws + L.xf1) + (size_t)8192 * 2048, (float*)(ws + L.z), ALPHA_F})); } if (DUP(12)) { xcd_barrier(bar); { pg8::EpiRes E{(const float*)(ws + L.xf1), (const float*)(ws + L.xf1) + (size_t)8192 * 2048, (float*)(ws + L.z), ALPHA_F}; GEMM_PHASE_DUPSEL(pg8::EpiRes, E, ws + L.um, ws + L.woutb, 2048, 6144, (MiniRes{(const float*)(ws + L.xf1), (const float*)(ws + L.xf1) + (size_t)8192 * 2048, (float*)(ws + L.z), ALPHA_F})); } } } SEAM(12);
    if (IN(13)) { { phase_ln<false>((const float*)(ws + L.z), args.in[16] + 2048, args.in[17] + 2048, (float*)nullptr, (bf16*)(ws + L.xb), ws + L.xq, (float*)(ws + L.sx), vcu, G, wave, LANE()); } if (DUP(13)) { xcd_barrier(bar); { phase_ln<false>((const float*)(ws + L.z), args.in[16] + 2048, args.in[17] + 2048, (float*)nullptr, (bf16*)(ws + L.xb), ws + L.xq, (float*)(ws + L.sx), vcu, G, wave, LANE()); } } } SEAM(13);
    if (IN(14)) { { pg8::EpiBf16S E{(pg8::bf16_t*)(ws + L.qp), 2048, 0, 0, 1.f}; GEMM_PHASE(pg8::EpiBf16S, E, ws + L.xb, (bf16*)(ws + L.wq) + (size_t)2048 * 2048, 2048, 2048, (MiniBf16S{(bf16*)(ws + L.qp), 2048, 0, 0})); } if (DUP(14)) { xcd_barrier(bar); { pg8::EpiBf16S E{(pg8::bf16_t*)(ws + L.qp), 2048, 0, 0, 1.f}; GEMM_PHASE(pg8::EpiBf16S, E, ws + L.xb, (bf16*)(ws + L.wq) + (size_t)2048 * 2048, 2048, 2048, (MiniBf16S{(bf16*)(ws + L.qp), 2048, 0, 0})); } } } SEAM(14);
#undef RINV_U
#undef RINV_V
#define RINV_U ((const float*)(ws + L.rinv) + 32768)
#define RINV_V ((const float*)(ws + L.rinv) + 49152)
    if (IN(15)) { { phase_topk<0>((const bf16*)(ws + L.qp), (const bf16*)(ws + L.sk) + (size_t)16 * 128 * 128, (int*)(ws + L.idx), (float*)(ws + L.gt), (float*)(ws + L.ww), (float*)(ws + L.su), RINV_U, RINV_V, lds, vcu, G, wave, LANE()); } if (DUP(15)) { xcd_barrier(bar); { phase_topk<TK_ABL>((const bf16*)(ws + L.qp), (const bf16*)(ws + L.sk) + (size_t)16 * 128 * 128, (int*)(ws + L.um), (float*)(ws + L.um + 8388608), (float*)(ws + L.um + 16777216), (float*)(ws + L.um + 25165824), RINV_U, RINV_V, lds, vcu, G, wave, LANE()); } } } SEAM(15);
    if (IN(16)) { { phase_upass_sl<0>((const unsigned char*)(ws + L.ptu1), (const unsigned char*)(ws + L.xq), (const float*)(ws + L.sx), (const int*)(ws + L.idx), (float*)(ws + L.ww), (float*)(ws + L.gt), (float*)(ws + L.su), RINV_U, RINV_V, xcd_topology(bar.bar, bar.x, MISC[10], wave), LANE()); } if (DUP(16)) { xcd_barrier(bar); { phase_upass_sl<UP_ABL>((const unsigned char*)(ws + L.ptu1), (const unsigned char*)(ws + L.xq), (const float*)(ws + L.sx), (const int*)(ws + L.idx), (float*)(ws + L.um), (float*)(ws + L.gt), (float*)(ws + L.su), RINV_U, RINV_V, xcd_topology(bar.bar, bar.x, MISC[10], wave), LANE()); } } } SEAM(16);
    if (IN(17)) { { phase_vpass_sl<0>((const unsigned char*)(ws + L.ptv1), (const bf16*)(ws + L.xb), (const int*)(ws + L.idx), (const float*)(ws + L.ww), (const float*)(ws + L.su), (const float*)(ws + L.gt), (bf16*)(ws + L.z), ALPHA_F, xcd_topology(bar.bar, bar.x, MISC[10], wave), lds, wave, LANE()); } if (DUP(17)) { xcd_barrier(bar); { phase_vpass_sl<VP_ABL>((const unsigned char*)(ws + L.ptv1), (const bf16*)(ws + L.xb), (const int*)(ws + L.idx), (const float*)(ws + L.ww), (const float*)(ws + L.su), (const float*)(ws + L.gt), (bf16*)(ws + L.um), ALPHA_F, xcd_topology(bar.bar, bar.x, MISC[10], wave), lds, wave, LANE()); } } } SEAM(17);
#ifdef XBAR_EXTRA
    if (IN(17) && IN(18)) { for (int e_ = 0; e_ < XBAR_EXTRA; ++e_) xcd_barrier(bar); }
#endif
    if (IN(18)) { phase_ln<true>((const float*)(ws + L.z), args.in[18] + 2048, args.in[19] + 2048, args.out, nullptr, (unsigned char*)nullptr, (float*)nullptr, vcu, G, wave, LANE()); }
#undef IN
#undef SEAM
#undef GEMM_PHASE
}

static int g_grid = 0;
static bool mk_init() {
    if (g_grid == 0) {
        int dev = 0, cus = 0;
        if (hipGetDevice(&dev) != hipSuccess || hipDeviceGetAttribute(&cus, hipDeviceAttributeMultiprocessorCount, dev) != hipSuccess) { g_grid = -1; return false; }
        if (hipFuncSetAttribute((const void*)mk, hipFuncAttributeMaxDynamicSharedMemorySize, LDS_BYTES) != hipSuccess) { g_grid = -1; return false; }
        (void)hipGetLastError();
        g_grid = cus;
    }
    return g_grid > 0;
}
static void mk_launch(const Args& a0, int lo, int hi, int li, hipStream_t st) {
    Args a = a0; a.ph_lo = lo; a.ph_hi = hi; a.li = li;
    hipLaunchKernelGGL(mk, dim3(g_grid), dim3(NWAVES * 64), LDS_BYTES, st, a);
}
extern "C" void kernel_launch(void* const* d_in, const int* in_sizes, int n_in, void* d_out, int out_size, void* d_ws, size_t ws_size, hipStream_t stream) {
    if (!mk_init()) return;
    constexpr unsigned long long MiB = 1ull << 20;
    Args a{};
    for (int i = 0; i < 24; ++i) a.in[i] = (const float*)d_in[i];
    a.out = (float*)d_out; a.ws = (unsigned char*)d_ws;
    Lay& L = a.L;
    L.ctl = 0; L.wina = 1 * MiB; L.wouta = 25 * MiB; L.winb = 33 * MiB; L.woutb = 81 * MiB; L.wq = 105 * MiB; L.sk = 121 * MiB; L.gates = 122 * MiB; L.vst = 123 * MiB; L.wsb = 124 * MiB;
    L.idx = 125 * MiB; L.gt = 130 * MiB; L.ww = 135 * MiB; L.ptu = 140 * MiB; L.ptv = 204 * MiB; L.xf0 = 268 * MiB; L.xf1 = 336 * MiB; L.z = 404 * MiB; L.xb = 472 * MiB; L.qp = 506 * MiB;
    L.qkvo = 540 * MiB; L.ub = 540 * MiB; L.vb = 642 * MiB; L.um = 744 * MiB; L.ptu1 = 846 * MiB; L.ptv1 = 910 * MiB; L.rinv = 974 * MiB; L.su = 975 * MiB; L.xq = 980 * MiB; L.sx = 997 * MiB;
    (void)hipMemsetAsync((unsigned char*)d_ws + L.ctl, 0, MiB, stream);
    mk_launch(a, 0, 19, 0, stream);
}
```

```cpp
#include <hip/hip_runtime.h>
#include <stdint.h>
#include <math.h>
#define DUPMASK 0u
#define MLSTM_DUPSEL 7
#define GAS __attribute__((address_space(1)))
#define LAS __attribute__((address_space(3)))
typedef unsigned short bf16;
typedef unsigned v4u __attribute__((ext_vector_type(4)));
typedef float f32x4 __attribute__((ext_vector_type(4)));
typedef short bf16x8 __attribute__((ext_vector_type(8)));
typedef GAS unsigned gu32;
typedef GAS unsigned long long gu64;
#define RLX_AGENT __ATOMIC_RELAXED, __HIP_MEMORY_SCOPE_AGENT
#define LDS_WAIT() asm volatile("s_waitcnt lgkmcnt(0)" ::: "memory")
#define VM_WAIT() asm volatile("s_waitcnt vmcnt(0)" ::: "memory")
__device__ __forceinline__ unsigned long long rt() { return __builtin_amdgcn_s_memrealtime(); }
__device__ __forceinline__ unsigned f2bf(float f) { unsigned u = __builtin_bit_cast(unsigned, f); return (u + 0x7fffu + ((u >> 16) & 1u)) >> 16; }
__device__ __forceinline__ unsigned pk2(float lo, float hi) { unsigned r; asm("v_cvt_pk_bf16_f32 %0, %1, %2" : "=v"(r) : "v"(lo), "v"(hi)); return r; }

#define XB_TMO      128
#define XB_XCNT(j)  (256  + 64 * (j))
#define XB_XSUB(j)  (1280 + 64 * (j))
#define XB_XGEN(j)  (2304 + 64 * (j))
#define XB_TOP      3328
#define XB_TOPGEN   3392
#define XCD_BAR_WORDS 3456
#define XB_SPIN_CAP (1u << 22)

__device__ __forceinline__ unsigned xb_ld(unsigned* p)              { return __hip_atomic_load(p, __ATOMIC_RELAXED, __HIP_MEMORY_SCOPE_AGENT); }
__device__ __forceinline__ unsigned xb_add(unsigned* p, unsigned v) { return __hip_atomic_fetch_add(p, v, __ATOMIC_RELAXED, __HIP_MEMORY_SCOPE_AGENT); }
__device__ __forceinline__ unsigned xb_xcc_id() { return (unsigned)__builtin_amdgcn_s_getreg((3 << 11) | 20) & 0xFu; }
#define XB_SPIN(cond, bar) do { unsigned _sp = 0; while (cond) { __builtin_amdgcn_s_sleep(1); \
    if ((++_sp & 255u) == 0u) { if (xb_ld(&(bar)[XB_TMO])) break; if (_sp > XB_SPIN_CAP) { atomicAdd(&(bar)[XB_TMO], 1u); break; } } } } while (0)

struct XcdBarrier {
    unsigned* bar; unsigned x;
    volatile LAS unsigned* st;
};

__device__ __forceinline__ XcdBarrier xcd_barrier_post(unsigned* bar, volatile LAS unsigned* st) {
    XcdBarrier b; b.bar = bar; b.x = xb_xcc_id(); b.st = st;
    if (threadIdx.x == 0) st[2] = xb_add(&bar[XB_XCNT(b.x)], 1u);
    return b;
}
__device__ __forceinline__ void xcd_barrier_complete(unsigned* bar, unsigned x, unsigned& nloc, unsigned& nx) {
    const unsigned G = gridDim.x * gridDim.y * gridDim.z;
    unsigned sum, cnt, mine, sp = 0u;
    for (;;) {
        sum = 0u; cnt = 0u; mine = 0u;
#pragma unroll
        for (unsigned j = 0; j < 16; ++j) { const unsigned c = xb_ld(&bar[XB_XCNT(j)]); sum += c; cnt += (c > 0u) ? 1u : 0u; mine = (j == x) ? c : mine; }
        if (sum == G) break;
        __builtin_amdgcn_s_sleep(1);
        if ((++sp & 255u) == 0u) { if (xb_ld(&bar[XB_TMO])) break; if (sp > XB_SPIN_CAP) { atomicAdd(&bar[XB_TMO], 1u); break; } }
    }
    nloc = mine > 0u ? mine : 1u; nx = cnt > 0u ? cnt : 1u;
}

__device__ __forceinline__ void xcd_barrier(const XcdBarrier& b) {
    asm volatile("s_waitcnt vmcnt(0)" ::: "memory");
    __syncthreads();
    if (threadIdx.x == 0) {
        unsigned* bar = b.bar;
        __builtin_amdgcn_s_waitcnt(0);
        unsigned nloc = b.st[0], nx = b.st[1];
        if (nloc == 0u) { xcd_barrier_complete(bar, b.x, nloc, nx); b.st[0] = nloc; b.st[1] = nx; }
        const unsigned old = xb_add(&bar[XB_XSUB(b.x)], 1u);
        const unsigned gen = old / nloc;
        if (old + 1u == (gen + 1u) * nloc) {
            __builtin_amdgcn_fence(__ATOMIC_RELEASE, "agent");
            asm volatile("s_waitcnt vmcnt(0)" ::: "memory");
            const unsigned og = xb_add(&bar[XB_TOP], 1u);
            const unsigned tg = og / nx;
            if (og + 1u == (tg + 1u) * nx) xb_add(&bar[XB_TOPGEN], 1u);
            else XB_SPIN(xb_ld(&bar[XB_TOPGEN]) == tg, bar);
            __builtin_amdgcn_fence(__ATOMIC_ACQUIRE, "agent");
            xb_add(&bar[XB_XGEN(b.x)], 1u);
            asm volatile("s_waitcnt vmcnt(0)" ::: "memory");
        } else {
            XB_SPIN(xb_ld(&bar[XB_XGEN(b.x)]) == gen, bar);
            __builtin_amdgcn_fence(__ATOMIC_ACQUIRE, "agent");
            asm volatile("s_waitcnt vmcnt(0)" ::: "memory");
        }
    }
    __syncthreads();
}

namespace pg8 {
#define PG8_LAS __attribute__((address_space(3)))
typedef unsigned short bf16_t;
typedef short bf16x8 __attribute__((ext_vector_type(8)));
typedef float f32x4 __attribute__((ext_vector_type(4)));
typedef unsigned u32x4 __attribute__((ext_vector_type(4)));
typedef unsigned pu32x2 __attribute__((ext_vector_type(2)));
constexpr int BM = 256, BK = 64, HALF = 128, HTB = HALF * BK * 2  , STAGE_BYTES = 8 * HTB, NXCD = 8, WGM = 8;

__host__ __device__ __forceinline__ int lds_byte(int r, int c) { const int st = (r >> 4) * 2 + (c >> 5), rr = r & 15, cc = c & 31, ob = rr * 64 + cc * 2; return st * 1024 + (ob ^ (((ob >> 9) & 1) << 5)); }
__host__ __device__ __forceinline__ void stage_rc(int b, int& R, int& C) { const int st = b / 1024, sb = b % 1024, swz = sb ^ (((sb >> 9) & 1) << 5); R = (st >> 1) * 16 + swz / 64; C = (st & 1) * 32 + (swz % 64) / 2; }
__host__ __device__ __forceinline__ int perm32(int rho) { const int n = rho >> 4, i = rho & 15; return 8 * (i >> 2) + 4 * n + (i & 3); }

struct Unit { int pm, pn; };
struct Gemm { const bf16_t* A; const bf16_t* Bt; int M, N, K; };

struct StaticOrder {
    int nM, nN, nwg, G, c;
    __host__ __device__ void init(int M, int N, int G_, int c_) { nM = M / BM; nN = N / BM; nwg = nM * nN; G = G_; c = c_; }
    __host__ __device__ bool next(int i, Unit& u) const {
        const long L = (long)i * G + c; if (L >= nwg) return false;
        int wgid = (int)L; { const int q = nwg / NXCD, r = nwg % NXCD, xcd = wgid % NXCD, off = wgid / NXCD; wgid = (xcd < r ? xcd * (q + 1) : r * (q + 1) + (xcd - r) * q) + off; }
        const int nig = WGM * nN, gid = wgid / nig, fm = gid * WGM, gsz = (nM - fm) < WGM ? (nM - fm) : WGM;
        u.pm = fm + ((wgid % nig) % gsz); u.pn = (wgid % nig) / gsz; return true;
    }
    __device__ __forceinline__ void a_ready(const Unit&) const {}
    __device__ __forceinline__ void done(const Unit&) const {}
};


__device__ __forceinline__ unsigned cvt_pk_bf16(float lo, float hi) { unsigned r; asm volatile("v_cvt_pk_bf16_f32 %0, %1, %2" : "=v"(r) : "v"(lo), "v"(hi)); return r; }
__device__ __forceinline__ float gelu_tanh_f(float x) { const float u = x + 0.044715f * x * x * x; const float e = __builtin_amdgcn_exp2f(u * -2.302208198f); return x * __builtin_amdgcn_rcpf(1.0f + e); }
struct EpiBf16S {
    static constexpr bool PERM = true, AFTER_DRAIN = false;
    bf16_t* O; int ldc; int sc_lo, sc_hi; float sc;
    __device__ __forceinline__ void operator()(const f32x4 (&acc)[2][2][4][2], const Unit& u, int wr, int wc, int fr, int fq) const {
        const int row0 = u.pm * BM + wr * 64 + fr; const int colt = u.pn * BM;
        const float s = (colt >= sc_lo && colt < sc_hi) ? sc : 1.f;
        const int col0 = colt + wc * 32 + 8 * fq;
#pragma unroll
        for (int ai = 0; ai < 2; ++ai)
#pragma unroll
            for (int m = 0; m < 4; ++m) { bf16_t* rowp = O + (size_t)(row0 + ai * HALF + m * 16) * ldc + col0;
#pragma unroll
                for (int bj = 0; bj < 2; ++bj) { const f32x4 v0 = acc[ai][bj][m][0] * s, v1 = acc[ai][bj][m][1] * s;
                    u32x4 w; w.x = cvt_pk_bf16(v0[0], v0[1]); w.y = cvt_pk_bf16(v0[2], v0[3]); w.z = cvt_pk_bf16(v1[0], v1[1]); w.w = cvt_pk_bf16(v1[2], v1[3]);
                    *(u32x4*)(rowp + bj * HALF) = w; } }
    }
};
struct EpiRes {
    static constexpr bool PERM = false, AFTER_DRAIN = false;
    const bf16_t* xb; bf16_t* Z; float alpha;
    __device__ __forceinline__ void operator()(const f32x4 (&acc)[2][2][4][2], const Unit& u, int wr, int wc, int fr, int fq) const {
        const int col0 = u.pn * BM + wc * 32 + 4 * fq;
#pragma unroll
        for (int ai = 0; ai < 2; ++ai)
#pragma unroll
            for (int m = 0; m < 4; ++m) { const int r = u.pm * BM + ai * HALF + wr * 64 + m * 16 + fr;
                const bf16_t* rp = xb + (size_t)r * 2048; bf16_t* zp = Z + (size_t)r * 2048;
#pragma unroll
                for (int bj = 0; bj < 2; ++bj)
#pragma unroll
                    for (int n = 0; n < 2; ++n) { const int c = col0 + bj * HALF + n * 16; const pu32x2 x = *(const pu32x2*)(rp + c); const f32x4 a = acc[ai][bj][m][n];
                        pu32x2 o; o.x = pk2(__builtin_bit_cast(float, x.x << 16) * alpha + a[0], __builtin_bit_cast(float, x.x & 0xffff0000u) * alpha + a[1]);
                        o.y = pk2(__builtin_bit_cast(float, x.y << 16) * alpha + a[2], __builtin_bit_cast(float, x.y & 0xffff0000u) * alpha + a[3]); *(pu32x2*)(zp + c) = o; } }
    }
};
struct EpiGelu {
    static constexpr bool PERM = true, AFTER_DRAIN = false;
    bf16_t* U; bf16_t* V; const float* bias; float* VST;
    __device__ __forceinline__ void operator()(const f32x4 (&acc)[2][2][4][2], const Unit& u, int wr, int wc, int fr, int fq) const {
        const int row0 = u.pm * BM + wr * 64 + fr; const bool isv = u.pn >= 24; const int colt = (isv ? u.pn - 24 : u.pn) * BM;
        bf16_t* base = isv ? V : U;
        const int col0 = colt + wc * 32 + 8 * fq, bcol0 = u.pn * BM + wc * 32 + 8 * fq;
        f32x4 bv[2][2];
#pragma unroll
        for (int bj = 0; bj < 2; ++bj)
#pragma unroll
            for (int n = 0; n < 2; ++n) bv[bj][n] = *(const f32x4*)(bias + bcol0 + bj * HALF + 4 * n);
#pragma unroll
        for (int ai = 0; ai < 2; ++ai)
#pragma unroll
            for (int m = 0; m < 4; ++m) { const int r = row0 + ai * HALF + m * 16; bf16_t* rowp = base + (size_t)r * 6144 + col0; float s1 = 0.f, s2 = 0.f;
#pragma unroll
                for (int bj = 0; bj < 2; ++bj) { f32x4 v0 = acc[ai][bj][m][0] + bv[bj][0], v1 = acc[ai][bj][m][1] + bv[bj][1];
#pragma unroll
                    for (int e = 0; e < 4; ++e) { v0[e] = gelu_tanh_f(v0[e]); v1[e] = gelu_tanh_f(v1[e]); s1 += v0[e] + v1[e]; s2 += v0[e] * v0[e] + v1[e] * v1[e]; }
                    u32x4 w; w.x = cvt_pk_bf16(v0[0], v0[1]); w.y = cvt_pk_bf16(v0[2], v0[3]); w.z = cvt_pk_bf16(v1[0], v1[1]); w.w = cvt_pk_bf16(v1[2], v1[3]);
                    *(u32x4*)(rowp + bj * HALF) = w; }
                if (isv) { s1 += __shfl_xor(s1, 16); s1 += __shfl_xor(s1, 32); s2 += __shfl_xor(s2, 16); s2 += __shfl_xor(s2, 32);
                    if (fq == 0) { atomicAdd(VST + 2 * r, s1); atomicAdd(VST + 2 * r + 1, s2); } } }
    }
};
template <class Epi, class Sched, bool ALIGN_EPI = false, bool SP2 = false>
__device__ __forceinline__ void gemm_phase(PG8_LAS unsigned char* lds, const Gemm g, const Sched& S, const Epi& E) {
    int tid_l = threadIdx.x; asm volatile("" : "+v"(tid_l));
    const int tid = tid_l, wid = __builtin_amdgcn_readfirstlane(tid >> 6), lane = tid & 63, wr = wid >> 2, wc = wid & 3, fr = lane & 15, fq = lane >> 4;
    const int K = g.K, nt = K / BK;
    unsigned voffA[2], voffB[2];
#pragma unroll
    for (int i = 0; i < 2; ++i) { int R, C; stage_rc(tid * 16 + i * 8192, R, C); const int Rb = Epi::PERM ? ((R & ~31) + perm32(R & 31)) : R;
        voffA[i] = (unsigned)(R * K + C) * 2u; voffB[i] = (unsigned)(Rb * K + C) * 2u; }
    const size_t kstep = (size_t)(BK * 2);
    const size_t hstep = (size_t)HALF * K * 2;
    const size_t tstep = 2 * hstep;
    const unsigned ldsw = (unsigned)wid * 1024u;
    const int aoff = lds_byte(wr * 64 + fr, fq * 8), boff = lds_byte(wc * 32 + fr, fq * 8);
#define PG8_SA(b, h) (((b) * 2 + (h)) * HTB)
#define PG8_SB(b, h) ((4 + (b) * 2 + (h)) * HTB)
#define PG8_STAGE(bufoff, gbase, voff) do { _Pragma("unroll") for (int _i = 0; _i < 2; ++_i) \
        __builtin_amdgcn_global_load_lds((const unsigned*)((const char*)(gbase) + (voff)[_i]), (PG8_LAS unsigned*)(lds + (bufoff) + ldsw + _i * 8192), 16, 0, 0); } while (0)
#define PG8_LDA(dst, b, h) do { _Pragma("unroll") for (int m = 0; m < 4; ++m) _Pragma("unroll") for (int k = 0; k < 2; ++k) dst[m][k] = *(const PG8_LAS bf16x8*)(lds + PG8_SA(b, h) + aoff + m * 2048 + k * 1024); } while (0)
#define PG8_LDB(dst, b, h) do { _Pragma("unroll") for (int n = 0; n < 2; ++n) _Pragma("unroll") for (int k = 0; k < 2; ++k) dst[n][k] = *(const PG8_LAS bf16x8*)(lds + PG8_SB(b, h) + boff + n * 2048 + k * 1024); } while (0)
#define PG8_MMA(ai, bj, At, Bt) do { __builtin_amdgcn_s_setprio(1); _Pragma("unroll") for (int m = 0; m < 4; ++m) _Pragma("unroll") for (int n = 0; n < 2; ++n) _Pragma("unroll") for (int k = 0; k < 2; ++k) \
        acc[ai][bj][m][n] = __builtin_amdgcn_mfma_f32_16x16x32_bf16(Bt[n][k], At[m][k], acc[ai][bj][m][n], 0, 0, 0); __builtin_amdgcn_s_setprio(0); } while (0)
#define PG8_WAIT_V(n) asm volatile("s_waitcnt vmcnt(" #n ")" ::: "memory")
#define PG8_WAIT_L(n) asm volatile("s_waitcnt lgkmcnt(" #n ")" ::: "memory")
#define PG8_BAR __builtin_amdgcn_s_barrier()
#define PG8_SCHED __builtin_amdgcn_sched_barrier(0)
    Unit cur, nxt; int ui = 0;
    if (!S.next(0, cur)) return;
    f32x4 acc[2][2][4][2];
#pragma unroll
    for (int a = 0; a < 2; ++a)
#pragma unroll
        for (int b = 0; b < 2; ++b)
#pragma unroll
            for (int m = 0; m < 4; ++m)
#pragma unroll
                for (int n = 0; n < 2; ++n) acc[a][b][m][n] = (f32x4){0.f, 0.f, 0.f, 0.f};
    bf16x8 At[4][2], B0[2][2], B1[2][2];
    const char* cA = (const char*)g.A + (size_t)cur.pm * tstep; const char* cB = (const char*)g.Bt + (size_t)cur.pn * tstep;
    S.a_ready(cur);
    if constexpr (SP2) {
        PG8_STAGE(PG8_SB(0, 0), cB, voffB); PG8_STAGE(PG8_SB(0, 1), cB + hstep, voffB); PG8_STAGE(PG8_SA(0, 0), cA, voffA); PG8_STAGE(PG8_SA(0, 1), cA + hstep, voffA);
        if (wr == 1) PG8_BAR;
        PG8_WAIT_V(2); PG8_BAR;
        PG8_STAGE(PG8_SB(1, 0), cB + kstep, voffB); PG8_STAGE(PG8_SA(1, 0), cA + kstep, voffA); PG8_STAGE(PG8_SB(1, 1), cB + hstep + kstep, voffB);
        PG8_WAIT_V(6); PG8_BAR;
    } else {
        PG8_STAGE(PG8_SB(0, 0), cB, voffB); PG8_STAGE(PG8_SA(0, 0), cA, voffA); PG8_STAGE(PG8_SB(0, 1), cB + hstep, voffB); PG8_STAGE(PG8_SA(0, 1), cA + hstep, voffA);
        if (wr == 1) PG8_BAR;
        PG8_WAIT_V(4); PG8_BAR;
        PG8_STAGE(PG8_SB(1, 0), cB + kstep, voffB); PG8_STAGE(PG8_SA(1, 0), cA + kstep, voffA); PG8_STAGE(PG8_SB(1, 1), cB + hstep + kstep, voffB);
        PG8_WAIT_V(6); PG8_BAR;
    }
    for (;;) {
        const bool has_next = S.next(ui + 1, nxt);
        const char* nA = has_next ? (const char*)g.A + (size_t)nxt.pm * tstep : cA; const char* nB = has_next ? (const char*)g.Bt + (size_t)nxt.pn * tstep : cB;
        for (int t = 0; t < nt; t += 2) {
            const bool last = (t == nt - 2);
            const char* a1 = cA + (size_t)(t + 1) * kstep;
            const char* a2 = last ? nA : cA + (size_t)(t + 2) * kstep; const char* b2 = last ? nB : cB + (size_t)(t + 2) * kstep;
            const char* a3 = a2 + kstep; const char* b3 = b2 + kstep;
            if (last && has_next) S.a_ready(nxt);
            if constexpr (SP2) {
            PG8_LDB(B0, 0, 0); PG8_LDB(B1, 0, 1); PG8_SCHED; PG8_LDA(At, 0, 0); PG8_STAGE(PG8_SA(1, 1), a1 + hstep, voffA);
            PG8_WAIT_V(8); PG8_WAIT_L(0); PG8_BAR; PG8_MMA(0, 0, At, B0); PG8_MMA(0, 1, At, B1); PG8_BAR; PG8_SCHED;
            PG8_LDA(At, 0, 1); PG8_STAGE(PG8_SB(0, 0), b2, voffB); PG8_STAGE(PG8_SB(0, 1), b2 + hstep, voffB); PG8_STAGE(PG8_SA(0, 0), a2, voffA);
            PG8_WAIT_V(8); PG8_WAIT_L(0); PG8_BAR; PG8_MMA(1, 0, At, B0); PG8_MMA(1, 1, At, B1); PG8_BAR; PG8_SCHED;
            PG8_LDB(B0, 1, 0); PG8_LDB(B1, 1, 1); PG8_SCHED; PG8_LDA(At, 1, 0); PG8_STAGE(PG8_SA(0, 1), a2 + hstep, voffA);
            PG8_WAIT_V(8); PG8_WAIT_L(0); PG8_BAR; PG8_MMA(0, 0, At, B0); PG8_MMA(0, 1, At, B1); PG8_BAR; PG8_SCHED;
            PG8_LDA(At, 1, 1); PG8_STAGE(PG8_SB(1, 0), b3, voffB); PG8_STAGE(PG8_SB(1, 1), b3 + hstep, voffB); PG8_STAGE(PG8_SA(1, 0), a3, voffA);
            PG8_WAIT_V(8); PG8_WAIT_L(0); PG8_BAR; PG8_MMA(1, 0, At, B0); PG8_MMA(1, 1, At, B1); PG8_BAR; PG8_SCHED;
            } else {
            PG8_LDB(B0, 0, 0); PG8_SCHED; PG8_LDA(At, 0, 0); PG8_STAGE(PG8_SA(1, 1), a1 + hstep, voffA);
            PG8_WAIT_L(8); PG8_BAR; PG8_WAIT_L(0); PG8_MMA(0, 0, At, B0); PG8_BAR; PG8_SCHED;
            PG8_LDB(B1, 0, 1); PG8_STAGE(PG8_SB(0, 0), b2, voffB);
            PG8_BAR; PG8_WAIT_L(0); PG8_MMA(0, 1, At, B1); PG8_BAR;
            PG8_LDA(At, 0, 1); PG8_STAGE(PG8_SA(0, 0), a2, voffA);
            PG8_BAR; PG8_WAIT_L(0); PG8_MMA(1, 0, At, B0); PG8_BAR; PG8_SCHED;
            PG8_STAGE(PG8_SB(0, 1), b2 + hstep, voffB);
            PG8_WAIT_V(6); PG8_BAR; PG8_MMA(1, 1, At, B1); PG8_BAR;
            PG8_LDB(B0, 1, 0); PG8_SCHED; PG8_LDA(At, 1, 0); PG8_STAGE(PG8_SA(0, 1), a2 + hstep, voffA);
            PG8_WAIT_L(8); PG8_BAR; PG8_WAIT_L(0); PG8_MMA(0, 0, At, B0); PG8_BAR; PG8_SCHED;
            PG8_LDB(B1, 1, 1); PG8_STAGE(PG8_SB(1, 0), b3, voffB);
            PG8_BAR; PG8_WAIT_L(0); PG8_MMA(0, 1, At, B1); PG8_BAR;
            PG8_LDA(At, 1, 1); PG8_STAGE(PG8_SA(1, 0), a3, voffA);
            PG8_BAR; PG8_WAIT_L(0); PG8_MMA(1, 0, At, B0); PG8_BAR; PG8_SCHED;
            PG8_STAGE(PG8_SB(1, 1), b3 + hstep, voffB);
            PG8_WAIT_V(6); PG8_BAR; PG8_MMA(1, 1, At, B1); PG8_BAR;
            }
        }
        if constexpr (ALIGN_EPI) { if (wr == 0) PG8_BAR; }
        if constexpr (!Epi::AFTER_DRAIN) { E(acc, cur, wr, wc, fr, fq); S.done(cur); }
        if (!has_next) break;
#pragma unroll
        for (int a = 0; a < 2; ++a)
#pragma unroll
            for (int b = 0; b < 2; ++b)
#pragma unroll
                for (int m = 0; m < 4; ++m)
#pragma unroll
                    for (int n = 0; n < 2; ++n) acc[a][b][m][n] = (f32x4){0.f, 0.f, 0.f, 0.f};
        cur = nxt; cA = nA; cB = nB; ++ui;
        if constexpr (ALIGN_EPI) { if (wr == 1) PG8_BAR; }
    }
    PG8_WAIT_V(0);
    if constexpr (!ALIGN_EPI) { if (wr == 0) PG8_BAR; }
    PG8_BAR;
    if constexpr (Epi::AFTER_DRAIN) { E.fused(acc, cur, wr, wc, fr, fq, lds, wid, lane); S.done(cur); }
#undef PG8_SA
#undef PG8_SB
#undef PG8_STAGE
#undef PG8_LDA
#undef PG8_LDB
#undef PG8_MMA
#undef PG8_WAIT_V
#undef PG8_WAIT_L
#undef PG8_BAR
#undef PG8_SCHED
}
}
constexpr int NWAVES = 8;
constexpr int LDS_BYTES = 147456;
constexpr int RING_BYTES = 131072;
constexpr int MISC_OFF = RING_BYTES + 320;
constexpr int NTOKF = 8704;
constexpr float ALPHA_F = 1.4142135623730951f;
constexpr size_t OUT_VS = 52565024;

struct Lay {
    unsigned long long ctl, wina, wouta, winb, woutb, wq, sk, gates, vst, idx, gt, ww, ptu, ptv, xf0, xf1, z, xb, qp, qkvo, ub, vb, um, wsb, ptu1, ptv1, rinv, su, xq, sx;
};
struct Args { const float* in[24]; float* out; unsigned char* ws; Lay L; int ph_lo, ph_hi, li, pad; };

__device__ __forceinline__ float wave_sum_f(float v) {
#pragma unroll
    for (int o = 1; o < 64; o <<= 1) v += __shfl_xor(v, o);
    return v;
}
__device__ __forceinline__ void p0_transpose_item(const float* W, int K, int ldw, int Nuse, bf16* WT, LAS float* scr, int item, int lane) {
    const int nblk = Nuse / 32, kb = item / nblk, nb = item % nblk, k0 = 64 * kb, n0 = 32 * nb;
    f32x4 ld[8];
#pragma unroll
    for (int i = 0; i < 8; ++i) ld[i] = __builtin_nontemporal_load((const GAS f32x4*)(W + (size_t)(k0 + 8 * i + (lane >> 3)) * ldw + n0 + (lane & 7) * 4));
#pragma unroll
    for (int i = 0; i < 8; ++i) { LAS float* d = scr + (8 * i + (lane >> 3)) * 33 + (lane & 7) * 4; d[0] = ld[i].x; d[1] = ld[i].y; d[2] = ld[i].z; d[3] = ld[i].w; }
    LDS_WAIT(); asm volatile("" ::: "memory");
    const int c = lane & 7;
#pragma unroll
    for (int j = 0; j < 4; ++j) { const int n = (lane >> 3) + 8 * j; const LAS float* s = scr + (8 * c) * 33 + n;
        v4u o; o.x = pk2(s[0 * 33], s[1 * 33]); o.y = pk2(s[2 * 33], s[3 * 33]); o.z = pk2(s[4 * 33], s[5 * 33]); o.w = pk2(s[6 * 33], s[7 * 33]);
        *(GAS v4u*)(WT + (size_t)(n0 + n) * K + k0 + 8 * c) = o; }
    LDS_WAIT(); asm volatile("" ::: "memory");
}
__device__ __forceinline__ void cvt_stream(const float* src, bf16* dst, size_t n8, int gw, int NGW, int lane) {
    for (size_t i = (size_t)gw * 64 + lane; i < n8; i += (size_t)NGW * 64) {
        const f32x4 a = *(const GAS f32x4*)(src + i * 8), b = *(const GAS f32x4*)(src + i * 8 + 4);
        v4u o; o.x = pk2(a.x, a.y); o.y = pk2(a.z, a.w); o.z = pk2(b.x, b.y); o.w = pk2(b.z, b.w);
        *(GAS v4u*)(dst + i * 8) = o;
    }
}
__device__ __forceinline__ void cvt_peer_table(const float* src, bf16* dst, int gw, int NGW, int lane) {
    const size_t n8 = (size_t)16384 * 2048 / 8;
    for (size_t i = (size_t)gw * 64 + lane; i < n8; i += (size_t)NGW * 64) {
        const f32x4 a = __builtin_nontemporal_load((const GAS f32x4*)(src + i * 8)), b = __builtin_nontemporal_load((const GAS f32x4*)(src + i * 8 + 4));
        v4u o; o.x = pk2(a.x, a.y); o.y = pk2(a.z, a.w); o.z = pk2(b.x, b.y); o.w = pk2(b.z, b.w);
        const size_t e = i >> 8; const int c8 = (int)(i & 255) * 8;
        *(GAS v4u*)(dst + ((size_t)(c8 >> 6) * 16384 + e) * 64 + (c8 & 63)) = o;
    }
}
__device__ __forceinline__ void cvt_peer_table_fp8(const float* src, unsigned char* dst, float* rinv, int gw, int NGW, int lane) {
    f32x4 nx[8];
    if (gw < 16384) {
#pragma unroll
        for (int j = 0; j < 8; ++j) nx[j] = __builtin_nontemporal_load((const GAS f32x4*)(src + (size_t)gw * 2048 + j * 256 + lane * 4)); }
    for (int e = gw; e < 16384; e += NGW) {
        f32x4 v[8]; float am = 0.f;
#pragma unroll
        for (int j = 0; j < 8; ++j) { v[j] = nx[j]; am = fmaxf(am, fmaxf(fmaxf(fabsf(v[j].x), fabsf(v[j].y)), fmaxf(fabsf(v[j].z), fabsf(v[j].w)))); }
        if (e + NGW < 16384) {
#pragma unroll
            for (int j = 0; j < 8; ++j) nx[j] = __builtin_nontemporal_load((const GAS f32x4*)(src + (size_t)(e + NGW) * 2048 + j * 256 + lane * 4)); }
#pragma unroll
        for (int o = 1; o < 64; o <<= 1) am = fmaxf(am, __shfl_xor(am, o));
        const float sc = (am > 0.f) ? exp2f(floorf(log2f(224.f / am))) : 1.f;
        if (lane == 0) rinv[e] = 1.f / sc;
#pragma unroll
        for (int j = 0; j < 8; ++j) { unsigned p = __builtin_amdgcn_cvt_pk_fp8_f32(v[j].x * sc, v[j].y * sc, 0u, false); p = __builtin_amdgcn_cvt_pk_fp8_f32(v[j].z * sc, v[j].w * sc, p, true);
            const int w = lane & 31, pw = ((((w >> 2) & 1) * 4 + (w & 3)) << 2) + ((w >> 4) & 1) * 2 + ((w >> 3) & 1);
            *(GAS unsigned*)(dst + ((size_t)(2 * j + (lane >> 5)) * 16384 + e) * 128 + pw * 4) = p; }
    }
}
__device__ __forceinline__ unsigned pack_i8x4(f32x4 v, float sc) { const int a = __float2int_rn(v.x * sc), b = __float2int_rn(v.y * sc), c = __float2int_rn(v.z * sc), d = __float2int_rn(v.w * sc);
    return (unsigned)(a & 0xFF) | ((unsigned)(b & 0xFF) << 8) | ((unsigned)(c & 0xFF) << 16) | ((unsigned)d << 24); }
__device__ __forceinline__ void cvt_peer_table_i8(const float* src, unsigned char* dst, float* rinv, int gw, int NGW, int lane) {
    f32x4 nx[8];
    if (gw < 16384) {
#pragma unroll
        for (int j = 0; j < 8; ++j) nx[j] = __builtin_nontemporal_load((const GAS f32x4*)(src + (size_t)gw * 2048 + j * 256 + lane * 4)); }
    for (int e = gw; e < 16384; e += NGW) {
        f32x4 v[8]; float am = 0.f;
#pragma unroll
        for (int j = 0; j < 8; ++j) { v[j] = nx[j]; am = fmaxf(am, fmaxf(fmaxf(fabsf(v[j].x), fabsf(v[j].y)), fmaxf(fabsf(v[j].z), fabsf(v[j].w)))); }
        if (e + NGW < 16384) {
#pragma unroll
            for (int j = 0; j < 8; ++j) nx[j] = __builtin_nontemporal_load((const GAS f32x4*)(src + (size_t)(e + NGW) * 2048 + j * 256 + lane * 4)); }
#pragma unroll
        for (int o = 1; o < 64; o <<= 1) am = fmaxf(am, __shfl_xor(am, o));
        const float sc = (am > 0.f) ? 127.f / am : 0.f;
        if (lane == 0) rinv[e] = am * (1.f / 127.f);
#pragma unroll
        for (int j = 0; j < 8; ++j) *(GAS unsigned*)(dst + ((size_t)(2 * j + (lane >> 5)) * 16384 + e) * 128 + (lane & 31) * 4) = pack_i8x4(v[j], sc);
    }
}
__device__ __forceinline__ const float* xrow_in(const Args& a, int r) { return r < 8192 ? a.in[0] + (size_t)r * 2048 : a.in[1] + (size_t)(r - 8192) * 2048; }

__device__ __forceinline__ void phase_prologue(const Args& a, LAS unsigned char* lds, int vcu, int G, int wave, int lane) {
    unsigned char* ws = a.ws;
    LAS float* scr = (LAS float*)(lds + wave * 16384);
    const int gw = vcu * NWAVES + wave, NGW = G * NWAVES;
    for (int it = gw; it < 32 * 192; it += NGW) p0_transpose_item(a.in[5], 2048, 6160, 6144, (bf16*)(ws + a.L.wina), scr, it, lane);
    __syncthreads();
    { LAS f32x4* wg = (LAS f32x4*)lds; const float* w = a.in[5];
      for (int i = threadIdx.x; i < 2048 * 4; i += NWAVES * 64) { const int k = i >> 2, q4 = i & 3; wg[(k >> 2) * 16 + ((((k & 3) * 4 + q4)) ^ ((k >> 2) & 15))] = *(const GAS f32x4*)(w + (size_t)k * 6160 + 6144 + q4 * 4); } }
    __syncthreads();
    const float* bg = a.in[6];
    for (int r = gw; r < NTOKF; r += NGW) {
        const float* xr = xrow_in(a, r);
        GAS unsigned long long* o8 = (GAS unsigned long long*)((bf16*)(ws + a.L.xb) + (size_t)r * 2048) + lane;
        float g[16];
#pragma unroll
        for (int q = 0; q < 16; ++q) g[q] = 0.f;
#pragma unroll 1
        for (int j = 0; j < 8; ++j) {
            const f32x4 xv = *(const GAS f32x4*)(xr + j * 256 + lane * 4);
            o8[64 * j] = (unsigned long long)pk2(xv.x, xv.y) | ((unsigned long long)pk2(xv.z, xv.w) << 32);
            const int kq = j * 64 + lane;
#pragma unroll
            for (int e = 0; e < 4; ++e) { const float x = xv[e];
#pragma unroll
                for (int q4 = 0; q4 < 4; ++q4) { const f32x4 w4 = ((const LAS f32x4*)lds)[kq * 16 + ((e * 4 + q4) ^ (kq & 15))]; g[q4 * 4 + 0] += x * w4.x; g[q4 * 4 + 1] += x * w4.y; g[q4 * 4 + 2] += x * w4.z; g[q4 * 4 + 3] += x * w4.w; } }
        }
        float mine = 0.f;
#pragma unroll
        for (int q = 0; q < 16; ++q) { const float s = wave_sum_f(g[q]); if (lane == q) mine = s; }
        if (lane < 16) { float v = mine + bg[lane]; if (lane >= 8) v = fminf(v, 0.f) - log1pf(expf(-fabsf(v))); ((float*)(ws + a.L.gates))[(size_t)r * 16 + lane] = v; }
    }
    __syncthreads();
}

__device__ __forceinline__ void side_convert(const Args& a, LAS unsigned char* lds, int gw, int NGW, int wave, int lane, int parts) {
    unsigned char* ws = a.ws;
    LAS float* scr = (LAS float*)(lds + wave * 16384);
    constexpr int I_OA = 32 * 64, I_B = 32 * 384, I_OB = 96 * 64, I_Q = 32 * 64;
    constexpr int NITEMS = I_OA + I_B + I_OB + 2 * I_Q;
    if (parts & 1) for (int it = gw; it < NITEMS; it += NGW) {
        int r = it;
        if (r < I_OA) { p0_transpose_item(a.in[8], 2048, 2048, 2048, (bf16*)(ws + a.L.wouta), scr, r, lane); continue; } r -= I_OA;
        if (r < I_B) { p0_transpose_item(a.in[9], 2048, 12288, 12288, (bf16*)(ws + a.L.winb), scr, r, lane); continue; } r -= I_B;
        if (r < I_OB) { p0_transpose_item(a.in[15], 6144, 2048, 2048, (bf16*)(ws + a.L.woutb), scr, r, lane); continue; } r -= I_OB;
        if (r < I_Q) { p0_transpose_item(a.in[20], 2048, 2048, 2048, (bf16*)(ws + a.L.wq), scr, r, lane); continue; } r -= I_Q;
        p0_transpose_item(a.in[20] + (size_t)2048 * 2048, 2048, 2048, 2048, (bf16*)(ws + a.L.wq) + (size_t)2048 * 2048, scr, r, lane);
    }
    if (parts & 2) { float* ri = (float*)(ws + a.L.rinv);
      cvt_peer_table_i8(a.in[22], ws + a.L.ptu, ri, gw, NGW, lane);
      cvt_peer_table_fp8(a.in[23], ws + a.L.ptv, ri + 16384, gw, NGW, lane);
      cvt_peer_table_i8(a.in[22] + (size_t)16384 * 2048, ws + a.L.ptu1, ri + 32768, gw, NGW, lane);
      cvt_peer_table_fp8(a.in[23] + (size_t)16384 * 2048, ws + a.L.ptv1, ri + 49152, gw, NGW, lane); }
    cvt_stream(a.in[21], (bf16*)(ws + a.L.sk), (size_t)2 * 16 * 128 * 128 / 8, gw, NGW, lane);
    { bf16* wsb = (bf16*)(ws + a.L.wsb); const float* wsf = a.in[13]; for (int i = gw * 64 + lane; i < 8 * 128 * 128; i += NGW * 64) { const int t = (i >> 7) & 127, s = i & 127; wsb[i] = (bf16)(s <= t ? f2bf(wsf[i]) : 0u); } }
    { float* vst = (float*)(ws + a.L.vst); for (int i = gw * 64 + lane; i < NTOKF * 2; i += NGW * 64) vst[i] = 0.f; }
}

template <bool ZBF>
__device__ __forceinline__ void phase_ln(const float* Z, const float* g, const float* b, float* Xf, bf16* Xb, unsigned char* Xq, float* sx, int vcu, int G, int wave, int lane) {
    const int gw = vcu * NWAVES + wave, NGW = G * NWAVES;
    f32x4 gv[8], bv[8];
#pragma unroll
    for (int j = 0; j < 8; ++j) { gv[j] = *(const GAS f32x4*)(g + j * 256 + lane * 4); bv[j] = *(const GAS f32x4*)(b + j * 256 + lane * 4); }
    for (int r = gw; r < NTOKF; r += NGW) {
        const float* zr = Z + (size_t)r * 2048;
        f32x4 v[8]; float s = 0.f;
#pragma unroll
        for (int j = 0; j < 8; ++j) {
            if (ZBF) { const unsigned long long q = *((const GAS unsigned long long*)((const bf16*)Z + (size_t)r * 2048) + 64 * j + lane); const unsigned lo = (unsigned)q, hi = (unsigned)(q >> 32);
                v[j] = (f32x4){__builtin_bit_cast(float, lo << 16), __builtin_bit_cast(float, lo & 0xffff0000u), __builtin_bit_cast(float, hi << 16), __builtin_bit_cast(float, hi & 0xffff0000u)}; }
            else v[j] = *(const GAS f32x4*)(zr + j * 256 + lane * 4);
            s += (v[j].x + v[j].y) + (v[j].z + v[j].w); }
        const float mean = wave_sum_f(s) * (1.f / 2048.f); float s2 = 0.f;
#pragma unroll
        for (int j = 0; j < 8; ++j) { v[j] = v[j] - mean; s2 += (v[j].x * v[j].x + v[j].y * v[j].y) + (v[j].z * v[j].z + v[j].w * v[j].w); }
        const float rstd = 1.f / sqrtf(wave_sum_f(s2) * (1.f / 2048.f) + 1e-5f);
#pragma unroll
        for (int j = 0; j < 8; ++j) { v[j] = v[j] * rstd * gv[j] + bv[j]; if (Xf) *(GAS f32x4*)(Xf + (size_t)r * 2048 + j * 256 + lane * 4) = v[j]; }
        if (Xq) {
            float am = 0.f;
#pragma unroll
            for (int j = 0; j < 8; ++j) am = fmaxf(am, fmaxf(fmaxf(fabsf(v[j].x), fabsf(v[j].y)), fmaxf(fabsf(v[j].z), fabsf(v[j].w))));
#pragma unroll
            for (int o = 1; o < 64; o <<= 1) am = fmaxf(am, __shfl_xor(am, o));
            const float sc = (am > 0.f) ? 127.f / am : 0.f;
            if (lane == 0) sx[r] = am * (1.f / 127.f);
#pragma unroll
            for (int j = 0; j < 8; ++j) *(GAS unsigned*)(Xq + (size_t)r * 2048 + j * 256 + lane * 4) = pack_i8x4(v[j], sc);
        }
        if (Xb) { GAS unsigned long long* o8 = (GAS unsigned long long*)(Xb + (size_t)r * 2048) + lane;
#pragma unroll
            for (int j = 0; j < 8; ++j) o8[64 * j] = (unsigned long long)pk2(v[j].x, v[j].y) | ((unsigned long long)pk2(v[j].z, v[j].w) << 32); }
    }
}
typedef __bf16 bf16x2_t __attribute__((ext_vector_type(2)));
typedef int i32x4 __attribute__((ext_vector_type(4)));
__device__ __forceinline__ unsigned fkey(float f) { const unsigned u = __builtin_bit_cast(unsigned, f); return (u & 0x80000000u) ? ~u : (u | 0x80000000u); }
__device__ __forceinline__ float keyf(unsigned k) { const unsigned u = (k & 0x80000000u) ? (k & 0x7fffffffu) : ~k; return __builtin_bit_cast(float, u); }
__device__ __forceinline__ float dot2bf(unsigned a, unsigned b, float c) { return __builtin_amdgcn_fdot2_f32_bf16(__builtin_bit_cast(bf16x2_t, a), __builtin_bit_cast(bf16x2_t, b), c, false); }
__device__ __forceinline__ float bflo(unsigned w) { return __builtin_bit_cast(float, w << 16); }
__device__ __forceinline__ float bfhi(unsigned w) { return __builtin_bit_cast(float, w & 0xffff0000u); }
__device__ __forceinline__ float gelu_tanh_g(float x) { const float u = x + 0.044715f * x * x * x; const float e = __builtin_amdgcn_exp2f(u * -2.302208198f); return x * __builtin_amdgcn_rcpf(1.0f + e); }
#define INS16(v, x) do { unsigned nw_ = (x); _Pragma("unroll") for (int k_ = 0; k_ < 16; ++k_) { const unsigned hi_ = max(v[k_], nw_); nw_ = min(v[k_], nw_); v[k_] = hi_; } } while (0)


#define CE_DESC(a, b) do { const unsigned hi_ = max(a, b), lo_ = min(a, b); a = hi_; b = lo_; } while (0)
__device__ __forceinline__ void sort16_desc(unsigned (&v)[16]) {
#pragma unroll
    for (int k = 2; k <= 16; k <<= 1)
#pragma unroll
        for (int j = k >> 1; j > 0; j >>= 1)
#pragma unroll
            for (int i = 0; i < 16; ++i) { const int l = i ^ j; if (l > i) { if ((i & k) == 0) CE_DESC(v[i], v[l]); else CE_DESC(v[l], v[i]); } }
}
__device__ __forceinline__ void merge_top16(unsigned (&a)[16], const unsigned (&b)[16]) {
#pragma unroll
    for (int i = 0; i < 16; ++i) a[i] = max(a[i], b[15 - i]);
#pragma unroll
    for (int sd = 8; sd >= 1; sd >>= 1)
#pragma unroll
        for (int i = 0; i < 16; ++i) if ((i & sd) == 0) CE_DESC(a[i], a[i + sd]);
}
static __device__ const unsigned char CAND_TAB[52] = {
    0, 1, 2, 3, 4, 5, 6, 7, 8, 9, 10, 11, 12, 13, 14, 15,
    16, 17, 18, 19, 20, 21, 22, 23,
    32, 33, 34, 35, 36,
    48, 49, 50, 51,
    64, 65, 66,
    80, 81,
    96, 97,
    112, 113,
    128, 144, 160, 176, 192, 208, 224, 240,
    255, 255 };

template <int MODE>
__device__ __forceinline__ void phase_topk(const bf16* QP, const bf16* SK, int* IDX, float* GT, float* AACC, float* SU, const float* rinvU, const float* rinvV, LAS unsigned char* lds, int vcu, int G, int wave, int lane) {
    LAS float* S = (LAS float*)lds;
    LAS unsigned char* NL = lds + 2 * 64 * 132 * 4;
    LAS float* FL = (LAS float*)(NL + 512 * 32);
    const int tid = wave * 64 + lane;
    for (int u = vcu; u < 136 * 8; u += G) {
        const int tt = u >> 3, h = u & 7;
        if (MODE != 1) {
            const int p = wave >> 2, rt = wave & 3, fr = lane & 15, fq = lane >> 4;
            const bf16* qrow = QP + (size_t)(tt * 64 + rt * 16 + fr) * 2048 + h * 256 + p * 128 + 8 * fq;
            bf16x8 af[4];
#pragma unroll
            for (int ks = 0; ks < 4; ++ks) af[ks] = *(const GAS bf16x8*)(qrow + ks * 32);
            const bf16* kbase = SK + (size_t)((h * 2 + p) * 128 + fr) * 128 + 8 * fq;
#pragma unroll 4
            for (int nt = 0; nt < 8; ++nt) {
                bf16x8 bfr[4];
#pragma unroll
                for (int ks = 0; ks < 4; ++ks) bfr[ks] = *(const GAS bf16x8*)(kbase + (size_t)nt * 16 * 128 + ks * 32);
                f32x4 acc = (f32x4){0.f, 0.f, 0.f, 0.f};
#pragma unroll
                for (int ks = 0; ks < 4; ++ks) acc = __builtin_amdgcn_mfma_f32_16x16x32_bf16(af[ks], bfr[ks], acc, 0, 0, 0);
                LAS float* sp = S + (size_t)(p * 64 + rt * 16 + fq * 4) * 132 + nt * 16 + fr;
                sp[0] = acc[0]; sp[132] = acc[1]; sp[264] = acc[2]; sp[396] = acc[3];
            }
        }
        __syncthreads();
        if (MODE != 2) {
            const int tl = lane >> 3, p = (lane >> 2) & 1, qr = lane & 3, t = wave * 8 + tl;
            unsigned own[16], oth_[16];
            const LAS f32x4* sp = (const LAS f32x4*)(S + (size_t)(p * 64 + t) * 132 + qr * 32);
#pragma unroll
            for (int c = 0; c < 4; ++c) { const f32x4 v = sp[c], w = sp[4 + c];
#pragma unroll
                for (int e = 0; e < 4; ++e) { own[c * 4 + e] = (fkey(v[e]) & ~127u) | (unsigned)(127 - (qr * 32 + c * 4 + e)); oth_[c * 4 + e] = (fkey(w[e]) & ~127u) | (unsigned)(127 - (qr * 32 + 16 + c * 4 + e)); } }
            sort16_desc(own); sort16_desc(oth_); merge_top16(own, oth_);
#pragma unroll
            for (int st = 1; st <= 2; st <<= 1) {
#pragma unroll
                for (int i = 0; i < 16; ++i) oth_[i] = (unsigned)__shfl_xor((int)own[i], st);
                merge_top16(own, oth_);
            }
            LAS unsigned char* nl = NL + tid * 32;
            LAS float* fl = FL + (tid >> 2) * 32;
#pragma unroll
            for (int i = 0; i < 16; ++i) { const unsigned oth = (unsigned)__shfl_xor((int)own[i], 4); const unsigned a0 = p ? oth : own[i], a1 = p ? own[i] : oth;
                if (qr == 0) { fl[i] = keyf(a0 & ~127u); fl[16 + i] = keyf(a1 & ~127u); }
                nl[i] = (unsigned char)(127u - (a0 & 127u)); nl[16 + i] = (unsigned char)(127u - (a1 & 127u)); }
            unsigned tv[16];
#pragma unroll
            for (int k = 0; k < 16; ++k) tv[k] = 0u;
#pragma unroll
            for (int m = 0; m < 13; ++m) { const unsigned c = CAND_TAB[m * 4 + qr]; unsigned key = 0u;
                if (c != 255u) { const float s = fl[c >> 4] + fl[16 + (c & 15u)]; key = (fkey(s) & ~255u) | (255u - c); }
                INS16(tv, key); }
#pragma unroll
            for (int st = 1; st <= 2; st <<= 1) {
#pragma unroll
                for (int i = 0; i < 16; ++i) oth_[i] = (unsigned)__shfl_xor((int)tv[i], st);
                merge_top16(tv, oth_);
            }
            float ev[16]; int ex[16]; float sum = 0.f; const float mx = keyf(tv[0] & ~255u);
#pragma unroll
            for (int k = 0; k < 16; ++k) { const unsigned c = 255u - (tv[k] & 255u); const int i = (int)(c >> 4), j = (int)(c & 15u);
                ex[k] = (int)nl[i] * 128 + (int)nl[16 + j]; ev[k] = __expf(keyf(tv[k] & ~255u) - mx); sum += ev[k]; }
            const float inv = 1.f / sum;
            if (MODE == 3) { if (ex[0] == 0x7fffffff) IDX[0] = (int)inv; }
            else if (p == 0 && qr == 0) {
                const size_t o = (size_t)(tt * 64 + t) * 128 + h * 16;
#pragma unroll
                for (int k4 = 0; k4 < 4; ++k4) { *(GAS i32x4*)(IDX + o + k4 * 4) = (i32x4){ex[k4 * 4], ex[k4 * 4 + 1], ex[k4 * 4 + 2], ex[k4 * 4 + 3]};
                    *(GAS f32x4*)(GT + o + k4 * 4) = (f32x4){ev[k4 * 4] * inv, ev[k4 * 4 + 1] * inv, ev[k4 * 4 + 2] * inv, ev[k4 * 4 + 3] * inv};
                    *(GAS f32x4*)(AACC + o + k4 * 4) = (f32x4){0.f, 0.f, 0.f, 0.f}; }
            }
        }
        __syncthreads();
    }
}

__device__ __forceinline__ void phase_upass(const bf16* U, const bf16* XBt, const int* IDX, const float* GT, float* WW, int vcu, int G, int wave, int lane) {
    const int gw = vcu * NWAVES + wave, NGW = G * NWAVES;
    for (int t = gw; t < NTOKF; t += NGW) {
        v4u xq[4];
#pragma unroll
        for (int j = 0; j < 4; ++j) xq[j] = *(const GAS v4u*)(XBt + (size_t)t * 2048 + j * 512 + lane * 8);
        const int ilo = IDX[(size_t)t * 128 + lane], ihi = IDX[(size_t)t * 128 + 64 + lane];
        float wlo = 0.f, whi = 0.f;
#pragma unroll 1
        for (int e0 = 0; e0 < 128; e0 += 4) {
            v4u uq[4][4];
#pragma unroll
            for (int ee = 0; ee < 4; ++ee) { const int e = e0 + ee; const int id = __builtin_amdgcn_readlane(e0 < 64 ? ilo : ihi, e & 63);
                const bf16* ur = U + (size_t)id * 2048 + lane * 8;
#pragma unroll
                for (int j = 0; j < 4; ++j) uq[ee][j] = *(const GAS v4u*)(ur + j * 512); }
#pragma unroll
            for (int ee = 0; ee < 4; ++ee) { float acc = 0.f;
#pragma unroll
                for (int j = 0; j < 4; ++j) { acc = dot2bf(uq[ee][j].x, xq[j].x, acc); acc = dot2bf(uq[ee][j].y, xq[j].y, acc); acc = dot2bf(uq[ee][j].z, xq[j].z, acc); acc = dot2bf(uq[ee][j].w, xq[j].w, acc); }
                acc = wave_sum_f(acc);
                const int e = e0 + ee;
                if (lane == (e & 63)) { if (e0 < 64) wlo = acc; else whi = acc; } }
        }
        WW[(size_t)t * 128 + lane] = gelu_tanh_g(wlo) * GT[(size_t)t * 128 + lane];
        WW[(size_t)t * 128 + 64 + lane] = gelu_tanh_g(whi) * GT[(size_t)t * 128 + 64 + lane];
    }
}

__device__ __forceinline__ void phase_vpass(const bf16* V, const float* Xf, const int* IDX, const float* WW, float* Z, float alpha, int vcu, int G, int wave, int lane) {
    const int gw = vcu * NWAVES + wave, NGW = G * NWAVES;
    for (int t = gw; t < NTOKF; t += NGW) {
        f32x4 acc[4][2];
#pragma unroll
        for (int j = 0; j < 4; ++j)
#pragma unroll
            for (int q = 0; q < 2; ++q) acc[j][q] = *(const GAS f32x4*)(Xf + (size_t)t * 2048 + j * 512 + lane * 8 + q * 4) * alpha;
        const int ilo = IDX[(size_t)t * 128 + lane], ihi = IDX[(size_t)t * 128 + 64 + lane];
        const float wlo = WW[(size_t)t * 128 + lane], whi = WW[(size_t)t * 128 + 64 + lane];
#pragma unroll 1
        for (int e0 = 0; e0 < 128; e0 += 4) {
            v4u vq[4][4]; float wv[4];
#pragma unroll
            for (int ee = 0; ee < 4; ++ee) { const int e = e0 + ee; const int id = __builtin_amdgcn_readlane(e0 < 64 ? ilo : ihi, e & 63);
                wv[ee] = __builtin_bit_cast(float, __builtin_amdgcn_readlane(__builtin_bit_cast(int, e0 < 64 ? wlo : whi), e & 63));
                const bf16* vr = V + (size_t)id * 2048 + lane * 8;
#pragma unroll
                for (int j = 0; j < 4; ++j) vq[ee][j] = *(const GAS v4u*)(vr + j * 512); }
#pragma unroll
            for (int ee = 0; ee < 4; ++ee)
#pragma unroll
                for (int j = 0; j < 4; ++j) { const v4u q = vq[ee][j]; const float w = wv[ee];
                    acc[j][0].x += w * bflo(q.x); acc[j][0].y += w * bfhi(q.x); acc[j][0].z += w * bflo(q.y); acc[j][0].w += w * bfhi(q.y);
                    acc[j][1].x += w * bflo(q.z); acc[j][1].y += w * bfhi(q.z); acc[j][1].z += w * bflo(q.w); acc[j][1].w += w * bfhi(q.w); }
        }
#pragma unroll
        for (int j = 0; j < 4; ++j)
#pragma unroll
            for (int q = 0; q < 2; ++q) *(GAS f32x4*)(Z + (size_t)t * 2048 + j * 512 + lane * 8 + q * 4) = acc[j][q];
    }
}

struct XTopo { int xi, nx, wq, nwq; };
__device__ __forceinline__ XTopo xcd_topology(unsigned* bar, unsigned x, unsigned rank, int wave) {
    XTopo t; int xi = 0, nx = 0, nloc = 1;
#pragma unroll
    for (unsigned j = 0; j < 16; ++j) { const unsigned c = xb_ld(&bar[XB_XCNT(j)]); if (c > 0u) { if (j < x) ++xi; ++nx; } if (j == x) nloc = (int)c; }
    if (nloc < 1) nloc = 1; if (nx < 1) nx = 1;
    t.xi = __builtin_amdgcn_readfirstlane(xi); t.nx = __builtin_amdgcn_readfirstlane(nx); t.wq = __builtin_amdgcn_readfirstlane((int)rank * NWAVES + wave); t.nwq = __builtin_amdgcn_readfirstlane(nloc * NWAVES); return t;
}
typedef float f32x2 __attribute__((ext_vector_type(2)));
template <int MODE>
__device__ __forceinline__ void upass_reduce_add(float (&acc)[16], float* ap, int lane) {
    const bool b2 = (lane & 4) != 0, b1 = (lane & 2) != 0, b0 = (lane & 1) != 0;
    float r8[8], r4[4], r2[2];
#pragma unroll
    for (int j = 0; j < 8; ++j) { const float keep = b2 ? acc[8 + j] : acc[j], send = b2 ? acc[j] : acc[8 + j]; r8[j] = keep + __shfl_xor(send, 4); }
#pragma unroll
    for (int j = 0; j < 4; ++j) { const float keep = b1 ? r8[4 + j] : r8[j], send = b1 ? r8[j] : r8[4 + j]; r4[j] = keep + __shfl_xor(send, 2); }
#pragma unroll
    for (int j = 0; j < 2; ++j) { const float keep = b0 ? r4[2 + j] : r4[j], send = b0 ? r4[j] : r4[2 + j]; r2[j] = keep + __shfl_xor(send, 1); }
    if (MODE == 1) { ap[0] = r2[0]; ap[64] = r2[1]; } else { unsafeAtomicAdd(ap, r2[0]); unsafeAtomicAdd(ap + 64, r2[1]); }
}
__device__ __forceinline__ float dot16_i8(const v4u q, const v4u x) {
    int a = __builtin_amdgcn_sdot4((int)q.x, (int)x.x, 0, false); a = __builtin_amdgcn_sdot4((int)q.y, (int)x.y, a, false);
    a = __builtin_amdgcn_sdot4((int)q.z, (int)x.z, a, false); a = __builtin_amdgcn_sdot4((int)q.w, (int)x.w, a, false);
    return (float)a;
}
__device__ __forceinline__ void unpack16bf(const v4u a, const v4u b, float (&xf)[16]) {
    xf[0] = bflo(a.x); xf[1] = bfhi(a.x); xf[2] = bflo(a.y); xf[3] = bfhi(a.y); xf[4] = bflo(a.z); xf[5] = bfhi(a.z); xf[6] = bflo(a.w); xf[7] = bfhi(a.w);
    xf[8] = bflo(b.x); xf[9] = bfhi(b.x); xf[10] = bflo(b.y); xf[11] = bfhi(b.y); xf[12] = bflo(b.z); xf[13] = bfhi(b.z); xf[14] = bflo(b.w); xf[15] = bfhi(b.w);
}
template <int MODE>
__device__ __forceinline__ void phase_upass_sl(const unsigned char* U, const unsigned char* XQ, const float* SX, const int* IDX, float* AACC, float* GT, float* SU, const float* rinvU, const float* rinvV, const XTopo tp, int lane0) {
#define UP_IDX(dst, tt) do { const int t_ = min((tt), NTOKF - 1); const int* ip_ = IDX + (size_t)t_ * 128 + (lane >> 3) * 8; dst[0] = *(const GAS i32x4*)ip_; dst[1] = *(const GAS i32x4*)(ip_ + 4); dst[2] = *(const GAS i32x4*)(ip_ + 64); dst[3] = *(const GAS i32x4*)(ip_ + 68); } while (0)
#define UP_SEL(id, s_) id[2 * ((s_) & 1) + ((s_) >> 3)][((s_) >> 1) & 3]
#define UP_GATHER8(dst, id, h) do { _Pragma("unroll") for (int j_ = 0; j_ < 8; ++j_) { if (MODE == 2) dst[j_] = (v4u){(unsigned)UP_SEL(id, 8 * (h) + j_), 0x38383838u, 0x38383838u, 0x38383838u}; else dst[j_] = __builtin_bit_cast(v4u, __builtin_amdgcn_raw_buffer_load_b128(urs, (UP_SEL(id, 8 * (h) + j_) << 7) + i * 16, 0, 0)); } } while (0)
#define UP_X(xa, xb, tt) do { const int t_ = min((tt), NTOKF - 1); xa = *(const GAS v4u*)(XQ + (size_t)t_ * 2048 + sl * 128 + (lane & 7) * 16); xb.x = __builtin_bit_cast(unsigned, SX[t_]); } while (0)
    for (int sl = tp.xi; sl < 16; sl += tp.nx) {
        int lane = lane0; asm volatile("" : "+v"(lane));
        const int g = lane >> 3, i = lane & 7;
        const __amdgpu_buffer_rsrc_t urs = __builtin_amdgcn_make_buffer_rsrc((void*)(U + (size_t)sl * 16384 * 128), 0, 16384 * 128, 0x00020000);
        i32x4 idn[4]; v4u qa[8], qb[8], xa, xb;
        UP_IDX(idn, tp.wq); UP_GATHER8(qa, idn, 0); UP_GATHER8(qb, idn, 1); UP_X(xa, xb, tp.wq); UP_IDX(idn, tp.wq + tp.nwq);
#pragma unroll 1
        for (int t = tp.wq; t < NTOKF; t += tp.nwq) {
            float acc[16]; const v4u xq_ = xa; const float sx_ = __builtin_bit_cast(float, xb.x);
#pragma unroll
            for (int j = 0; j < 8; ++j) acc[j] = dot16_i8(qa[j], xq_) * sx_;
            UP_GATHER8(qa, idn, 0);
#pragma unroll
            for (int j = 0; j < 8; ++j) acc[8 + j] = dot16_i8(qb[j], xq_) * sx_;
            UP_GATHER8(qb, idn, 1);
            UP_X(xa, xb, t + tp.nwq); UP_IDX(idn, t + 2 * tp.nwq);
            upass_reduce_add<MODE>(acc, AACC + (size_t)t * 128 + lane, lane);
            if (MODE == 0 && sl == tp.xi && ((t >> 8) % tp.nx) == tp.xi) {
                const size_t o_ = (size_t)t * 128 + lane; const int e0_ = IDX[o_], e1_ = IDX[o_ + 64];
                SU[o_] = rinvU[e0_]; SU[o_ + 64] = rinvU[e1_]; GT[o_] *= rinvV[e0_]; GT[o_ + 64] *= rinvV[e1_]; }
        }
    }
#undef UP_IDX
#undef UP_SEL
#undef UP_GATHER8
#undef UP_X
}
__device__ __forceinline__ void vpass_finish(const v4u (&vq)[16], const LAS float* wl, const float* Xf, float* Z, float alpha, int t, int sl, int lane) {
    const int g = lane >> 3, i = lane & 7;
    f32x4 w4[4];
#pragma unroll
    for (int q = 0; q < 4; ++q) w4[q] = *(const LAS f32x4*)(wl + g * 16 + q * 4);
    float acc[16];
#pragma unroll
    for (int c = 0; c < 16; ++c) acc[c] = 0.f;
#pragma unroll
    for (int j = 0; j < 16; ++j) { const float w = w4[j >> 2][j & 3]; const unsigned wd[4] = {vq[j].x, vq[j].y, vq[j].z, vq[j].w};
#pragma unroll
        for (int d = 0; d < 4; ++d) { const f32x2 lo = __builtin_amdgcn_cvt_pk_f32_fp8(wd[d], false), hi = __builtin_amdgcn_cvt_pk_f32_fp8(wd[d], true);
            acc[d * 4 + 0] += w * lo.x; acc[d * 4 + 1] += w * lo.y; acc[d * 4 + 2] += w * hi.x; acc[d * 4 + 3] += w * hi.y; } }
    const bool b3 = (lane & 8) != 0, b4 = (lane & 16) != 0, b5 = (lane & 32) != 0;
    float r8[8], r4[4], r2[2];
#pragma unroll
    for (int c = 0; c < 8; ++c) { const float keep = b3 ? acc[8 + c] : acc[c], send = b3 ? acc[c] : acc[8 + c]; r8[c] = keep + __shfl_xor(send, 8); }
#pragma unroll
    for (int c = 0; c < 4; ++c) { const float keep = b4 ? r8[4 + c] : r8[c], send = b4 ? r8[c] : r8[4 + c]; r4[c] = keep + __shfl_xor(send, 16); }
#pragma unroll
    for (int c = 0; c < 2; ++c) { const float keep = b5 ? r4[2 + c] : r4[c], send = b5 ? r4[c] : r4[2 + c]; r2[c] = keep + __shfl_xor(send, 32); }
    const int col = sl * 128 + i * 16 + (b3 ? 8 : 0) + (b4 ? 4 : 0) + (b5 ? 2 : 0);
    const f32x2 xr = *(const GAS f32x2*)(Xf + (size_t)t * 2048 + col);
    *(GAS f32x2*)(Z + (size_t)t * 2048 + col) = (f32x2){alpha * xr.x + r2[0], alpha * xr.y + r2[1]};
}
__device__ __forceinline__ int wave_max_bits(int x) {
    x = max(x, __builtin_amdgcn_update_dpp(x, x, 0x111, 0xf, 0xf, false));
    x = max(x, __builtin_amdgcn_update_dpp(x, x, 0x112, 0xf, 0xf, false));
    x = max(x, __builtin_amdgcn_update_dpp(x, x, 0x114, 0xf, 0xf, false));
    x = max(x, __builtin_amdgcn_update_dpp(x, x, 0x118, 0xf, 0xf, false));
    x = max(x, __builtin_amdgcn_update_dpp(x, x, 0x142, 0xa, 0xf, false));
    x = max(x, __builtin_amdgcn_update_dpp(x, x, 0x143, 0xc, 0xf, false));
    return __builtin_amdgcn_readlane(x, 63);
}
typedef unsigned u32x2v __attribute__((ext_vector_type(2)));
template <int MODE>
__device__ __forceinline__ void vpass_step(const v4u (&cur)[16], v4u (&nxt)[16], const i32x4 (&idin)[4], i32x4 (&idout)[4], const float (&scc)[6], float (&scn)[6], const u32x2v xr, u32x2v& xrn, const __amdgpu_buffer_rsrc_t vrs,
                                           const bf16* Xf, const int* IDX, const float* AACC, const float* SU, const float* GT, bf16* Z, float alpha, LAS float* wl, int t, int tn, int tnn, int sl, int lane0, bool live = true) {
    int lane = lane0; asm volatile("" : "+v"(lane));
    const int g = lane >> 3, i = lane & 7;
#pragma unroll
    for (int q = 0; q < 4; ++q) idout[q] = *(const GAS i32x4*)(IDX + (size_t)tnn * 128 + g * 16 + q * 4);
    { const size_t o0 = (size_t)tn * 128 + lane; scn[0] = AACC[o0]; scn[1] = AACC[o0 + 64]; scn[2] = SU[o0]; scn[3] = SU[o0 + 64]; scn[4] = GT[o0]; scn[5] = GT[o0 + 64]; }
    const bool hv = (lane & 32) != 0, valid = (((lane >> 5) ^ (lane >> 3)) & 1) == 0;
    const int col = sl * 128 + (hv ? 64 : 0) + ((lane >> 4) & 1) * 32 + (i >> 2) * 16 + (i & 3) * 4;
    if (MODE != 3) xrn = *(const GAS u32x2v*)(Xf + (size_t)tn * 2048 + col);
    __builtin_amdgcn_sched_barrier(0);
#pragma unroll
    for (int j = 0; j < 16; ++j) { if (MODE == 1) nxt[j] = (v4u){(unsigned)idin[j >> 2][j & 3], 0x38383838u, 0x38383838u, 0x38383838u}; else nxt[j] = __builtin_bit_cast(v4u, __builtin_amdgcn_raw_buffer_load_b128(vrs, (idin[j >> 2][j & 3] << 7) + i * 16, 0, 0)); }
    __builtin_amdgcn_sched_barrier(0);
    const float w0 = gelu_tanh_g(scc[0] * scc[2]) * scc[4], w1 = gelu_tanh_g(scc[1] * scc[3]) * scc[5];
    const int e8 = max(wave_max_bits(__builtin_bit_cast(int, fmaxf(fabsf(w0), fabsf(w1)))) >> 23, 8);
    const float S = __builtin_bit_cast(float, (261 - e8) << 23), invS = __builtin_bit_cast(float, (e8 - 7) << 23);
    wl[lane] = w0 * S; wl[64 + lane] = w1 * S;
    if (MODE == 2) { unsigned s_ = 0u;
#pragma unroll
        for (int j = 0; j < 16; ++j) s_ += cur[j].x ^ cur[j].y ^ cur[j].z ^ cur[j].w;
        if (s_ == 0x12345u) Z[(size_t)t * 2048 + sl * 128 + lane] = 1; }
    else {
        f32x4 w4[4];
#pragma unroll
        for (int q = 0; q < 4; ++q) w4[q] = *(const LAS f32x4*)(wl + g * 16 + q * 4);
        const int p8 = (lane & 3) * 8;
        const unsigned selp = 0x0c0c0c0cu & ~(0xffu << p8);
        const unsigned selLo = (lane & 4) ? 0x0c0c0c0cu : selp, selHi = (lane & 4) ? selp : 0x0c0c0c0cu;
        f32x4 D1 = {0.f, 0.f, 0.f, 0.f}, D2 = {0.f, 0.f, 0.f, 0.f};
#pragma unroll
        for (int j = 0; j < 16; ++j) {
            const unsigned tb = (unsigned)__builtin_amdgcn_cvt_pk_fp8_f32(w4[j >> 2][j & 3], 0.f, 0, false);
            const unsigned alo = __builtin_amdgcn_perm(0u, tb, selLo), ahi = __builtin_amdgcn_perm(0u, tb, selHi);
            const long A = (long)(((unsigned long)ahi << 32) | (unsigned long)alo);
            const long B1 = (long)(((unsigned long)cur[j].y << 32) | (unsigned long)cur[j].x), B2 = (long)(((unsigned long)cur[j].w << 32) | (unsigned long)cur[j].z);
            D1 = __builtin_amdgcn_mfma_f32_16x16x32_fp8_fp8(A, B1, D1, 0, 0, 0);
            D2 = __builtin_amdgcn_mfma_f32_16x16x32_fp8_fp8(A, B2, D2, 0, 0, 0);
        }
        f32x4 o;
#pragma unroll
        for (int r = 0; r < 4; ++r) { const float snd = hv ? D1[r] : D2[r], own = hv ? D2[r] : D1[r]; const unsigned xw = (r & 2) ? xr.y : xr.x; const float xv = (r & 1) ? bfhi(xw) : bflo(xw); o[r] = alpha * xv + (own + __shfl_xor(snd, 40)) * invS; }
        u32x2v ob; ob.x = pk2(o[0], o[1]); ob.y = pk2(o[2], o[3]);
        if (MODE == 3 || MODE == 4) { if (o[0] + o[1] + o[2] + o[3] == 1.2345f) *(GAS u32x2v*)(Z + (size_t)t * 2048 + col) = ob; } else
        if (MODE == 6) { if (valid && live) *(GAS u32x2v*)(Z + (size_t)(t & 127) * 2048 + col) = ob; } else
        if (valid && live) { bf16* zp = Z + (size_t)t * 2048 + col; asm volatile("global_store_dwordx2 %0, %1, off sc0 sc1" :: "v"(zp), "v"(ob) : "memory"); }
    }
}
template <int MODE>
__device__ __forceinline__ void phase_vpass_sl(const unsigned char* V, const bf16* Xf, const int* IDX, const float* AACC, const float* SU, const float* GT, bf16* Z, float alpha, const XTopo tp, LAS unsigned char* lds, int wave, int lane_in) {
    const int lane0 = lane_in;
    LAS float* wl = (LAS float*)lds + wave * 128;
    for (int sl = tp.xi; sl < 16; sl += tp.nx) {
        const __amdgpu_buffer_rsrc_t vrs = __builtin_amdgcn_make_buffer_rsrc((void*)(V + (size_t)sl * 16384 * 128), 0, 16384 * 128, 0x00020000);
        v4u vqA[16], vqB[16]; i32x4 idA[4], idB[4]; float scA[6], scB[6]; u32x2v xrA = {0u, 0u}, xrB = {0u, 0u};
        {   int lane = lane0; asm volatile("" : "+v"(lane));
            const int g = lane >> 3, i = lane & 7, t0 = tp.wq, t1 = min(tp.wq + tp.nwq, NTOKF - 1);
#pragma unroll
            for (int q = 0; q < 4; ++q) { idA[q] = *(const GAS i32x4*)(IDX + (size_t)t0 * 128 + g * 16 + q * 4); idB[q] = *(const GAS i32x4*)(IDX + (size_t)t1 * 128 + g * 16 + q * 4); }
            const size_t o0 = (size_t)t0 * 128 + lane; scA[0] = AACC[o0]; scA[1] = AACC[o0 + 64]; scA[2] = SU[o0]; scA[3] = SU[o0 + 64]; scA[4] = GT[o0]; scA[5] = GT[o0 + 64];
            if (MODE != 3) xrA = *(const GAS u32x2v*)(Xf + (size_t)t0 * 2048 + sl * 128 + ((lane & 32) ? 64 : 0) + ((lane >> 4) & 1) * 32 + (i >> 2) * 16 + (i & 3) * 4);
            __builtin_amdgcn_sched_barrier(0);
#pragma unroll
            for (int j = 0; j < 16; ++j) { if (MODE == 1) vqA[j] = (v4u){(unsigned)idA[j >> 2][j & 3], 0x38383838u, 0x38383838u, 0x38383838u}; else vqA[j] = __builtin_bit_cast(v4u, __builtin_amdgcn_raw_buffer_load_b128(vrs, (idA[j >> 2][j & 3] << 7) + i * 16, 0, 0)); }
        }
#pragma unroll 1
        for (int t = tp.wq; t < NTOKF; t += 2 * tp.nwq) {
            const int t1 = min(t + tp.nwq, NTOKF - 1), t2 = min(t + 2 * tp.nwq, NTOKF - 1), t3 = min(t + 3 * tp.nwq, NTOKF - 1);
            vpass_step<MODE>(vqA, vqB, idB, idA, scA, scB, xrA, xrB, vrs, Xf, IDX, AACC, SU, GT, Z, alpha, wl, t, t1, t2, sl, lane0);
            vpass_step<MODE>(vqB, vqA, idA, idB, scB, scA, xrB, xrA, vrs, Xf, IDX, AACC, SU, GT, Z, alpha, wl, t1, t2, t3, sl, lane0, t + tp.nwq < NTOKF);
        }
    }
}
typedef short s16x4 __attribute__((ext_vector_type(4)));
typedef unsigned u32x2 __attribute__((ext_vector_type(2)));
template <int MODE>
__device__ __forceinline__ void phase_spatial(const bf16* UB, const bf16* VB, const float* VST, const float* lng, const float* lnb, const bf16* WSB, const float* wsf, const float* bs,
                                              bf16* UM, float* vs_out, LAS unsigned char* lds, int vcu, int G, int wave, int lane) {
    constexpr int PITCH = 136;
    LAS bf16* T = (LAS bf16*)lds;
    LAS bf16* WS = (LAS bf16*)(lds + 128 * PITCH * 2);
    const int tid = wave * 64 + lane;
    const int nbg = G >> 3, g = (nbg > 0) ? vcu / nbg : 0, jb = (nbg > 0) ? vcu % nbg : 0;
    if (MODE != 1 && nbg > 0 && g < 8) {
        for (int i = tid; i < 128 * 16; i += 512) { const int t = i >> 4, ch = i & 15; *(LAS v4u*)(WS + t * 128 + ((ch ^ (t & 15)) << 3)) = *(const GAS v4u*)(WSB + (size_t)(g * 128 + t) * 128 + ch * 8); }
        const int s_ = tid >> 2, cq_ = (tid & 3) * 32;
        v4u pvq[4]; float ps1 = 1.f, ps2 = 2.f;
        if (MODE == 2) pvq[0] = pvq[1] = pvq[2] = pvq[3] = (v4u){0x3f803f80u, 0x3f803f80u, 0x3f803f80u, 0x3f803f80u};
        else if (jb < 384) { const int ck = jb / 6, cb = g * 6 + jb % 6; const size_t r = (size_t)ck * 128 + s_;
            ps1 = VST[r * 2]; ps2 = VST[r * 2 + 1];
#pragma unroll
            for (int i = 0; i < 4; ++i) pvq[i] = *(const GAS v4u*)(VB + r * 6144 + cb * 128 + cq_ + i * 8); }
        for (int u = jb; u < 384; u += nbg) {
            const int ck = u / 6, cb = g * 6 + u % 6;
            const size_t row0 = (size_t)ck * 128; const int col0 = cb * 128;
            u32x2 uq[8]; float bsv[8];
            { const int fr = lane & 15, fq = lane >> 4, c0 = 16 * wave;
#pragma unroll
              for (int jt = 0; jt < 8; ++jt) { const int t = jt * 16 + fr; if (MODE == 3) uq[jt] = (u32x2){0x3f803f80u, 0x3f803f80u}; else uq[jt] = *(const GAS u32x2*)(UB + (row0 + t) * 6144 + col0 + c0 + 4 * fq); bsv[jt] = bs[g * 128 + t]; } }
            {
                const float mu = ps1 * (1.f / 6144.f); const float rstd = rsqrtf(ps2 * (1.f / 6144.f) - mu * mu + 1e-5f);
#pragma unroll
                for (int i = 0; i < 4; ++i) { const v4u q = pvq[i];
                    const float* gp = lng + col0 + cq_ + i * 8; const float* bp = lnb + col0 + cq_ + i * 8;
                    const f32x4 g0 = *(const GAS f32x4*)gp, g1 = *(const GAS f32x4*)(gp + 4), b0 = *(const GAS f32x4*)bp, b1 = *(const GAS f32x4*)(bp + 4);
                    v4u o;
                    o.x = pk2((bflo(q.x) - mu) * rstd * g0.x + b0.x, (bfhi(q.x) - mu) * rstd * g0.y + b0.y);
                    o.y = pk2((bflo(q.y) - mu) * rstd * g0.z + b0.z, (bfhi(q.y) - mu) * rstd * g0.w + b0.w);
                    o.z = pk2((bflo(q.z) - mu) * rstd * g1.x + b1.x, (bfhi(q.z) - mu) * rstd * g1.y + b1.y);
                    o.w = pk2((bflo(q.w) - mu) * rstd * g1.z + b1.z, (bfhi(q.w) - mu) * rstd * g1.w + b1.w);
                    *(LAS v4u*)(T + s_ * PITCH + cq_ + i * 8) = o; }
            }
            __syncthreads();
            {
                const int fr = lane & 15, fq = lane >> 4, qq = fr >> 2, pp = fr & 3, c0 = 16 * wave;
                if (MODE != 2 && u + nbg < 384) { const int un = u + nbg, ckn = un / 6, cbn = g * 6 + un % 6; const size_t r = (size_t)ckn * 128 + s_;
                    ps1 = VST[r * 2]; ps2 = VST[r * 2 + 1];
#pragma unroll
                    for (int i = 0; i < 4; ++i) pvq[i] = *(const GAS v4u*)(VB + r * 6144 + cbn * 128 + cq_ + i * 8); }
                bf16x8 af[4];
#pragma unroll
                for (int ks = 0; ks < 4; ++ks) {
                    const s16x4 r0 = __builtin_amdgcn_ds_read_tr16_b64_v4i16((LAS s16x4*)(T + (32 * ks + 8 * fq + qq) * PITCH + c0 + 4 * pp));
                    const s16x4 r1 = __builtin_amdgcn_ds_read_tr16_b64_v4i16((LAS s16x4*)(T + (32 * ks + 8 * fq + 4 + qq) * PITCH + c0 + 4 * pp));
                    af[ks] = (bf16x8){r0.x, r0.y, r0.z, r0.w, r1.x, r1.y, r1.z, r1.w};
                }
                f32x4 acc[8];
#pragma unroll
                for (int jt = 0; jt < 8; ++jt) {
                    acc[jt] = (f32x4){0.f, 0.f, 0.f, 0.f};
#pragma unroll
                    for (int ks = 0; ks < 4; ++ks) if (ks <= (jt >> 1)) { const bf16x8 bfr = *(const LAS bf16x8*)(WS + (jt * 16 + fr) * 128 + (((ks * 4 + fq) ^ fr) << 3)); acc[jt] = __builtin_amdgcn_mfma_f32_16x16x32_bf16(af[ks], bfr, acc[jt], 0, 0, 0); }
                }
#pragma unroll
                for (int jt = 0; jt < 8; ++jt) {
                    const int t = jt * 16 + fr; const size_t off = (row0 + t) * 6144 + col0 + c0 + 4 * fq;
                    u32x2 o; o.x = pk2(bflo(uq[jt].x) * (acc[jt][0] + bsv[jt]), bfhi(uq[jt].x) * (acc[jt][1] + bsv[jt])); o.y = pk2(bflo(uq[jt].y) * (acc[jt][2] + bsv[jt]), bfhi(uq[jt].y) * (acc[jt][3] + bsv[jt]));
                    if (MODE == 3) { if (o.x == 0x12345u) *(GAS u32x2*)(UM + off) = o; } else *(GAS u32x2*)(UM + off) = o;
                }
            }
            __syncthreads();
        }
    }
    if (MODE == 0 || MODE == 1) for (int it = vcu * 512 + tid; it < 128 * 768; it += G * 512) {
        const int sq = it / 768, c8 = (it % 768) * 8, gg = c8 / 768;
        const size_t r0 = 8192 + (size_t)sq * 4;
        const f32x4 g0 = *(const GAS f32x4*)(lng + c8), g1 = *(const GAS f32x4*)(lng + c8 + 4), b0 = *(const GAS f32x4*)(lnb + c8), b1 = *(const GAS f32x4*)(lnb + c8 + 4);
        v4u vq4[4], uq4[4]; float st1[4], st2[4], bsv4[4], wv[4][4];
#pragma unroll
        for (int s = 0; s < 4; ++s) { st1[s] = VST[(r0 + s) * 2]; st2[s] = VST[(r0 + s) * 2 + 1]; vq4[s] = *(const GAS v4u*)(VB + (r0 + s) * 6144 + c8); uq4[s] = *(const GAS v4u*)(UB + (r0 + s) * 6144 + c8); bsv4[s] = bs[gg * 128 + s];
#pragma unroll
            for (int s2 = 0; s2 < 4; ++s2) wv[s][s2] = (s2 <= s) ? wsf[(size_t)(gg * 128 + s) * 128 + s2] : 0.f; }
        float vn[4][8];
#pragma unroll
        for (int s = 0; s < 4; ++s) {
            const float mu = st1[s] * (1.f / 6144.f); const float rstd = rsqrtf(st2[s] * (1.f / 6144.f) - mu * mu + 1e-5f); const v4u q = vq4[s];
            vn[s][0] = (bflo(q.x) - mu) * rstd * g0.x + b0.x; vn[s][1] = (bfhi(q.x) - mu) * rstd * g0.y + b0.y; vn[s][2] = (bflo(q.y) - mu) * rstd * g0.z + b0.z; vn[s][3] = (bfhi(q.y) - mu) * rstd * g0.w + b0.w;
            vn[s][4] = (bflo(q.z) - mu) * rstd * g1.x + b1.x; vn[s][5] = (bfhi(q.z) - mu) * rstd * g1.y + b1.y; vn[s][6] = (bflo(q.w) - mu) * rstd * g1.z + b1.z; vn[s][7] = (bfhi(q.w) - mu) * rstd * g1.w + b1.w;
        }
#pragma unroll
        for (int s = 0; s < 4; ++s) { float* vo = vs_out + ((size_t)sq * 4 + s) * 6144 + c8;
            *(GAS f32x4*)vo = (f32x4){vn[s][0], vn[s][1], vn[s][2], vn[s][3]}; *(GAS f32x4*)(vo + 4) = (f32x4){vn[s][4], vn[s][5], vn[s][6], vn[s][7]}; }
#pragma unroll
        for (int t = 0; t < 4; ++t) {
            float mx[8];
#pragma unroll
            for (int e = 0; e < 8; ++e) mx[e] = bsv4[t];
#pragma unroll
            for (int s = 0; s < 4; ++s) if (s <= t) {
#pragma unroll
                for (int e = 0; e < 8; ++e) mx[e] += wv[t][s] * vn[s][e]; }
            const v4u uq = uq4[t];
            v4u o; o.x = pk2(bflo(uq.x) * mx[0], bfhi(uq.x) * mx[1]); o.y = pk2(bflo(uq.y) * mx[2], bfhi(uq.y) * mx[3]); o.z = pk2(bflo(uq.z) * mx[4], bfhi(uq.z) * mx[5]); o.w = pk2(bflo(uq.w) * mx[6], bfhi(uq.w) * mx[7]);
            *(GAS v4u*)(UM + (r0 + t) * 6144 + c8) = o;
        }
    }
}
__device__ __forceinline__ float wave_scan_add(float v, int lane) {
#pragma unroll
    for (int o = 1; o < 64; o <<= 1) { const float t = __shfl_up(v, o); if (lane >= o) v += t; }
    return v;
}
__device__ __forceinline__ float wave_scan_max(float v, int lane) {
#pragma unroll
    for (int o = 1; o < 64; o <<= 1) { const float t = __shfl_up(v, o); if (lane >= o) v = fmaxf(v, t); }
    return v;
}
__device__ __forceinline__ bf16x8 tr_frag2(const LAS bf16* p0, const LAS bf16* p1) {
    const s16x4 r0 = __builtin_amdgcn_ds_read_tr16_b64_v4i16((LAS s16x4*)p0);
    const s16x4 r1 = __builtin_amdgcn_ds_read_tr16_b64_v4i16((LAS s16x4*)p1);
    return (bf16x8){r0.x, r0.y, r0.z, r0.w, r1.x, r1.y, r1.z, r1.w};
}
__device__ __forceinline__ bf16x8 tr_frag(const LAS bf16* p0, int rowstep4) { return tr_frag2(p0, p0 + rowstep4); }
__device__ __forceinline__ int qk_off(int row, int chunk) { return row * 128 + ((chunk ^ (row & 15)) << 3); }
__device__ __forceinline__ int v_off(int row, int chunk) { return row * 256 + ((chunk ^ (row & 7)) << 3); }
__device__ __forceinline__ int p_off(int row, int chunk) { return row * 64 + ((chunk ^ ((row >> 1) & 7)) << 3); }

__device__ __forceinline__ void mlstm_prompt_seq(const bf16* QKVO, const float* GATES, const float* hn_gain, bf16* HN, float* Cp, float* np_, float* mp, int seq, int h, LAS unsigned char* lds, int wave, int lane) {
    LAS bf16* Qs = (LAS bf16*)lds;
    LAS bf16* Ks = (LAS bf16*)(lds + 16384);
    LAS bf16* Vs = (LAS bf16*)(lds + 32768);
    LAS bf16* Cd = (LAS bf16*)(lds + 65536) + wave * 4096;
    LAS unsigned char* hi = lds + RING_BYTES + 512;
    LAS bf16* Ps = (LAS bf16*)hi;
    LAS float* A_ = (LAS float*)(hi + 8192);
    LAS float* M_ = A_ + 64;
    LAS float* B_ = M_ + 64;
    LAS float* SC = B_ + 64;
    LAS float* X_ = SC + 4;
    LAS bf16* nd = (LAS bf16*)(X_ + 1024);
    LAS float* GN = X_ + 1024 + 64;
    const int tid = wave * 64 + lane, fr = lane & 15, fq = lane >> 4;
    const size_t row0 = (size_t)seq * 2048;
    for (int i = tid; i < 65536 / 16; i += 512) ((LAS v4u*)(lds + 65536))[i] = (v4u){0u, 0u, 0u, 0u};
    if (tid < 16) ((LAS v4u*)nd)[tid] = (v4u){0u, 0u, 0u, 0u};
    if (tid < 256) GN[tid] = hn_gain[h * 256 + tid];
    float nreg = 0.f;
    f32x4 Cacc[2][8];
#pragma unroll
    for (int it = 0; it < 2; ++it)
#pragma unroll
        for (int jd = 0; jd < 8; ++jd) Cacc[it][jd] = (f32x4){0.f, 0.f, 0.f, 0.f};
    float m = 0.f;
    const bf16x8 ones = (fr == 0) ? (bf16x8){0x3F80, 0x3F80, 0x3F80, 0x3F80, 0x3F80, 0x3F80, 0x3F80, 0x3F80} : (bf16x8){0, 0, 0, 0, 0, 0, 0, 0};
    const int srow = tid >> 3, sc16 = (tid & 7) * 16, sc32 = (tid & 7) * 32;
    v4u pq[2], pk[2], pv[4];
    {   const bf16* r = QKVO + (row0 + srow) * 6144;
#pragma unroll
        for (int i = 0; i < 2; ++i) { pq[i] = *(const GAS v4u*)(r + h * 128 + sc16 + i * 8); pk[i] = *(const GAS v4u*)(r + 1024 + h * 128 + sc16 + i * 8); }
#pragma unroll
        for (int i = 0; i < 4; ++i) pv[i] = *(const GAS v4u*)(r + 2048 + h * 256 + sc32 + i * 8); }
    float ig_n = 0.f, lf_n = 0.f;
    if (wave == 0) { ig_n = GATES[(row0 + lane) * 16 + h]; lf_n = GATES[(row0 + lane) * 16 + 8 + h]; }
    __syncthreads();
#pragma unroll 1
    for (int c = 0; c < 32; ++c) {
        const size_t rb = row0 + (size_t)c * 64;
        int fr_l = lane & 15, fq_l = lane >> 4; asm volatile("" : "+v"(fr_l), "+v"(fq_l));
        const int fr = fr_l, fq = fq_l;
#pragma unroll
        for (int i = 0; i < 2; ++i) { *(LAS v4u*)(Qs + qk_off(srow, (sc16 >> 3) + i)) = pq[i]; *(LAS v4u*)(Ks + qk_off(srow, (sc16 >> 3) + i)) = pk[i]; }
#pragma unroll
        for (int i = 0; i < 4; ++i) *(LAS v4u*)(Vs + v_off(srow, (sc32 >> 3) + i)) = pv[i];
        if (c + 1 < 32) { const bf16* r = QKVO + (rb + 64 + srow) * 6144;
#pragma unroll
            for (int i = 0; i < 2; ++i) { pq[i] = *(const GAS v4u*)(r + h * 128 + sc16 + i * 8); pk[i] = *(const GAS v4u*)(r + 1024 + h * 128 + sc16 + i * 8); }
#pragma unroll
            for (int i = 0; i < 4; ++i) pv[i] = *(const GAS v4u*)(r + 2048 + h * 256 + sc32 + i * 8); }
        if (wave == 0) {
            const float ig = ig_n, lf = lf_n;
            if (c + 1 < 32) { ig_n = GATES[(rb + 64 + lane) * 16 + h]; lf_n = GATES[(rb + 64 + lane) * 16 + 8 + h]; }
            const float b = wave_scan_add(lf, lane); const float a = ig - b; const float pm = wave_scan_max(a, lane);
            const float Mt = fmaxf(m, pm);
            A_[lane] = a; M_[lane] = Mt; B_[lane] = b;
            const float M63 = __shfl(Mt, 63), b63 = __shfl(b, 63);
            if (lane == 0) { SC[0] = __expf(m - M63); SC[1] = b63 + M63; SC[2] = m; }
            m = b63 + M63;
        }
        __syncthreads();
        f32x4 nacc[3][4];
#pragma unroll
        for (int it = 0; it < 3; ++it)
#pragma unroll
            for (int jt = 0; jt < 4; ++jt) nacc[it][jt] = (f32x4){0.f, 0.f, 0.f, 0.f};
#pragma unroll 1
        for (int ks = 0; ks < 4; ++ks) {
            bf16x8 ca[3];
#pragma unroll
            for (int it = 0; it < 2; ++it) ca[it] = tr_frag(Cd + (32 * ks + 8 * fq + (fr >> 2)) * 32 + 16 * it + 4 * (fr & 3), 4 * 32);
            ca[2] = (fr == 0) ? *(const LAS bf16x8*)(nd + 32 * ks + 8 * fq) : (bf16x8){0, 0, 0, 0, 0, 0, 0, 0};
#pragma unroll
            for (int jt = 0; jt < 4; ++jt) { const bf16x8 qb = *(const LAS bf16x8*)(Qs + qk_off(16 * jt + fr, 4 * ks + fq));
#pragma unroll
                for (int it = 0; it < 3; ++it) nacc[it][jt] = __builtin_amdgcn_mfma_f32_16x16x32_bf16(ca[it], qb, nacc[it][jt], 0, 0, 0); }
        }
#pragma unroll
        for (int jt = 0; jt < 4; ++jt) { const float mt = M_[16 * jt + fr]; const float wi = __expf(SC[2] - mt);
#pragma unroll
            for (int it = 0; it < 3; ++it) nacc[it][jt] = nacc[it][jt] * wi; }
        {
#pragma unroll 1
            for (int ti = wave; ti < 16; ti += 8) {
                int tt, st;
                if (ti < 10) { tt = (ti >= 6) ? 3 : (ti >= 3) ? 2 : (ti >= 1) ? 1 : 0; st = ti - (tt * (tt + 1)) / 2; }
                else { const int z = ti - 10; tt = (z >= 5) ? 2 : (z >= 3) ? 1 : 0; st = (z >= 5) ? 3 : (z >= 3) ? (z - 3 + 2) : (z + 1); }
                u32x2 o = (u32x2){0u, 0u};
                if (ti < 10) {
                    f32x4 sa = (f32x4){0.f, 0.f, 0.f, 0.f};
#pragma unroll
                    for (int ks = 0; ks < 4; ++ks) { const bf16x8 ka = *(const LAS bf16x8*)(Ks + qk_off(16 * st + fr, 4 * ks + fq)); const bf16x8 qb = *(const LAS bf16x8*)(Qs + qk_off(16 * tt + fr, 4 * ks + fq));
                        sa = __builtin_amdgcn_mfma_f32_16x16x32_bf16(ka, qb, sa, 0, 0, 0); }
                    const int t = 16 * tt + fr, s0 = 16 * st + 4 * fq; const float mt = M_[t];
                    float pvv[4];
#pragma unroll
                    for (int r = 0; r < 4; ++r) pvv[r] = (s0 + r <= t) ? sa[r] * __expf(A_[s0 + r] - mt) : 0.f;
                    o.x = pk2(pvv[0], pvv[1]); o.y = pk2(pvv[2], pvv[3]);
                }
                *(LAS u32x2*)(Ps + p_off(16 * tt + fr, 2 * st + (fq >> 1)) + 4 * (fq & 1)) = o;
            }
        }
        __syncthreads();
        {   const float M63 = M_[63]; const float wk = __expf(A_[srow] - M63);
#pragma unroll
            for (int i = 0; i < 2; ++i) { v4u q = *(LAS v4u*)(Ks + qk_off(srow, (sc16 >> 3) + i));
                q.x = pk2(bflo(q.x) * wk, bfhi(q.x) * wk); q.y = pk2(bflo(q.y) * wk, bfhi(q.y) * wk); q.z = pk2(bflo(q.z) * wk, bfhi(q.z) * wk); q.w = pk2(bflo(q.w) * wk, bfhi(q.w) * wk);
                *(LAS v4u*)(Ks + qk_off(srow, (sc16 >> 3) + i)) = q; } }
        bf16x8 va[2][2];
#pragma unroll
        for (int ks = 0; ks < 2; ++ks)
#pragma unroll
            for (int it = 0; it < 2; ++it) { const int r_ = 32 * ks + 8 * fq + (fr >> 2), ch_ = 4 * wave + 2 * it + ((fr & 3) >> 1), w_ = 4 * (fr & 1); va[ks][it] = tr_frag2(Vs + v_off(r_, ch_) + w_, Vs + v_off(r_ + 4, ch_) + w_); }
#pragma unroll
        for (int ks = 0; ks < 2; ++ks)
#pragma unroll
            for (int jt = 0; jt < 4; ++jt) { const bf16x8 pb = *(const LAS bf16x8*)(Ps + p_off(16 * jt + fr, 4 * ks + fq));
                nacc[0][jt] = __builtin_amdgcn_mfma_f32_16x16x32_bf16(va[ks][0], pb, nacc[0][jt], 0, 0, 0);
                nacc[1][jt] = __builtin_amdgcn_mfma_f32_16x16x32_bf16(va[ks][1], pb, nacc[1][jt], 0, 0, 0);
                nacc[2][jt] = __builtin_amdgcn_mfma_f32_16x16x32_bf16(ones, pb, nacc[2][jt], 0, 0, 0); }
        u32x2 oq[4][2];
#pragma unroll
        for (int jt = 0; jt < 4; ++jt)
#pragma unroll
            for (int it = 0; it < 2; ++it) oq[jt][it] = *(const GAS u32x2*)(QKVO + (rb + 16 * jt + fr) * 6144 + 4096 + h * 256 + 32 * wave + 16 * it + 4 * fq);
        float s1[4], s2[4];
#pragma unroll
        for (int jt = 0; jt < 4; ++jt) {
            const int t = 16 * jt + fr;
            const float den = __shfl(nacc[2][jt][0], fr);
            const float dd = fmaxf(fabsf(den), __expf(-(B_[t] + M_[t]))); const float inv = 1.f / dd;
            s1[jt] = 0.f; s2[jt] = 0.f;
#pragma unroll
            for (int it = 0; it < 2; ++it) { const u32x2 oq_ = oq[jt][it];
                const float og[4] = {bflo(oq_.x), bfhi(oq_.x), bflo(oq_.y), bfhi(oq_.y)};
#pragma unroll
                for (int r = 0; r < 4; ++r) { const float hv = nacc[it][jt][r] * inv * __builtin_amdgcn_rcpf(1.f + __expf(-og[r])); nacc[it][jt][r] = hv; s1[jt] += hv; s2[jt] += hv * hv; } }
            s1[jt] += __shfl_xor(s1[jt], 16); s1[jt] += __shfl_xor(s1[jt], 32); s2[jt] += __shfl_xor(s2[jt], 16); s2[jt] += __shfl_xor(s2[jt], 32);
            if (fq == 0) { X_[(wave * 64 + t) * 2] = s1[jt]; X_[(wave * 64 + t) * 2 + 1] = s2[jt]; }
        }
        __syncthreads();
#pragma unroll
        for (int jt = 0; jt < 4; ++jt) {
            const int t = 16 * jt + fr; float a1 = 0.f, a2 = 0.f;
#pragma unroll
            for (int w = 0; w < 8; ++w) { a1 += X_[(w * 64 + t) * 2]; a2 += X_[(w * 64 + t) * 2 + 1]; }
            const float mu = a1 * (1.f / 256.f); const float rstd = rsqrtf(a2 * (1.f / 256.f) - mu * mu + 1e-5f);
#pragma unroll
            for (int it = 0; it < 2; ++it) { const int e = 32 * wave + 16 * it + 4 * fq; const f32x4 gn = *(const LAS f32x4*)(GN + e);
                u32x2 o; o.x = pk2((nacc[it][jt][0] - mu) * rstd * gn.x, (nacc[it][jt][1] - mu) * rstd * gn.y); o.y = pk2((nacc[it][jt][2] - mu) * rstd * gn.z, (nacc[it][jt][3] - mu) * rstd * gn.w);
                *(GAS u32x2*)(HN + (rb + t) * 2048 + h * 256 + e) = o; }
        }
        {   const float decay = SC[0];
#pragma unroll
            for (int it = 0; it < 2; ++it)
#pragma unroll
                for (int jd = 0; jd < 8; ++jd) Cacc[it][jd] = Cacc[it][jd] * decay;
            if (tid < 128) { float sum = 0.f;
#pragma unroll 8
                for (int s2_ = 0; s2_ < 64; ++s2_) sum += bflo((unsigned)Ks[qk_off(s2_, tid >> 3) + (tid & 7)]);
                nreg = decay * nreg + sum; nd[tid] = (bf16)f2bf(nreg); }
#pragma unroll
            for (int ks = 0; ks < 2; ++ks)
#pragma unroll
                for (int jd = 0; jd < 8; ++jd) { asm volatile("" ::: "memory"); const int r_ = 32 * ks + 8 * fq + (fr >> 2), ch_ = 2 * jd + ((fr & 3) >> 1), w_ = 4 * (fr & 1); const bf16x8 kb = tr_frag2(Ks + qk_off(r_, ch_) + w_, Ks + qk_off(r_ + 4, ch_) + w_);
                    Cacc[0][jd] = __builtin_amdgcn_mfma_f32_16x16x32_bf16(va[ks][0], kb, Cacc[0][jd], 0, 0, 0);
                    Cacc[1][jd] = __builtin_amdgcn_mfma_f32_16x16x32_bf16(va[ks][1], kb, Cacc[1][jd], 0, 0, 0);
                }
#pragma unroll
            for (int jd = 0; jd < 8; ++jd) {
#pragma unroll
                for (int it = 0; it < 2; ++it) { u32x2 o; o.x = pk2(Cacc[it][jd][0], Cacc[it][jd][1]); o.y = pk2(Cacc[it][jd][2], Cacc[it][jd][3]); *(LAS u32x2*)(Cd + (16 * jd + fr) * 32 + 16 * it + 4 * fq) = o; }
            }
        }
        __syncthreads();
    }
    float* Co = Cp + (size_t)(seq * 8 + h) * 32768;
#pragma unroll
    for (int jd = 0; jd < 8; ++jd) {
#pragma unroll
        for (int it = 0; it < 2; ++it) *(GAS f32x4*)(Co + (size_t)(16 * jd + fr) * 256 + 32 * wave + 16 * it + 4 * fq) = Cacc[it][jd];
    }
    if (tid < 128) np_[(seq * 8 + h) * 128 + tid] = nreg;
    if (wave == 0 && lane == 0) mp[seq * 8 + h] = m;
}

__device__ __forceinline__ void mlstm_sample_unit(const bf16* QKVO, const float* GATES, const float* hn_gain, const float* C0, const float* n0, const float* m0,
                                                  bf16* HN, float* Cs, float* ns, float* ms, int u, LAS unsigned char* lds, int wave, int lane) {
    const int h = u & 7, tid = wave * 64 + lane; const size_t r0 = 8192 + (size_t)(u >> 3) * 4;
    LAS float* q = (LAS float*)lds;
    LAS float* k = q + 512;
    LAS float* v = k + 512;
    LAS float* Sm = v + 1024;
    LAS float* gv = Sm + 16;
    LAS float* nn = gv + 32;
    LAS float* part = nn + 128;
    LAS float* red = part + 8192;
    { const int t = tid >> 7, d = tid & 127; const bf16* r = QKVO + (r0 + t) * 6144; q[tid] = bflo((unsigned)r[h * 128 + d]); k[tid] = bflo((unsigned)r[1024 + h * 128 + d]);
#pragma unroll
      for (int i = 0; i < 2; ++i) { const int idx = tid + 512 * i, tv = idx >> 8, e = idx & 255; v[idx] = bflo((unsigned)QKVO[(r0 + tv) * 6144 + 2048 + h * 256 + e]); } }
    if (tid < 128) nn[tid] = n0[(size_t)u * 128 + tid];
    if (tid == 0) {
        const float mprev = m0[u]; float b = 0.f, pm = -INFINITY;
        for (int t = 0; t < 4; ++t) { const float ig = GATES[(r0 + t) * 16 + h], lf = GATES[(r0 + t) * 16 + 8 + h]; b += lf; const float a = ig - b; pm = fmaxf(pm, a); const float Mt = fmaxf(mprev, pm);
            gv[t] = a; gv[4 + t] = Mt; gv[8 + t] = b; gv[12 + t] = __expf(mprev - Mt); }
        const float M3 = gv[7], b3 = gv[11];
        gv[28] = __expf(mprev - M3); gv[29] = b3 + M3;
        for (int s = 0; s < 4; ++s) gv[20 + s] = __expf(gv[s] - M3);
    }
    __syncthreads();
    if (tid < 16) { const int t = tid >> 2, s = tid & 3; float r = 0.f; if (s <= t) { float dot = 0.f; for (int d = 0; d < 128; ++d) dot += q[t * 128 + d] * k[s * 128 + d]; r = dot * __expf(gv[s] - gv[4 + t]); } Sm[tid] = r; }
    else if (tid < 20) { const int t = tid - 16; float dot = 0.f; for (int d = 0; d < 128; ++d) dot += q[t * 128 + d] * nn[d]; gv[24 + t] = dot; }
    __syncthreads();
    if (tid < 4) { float den = gv[12 + tid] * gv[24 + tid]; for (int s = 0; s <= tid; ++s) den += Sm[tid * 4 + s]; gv[16 + tid] = fmaxf(fabsf(den), __expf(-(gv[8 + tid] + gv[4 + tid]))); }
    k[tid] *= gv[20 + (tid >> 7)];
    __syncthreads();
    {
        const int eq = tid & 63, dg = tid >> 6; const float decay = gv[28];
        f32x4 v4[4];
#pragma unroll
        for (int s = 0; s < 4; ++s) v4[s] = *(const LAS f32x4*)(v + s * 256 + 4 * eq);
        f32x4 acc[4];
#pragma unroll
        for (int t = 0; t < 4; ++t) acc[t] = (f32x4){0.f, 0.f, 0.f, 0.f};
        const float* cin = C0 + (size_t)u * 32768 + (size_t)(dg * 16) * 256 + 4 * eq; float* cout = Cs + (size_t)u * 32768 + (size_t)(dg * 16) * 256 + 4 * eq;
#pragma unroll
        for (int hb = 0; hb < 2; ++hb) {
            f32x4 cr[8];
#pragma unroll
            for (int dd = 0; dd < 8; ++dd) cr[dd] = __builtin_nontemporal_load((const GAS f32x4*)(cin + (hb * 8 + dd) * 256));
#pragma unroll
            for (int dd = 0; dd < 8; ++dd) { const int d = dg * 16 + hb * 8 + dd; const f32x4 c = cr[dd];
#pragma unroll
                for (int t = 0; t < 4; ++t) acc[t] += c * q[t * 128 + d];
                f32x4 cn = c * decay;
#pragma unroll
                for (int s = 0; s < 4; ++s) cn += v4[s] * k[s * 128 + d];
                __builtin_nontemporal_store(cn, (GAS f32x4*)(cout + (hb * 8 + dd) * 256)); }
        }
#pragma unroll
        for (int t = 0; t < 4; ++t) *(LAS f32x4*)(part + (dg * 4 + t) * 256 + 4 * eq) = acc[t];
    }
    __syncthreads();
    float hv[2];
    {   const int t = tid >> 7, e2 = (tid & 127) * 2;
        float s1 = 0.f, s2 = 0.f;
#pragma unroll
        for (int i = 0; i < 2; ++i) { const int e = e2 + i; float num2 = 0.f;
#pragma unroll
            for (int dg = 0; dg < 8; ++dg) num2 += part[(dg * 4 + t) * 256 + e];
            float num1 = 0.f; for (int s = 0; s <= t; ++s) num1 += Sm[t * 4 + s] * v[s * 256 + e];
            float x = (num1 + gv[12 + t] * num2) / gv[16 + t];
            const float o = bflo((unsigned)QKVO[(r0 + t) * 6144 + 4096 + h * 256 + e]);
            x *= 1.f / (1.f + __expf(-o)); hv[i] = x; s1 += x; s2 += x * x; }
        s1 = wave_sum_f(s1); s2 = wave_sum_f(s2);
        if (lane == 0) { red[wave * 2] = s1; red[wave * 2 + 1] = s2; }
    }
    __syncthreads();
    {   const int t = tid >> 7, e2 = (tid & 127) * 2;
        const float a1 = red[(2 * t) * 2] + red[(2 * t + 1) * 2], a2 = red[(2 * t) * 2 + 1] + red[(2 * t + 1) * 2 + 1];
        const float mu = a1 * (1.f / 256.f); const float rstd = rsqrtf(a2 * (1.f / 256.f) - mu * mu + 1e-5f);
        const unsigned o = pk2((hv[0] - mu) * rstd * hn_gain[h * 256 + e2], (hv[1] - mu) * rstd * hn_gain[h * 256 + e2 + 1]);
        *(GAS unsigned*)(HN + (r0 + t) * 2048 + h * 256 + e2) = o;
        if (tid < 128) { float a = gv[28] * nn[tid]; for (int s = 0; s < 4; ++s) a += k[s * 128 + tid]; ns[(size_t)u * 128 + tid] = a; }
        if (tid == 0) ms[u] = gv[29];
    }
    __syncthreads();
}

__device__ __forceinline__ void phase_mlstm(const Args& a, LAS unsigned char* lds, int G, int wave, int lane, int which) {
    const bf16* QKVO = (const bf16*)(a.ws + a.L.qkvo); const float* GATES = (const float*)(a.ws + a.L.gates); bf16* HN = (bf16*)(a.ws + a.L.qp);
    const int bx = blockIdx.x;
    constexpr size_t O_CP = 17825792, O_NP = O_CP + 1048576, O_MP = O_NP + 4096, O_CS = O_MP + 32, O_NS = O_CS + 33554432, O_MS = O_NS + 131072;
    if (bx < 32) { if (which & 1) mlstm_prompt_seq(QKVO, GATES, a.in[7], HN, a.out + O_CP, a.out + O_NP, a.out + O_MP, bx >> 3, bx & 7, lds, wave, lane); }
    else {
        if (which & 2) for (int u = bx - 32; u < 1024; u += G - 32) mlstm_sample_unit(QKVO, GATES, a.in[7], a.in[2], a.in[3], a.in[4], HN, a.out + O_CS, a.out + O_NS, a.out + O_MS, u, lds, wave, lane);
        if (which & 28) { __syncthreads(); side_convert(a, lds, (bx - 32) * NWAVES + wave, (G - 32) * NWAVES, wave, lane, (which & 4) ? 3 : ((which >> 3) & 3)); }
    }
}
struct MiniBf16S { bf16* O; int ldc, sclo, schi; __device__ __forceinline__ void operator()(int row, int col, f32x4 a) const { const float s = (col >= sclo && col < schi) ? 0.08838834764831845f : 1.f;
    u32x2 o; o.x = pk2(a[0] * s, a[1] * s); o.y = pk2(a[2] * s, a[3] * s); *(GAS u32x2*)(O + (size_t)row * ldc + col) = o; } };
struct MiniBf16 { bf16* O; int ldc; __device__ __forceinline__ void operator()(int row, int col, f32x4 a) const { u32x2 o; o.x = pk2(a[0], a[1]); o.y = pk2(a[2], a[3]); *(GAS u32x2*)(O + (size_t)row * ldc + col) = o; } };
struct MiniRes { const bf16* xb; bf16* Z; float alpha; __device__ __forceinline__ void operator()(int row, int col, f32x4 a) const {
    const u32x2 x = *(const GAS u32x2*)(xb + (size_t)row * 2048 + col); u32x2 o; o.x = pk2(bflo(x.x) * alpha + a[0], bfhi(x.x) * alpha + a[1]); o.y = pk2(bflo(x.y) * alpha + a[2], bfhi(x.y) * alpha + a[3]);
    *(GAS u32x2*)(Z + (size_t)row * 2048 + col) = o; } };
struct MiniGelu { bf16* U; bf16* V; const float* bias; float* VST; __device__ __forceinline__ void operator()(int row, int col, f32x4 a) const {
    const bool isv = col >= 6144; const f32x4 bv = *(const GAS f32x4*)(bias + col); float s1 = 0.f, s2 = 0.f;
#pragma unroll
    for (int e = 0; e < 4; ++e) { a[e] = pg8::gelu_tanh_f(a[e] + bv[e]); s1 += a[e]; s2 += a[e] * a[e]; }
    u32x2 o; o.x = pk2(a[0], a[1]); o.y = pk2(a[2], a[3]);
    *(GAS u32x2*)((isv ? V + (size_t)row * 6144 + (col - 6144) : U + (size_t)row * 6144 + col)) = o;
    if (isv) { s1 += __shfl_xor(s1, 16); s1 += __shfl_xor(s1, 32); s2 += __shfl_xor(s2, 16); s2 += __shfl_xor(s2, 32);
        if ((threadIdx.x & 48) == 0) { atomicAdd(VST + 2 * row, s1); atomicAdd(VST + 2 * row + 1, s2); } } } };
template <class Epi>
__device__ __forceinline__ void mini_gemm(const bf16* A, const bf16* Bt, int N, int K, const Epi& E, LAS unsigned char* lds, int vcu, int G, int wave, int lane) {
    const int tid = wave * 64 + lane, fr = lane & 15, fq = lane >> 4;
    const int srow = tid >> 4, sch = tid & 15;
    const int nct = N / 128, nunits = 16 * nct, nch = K / 128;
    const int wofs = srow * 256 + ((sch ^ (srow & 15)) << 4);
    const size_t bstep = (size_t)32 * K;
#define MG_LOAD(r, c) do { int cc_ = (c) + c0; if (cc_ >= nch) cc_ -= nch; r[0] = *(const GAS v4u*)(ag + (size_t)cc_ * 128); _Pragma("unroll") for (int p_ = 0; p_ < 4; ++p_) r[1 + p_] = *(const GAS v4u*)(bg + p_ * bstep + (size_t)cc_ * 128); } while (0)
#define MG_STORE(r, b) do { *(LAS v4u*)(lds + (b) * 40960 + wofs) = r[0]; _Pragma("unroll") for (int p_ = 0; p_ < 4; ++p_) *(LAS v4u*)(lds + (b) * 40960 + 8192 + p_ * 8192 + wofs) = r[1 + p_]; } while (0)
#define MG_COMPUTE(b) do { _Pragma("unroll") for (int ks_ = 0; ks_ < 4; ++ks_) { const int co_ = ((ks_ * 4 + fq) ^ fr) << 4; \
        const bf16x8 a0_ = *(const LAS bf16x8*)(lds + (b) * 40960 + fr * 256 + co_), a1_ = *(const LAS bf16x8*)(lds + (b) * 40960 + (16 + fr) * 256 + co_); \
        const bf16x8 b_ = *(const LAS bf16x8*)(lds + (b) * 40960 + 8192 + (wave * 16 + fr) * 256 + co_); \
        acc0 = __builtin_amdgcn_mfma_f32_16x16x32_bf16(b_, a0_, acc0, 0, 0, 0); acc1 = __builtin_amdgcn_mfma_f32_16x16x32_bf16(b_, a1_, acc1, 0, 0, 0); } } while (0)
    for (int u = vcu; u < nunits; u += G) {
        const int rt = u & 15, ct = u >> 4;
        const int row0 = 8192 + rt * 32, colB0 = ct * 128;
        const bf16* ag = A + (size_t)(row0 + srow) * K + sch * 8;
        const bf16* bg = Bt + (size_t)(colB0 + srow) * K + sch * 8;
        f32x4 acc0 = (f32x4){0.f, 0.f, 0.f, 0.f}, acc1 = acc0;
        const int c0 = (u * 5) % nch;
        v4u r0[5], r1[5], r2[5], r3[5];
        MG_LOAD(r0, 0); MG_LOAD(r1, 1); MG_LOAD(r2, 2); MG_LOAD(r3, 3);
        MG_STORE(r0, 0); __syncthreads();
#pragma unroll 1
        for (int c = 0; c < nch; c += 4) {
            MG_LOAD(r0, min(c + 4, nch - 1));
            MG_COMPUTE(0);
            MG_STORE(r1, 1); __syncthreads();
            MG_LOAD(r1, min(c + 5, nch - 1));
            MG_COMPUTE(1);
            MG_STORE(r2, 0); __syncthreads();
            MG_LOAD(r2, min(c + 6, nch - 1));
            MG_COMPUTE(0);
            MG_STORE(r3, 1); __syncthreads();
            MG_LOAD(r3, min(c + 7, nch - 1));
            MG_COMPUTE(1);
            MG_STORE(r0, 0);
            __syncthreads();
        }
        E(row0 + fr, colB0 + wave * 16 + 4 * fq, acc0); E(row0 + 16 + fr, colB0 + wave * 16 + 4 * fq, acc1);
    }
#undef MG_LOAD
#undef MG_STORE
#undef MG_COMPUTE
}
__global__ void __launch_bounds__(NWAVES * 64, 2) mk(Args args) {
    extern __shared__ __attribute__((aligned(16))) unsigned char lds_raw[];
    LAS unsigned char* lds = (LAS unsigned char*)lds_raw;
    volatile LAS unsigned* MISC = (volatile LAS unsigned*)(lds + MISC_OFF);
    const int tid = threadIdx.x, lane = tid & 63, wave = __builtin_amdgcn_readfirstlane(tid >> 6);
    const int G = gridDim.x, bx = blockIdx.x; const int vcu = (G % 8 == 0) ? (bx % 8) * (G / 8) + bx / 8 : bx;
    for (int u = tid; u < (LDS_BYTES - RING_BYTES) / 4; u += NWAVES * 64) ((LAS unsigned*)(lds + RING_BYTES))[u] = 0u;
    __syncthreads();
    unsigned char* ws = args.ws; const Lay& L = args.L;
    unsigned* ctl = (unsigned*)(ws + L.ctl);
    XcdBarrier bar = xcd_barrier_post(ctl + 4096 + args.li * XCD_BAR_WORDS, MISC + 8);
    const int lo = args.ph_lo, hi = args.ph_hi;
#ifndef PHMASK
#define PHMASK 0xFFFFFFFFu
#endif
#define IN(k) (((PHMASK >> (k)) & 1u) && lo <= (k) && (k) < hi)
#ifndef MLSTM_DUPSEL
#define MLSTM_DUPSEL 3
#endif
#ifndef TK_ABL
#define TK_ABL 0
#endif
#ifndef SP_ABL
#define SP_ABL 0
#endif
#ifndef UP_ABL
#define UP_ABL 0
#endif
#ifndef VP_ABL
#define VP_ABL 0
#endif
#ifndef DUPMASK
#define DUPMASK 0u
#endif
#define DUP(k) ((DUPMASK >> (k)) & 1u)
#define LANE() ({ int l_ = lane; asm volatile("" : "+v"(l_)); l_; })
#define SEAM(k) do { if (IN(k) && IN((k) + 1)) xcd_barrier(bar); } while (0)
#define GEMM_PHASE_FULL(EPI_T, E, Aptr, Btptr, Nn, Kk) do { pg8::Gemm g_{(const pg8::bf16_t*)(Aptr), (const pg8::bf16_t*)(Btptr), NTOKF, (Nn), (Kk)}; pg8::StaticOrder S_; S_.init(NTOKF, (Nn), G, bx); \
        pg8::gemm_phase<EPI_T, pg8::StaticOrder, true, true>(lds, g_, S_, E); } while (0)
#define GEMM_PHASE(EPI_T, E, Aptr, Btptr, Nn, Kk, MINI_E) do { pg8::Gemm g_{(const pg8::bf16_t*)(Aptr), (const pg8::bf16_t*)(Btptr), 8192, (Nn), (Kk)}; pg8::StaticOrder S_; S_.init(8192, (Nn), G, bx); \
        pg8::gemm_phase<EPI_T, pg8::StaticOrder, true, true>(lds, g_, S_, E); \
        mini_gemm((const bf16*)(Aptr), (const bf16*)(Btptr), (Nn), (Kk), MINI_E, lds, vcu, G, wave, LANE()); } while (0)

#define GEMM_PHASE_MINI(EPI_T, E, Aptr, Btptr, Nn, Kk, MINI_E) do { mini_gemm((const bf16*)(Aptr), (const bf16*)(Btptr), (Nn), (Kk), MINI_E, lds, vcu, G, wave, LANE()); } while (0)
#ifdef MINI_DUP
#define GEMM_PHASE_DUPSEL GEMM_PHASE_MINI
#else
#define GEMM_PHASE_DUPSEL GEMM_PHASE
#endif

    if (IN(0)) { { phase_prologue(args, lds, vcu, G, wave, LANE()); } if (DUP(0)) { xcd_barrier(bar); { phase_prologue(args, lds, vcu, G, wave, LANE()); } } } SEAM(0);
    if (IN(1)) { { pg8::EpiBf16S E{(pg8::bf16_t*)(ws + L.qkvo), 6144, 1024, 2048, 0.08838834764831845f}; GEMM_PHASE_FULL(pg8::EpiBf16S, E, ws + L.xb, ws + L.wina, 6144, 2048); } if (DUP(1)) { xcd_barrier(bar); { pg8::EpiBf16S E{(pg8::bf16_t*)(ws + L.qkvo), 6144, 1024, 2048, 0.08838834764831845f}; GEMM_PHASE_FULL(pg8::EpiBf16S, E, ws + L.xb, ws + L.wina, 6144, 2048); } } } SEAM(1);
    if (IN(2)) { { phase_mlstm(args, lds, G, wave, lane, 7); } if (DUP(2)) { xcd_barrier(bar); { phase_mlstm(args, lds, G, wave, lane, MLSTM_DUPSEL); } } } SEAM(2);
    if (IN(3)) { { pg8::EpiRes E{(const pg8::bf16_t*)(ws + L.xb), (pg8::bf16_t*)(ws + L.z), ALPHA_F}; GEMM_PHASE(pg8::EpiRes, E, ws + L.qp, ws + L.wouta, 2048, 2048, (MiniRes{(const bf16*)(ws + L.xb), (bf16*)(ws + L.z), ALPHA_F})); } if (DUP(3)) { xcd_barrier(bar); { pg8::EpiRes E{(const pg8::bf16_t*)(ws + L.xb), (pg8::bf16_t*)(ws + L.z), ALPHA_F}; GEMM_PHASE(pg8::EpiRes, E, ws + L.qp, ws + L.wouta, 2048, 2048, (MiniRes{(const bf16*)(ws + L.xb), (bf16*)(ws + L.z), ALPHA_F})); } } } SEAM(3);
    if (IN(4)) { { phase_ln<true>((const float*)(ws + L.z), args.in[16], args.in[17], (float*)nullptr, (bf16*)(ws + L.xb), ws + L.xq, (float*)(ws + L.sx), vcu, G, wave, LANE()); } if (DUP(4)) { xcd_barrier(bar); { phase_ln<true>((const float*)(ws + L.z), args.in[16], args.in[17], (float*)nullptr, (bf16*)(ws + L.xb), ws + L.xq, (float*)(ws + L.sx), vcu, G, wave, LANE()); } } } SEAM(4);
    if (IN(5)) { { pg8::EpiBf16S E{(pg8::bf16_t*)(ws + L.qp), 2048, 0, 0, 1.f}; GEMM_PHASE(pg8::EpiBf16S, E, ws + L.xb, ws + L.wq, 2048, 2048, (MiniBf16S{(bf16*)(ws + L.qp), 2048, 0, 0})); } if (DUP(5)) { xcd_barrier(bar); { pg8::EpiBf16S E{(pg8::bf16_t*)(ws + L.qp), 2048, 0, 0, 1.f}; GEMM_PHASE(pg8::EpiBf16S, E, ws + L.xb, ws + L.wq, 2048, 2048, (MiniBf16S{(bf16*)(ws + L.qp), 2048, 0, 0})); } } } SEAM(5);
#define RINV_U ((const float*)(ws + L.rinv))
#define RINV_V ((const float*)(ws + L.rinv) + 16384)
    if (IN(6)) { { phase_topk<0>((const bf16*)(ws + L.qp), (const bf16*)(ws + L.sk), (int*)(ws + L.idx), (float*)(ws + L.gt), (float*)(ws + L.ww), (float*)(ws + L.su), RINV_U, RINV_V, lds, vcu, G, wave, LANE()); } if (DUP(6)) { xcd_barrier(bar); { phase_topk<TK_ABL>((const bf16*)(ws + L.qp), (const bf16*)(ws + L.sk), (int*)(ws + L.um), (float*)(ws + L.um + 8388608), (float*)(ws + L.um + 16777216), (float*)(ws + L.um + 25165824), RINV_U, RINV_V, lds, vcu, G, wave, LANE()); } } } SEAM(6);
    if (IN(7)) { { phase_upass_sl<0>((const unsigned char*)(ws + L.ptu), (const unsigned char*)(ws + L.xq), (const float*)(ws + L.sx), (const int*)(ws + L.idx), (float*)(ws + L.ww), (float*)(ws + L.gt), (float*)(ws + L.su), RINV_U, RINV_V, xcd_topology(bar.bar, bar.x, MISC[10], wave), LANE()); } if (DUP(7)) { xcd_barrier(bar); { phase_upass_sl<UP_ABL>((const unsigned char*)(ws + L.ptu), (const unsigned char*)(ws + L.xq), (const float*)(ws + L.sx), (const int*)(ws + L.idx), (float*)(ws + L.um), (float*)(ws + L.gt), (float*)(ws + L.su), RINV_U, RINV_V, xcd_topology(bar.bar, bar.x, MISC[10], wave), LANE()); } } } SEAM(7);
    if (IN(8)) { { phase_vpass_sl<0>((const unsigned char*)(ws + L.ptv), (const bf16*)(ws + L.xb), (const int*)(ws + L.idx), (const float*)(ws + L.ww), (const float*)(ws + L.su), (const float*)(ws + L.gt), (bf16*)(ws + L.z), ALPHA_F, xcd_topology(bar.bar, bar.x, MISC[10], wave), lds, wave, LANE()); } if (DUP(8)) { xcd_barrier(bar); { phase_vpass_sl<VP_ABL>((const unsigned char*)(ws + L.ptv), (const bf16*)(ws + L.xb), (const int*)(ws + L.idx), (const float*)(ws + L.ww), (const float*)(ws + L.su), (const float*)(ws + L.gt), (bf16*)(ws + L.um), ALPHA_F, xcd_topology(bar.bar, bar.x, MISC[10], wave), lds, wave, LANE()); } } } SEAM(8);
    if (IN(9)) { { phase_ln<true>((const float*)(ws + L.z), args.in[18], args.in[19], (float*)nullptr, (bf16*)(ws + L.xb), (unsigned char*)nullptr, (float*)nullptr, vcu, G, wave, LANE()); } if (DUP(9)) { xcd_barrier(bar); { phase_ln<true>((const float*)(ws + L.z), args.in[18], args.in[19], (float*)nullptr, (bf16*)(ws + L.xb), (unsigned char*)nullptr, (float*)nullptr, vcu, G, wave, LANE()); } } } SEAM(9);
    if (IN(10)) { { pg8::EpiGelu E{(pg8::bf16_t*)(ws + L.ub), (pg8::bf16_t*)(ws + L.vb), args.in[10], (float*)(ws + L.vst)}; GEMM_PHASE_FULL(pg8::EpiGelu, E, ws + L.xb, ws + L.winb, 12288, 2048); } if (DUP(10)) { xcd_barrier(bar); { pg8::EpiGelu E{(pg8::bf16_t*)(ws + L.ub), (pg8::bf16_t*)(ws + L.vb), args.in[10], (float*)(ws + L.vst)}; GEMM_PHASE_FULL(pg8::EpiGelu, E, ws + L.xb, ws + L.winb, 12288, 2048); } } } SEAM(10);
    if (IN(11)) { { phase_spatial<0>((const bf16*)(ws + L.ub), (const bf16*)(ws + L.vb), (const float*)(ws + L.vst), args.in[11], args.in[12], (const bf16*)(ws + L.wsb), args.in[13], args.in[14],
                                (bf16*)(ws + L.um), args.out + OUT_VS, lds, vcu, G, wave, LANE()); } if (DUP(11)) { xcd_barrier(bar); { phase_spatial<SP_ABL>((const bf16*)(ws + L.ub), (const bf16*)(ws + L.vb), (const float*)(ws + L.vst), args.in[11], args.in[12], (const bf16*)(ws + L.wsb), args.in[13], args.in[14],
                                (bf16*)(ws + L.ptu), (float*)(ws + L.ptu1), lds, vcu, G, wave, LANE()); } } } SEAM(11);
    if (IN(12)) { { pg8::EpiRes E{(const pg8::bf16_t*)(ws + L.xb), (pg8::bf16_t*)(ws + L.z), ALPHA_F}; GEMM_PHASE(pg8::EpiRes, E, ws + L.um, ws + L.woutb, 2048, 6144, (MiniRes{(const bf16*)(ws + L.xb), (bf16*)(ws + L.z), ALPHA_F})); } if (DUP(12)) { xcd_barrier(bar); { pg8::EpiRes E{(const pg8::bf16_t*)(ws + L.xb), (pg8::bf16_t*)(ws + L.z), ALPHA_F}; GEMM_PHASE_DUPSEL(pg8::EpiRes, E, ws + L.um, ws + L.woutb, 2048, 6144, (MiniRes{(const bf16*)(ws + L.xb), (bf16*)(ws + L.z), ALPHA_F})); } } } SEAM(12);
    if (IN(13)) { { phase_ln<true>((const float*)(ws + L.z), args.in[16] + 2048, args.in[17] + 2048, (float*)nullptr, (bf16*)(ws + L.xb), ws + L.xq, (float*)(ws + L.sx), vcu, G, wave, LANE()); } if (DUP(13)) { xcd_barrier(bar); { phase_ln<true>((const float*)(ws + L.z), args.in[16] + 2048, args.in[17] + 2048, (float*)nullptr, (bf16*)(ws + L.xb), ws + L.xq, (float*)(ws + L.sx), vcu, G, wave, LANE()); } } } SEAM(13);
    if (IN(14)) { { pg8::EpiBf16S E{(pg8::bf16_t*)(ws + L.qp), 2048, 0, 0, 1.f}; GEMM_PHASE(pg8::EpiBf16S, E, ws + L.xb, (bf16*)(ws + L.wq) + (size_t)2048 * 2048, 2048, 2048, (MiniBf16S{(bf16*)(ws + L.qp), 2048, 0, 0})); } if (DUP(14)) { xcd_barrier(bar); { pg8::EpiBf16S E{(pg8::bf16_t*)(ws + L.qp), 2048, 0, 0, 1.f}; GEMM_PHASE(pg8::EpiBf16S, E, ws + L.xb, (bf16*)(ws + L.wq) + (size_t)2048 * 2048, 2048, 2048, (MiniBf16S{(bf16*)(ws + L.qp), 2048, 0, 0})); } } } SEAM(14);
#undef RINV_U
#undef RINV_V
#define RINV_U ((const float*)(ws + L.rinv) + 32768)
#define RINV_V ((const float*)(ws + L.rinv) + 49152)
    if (IN(15)) { { phase_topk<0>((const bf16*)(ws + L.qp), (const bf16*)(ws + L.sk) + (size_t)16 * 128 * 128, (int*)(ws + L.idx), (float*)(ws + L.gt), (float*)(ws + L.ww), (float*)(ws + L.su), RINV_U, RINV_V, lds, vcu, G, wave, LANE()); } if (DUP(15)) { xcd_barrier(bar); { phase_topk<TK_ABL>((const bf16*)(ws + L.qp), (const bf16*)(ws + L.sk) + (size_t)16 * 128 * 128, (int*)(ws + L.um), (float*)(ws + L.um + 8388608), (float*)(ws + L.um + 16777216), (float*)(ws + L.um + 25165824), RINV_U, RINV_V, lds, vcu, G, wave, LANE()); } } } SEAM(15);
    if (IN(16)) { { phase_upass_sl<0>((const unsigned char*)(ws + L.ptu1), (const unsigned char*)(ws + L.xq), (const float*)(ws + L.sx), (const int*)(ws + L.idx), (float*)(ws + L.ww), (float*)(ws + L.gt), (float*)(ws + L.su), RINV_U, RINV_V, xcd_topology(bar.bar, bar.x, MISC[10], wave), LANE()); } if (DUP(16)) { xcd_barrier(bar); { phase_upass_sl<UP_ABL>((const unsigned char*)(ws + L.ptu1), (const unsigned char*)(ws + L.xq), (const float*)(ws + L.sx), (const int*)(ws + L.idx), (float*)(ws + L.um), (float*)(ws + L.gt), (float*)(ws + L.su), RINV_U, RINV_V, xcd_topology(bar.bar, bar.x, MISC[10], wave), LANE()); } } } SEAM(16);
    if (IN(17)) { { phase_vpass_sl<0>((const unsigned char*)(ws + L.ptv1), (const bf16*)(ws + L.xb), (const int*)(ws + L.idx), (const float*)(ws + L.ww), (const float*)(ws + L.su), (const float*)(ws + L.gt), (bf16*)(ws + L.z), ALPHA_F, xcd_topology(bar.bar, bar.x, MISC[10], wave), lds, wave, LANE()); } if (DUP(17)) { xcd_barrier(bar); { phase_vpass_sl<VP_ABL>((const unsigned char*)(ws + L.ptv1), (const bf16*)(ws + L.xb), (const int*)(ws + L.idx), (const float*)(ws + L.ww), (const float*)(ws + L.su), (const float*)(ws + L.gt), (bf16*)(ws + L.um), ALPHA_F, xcd_topology(bar.bar, bar.x, MISC[10], wave), lds, wave, LANE()); } } } SEAM(17);
#ifdef XBAR_EXTRA
    if (IN(17) && IN(18)) { for (int e_ = 0; e_ < XBAR_EXTRA; ++e_) xcd_barrier(bar); }
#endif
    if (IN(18)) { phase_ln<true>((const float*)(ws + L.z), args.in[18] + 2048, args.in[19] + 2048, args.out, nullptr, (unsigned char*)nullptr, (float*)nullptr, vcu, G, wave, LANE()); }
#undef IN
#undef SEAM
#undef GEMM_PHASE
}

static int g_grid = 0;
static bool mk_init() {
    if (g_grid == 0) {
        int dev = 0, cus = 0;
        if (hipGetDevice(&dev) != hipSuccess || hipDeviceGetAttribute(&cus, hipDeviceAttributeMultiprocessorCount, dev) != hipSuccess) { g_grid = -1; return false; }
        if (hipFuncSetAttribute((const void*)mk, hipFuncAttributeMaxDynamicSharedMemorySize, LDS_BYTES) != hipSuccess) { g_grid = -1; return false; }
        (void)hipGetLastError();
        g_grid = cus;
    }
    return g_grid > 0;
}
static void mk_launch(const Args& a0, int lo, int hi, int li, hipStream_t st) {
    Args a = a0; a.ph_lo = lo; a.ph_hi = hi; a.li = li;
    hipLaunchKernelGGL(mk, dim3(g_grid), dim3(NWAVES * 64), LDS_BYTES, st, a);
}
extern "C" void kernel_launch(void* const* d_in, const int* in_sizes, int n_in, void* d_out, int out_size, void* d_ws, size_t ws_size, hipStream_t stream) {
    if (!mk_init()) return;
    constexpr unsigned long long MiB = 1ull << 20;
    Args a{};
    for (int i = 0; i < 24; ++i) a.in[i] = (const float*)d_in[i];
    a.out = (float*)d_out; a.ws = (unsigned char*)d_ws;
    Lay& L = a.L;
    L.ctl = 0; L.wina = 1 * MiB; L.wouta = 25 * MiB; L.winb = 33 * MiB; L.woutb = 81 * MiB; L.wq = 105 * MiB; L.sk = 121 * MiB; L.gates = 122 * MiB; L.vst = 123 * MiB; L.wsb = 124 * MiB;
    L.idx = 125 * MiB; L.gt = 130 * MiB; L.ww = 135 * MiB; L.ptu = 140 * MiB; L.ptv = 204 * MiB; L.xf0 = 268 * MiB; L.xf1 = 336 * MiB; L.z = 404 * MiB; L.xb = 472 * MiB; L.qp = 506 * MiB;
    L.qkvo = 540 * MiB; L.ub = 540 * MiB; L.vb = 642 * MiB; L.um = 744 * MiB; L.ptu1 = 846 * MiB; L.ptv1 = 910 * MiB; L.rinv = 974 * MiB; L.su = 975 * MiB; L.xq = 980 * MiB; L.sx = 997 * MiB;
    (void)hipMemsetAsync((unsigned char*)d_ws + L.ctl, 0, MiB, stream);
    mk_launch(a, 0, 19, 0, stream);
}
```

```cpp
#include <hip/hip_runtime.h>
#include <stdint.h>
#include <math.h>
#define DUPMASK 0u
#define MLSTM_DUPSEL 7
#define GAS __attribute__((address_space(1)))
#define LAS __attribute__((address_space(3)))
typedef unsigned short bf16;
typedef unsigned v4u __attribute__((ext_vector_type(4)));
typedef float f32x4 __attribute__((ext_vector_type(4)));
typedef short bf16x8 __attribute__((ext_vector_type(8)));
typedef GAS unsigned gu32;
typedef GAS unsigned long long gu64;
#define RLX_AGENT __ATOMIC_RELAXED, __HIP_MEMORY_SCOPE_AGENT
#define LDS_WAIT() asm volatile("s_waitcnt lgkmcnt(0)" ::: "memory")
#define VM_WAIT() asm volatile("s_waitcnt vmcnt(0)" ::: "memory")
__device__ __forceinline__ unsigned long long rt() { return __builtin_amdgcn_s_memrealtime(); }
__device__ __forceinline__ unsigned f2bf(float f) { unsigned u = __builtin_bit_cast(unsigned, f); return (u + 0x7fffu + ((u >> 16) & 1u)) >> 16; }
__device__ __forceinline__ unsigned pk2(float lo, float hi) { unsigned r; asm("v_cvt_pk_bf16_f32 %0, %1, %2" : "=v"(r) : "v"(lo), "v"(hi)); return r; }

#define XB_TMO      128
#define XB_XCNT(j)  (256  + 64 * (j))
#define XB_XSUB(j)  (1280 + 64 * (j))
#define XB_XGEN(j)  (2304 + 64 * (j))
#define XB_TOP      3328
#define XB_TOPGEN   3392
#define XCD_BAR_WORDS 3456
#define XB_SPIN_CAP (1u << 22)

__device__ __forceinline__ unsigned xb_ld(unsigned* p)              { return __hip_atomic_load(p, __ATOMIC_RELAXED, __HIP_MEMORY_SCOPE_AGENT); }
__device__ __forceinline__ unsigned xb_add(unsigned* p, unsigned v) { return __hip_atomic_fetch_add(p, v, __ATOMIC_RELAXED, __HIP_MEMORY_SCOPE_AGENT); }
__device__ __forceinline__ unsigned xb_xcc_id() { return (unsigned)__builtin_amdgcn_s_getreg((3 << 11) | 20) & 0xFu; }
#define XB_SPIN(cond, bar) do { unsigned _sp = 0; while (cond) { __builtin_amdgcn_s_sleep(1); \
    if ((++_sp & 255u) == 0u) { if (xb_ld(&(bar)[XB_TMO])) break; if (_sp > XB_SPIN_CAP) { atomicAdd(&(bar)[XB_TMO], 1u); break; } } } } while (0)

struct XcdBarrier {
    unsigned* bar; unsigned x;
    volatile LAS unsigned* st;
};

__device__ __forceinline__ XcdBarrier xcd_barrier_post(unsigned* bar, volatile LAS unsigned* st) {
    XcdBarrier b; b.bar = bar; b.x = xb_xcc_id(); b.st = st;
    if (threadIdx.x == 0) st[2] = xb_add(&bar[XB_XCNT(b.x)], 1u);
    return b;
}
__device__ __forceinline__ void xcd_barrier_complete(unsigned* bar, unsigned x, unsigned& nloc, unsigned& nx) {
    const unsigned G = gridDim.x * gridDim.y * gridDim.z;
    unsigned sum, cnt, mine, sp = 0u;
    for (;;) {
        sum = 0u; cnt = 0u; mine = 0u;
#pragma unroll
        for (unsigned j = 0; j < 16; ++j) { const unsigned c = xb_ld(&bar[XB_XCNT(j)]); sum += c; cnt += (c > 0u) ? 1u : 0u; mine = (j == x) ? c : mine; }
        if (sum == G) break;
        __builtin_amdgcn_s_sleep(1);
        if ((++sp & 255u) == 0u) { if (xb_ld(&bar[XB_TMO])) break; if (sp > XB_SPIN_CAP) { atomicAdd(&bar[XB_TMO], 1u); break; } }
    }
    nloc = mine > 0u ? mine : 1u; nx = cnt > 0u ? cnt : 1u;
}

__device__ __forceinline__ void xcd_barrier(const XcdBarrier& b) {
    asm volatile("s_waitcnt vmcnt(0)" ::: "memory");
    __syncthreads();
    if (threadIdx.x == 0) {
        unsigned* bar = b.bar;
        __builtin_amdgcn_s_waitcnt(0);
        unsigned nloc = b.st[0], nx = b.st[1];
        if (nloc == 0u) { xcd_barrier_complete(bar, b.x, nloc, nx); b.st[0] = nloc; b.st[1] = nx; }
        const unsigned old = xb_add(&bar[XB_XSUB(b.x)], 1u);
        const unsigned gen = old / nloc;
        if (old + 1u == (gen + 1u) * nloc) {
            __builtin_amdgcn_fence(__ATOMIC_RELEASE, "agent");
            asm volatile("s_waitcnt vmcnt(0)" ::: "memory");
            const unsigned og = xb_add(&bar[XB_TOP], 1u);
            const unsigned tg = og / nx;
            if (og + 1u == (tg + 1u) * nx) xb_add(&bar[XB_TOPGEN], 1u);
            else XB_SPIN(xb_ld(&bar[XB_TOPGEN]) == tg, bar);
            __builtin_amdgcn_fence(__ATOMIC_ACQUIRE, "agent");
            xb_add(&bar[XB_XGEN(b.x)], 1u);
            asm volatile("s_waitcnt vmcnt(0)" ::: "memory");
        } else {
            XB_SPIN(xb_ld(&bar[XB_XGEN(b.x)]) == gen, bar);
            __builtin_amdgcn_fence(__ATOMIC_ACQUIRE, "agent");
            asm volatile("s_waitcnt vmcnt(0)" ::: "memory");
        }
    }
    __syncthreads();
}

namespace pg8 {
#define PG8_LAS __attribute__((address_space(3)))
typedef unsigned short bf16_t;
typedef short bf16x8 __attribute__((ext_vector_type(8)));
typedef float f32x4 __attribute__((ext_vector_type(4)));
typedef unsigned u32x4 __attribute__((ext_vector_type(4)));
typedef unsigned pu32x2 __attribute__((ext_vector_type(2)));
constexpr int BM = 256, BK = 64, HALF = 128, HTB = HALF * BK * 2  , STAGE_BYTES = 8 * HTB, NXCD = 8, WGM = 8;

__host__ __device__ __forceinline__ int lds_byte(int r, int c) { const int st = (r >> 4) * 2 + (c >> 5), rr = r & 15, cc = c & 31, ob = rr * 64 + cc * 2; return st * 1024 + (ob ^ (((ob >> 9) & 1) << 5)); }
__host__ __device__ __forceinline__ void stage_rc(int b, int& R, int& C) { const int st = b / 1024, sb = b % 1024, swz = sb ^ (((sb >> 9) & 1) << 5); R = (st >> 1) * 16 + swz / 64; C = (st & 1) * 32 + (swz % 64) / 2; }
__host__ __device__ __forceinline__ int perm32(int rho) { const int n = rho >> 4, i = rho & 15; return 8 * (i >> 2) + 4 * n + (i & 3); }

struct Unit { int pm, pn; };
struct Gemm { const bf16_t* A; const bf16_t* Bt; int M, N, K; };

struct StaticOrder {
    int nM, nN, nwg, G, c;
    __host__ __device__ void init(int M, int N, int G_, int c_) { nM = M / BM; nN = N / BM; nwg = nM * nN; G = G_; c = c_; }
    __host__ __device__ bool next(int i, Unit& u) const {
        const long L = (long)i * G + c; if (L >= nwg) return false;
        int wgid = (int)L; { const int q = nwg / NXCD, r = nwg % NXCD, xcd = wgid % NXCD, off = wgid / NXCD; wgid = (xcd < r ? xcd * (q + 1) : r * (q + 1) + (xcd - r) * q) + off; }
        const int nig = WGM * nN, gid = wgid / nig, fm = gid * WGM, gsz = (nM - fm) < WGM ? (nM - fm) : WGM;
        u.pm = fm + ((wgid % nig) % gsz); u.pn = (wgid % nig) / gsz; return true;
    }
    __device__ __forceinline__ void a_ready(const Unit&) const {}
    __device__ __forceinline__ void done(const Unit&) const {}
};


__device__ __forceinline__ unsigned cvt_pk_bf16(float lo, float hi) { unsigned r; asm volatile("v_cvt_pk_bf16_f32 %0, %1, %2" : "=v"(r) : "v"(lo), "v"(hi)); return r; }
__device__ __forceinline__ float gelu_tanh_f(float x) { const float u = x + 0.044715f * x * x * x; const float e = __builtin_amdgcn_exp2f(u * -2.302208198f); return x * __builtin_amdgcn_rcpf(1.0f + e); }
struct EpiBf16S {
    static constexpr bool PERM = true, AFTER_DRAIN = false;
    bf16_t* O; int ldc; int sc_lo, sc_hi; float sc;
    __device__ __forceinline__ void operator()(const f32x4 (&acc)[2][2][4][2], const Unit& u, int wr, int wc, int fr, int fq) const {
        const int row0 = u.pm * BM + wr * 64 + fr; const int colt = u.pn * BM;
        const float s = (colt >= sc_lo && colt < sc_hi) ? sc : 1.f;
        const int col0 = colt + wc * 32 + 8 * fq;
#pragma unroll
        for (int ai = 0; ai < 2; ++ai)
#pragma unroll
            for (int m = 0; m < 4; ++m) { bf16_t* rowp = O + (size_t)(row0 + ai * HALF + m * 16) * ldc + col0;
#pragma unroll
                for (int bj = 0; bj < 2; ++bj) { const f32x4 v0 = acc[ai][bj][m][0] * s, v1 = acc[ai][bj][m][1] * s;
                    u32x4 w; w.x = cvt_pk_bf16(v0[0], v0[1]); w.y = cvt_pk_bf16(v0[2], v0[3]); w.z = cvt_pk_bf16(v1[0], v1[1]); w.w = cvt_pk_bf16(v1[2], v1[3]);
                    *(u32x4*)(rowp + bj * HALF) = w; } }
    }
};
struct EpiRes {
    static constexpr bool PERM = false, AFTER_DRAIN = false;
    const bf16_t* xb; bf16_t* Z; float alpha;
    __device__ __forceinline__ void operator()(const f32x4 (&acc)[2][2][4][2], const Unit& u, int wr, int wc, int fr, int fq) const {
        const int col0 = u.pn * BM + wc * 32 + 4 * fq;
#pragma unroll
        for (int ai = 0; ai < 2; ++ai)
#pragma unroll
            for (int m = 0; m < 4; ++m) { const int r = u.pm * BM + ai * HALF + wr * 64 + m * 16 + fr;
                const bf16_t* rp = xb + (size_t)r * 2048; bf16_t* zp = Z + (size_t)r * 2048;
#pragma unroll
                for (int bj = 0; bj < 2; ++bj)
#pragma unroll
                    for (int n = 0; n < 2; ++n) { const int c = col0 + bj * HALF + n * 16; const pu32x2 x = *(const pu32x2*)(rp + c); const f32x4 a = acc[ai][bj][m][n];
                        pu32x2 o; o.x = pk2(__builtin_bit_cast(float, x.x << 16) * alpha + a[0], __builtin_bit_cast(float, x.x & 0xffff0000u) * alpha + a[1]);
                        o.y = pk2(__builtin_bit_cast(float, x.y << 16) * alpha + a[2], __builtin_bit_cast(float, x.y & 0xffff0000u) * alpha + a[3]); *(pu32x2*)(zp + c) = o; } }
    }
};
struct EpiGelu {
    static constexpr bool PERM = true, AFTER_DRAIN = false;
    bf16_t* U; bf16_t* V; const float* bias; float* VST;
    __device__ __forceinline__ void operator()(const f32x4 (&acc)[2][2][4][2], const Unit& u, int wr, int wc, int fr, int fq) const {
        const int row0 = u.pm * BM + wr * 64 + fr; const bool isv = u.pn >= 24; const int colt = (isv ? u.pn - 24 : u.pn) * BM;
        bf16_t* base = isv ? V : U;
        const int col0 = colt + wc * 32 + 8 * fq, bcol0 = u.pn * BM + wc * 32 + 8 * fq;
        f32x4 bv[2][2];
#pragma unroll
        for (int bj = 0; bj < 2; ++bj)
#pragma unroll
            for (int n = 0; n < 2; ++n) bv[bj][n] = *(const f32x4*)(bias + bcol0 + bj * HALF + 4 * n);
#pragma unroll
        for (int ai = 0; ai < 2; ++ai)
#pragma unroll
            for (int m = 0; m < 4; ++m) { const int r = row0 + ai * HALF + m * 16; bf16_t* rowp = base + (size_t)r * 6144 + col0; float s1 = 0.f, s2 = 0.f;
#pragma unroll
                for (int bj = 0; bj < 2; ++bj) { f32x4 v0 = acc[ai][bj][m][0] + bv[bj][0], v1 = acc[ai][bj][m][1] + bv[bj][1];
#pragma unroll
                    for (int e = 0; e < 4; ++e) { v0[e] = gelu_tanh_f(v0[e]); v1[e] = gelu_tanh_f(v1[e]); s1 += v0[e] + v1[e]; s2 += v0[e] * v0[e] + v1[e] * v1[e]; }
                    u32x4 w; w.x = cvt_pk_bf16(v0[0], v0[1]); w.y = cvt_pk_bf16(v0[2], v0[3]); w.z = cvt_pk_bf16(v1[0], v1[1]); w.w = cvt_pk_bf16(v1[2], v1[3]);
                    *(u32x4*)(rowp + bj * HALF) = w; }
                if (isv) { s1 += __shfl_xor(s1, 16); s1 += __shfl_xor(s1, 32); s2 += __shfl_xor(s2, 16); s2 += __shfl_xor(s2, 32);
                    if (fq == 0) { atomicAdd(VST + 2 * r, s1); atomicAdd(VST + 2 * r + 1, s2); } } }
    }
};
template <class Epi, class Sched, bool ALIGN_EPI = false, bool SP2 = false>
__device__ __forceinline__ void gemm_phase(PG8_LAS unsigned char* lds, const Gemm g, const Sched& S, const Epi& E) {
    int tid_l = threadIdx.x; asm volatile("" : "+v"(tid_l));
    const int tid = tid_l, wid = __builtin_amdgcn_readfirstlane(tid >> 6), lane = tid & 63, wr = wid >> 2, wc = wid & 3, fr = lane & 15, fq = lane >> 4;
    const int K = g.K, nt = K / BK;
    unsigned voffA[2], voffB[2];
#pragma unroll
    for (int i = 0; i < 2; ++i) { int R, C; stage_rc(tid * 16 + i * 8192, R, C); const int Rb = Epi::PERM ? ((R & ~31) + perm32(R & 31)) : R;
        voffA[i] = (unsigned)(R * K + C) * 2u; voffB[i] = (unsigned)(Rb * K + C) * 2u; }
    const size_t kstep = (size_t)(BK * 2);
    const size_t hstep = (size_t)HALF * K * 2;
    const size_t tstep = 2 * hstep;
    const unsigned ldsw = (unsigned)wid * 1024u;
    const int aoff = lds_byte(wr * 64 + fr, fq * 8), boff = lds_byte(wc * 32 + fr, fq * 8);
#define PG8_SA(b, h) (((b) * 2 + (h)) * HTB)
#define PG8_SB(b, h) ((4 + (b) * 2 + (h)) * HTB)
#define PG8_STAGE(bufoff, gbase, voff) do { _Pragma("unroll") for (int _i = 0; _i < 2; ++_i) \
        __builtin_amdgcn_global_load_lds((const unsigned*)((const char*)(gbase) + (voff)[_i]), (PG8_LAS unsigned*)(lds + (bufoff) + ldsw + _i * 8192), 16, 0, 0); } while (0)
#define PG8_LDA(dst, b, h) do { _Pragma("unroll") for (int m = 0; m < 4; ++m) _Pragma("unroll") for (int k = 0; k < 2; ++k) dst[m][k] = *(const PG8_LAS bf16x8*)(lds + PG8_SA(b, h) + aoff + m * 2048 + k * 1024); } while (0)
#define PG8_LDB(dst, b, h) do { _Pragma("unroll") for (int n = 0; n < 2; ++n) _Pragma("unroll") for (int k = 0; k < 2; ++k) dst[n][k] = *(const PG8_LAS bf16x8*)(lds + PG8_SB(b, h) + boff + n * 2048 + k * 1024); } while (0)
#define PG8_MMA(ai, bj, At, Bt) do { __builtin_amdgcn_s_setprio(1); _Pragma("unroll") for (int m = 0; m < 4; ++m) _Pragma("unroll") for (int n = 0; n < 2; ++n) _Pragma("unroll") for (int k = 0; k < 2; ++k) \
        acc[ai][bj][m][n] = __builtin_amdgcn_mfma_f32_16x16x32_bf16(Bt[n][k], At[m][k], acc[ai][bj][m][n], 0, 0, 0); __builtin_amdgcn_s_setprio(0); } while (0)
#define PG8_WAIT_V(n) asm volatile("s_waitcnt vmcnt(" #n ")" ::: "memory")
#define PG8_WAIT_L(n) asm volatile("s_waitcnt lgkmcnt(" #n ")" ::: "memory")
#define PG8_BAR __builtin_amdgcn_s_barrier()
#define PG8_SCHED __builtin_amdgcn_sched_barrier(0)
    Unit cur, nxt; int ui = 0;
    if (!S.next(0, cur)) return;
    f32x4 acc[2][2][4][2];
#pragma unroll
    for (int a = 0; a < 2; ++a)
#pragma unroll
        for (int b = 0; b < 2; ++b)
#pragma unroll
            for (int m = 0; m < 4; ++m)
#pragma unroll
                for (int n = 0; n < 2; ++n) acc[a][b][m][n] = (f32x4){0.f, 0.f, 0.f, 0.f};
    bf16x8 At[4][2], B0[2][2], B1[2][2];
    const char* cA = (const char*)g.A + (size_t)cur.pm * tstep; const char* cB = (const char*)g.Bt + (size_t)cur.pn * tstep;
    S.a_ready(cur);
    if constexpr (SP2) {
        PG8_STAGE(PG8_SB(0, 0), cB, voffB); PG8_STAGE(PG8_SB(0, 1), cB + hstep, voffB); PG8_STAGE(PG8_SA(0, 0), cA, voffA); PG8_STAGE(PG8_SA(0, 1), cA + hstep, voffA);
        if (wr == 1) PG8_BAR;
        PG8_WAIT_V(2); PG8_BAR;
        PG8_STAGE(PG8_SB(1, 0), cB + kstep, voffB); PG8_STAGE(PG8_SA(1, 0), cA + kstep, voffA); PG8_STAGE(PG8_SB(1, 1), cB + hstep + kstep, voffB);
        PG8_WAIT_V(6); PG8_BAR;
    } else {
        PG8_STAGE(PG8_SB(0, 0), cB, voffB); PG8_STAGE(PG8_SA(0, 0), cA, voffA); PG8_STAGE(PG8_SB(0, 1), cB + hstep, voffB); PG8_STAGE(PG8_SA(0, 1), cA + hstep, voffA);
        if (wr == 1) PG8_BAR;
        PG8_WAIT_V(4); PG8_BAR;
        PG8_STAGE(PG8_SB(1, 0), cB + kstep, voffB); PG8_STAGE(PG8_SA(1, 0), cA + kstep, voffA); PG8_STAGE(PG8_SB(1, 1), cB + hstep + kstep, voffB);
        PG8_WAIT_V(6); PG8_BAR;
    }
    for (;;) {
        const bool has_next = S.next(ui + 1, nxt);
        const char* nA = has_next ? (const char*)g.A + (size_t)nxt.pm * tstep : cA; const char* nB = has_next ? (const char*)g.Bt + (size_t)nxt.pn * tstep : cB;
        for (int t = 0; t < nt; t += 2) {
            const bool last = (t == nt - 2);
            const char* a1 = cA + (size_t)(t + 1) * kstep;
            const char* a2 = last ? nA : cA + (size_t)(t + 2) * kstep; const char* b2 = last ? nB : cB + (size_t)(t + 2) * kstep;
            const char* a3 = a2 + kstep; const char* b3 = b2 + kstep;
            if (last && has_next) S.a_ready(nxt);
            if constexpr (SP2) {
            PG8_LDB(B0, 0, 0); PG8_LDB(B1, 0, 1); PG8_SCHED; PG8_LDA(At, 0, 0); PG8_STAGE(PG8_SA(1, 1), a1 + hstep, voffA);
            PG8_WAIT_V(8); PG8_WAIT_L(0); PG8_BAR; PG8_MMA(0, 0, At, B0); PG8_MMA(0, 1, At, B1); PG8_BAR; PG8_SCHED;
            PG8_LDA(At, 0, 1); PG8_STAGE(PG8_SB(0, 0), b2, voffB); PG8_STAGE(PG8_SB(0, 1), b2 + hstep, voffB); PG8_STAGE(PG8_SA(0, 0), a2, voffA);
            PG8_WAIT_V(8); PG8_WAIT_L(0); PG8_BAR; PG8_MMA(1, 0, At, B0); PG8_MMA(1, 1, At, B1); PG8_BAR; PG8_SCHED;
            PG8_LDB(B0, 1, 0); PG8_LDB(B1, 1, 1); PG8_SCHED; PG8_LDA(At, 1, 0); PG8_STAGE(PG8_SA(0, 1), a2 + hstep, voffA);
            PG8_WAIT_V(8); PG8_WAIT_L(0); PG8_BAR; PG8_MMA(0, 0, At, B0); PG8_MMA(0, 1, At, B1); PG8_BAR; PG8_SCHED;
            PG8_LDA(At, 1, 1); PG8_STAGE(PG8_SB(1, 0), b3, voffB); PG8_STAGE(PG8_SB(1, 1), b3 + hstep, voffB); PG8_STAGE(PG8_SA(1, 0), a3, voffA);
            PG8_WAIT_V(8); PG8_WAIT_L(0); PG8_BAR; PG8_MMA(1, 0, At, B0); PG8_MMA(1, 1, At, B1); PG8_BAR; PG8_SCHED;
            } else {
            PG8_LDB(B0, 0, 0); PG8_SCHED; PG8_LDA(At, 0, 0); PG8_STAGE(PG8_SA(1, 1), a1 + hstep, voffA);
            PG8_WAIT_L(8); PG8_BAR; PG8_WAIT_L(0); PG8_MMA(0, 0, At, B0); PG8_BAR; PG8_SCHED;
            PG8_LDB(B1, 0, 1); PG8_STAGE(PG8_SB(0, 0), b2, voffB);
            PG8_BAR; PG8_WAIT_L(0); PG8_MMA(0, 1, At, B1); PG8_BAR;
            PG8_LDA(At, 0, 1); PG8_STAGE(PG8_SA(0, 0), a2, voffA);
            PG8_BAR; PG8_WAIT_L(0); PG8_MMA(1, 0, At, B0); PG8_BAR; PG8_SCHED;
            PG8_STAGE(PG8_SB(0, 1), b2 + hstep, voffB);
            PG8_WAIT_V(6); PG8_BAR; PG8_MMA(1, 1, At, B1); PG8_BAR;
            PG8_LDB(B0, 1, 0); PG8_SCHED; PG8_LDA(At, 1, 0); PG8_STAGE(PG8_SA(0, 1), a2 + hstep, voffA);
            PG8_WAIT_L(8); PG8_BAR; PG8_WAIT_L(0); PG8_MMA(0, 0, At, B0); PG8_BAR; PG8_SCHED;
            PG8_LDB(B1, 1, 1); PG8_STAGE(PG8_SB(1, 0), b3, voffB);
            PG8_BAR; PG8_WAIT_L(0); PG8_MMA(0, 1, At, B1); PG8_BAR;
            PG8_LDA(At, 1, 1); PG8_STAGE(PG8_SA(1, 0), a3, voffA);
            PG8_BAR; PG8_WAIT_L(0); PG8_MMA(1, 0, At, B0); PG8_BAR; PG8_SCHED;
            PG8_STAGE(PG8_SB(1, 1), b3 + hstep, voffB);
            PG8_WAIT_V(6); PG8_BAR; PG8_MMA(1, 1, At, B1); PG8_BAR;
            }
        }
        if constexpr (ALIGN_EPI) { if (wr == 0) PG8_BAR; }
        if constexpr (!Epi::AFTER_DRAIN) { E(acc, cur, wr, wc, fr, fq); S.done(cur); }
        if (!has_next) break;
#pragma unroll
        for (int a = 0; a < 2; ++a)
#pragma unroll
            for (int b = 0; b < 2; ++b)
#pragma unroll
                for (int m = 0; m < 4; ++m)
#pragma unroll
                    for (int n = 0; n < 2; ++n) acc[a][b][m][n] = (f32x4){0.f, 0.f, 0.f, 0.f};
        cur = nxt; cA = nA; cB = nB; ++ui;
        if constexpr (ALIGN_EPI) { if (wr == 1) PG8_BAR; }
    }
    PG8_WAIT_V(0);
    if constexpr (!ALIGN_EPI) { if (wr == 0) PG8_BAR; }
    PG8_BAR;
    if constexpr (Epi::AFTER_DRAIN) { E.fused(acc, cur, wr, wc, fr, fq, lds, wid, lane); S.done(cur); }
#undef PG8_SA
#undef PG8_SB
#undef PG8_STAGE
#undef PG8_LDA
#undef PG8_LDB
#undef PG8_MMA
#undef PG8_WAIT_V
#undef PG8_WAIT_L
#undef PG8_BAR
#undef PG8_SCHED
}
}
constexpr int NWAVES = 8;
constexpr int LDS_BYTES = 147456;
constexpr int RING_BYTES = 131072;
constexpr int MISC_OFF = RING_BYTES + 320;
constexpr int NTOKF = 8704;
constexpr float ALPHA_F = 1.4142135623730951f;
constexpr size_t OUT_VS = 52565024;

struct Lay {
    unsigned long long ctl, wina, wouta, winb, woutb, wq, sk, gates, vst, idx, gt, ww, ptu, ptv, xf0, xf1, z, xb, qp, qkvo, ub, vb, um, wsb, ptu1, ptv1, rinv, su, xq, sx;
};
struct Args { const float* in[24]; float* out; unsigned char* ws; Lay L; int ph_lo, ph_hi, li, pad; };

__device__ __forceinline__ float wave_sum_f(float v) {
#pragma unroll
    for (int o = 1; o < 64; o <<= 1) v += __shfl_xor(v, o);
    return v;
}
__device__ __forceinline__ void p0_transpose_item(const float* W, int K, int ldw, int Nuse, bf16* WT, LAS float* scr, int item, int lane) {
    const int nblk = Nuse / 32, kb = item / nblk, nb = item % nblk, k0 = 64 * kb, n0 = 32 * nb;
    f32x4 ld[8];
#pragma unroll
    for (int i = 0; i < 8; ++i) ld[i] = __builtin_nontemporal_load((const GAS f32x4*)(W + (size_t)(k0 + 8 * i + (lane >> 3)) * ldw + n0 + (lane & 7) * 4));
#pragma unroll
    for (int i = 0; i < 8; ++i) { LAS float* d = scr + (8 * i + (lane >> 3)) * 33 + (lane & 7) * 4; d[0] = ld[i].x; d[1] = ld[i].y; d[2] = ld[i].z; d[3] = ld[i].w; }
    LDS_WAIT(); asm volatile("" ::: "memory");
    const int c = lane & 7;
#pragma unroll
    for (int j = 0; j < 4; ++j) { const int n = (lane >> 3) + 8 * j; const LAS float* s = scr + (8 * c) * 33 + n;
        v4u o; o.x = pk2(s[0 * 33], s[1 * 33]); o.y = pk2(s[2 * 33], s[3 * 33]); o.z = pk2(s[4 * 33], s[5 * 33]); o.w = pk2(s[6 * 33], s[7 * 33]);
        *(GAS v4u*)(WT + (size_t)(n0 + n) * K + k0 + 8 * c) = o; }
    LDS_WAIT(); asm volatile("" ::: "memory");
}
__device__ __forceinline__ void cvt_stream(const float* src, bf16* dst, size_t n8, int gw, int NGW, int lane) {
    for (size_t i = (size_t)gw * 64 + lane; i < n8; i += (size_t)NGW * 64) {
        const f32x4 a = *(const GAS f32x4*)(src + i * 8), b = *(const GAS f32x4*)(src + i * 8 + 4);
        v4u o; o.x = pk2(a.x, a.y); o.y = pk2(a.z, a.w); o.z = pk2(b.x, b.y); o.w = pk2(b.z, b.w);
        *(GAS v4u*)(dst + i * 8) = o;
    }
}
__device__ __forceinline__ void cvt_peer_table(const float* src, bf16* dst, int gw, int NGW, int lane) {
    const size_t n8 = (size_t)16384 * 2048 / 8;
    for (size_t i = (size_t)gw * 64 + lane; i < n8; i += (size_t)NGW * 64) {
        const f32x4 a = __builtin_nontemporal_load((const GAS f32x4*)(src + i * 8)), b = __builtin_nontemporal_load((const GAS f32x4*)(src + i * 8 + 4));
        v4u o; o.x = pk2(a.x, a.y); o.y = pk2(a.z, a.w); o.z = pk2(b.x, b.y); o.w = pk2(b.z, b.w);
        const size_t e = i >> 8; const int c8 = (int)(i & 255) * 8;
        *(GAS v4u*)(dst + ((size_t)(c8 >> 6) * 16384 + e) * 64 + (c8 & 63)) = o;
    }
}
__device__ __forceinline__ void cvt_peer_table_fp8(const float* src, unsigned char* dst, float* rinv, int gw, int NGW, int lane) {
    f32x4 nx[8];
    if (gw < 16384) {
#pragma unroll
        for (int j = 0; j < 8; ++j) nx[j] = __builtin_nontemporal_load((const GAS f32x4*)(src + (size_t)gw * 2048 + j * 256 + lane * 4)); }
    for (int e = gw; e < 16384; e += NGW) {
        f32x4 v[8]; float am = 0.f;
#pragma unroll
        for (int j = 0; j < 8; ++j) { v[j] = nx[j]; am = fmaxf(am, fmaxf(fmaxf(fabsf(v[j].x), fabsf(v[j].y)), fmaxf(fabsf(v[j].z), fabsf(v[j].w)))); }
        if (e + NGW < 16384) {
#pragma unroll
            for (int j = 0; j < 8; ++j) nx[j] = __builtin_nontemporal_load((const GAS f32x4*)(src + (size_t)(e + NGW) * 2048 + j * 256 + lane * 4)); }
#pragma unroll
        for (int o = 1; o < 64; o <<= 1) am = fmaxf(am, __shfl_xor(am, o));
        const float sc = (am > 0.f) ? exp2f(floorf(log2f(224.f / am))) : 1.f;
        if (lane == 0) rinv[e] = 1.f / sc;
#pragma unroll
        for (int j = 0; j < 8; ++j) { unsigned p = __builtin_amdgcn_cvt_pk_fp8_f32(v[j].x * sc, v[j].y * sc, 0u, false); p = __builtin_amdgcn_cvt_pk_fp8_f32(v[j].z * sc, v[j].w * sc, p, true);
            const int w = lane & 31, pw = ((((w >> 2) & 1) * 4 + (w & 3)) << 2) + ((w >> 4) & 1) * 2 + ((w >> 3) & 1);
            *(GAS unsigned*)(dst + ((size_t)(2 * j + (lane >> 5)) * 16384 + e) * 128 + pw * 4) = p; }
    }
}
__device__ __forceinline__ unsigned pack_i8x4(f32x4 v, float sc) { const int a = __float2int_rn(v.x * sc), b = __float2int_rn(v.y * sc), c = __float2int_rn(v.z * sc), d = __float2int_rn(v.w * sc);
    return (unsigned)(a & 0xFF) | ((unsigned)(b & 0xFF) << 8) | ((unsigned)(c & 0xFF) << 16) | ((unsigned)d << 24); }
__device__ __forceinline__ void cvt_peer_table_i8(const float* src, unsigned char* dst, float* rinv, int gw, int NGW, int lane) {
    f32x4 nx[8];
    if (gw < 16384) {
#pragma unroll
        for (int j = 0; j < 8; ++j) nx[j] = __builtin_nontemporal_load((const GAS f32x4*)(src + (size_t)gw * 2048 + j * 256 + lane * 4)); }
    for (int e = gw; e < 16384; e += NGW) {
        f32x4 v[8]; float am = 0.f;
#pragma unroll
        for (int j = 0; j < 8; ++j) { v[j] = nx[j]; am = fmaxf(am, fmaxf(fmaxf(fabsf(v[j].x), fabsf(v[j].y)), fmaxf(fabsf(v[j].z), fabsf(v[j].w)))); }
        if (e + NGW < 16384) {
#pragma unroll
            for (int j = 0; j < 8; ++j) nx[j] = __builtin_nontemporal_load((const GAS f32x4*)(src + (size_t)(e + NGW) * 2048 + j * 256 + lane * 4)); }
#pragma unroll
        for (int o = 1; o < 64; o <<= 1) am = fmaxf(am, __shfl_xor(am, o));
        const float sc = (am > 0.f) ? 127.f / am : 0.f;
        if (lane == 0) rinv[e] = am * (1.f / 127.f);
#pragma unroll
        for (int j = 0; j < 8; ++j) *(GAS unsigned*)(dst + ((size_t)(2 * j + (lane >> 5)) * 16384 + e) * 128 + (lane & 31) * 4) = pack_i8x4(v[j], sc);
    }
}
__device__ __forceinline__ const float* xrow_in(const Args& a, int r) { return r < 8192 ? a.in[0] + (size_t)r * 2048 : a.in[1] + (size_t)(r - 8192) * 2048; }

__device__ __forceinline__ void phase_prologue(const Args& a, LAS unsigned char* lds, int vcu, int G, int wave, int lane) {
    unsigned char* ws = a.ws;
    LAS float* scr = (LAS float*)(lds + wave * 16384);
    const int gw = vcu * NWAVES + wave, NGW = G * NWAVES;
    for (int it = gw; it < 32 * 192; it += NGW) p0_transpose_item(a.in[5], 2048, 6160, 6144, (bf16*)(ws + a.L.wina), scr, it, lane);
    __syncthreads();
    { LAS f32x4* wg = (LAS f32x4*)lds; const float* w = a.in[5];
      for (int i = threadIdx.x; i < 2048 * 4; i += NWAVES * 64) { const int k = i >> 2, q4 = i & 3; wg[(k >> 2) * 16 + ((((k & 3) * 4 + q4)) ^ ((k >> 2) & 15))] = *(const GAS f32x4*)(w + (size_t)k * 6160 + 6144 + q4 * 4); } }
    __syncthreads();
    const float* bg = a.in[6];
    for (int r = gw; r < NTOKF; r += NGW) {
        const float* xr = xrow_in(a, r);
        GAS unsigned long long* o8 = (GAS unsigned long long*)((bf16*)(ws + a.L.xb) + (size_t)r * 2048) + lane;
        float g[16];
#pragma unroll
        for (int q = 0; q < 16; ++q) g[q] = 0.f;
#pragma unroll 1
        for (int j = 0; j < 8; ++j) {
            const f32x4 xv = *(const GAS f32x4*)(xr + j * 256 + lane * 4);
            o8[64 * j] = (unsigned long long)pk2(xv.x, xv.y) | ((unsigned long long)pk2(xv.z, xv.w) << 32);
            const int kq = j * 64 + lane;
#pragma unroll
            for (int e = 0; e < 4; ++e) { const float x = xv[e];
#pragma unroll
                for (int q4 = 0; q4 < 4; ++q4) { const f32x4 w4 = ((const LAS f32x4*)lds)[kq * 16 + ((e * 4 + q4) ^ (kq & 15))]; g[q4 * 4 + 0] += x * w4.x; g[q4 * 4 + 1] += x * w4.y; g[q4 * 4 + 2] += x * w4.z; g[q4 * 4 + 3] += x * w4.w; } }
        }
        float mine = 0.f;
#pragma unroll
        for (int q = 0; q < 16; ++q) { const float s = wave_sum_f(g[q]); if (lane == q) mine = s; }
        if (lane < 16) { float v = mine + bg[lane]; if (lane >= 8) v = fminf(v, 0.f) - log1pf(expf(-fabsf(v))); ((float*)(ws + a.L.gates))[(size_t)r * 16 + lane] = v; }
    }
    __syncthreads();
}

__device__ __forceinline__ void side_convert(const Args& a, LAS unsigned char* lds, int gw, int NGW, int wave, int lane, int parts) {
    unsigned char* ws = a.ws;
    LAS float* scr = (LAS float*)(lds + wave * 16384);
    constexpr int I_OA = 32 * 64, I_B = 32 * 384, I_OB = 96 * 64, I_Q = 32 * 64;
    constexpr int NITEMS = I_OA + I_B + I_OB + 2 * I_Q;
    if (parts & 1) for (int it = gw; it < NITEMS; it += NGW) {
        int r = it;
        if (r < I_OA) { p0_transpose_item(a.in[8], 2048, 2048, 2048, (bf16*)(ws + a.L.wouta), scr, r, lane); continue; } r -= I_OA;
        if (r < I_B) { p0_transpose_item(a.in[9], 2048, 12288, 12288, (bf16*)(ws + a.L.winb), scr, r, lane); continue; } r -= I_B;
        if (r < I_OB) { p0_transpose_item(a.in[15], 6144, 2048, 2048, (bf16*)(ws + a.L.woutb), scr, r, lane); continue; } r -= I_OB;
        if (r < I_Q) { p0_transpose_item(a.in[20], 2048, 2048, 2048, (bf16*)(ws + a.L.wq), scr, r, lane); continue; } r -= I_Q;
        p0_transpose_item(a.in[20] + (size_t)2048 * 2048, 2048, 2048, 2048, (bf16*)(ws + a.L.wq) + (size_t)2048 * 2048, scr, r, lane);
    }
    if (parts & 2) { float* ri = (float*)(ws + a.L.rinv);
      cvt_peer_table_i8(a.in[22], ws + a.L.ptu, ri, gw, NGW, lane);
      cvt_peer_table_fp8(a.in[23], ws + a.L.ptv, ri + 16384, gw, NGW, lane);
      cvt_peer_table_i8(a.in[22] + (size_t)16384 * 2048, ws + a.L.ptu1, ri + 32768, gw, NGW, lane);
      cvt_peer_table_fp8(a.in[23] + (size_t)16384 * 2048, ws + a.L.ptv1, ri + 49152, gw, NGW, lane); }
    cvt_stream(a.in[21], (bf16*)(ws + a.L.sk), (size_t)2 * 16 * 128 * 128 / 8, gw, NGW, lane);
    { bf16* wsb = (bf16*)(ws + a.L.wsb); const float* wsf = a.in[13]; for (int i = gw * 64 + lane; i < 8 * 128 * 128; i += NGW * 64) { const int t = (i >> 7) & 127, s = i & 127; wsb[i] = (bf16)(s <= t ? f2bf(wsf[i]) : 0u); } }
    { float* vst = (float*)(ws + a.L.vst); for (int i = gw * 64 + lane; i < NTOKF * 2; i += NGW * 64) vst[i] = 0.f; }
}

template <bool ZBF>
__device__ __forceinline__ void phase_ln(const float* Z, const float* g, const float* b, float* Xf, bf16* Xb, unsigned char* Xq, float* sx, int vcu, int G, int wave, int lane) {
    const int gw = vcu * NWAVES + wave, NGW = G * NWAVES;
    f32x4 gv[8], bv[8];
#pragma unroll
    for (int j = 0; j < 8; ++j) { gv[j] = *(const GAS f32x4*)(g + j * 256 + lane * 4); bv[j] = *(const GAS f32x4*)(b + j * 256 + lane * 4); }
    for (int r = gw; r < NTOKF; r += NGW) {
        const float* zr = Z + (size_t)r * 2048;
        f32x4 v[8]; float s = 0.f;
#pragma unroll
        for (int j = 0; j < 8; ++j) {
            if (ZBF) { const unsigned long long q = *((const GAS unsigned long long*)((const bf16*)Z + (size_t)r * 2048) + 64 * j + lane); const unsigned lo = (unsigned)q, hi = (unsigned)(q >> 32);
                v[j] = (f32x4){__builtin_bit_cast(float, lo << 16), __builtin_bit_cast(float, lo & 0xffff0000u), __builtin_bit_cast(float, hi << 16), __builtin_bit_cast(float, hi & 0xffff0000u)}; }
            else v[j] = *(const GAS f32x4*)(zr + j * 256 + lane * 4);
            s += (v[j].x + v[j].y) + (v[j].z + v[j].w); }
        const float mean = wave_sum_f(s) * (1.f / 2048.f); float s2 = 0.f;
#pragma unroll
        for (int j = 0; j < 8; ++j) { v[j] = v[j] - mean; s2 += (v[j].x * v[j].x + v[j].y * v[j].y) + (v[j].z * v[j].z + v[j].w * v[j].w); }
        const float rstd = 1.f / sqrtf(wave_sum_f(s2) * (1.f / 2048.f) + 1e-5f);
#pragma unroll
        for (int j = 0; j < 8; ++j) { v[j] = v[j] * rstd * gv[j] + bv[j]; if (Xf) *(GAS f32x4*)(Xf + (size_t)r * 2048 + j * 256 + lane * 4) = v[j]; }
        if (Xq) {
            float am = 0.f;
#pragma unroll
            for (int j = 0; j < 8; ++j) am = fmaxf(am, fmaxf(fmaxf(fabsf(v[j].x), fabsf(v[j].y)), fmaxf(fabsf(v[j].z), fabsf(v[j].w))));
#pragma unroll
            for (int o = 1; o < 64; o <<= 1) am = fmaxf(am, __shfl_xor(am, o));
            const float sc = (am > 0.f) ? 127.f / am : 0.f;
            if (lane == 0) sx[r] = am * (1.f / 127.f);
#pragma unroll
            for (int j = 0; j < 8; ++j) *(GAS unsigned*)(Xq + (size_t)r * 2048 + j * 256 + lane * 4) = pack_i8x4(v[j], sc);
        }
        if (Xb) { GAS unsigned long long* o8 = (GAS unsigned long long*)(Xb + (size_t)r * 2048) + lane;
#pragma unroll
            for (int j = 0; j < 8; ++j) o8[64 * j] = (unsigned long long)pk2(v[j].x, v[j].y) | ((unsigned long long)pk2(v[j].z, v[j].w) << 32); }
    }
}
typedef __bf16 bf16x2_t __attribute__((ext_vector_type(2)));
typedef int i32x4 __attribute__((ext_vector_type(4)));
__device__ __forceinline__ unsigned fkey(float f) { const unsigned u = __builtin_bit_cast(unsigned, f); return (u & 0x80000000u) ? ~u : (u | 0x80000000u); }
__device__ __forceinline__ float keyf(unsigned k) { const unsigned u = (k & 0x80000000u) ? (k & 0x7fffffffu) : ~k; return __builtin_bit_cast(float, u); }
__device__ __forceinline__ float dot2bf(unsigned a, unsigned b, float c) { return __builtin_amdgcn_fdot2_f32_bf16(__builtin_bit_cast(bf16x2_t, a), __builtin_bit_cast(bf16x2_t, b), c, false); }
__device__ __forceinline__ float bflo(unsigned w) { return __builtin_bit_cast(float, w << 16); }
__device__ __forceinline__ float bfhi(unsigned w) { return __builtin_bit_cast(float, w & 0xffff0000u); }
__device__ __forceinline__ float gelu_tanh_g(float x) { const float u = x + 0.044715f * x * x * x; const float e = __builtin_amdgcn_exp2f(u * -2.302208198f); return x * __builtin_amdgcn_rcpf(1.0f + e); }
#define INS16(v, x) do { unsigned nw_ = (x); _Pragma("unroll") for (int k_ = 0; k_ < 16; ++k_) { const unsigned hi_ = max(v[k_], nw_); nw_ = min(v[k_], nw_); v[k_] = hi_; } } while (0)


#define CE_DESC(a, b) do { const unsigned hi_ = max(a, b), lo_ = min(a, b); a = hi_; b = lo_; } while (0)
__device__ __forceinline__ void sort16_desc(unsigned (&v)[16]) {
#pragma unroll
    for (int k = 2; k <= 16; k <<= 1)
#pragma unroll
        for (int j = k >> 1; j > 0; j >>= 1)
#pragma unroll
            for (int i = 0; i < 16; ++i) { const int l = i ^ j; if (l > i) { if ((i & k) == 0) CE_DESC(v[i], v[l]); else CE_DESC(v[l], v[i]); } }
}
__device__ __forceinline__ void merge_top16(unsigned (&a)[16], const unsigned (&b)[16]) {
#pragma unroll
    for (int i = 0; i < 16; ++i) a[i] = max(a[i], b[15 - i]);
#pragma unroll
    for (int sd = 8; sd >= 1; sd >>= 1)
#pragma unroll
        for (int i = 0; i < 16; ++i) if ((i & sd) == 0) CE_DESC(a[i], a[i + sd]);
}
static __device__ const unsigned char CAND_TAB[52] = {
    0, 1, 2, 3, 4, 5, 6, 7, 8, 9, 10, 11, 12, 13, 14, 15,
    16, 17, 18, 19, 20, 21, 22, 23,
    32, 33, 34, 35, 36,
    48, 49, 50, 51,
    64, 65, 66,
    80, 81,
    96, 97,
    112, 113,
    128, 144, 160, 176, 192, 208, 224, 240,
    255, 255 };

template <int MODE>
__device__ __forceinline__ void phase_topk(const bf16* QP, const bf16* SK, int* IDX, float* GT, float* AACC, float* SU, const float* rinvU, const float* rinvV, LAS unsigned char* lds, int vcu, int G, int wave, int lane) {
    LAS float* S = (LAS float*)lds;
    LAS unsigned char* NL = lds + 2 * 64 * 132 * 4;
    LAS float* FL = (LAS float*)(NL + 512 * 32);
    const int tid = wave * 64 + lane;
    for (int u = vcu; u < 136 * 8; u += G) {
        const int tt = u >> 3, h = u & 7;
        if (MODE != 1) {
            const int p = wave >> 2, rt = wave & 3, fr = lane & 15, fq = lane >> 4;
            const bf16* qrow = QP + (size_t)(tt * 64 + rt * 16 + fr) * 2048 + h * 256 + p * 128 + 8 * fq;
            bf16x8 af[4];
#pragma unroll
            for (int ks = 0; ks < 4; ++ks) af[ks] = *(const GAS bf16x8*)(qrow + ks * 32);
            const bf16* kbase = SK + (size_t)((h * 2 + p) * 128 + fr) * 128 + 8 * fq;
#pragma unroll 4
            for (int nt = 0; nt < 8; ++nt) {
                bf16x8 bfr[4];
#pragma unroll
                for (int ks = 0; ks < 4; ++ks) bfr[ks] = *(const GAS bf16x8*)(kbase + (size_t)nt * 16 * 128 + ks * 32);
                f32x4 acc = (f32x4){0.f, 0.f, 0.f, 0.f};
#pragma unroll
                for (int ks = 0; ks < 4; ++ks) acc = __builtin_amdgcn_mfma_f32_16x16x32_bf16(af[ks], bfr[ks], acc, 0, 0, 0);
                LAS float* sp = S + (size_t)(p * 64 + rt * 16 + fq * 4) * 132 + nt * 16 + fr;
                sp[0] = acc[0]; sp[132] = acc[1]; sp[264] = acc[2]; sp[396] = acc[3];
            }
        }
        __syncthreads();
        if (MODE != 2) {
            const int tl = lane >> 3, p = (lane >> 2) & 1, qr = lane & 3, t = wave * 8 + tl;
            unsigned own[16], oth_[16];
            const LAS f32x4* sp = (const LAS f32x4*)(S + (size_t)(p * 64 + t) * 132 + qr * 32);
#pragma unroll
            for (int c = 0; c < 4; ++c) { const f32x4 v = sp[c], w = sp[4 + c];
#pragma unroll
                for (int e = 0; e < 4; ++e) { own[c * 4 + e] = (fkey(v[e]) & ~127u) | (unsigned)(127 - (qr * 32 + c * 4 + e)); oth_[c * 4 + e] = (fkey(w[e]) & ~127u) | (unsigned)(127 - (qr * 32 + 16 + c * 4 + e)); } }
            sort16_desc(own); sort16_desc(oth_); merge_top16(own, oth_);
#pragma unroll
            for (int st = 1; st <= 2; st <<= 1) {
#pragma unroll
                for (int i = 0; i < 16; ++i) oth_[i] = (unsigned)__shfl_xor((int)own[i], st);
                merge_top16(own, oth_);
            }
            LAS unsigned char* nl = NL + tid * 32;
            LAS float* fl = FL + (tid >> 2) * 32;
#pragma unroll
            for (int i = 0; i < 16; ++i) { const unsigned oth = (unsigned)__shfl_xor((int)own[i], 4); const unsigned a0 = p ? oth : own[i], a1 = p ? own[i] : oth;
                if (qr == 0) { fl[i] = keyf(a0 & ~127u); fl[16 + i] = keyf(a1 & ~127u); }
                nl[i] = (unsigned char)(127u - (a0 & 127u)); nl[16 + i] = (unsigned char)(127u - (a1 & 127u)); }
            unsigned tv[16];
#pragma unroll
            for (int k = 0; k < 16; ++k) tv[k] = 0u;
#pragma unroll
            for (int m = 0; m < 13; ++m) { const unsigned c = CAND_TAB[m * 4 + qr]; unsigned key = 0u;
                if (c != 255u) { const float s = fl[c >> 4] + fl[16 + (c & 15u)]; key = (fkey(s) & ~255u) | (255u - c); }
                INS16(tv, key); }
#pragma unroll
            for (int st = 1; st <= 2; st <<= 1) {
#pragma unroll
                for (int i = 0; i < 16; ++i) oth_[i] = (unsigned)__shfl_xor((int)tv[i], st);
                merge_top16(tv, oth_);
            }
            float ev[16]; int ex[16]; float sum = 0.f; const float mx = keyf(tv[0] & ~255u);
#pragma unroll
            for (int k = 0; k < 16; ++k) { const unsigned c = 255u - (tv[k] & 255u); const int i = (int)(c >> 4), j = (int)(c & 15u);
                ex[k] = (int)nl[i] * 128 + (int)nl[16 + j]; ev[k] = __expf(keyf(tv[k] & ~255u) - mx); sum += ev[k]; }
            const float inv = 1.f / sum;
            if (MODE == 3) { if (ex[0] == 0x7fffffff) IDX[0] = (int)inv; }
            else if (p == 0 && qr == 0) {
                const size_t o = (size_t)(tt * 64 + t) * 128 + h * 16;
#pragma unroll
                for (int k4 = 0; k4 < 4; ++k4) { *(GAS i32x4*)(IDX + o + k4 * 4) = (i32x4){ex[k4 * 4], ex[k4 * 4 + 1], ex[k4 * 4 + 2], ex[k4 * 4 + 3]};
                    *(GAS f32x4*)(GT + o + k4 * 4) = (f32x4){ev[k4 * 4] * inv, ev[k4 * 4 + 1] * inv, ev[k4 * 4 + 2] * inv, ev[k4 * 4 + 3] * inv};
                    *(GAS f32x4*)(AACC + o + k4 * 4) = (f32x4){0.f, 0.f, 0.f, 0.f}; }
            }
        }
        __syncthreads();
    }
}

__device__ __forceinline__ void phase_upass(const bf16* U, const bf16* XBt, const int* IDX, const float* GT, float* WW, int vcu, int G, int wave, int lane) {
    const int gw = vcu * NWAVES + wave, NGW = G * NWAVES;
    for (int t = gw; t < NTOKF; t += NGW) {
        v4u xq[4];
#pragma unroll
        for (int j = 0; j < 4; ++j) xq[j] = *(const GAS v4u*)(XBt + (size_t)t * 2048 + j * 512 + lane * 8);
        const int ilo = IDX[(size_t)t * 128 + lane], ihi = IDX[(size_t)t * 128 + 64 + lane];
        float wlo = 0.f, whi = 0.f;
#pragma unroll 1
        for (int e0 = 0; e0 < 128; e0 += 4) {
            v4u uq[4][4];
#pragma unroll
            for (int ee = 0; ee < 4; ++ee) { const int e = e0 + ee; const int id = __builtin_amdgcn_readlane(e0 < 64 ? ilo : ihi, e & 63);
                const bf16* ur = U + (size_t)id * 2048 + lane * 8;
#pragma unroll
                for (int j = 0; j < 4; ++j) uq[ee][j] = *(const GAS v4u*)(ur + j * 512); }
#pragma unroll
            for (int ee = 0; ee < 4; ++ee) { float acc = 0.f;
#pragma unroll
                for (int j = 0; j < 4; ++j) { acc = dot2bf(uq[ee][j].x, xq[j].x, acc); acc = dot2bf(uq[ee][j].y, xq[j].y, acc); acc = dot2bf(uq[ee][j].z, xq[j].z, acc); acc = dot2bf(uq[ee][j].w, xq[j].w, acc); }
                acc = wave_sum_f(acc);
                const int e = e0 + ee;
                if (lane == (e & 63)) { if (e0 < 64) wlo = acc; else whi = acc; } }
        }
        WW[(size_t)t * 128 + lane] = gelu_tanh_g(wlo) * GT[(size_t)t * 128 + lane];
        WW[(size_t)t * 128 + 64 + lane] = gelu_tanh_g(whi) * GT[(size_t)t * 128 + 64 + lane];
    }
}

__device__ __forceinline__ void phase_vpass(const bf16* V, const float* Xf, const int* IDX, const float* WW, float* Z, float alpha, int vcu, int G, int wave, int lane) {
    const int gw = vcu * NWAVES + wave, NGW = G * NWAVES;
    for (int t = gw; t < NTOKF; t += NGW) {
        f32x4 acc[4][2];
#pragma unroll
        for (int j = 0; j < 4; ++j)
#pragma unroll
            for (int q = 0; q < 2; ++q) acc[j][q] = *(const GAS f32x4*)(Xf + (size_t)t * 2048 + j * 512 + lane * 8 + q * 4) * alpha;
        const int ilo = IDX[(size_t)t * 128 + lane], ihi = IDX[(size_t)t * 128 + 64 + lane];
        const float wlo = WW[(size_t)t * 128 + lane], whi = WW[(size_t)t * 128 + 64 + lane];
#pragma unroll 1
        for (int e0 = 0; e0 < 128; e0 += 4) {
            v4u vq[4][4]; float wv[4];
#pragma unroll
            for (int ee = 0; ee < 4; ++ee) { const int e = e0 + ee; const int id = __builtin_amdgcn_readlane(e0 < 64 ? ilo : ihi, e & 63);
                wv[ee] = __builtin_bit_cast(float, __builtin_amdgcn_readlane(__builtin_bit_cast(int, e0 < 64 ? wlo : whi), e & 63));
                const bf16* vr = V + (size_t)id * 2048 + lane * 8;
#pragma unroll
                for (int j = 0; j < 4; ++j) vq[ee][j] = *(const GAS v4u*)(vr + j * 512); }
#pragma unroll
            for (int ee = 0; ee < 4; ++ee)
#pragma unroll
                for (int j = 0; j < 4; ++j) { const v4u q = vq[ee][j]; const float w = wv[ee];
                    acc[j][0].x += w * bflo(q.x); acc[j][0].y += w * bfhi(q.x); acc[j][0].z += w * bflo(q.y); acc[j][0].w += w * bfhi(q.y);
                    acc[j][1].x += w * bflo(q.z); acc[j][1].y += w * bfhi(q.z); acc[j][1].z += w * bflo(q.w); acc[j][1].w += w * bfhi(q.w); }
        }
#pragma unroll
        for (int j = 0; j < 4; ++j)
#pragma unroll
            for (int q = 0; q < 2; ++q) *(GAS f32x4*)(Z + (size_t)t * 2048 + j * 512 + lane * 8 + q * 4) = acc[j][q];
    }
}

struct XTopo { int xi, nx, wq, nwq; };
__device__ __forceinline__ XTopo xcd_topology(unsigned* bar, unsigned x, unsigned rank, int wave) {
    XTopo t; int xi = 0, nx = 0, nloc = 1;
#pragma unroll
    for (unsigned j = 0; j < 16; ++j) { const unsigned c = xb_ld(&bar[XB_XCNT(j)]); if (c > 0u) { if (j < x) ++xi; ++nx; } if (j == x) nloc = (int)c; }
    if (nloc < 1) nloc = 1; if (nx < 1) nx = 1;
    t.xi = __builtin_amdgcn_readfirstlane(xi); t.nx = __builtin_amdgcn_readfirstlane(nx); t.wq = __builtin_amdgcn_readfirstlane((int)rank * NWAVES + wave); t.nwq = __builtin_amdgcn_readfirstlane(nloc * NWAVES); return t;
}
typedef float f32x2 __attribute__((ext_vector_type(2)));
template <int MODE>
__device__ __forceinline__ void upass_reduce_add(float (&acc)[16], float* ap, int lane) {
    const bool b2 = (lane & 4) != 0, b1 = (lane & 2) != 0, b0 = (lane & 1) != 0;
    float r8[8], r4[4], r2[2];
#pragma unroll
    for (int j = 0; j < 8; ++j) { const float keep = b2 ? acc[8 + j] : acc[j], send = b2 ? acc[j] : acc[8 + j]; r8[j] = keep + __shfl_xor(send, 4); }
#pragma unroll
    for (int j = 0; j < 4; ++j) { const float keep = b1 ? r8[4 + j] : r8[j], send = b1 ? r8[j] : r8[4 + j]; r4[j] = keep + __shfl_xor(send, 2); }
#pragma unroll
    for (int j = 0; j < 2; ++j) { const float keep = b0 ? r4[2 + j] : r4[j], send = b0 ? r4[j] : r4[2 + j]; r2[j] = keep + __shfl_xor(send, 1); }
    if (MODE == 1) { ap[0] = r2[0]; ap[64] = r2[1]; } else { unsafeAtomicAdd(ap, r2[0]); unsafeAtomicAdd(ap + 64, r2[1]); }
}
__device__ __forceinline__ float dot16_i8(const v4u q, const v4u x) {
    int a = __builtin_amdgcn_sdot4((int)q.x, (int)x.x, 0, false); a = __builtin_amdgcn_sdot4((int)q.y, (int)x.y, a, false);
    a = __builtin_amdgcn_sdot4((int)q.z, (int)x.z, a, false); a = __builtin_amdgcn_sdot4((int)q.w, (int)x.w, a, false);
    return (float)a;
}
__device__ __forceinline__ void unpack16bf(const v4u a, const v4u b, float (&xf)[16]) {
    xf[0] = bflo(a.x); xf[1] = bfhi(a.x); xf[2] = bflo(a.y); xf[3] = bfhi(a.y); xf[4] = bflo(a.z); xf[5] = bfhi(a.z); xf[6] = bflo(a.w); xf[7] = bfhi(a.w);
    xf[8] = bflo(b.x); xf[9] = bfhi(b.x); xf[10] = bflo(b.y); xf[11] = bfhi(b.y); xf[12] = bflo(b.z); xf[13] = bfhi(b.z); xf[14] = bflo(b.w); xf[15] = bfhi(b.w);
}
template <int MODE>
__device__ __forceinline__ void phase_upass_sl(const unsigned char* U, const unsigned char* XQ, const float* SX, const int* IDX, float* AACC, float* GT, float* SU, const float* rinvU, const float* rinvV, const XTopo tp, int lane0) {
#define UP_IDX(dst, tt) do { const int t_ = min((tt), NTOKF - 1); const int* ip_ = IDX + (size_t)t_ * 128 + (lane >> 3) * 8; dst[0] = *(const GAS i32x4*)ip_; dst[1] = *(const GAS i32x4*)(ip_ + 4); dst[2] = *(const GAS i32x4*)(ip_ + 64); dst[3] = *(const GAS i32x4*)(ip_ + 68); } while (0)
#define UP_SEL(id, s_) id[2 * ((s_) & 1) + ((s_) >> 3)][((s_) >> 1) & 3]
#define UP_GATHER8(dst, id, h) do { _Pragma("unroll") for (int j_ = 0; j_ < 8; ++j_) { if (MODE == 2) dst[j_] = (v4u){(unsigned)UP_SEL(id, 8 * (h) + j_), 0x38383838u, 0x38383838u, 0x38383838u}; else dst[j_] = __builtin_bit_cast(v4u, __builtin_amdgcn_raw_buffer_load_b128(urs, (UP_SEL(id, 8 * (h) + j_) << 7) + i * 16, 0, 0)); } } while (0)
#define UP_X(xa, xb, tt) do { const int t_ = min((tt), NTOKF - 1); xa = *(const GAS v4u*)(XQ + (size_t)t_ * 2048 + sl * 128 + (lane & 7) * 16); xb.x = __builtin_bit_cast(unsigned, SX[t_]); } while (0)
    for (int sl = tp.xi; sl < 16; sl += tp.nx) {
        int lane = lane0; asm volatile("" : "+v"(lane));
        const int g = lane >> 3, i = lane & 7;
        const __amdgpu_buffer_rsrc_t urs = __builtin_amdgcn_make_buffer_rsrc((void*)(U + (size_t)sl * 16384 * 128), 0, 16384 * 128, 0x00020000);
        i32x4 idn[4]; v4u qa[8], qb[8], xa, xb;
        UP_IDX(idn, tp.wq); UP_GATHER8(qa, idn, 0); UP_GATHER8(qb, idn, 1); UP_X(xa, xb, tp.wq); UP_IDX(idn, tp.wq + tp.nwq);
#pragma unroll 1
        for (int t = tp.wq; t < NTOKF; t += tp.nwq) {
            float acc[16]; const v4u xq_ = xa; const float sx_ = __builtin_bit_cast(float, xb.x);
#pragma unroll
            for (int j = 0; j < 8; ++j) acc[j] = dot16_i8(qa[j], xq_) * sx_;
            UP_GATHER8(qa, idn, 0);
#pragma unroll
            for (int j = 0; j < 8; ++j) acc[8 + j] = dot16_i8(qb[j], xq_) * sx_;
            UP_GATHER8(qb, idn, 1);
            UP_X(xa, xb, t + tp.nwq); UP_IDX(idn, t + 2 * tp.nwq);
            upass_reduce_add<MODE>(acc, AACC + (size_t)t * 128 + lane, lane);
            if (MODE == 0 && sl == tp.xi && ((t >> 8) % tp.nx) == tp.xi) {
                const size_t o_ = (size_t)t * 128 + lane; const int e0_ = IDX[o_], e1_ = IDX[o_ + 64];
                SU[o_] = rinvU[e0_]; SU[o_ + 64] = rinvU[e1_]; GT[o_] *= rinvV[e0_]; GT[o_ + 64] *= rinvV[e1_]; }
        }
    }
#undef UP_IDX
#undef UP_SEL
#undef UP_GATHER8
#undef UP_X
}
__device__ __forceinline__ void vpass_finish(const v4u (&vq)[16], const LAS float* wl, const float* Xf, float* Z, float alpha, int t, int sl, int lane) {
    const int g = lane >> 3, i = lane & 7;
    f32x4 w4[4];
#pragma unroll
    for (int q = 0; q < 4; ++q) w4[q] = *(const LAS f32x4*)(wl + g * 16 + q * 4);
    float acc[16];
#pragma unroll
    for (int c = 0; c < 16; ++c) acc[c] = 0.f;
#pragma unroll
    for (int j = 0; j < 16; ++j) { const float w = w4[j >> 2][j & 3]; const unsigned wd[4] = {vq[j].x, vq[j].y, vq[j].z, vq[j].w};
#pragma unroll
        for (int d = 0; d < 4; ++d) { const f32x2 lo = __builtin_amdgcn_cvt_pk_f32_fp8(wd[d], false), hi = __builtin_amdgcn_cvt_pk_f32_fp8(wd[d], true);
            acc[d * 4 + 0] += w * lo.x; acc[d * 4 + 1] += w * lo.y; acc[d * 4 + 2] += w * hi.x; acc[d * 4 + 3] += w * hi.y; } }
    const bool b3 = (lane & 8) != 0, b4 = (lane & 16) != 0, b5 = (lane & 32) != 0;
    float r8[8], r4[4], r2[2];
#pragma unroll
    for (int c = 0; c < 8; ++c) { const float keep = b3 ? acc[8 + c] : acc[c], send = b3 ? acc[c] : acc[8 + c]; r8[c] = keep + __shfl_xor(send, 8); }
#pragma unroll
    for (int c = 0; c < 4; ++c) { const float keep = b4 ? r8[4 + c] : r8[c], send = b4 ? r8[c] : r8[4 + c]; r4[c] = keep + __shfl_xor(send, 16); }
#pragma unroll
    for (int c = 0; c < 2; ++c) { const float keep = b5 ? r4[2 + c] : r4[c], send = b5 ? r4[c] : r4[2 + c]; r2[c] = keep + __shfl_xor(send, 32); }
    const int col = sl * 128 + i * 16 + (b3 ? 8 : 0) + (b4 ? 4 : 0) + (b5 ? 2 : 0);
    const f32x2 xr = *(const GAS f32x2*)(Xf + (size_t)t * 2048 + col);
    *(GAS f32x2*)(Z + (size_t)t * 2048 + col) = (f32x2){alpha * xr.x + r2[0], alpha * xr.y + r2[1]};
}
__device__ __forceinline__ int wave_max_bits(int x) {
    x = max(x, __builtin_amdgcn_update_dpp(x, x, 0x111, 0xf, 0xf, false));
    x = max(x, __builtin_amdgcn_update_dpp(x, x, 0x112, 0xf, 0xf, false));
    x = max(x, __builtin_amdgcn_update_dpp(x, x, 0x114, 0xf, 0xf, false));
    x = max(x, __builtin_amdgcn_update_dpp(x, x, 0x118, 0xf, 0xf, false));
    x = max(x, __builtin_amdgcn_update_dpp(x, x, 0x142, 0xa, 0xf, false));
    x = max(x, __builtin_amdgcn_update_dpp(x, x, 0x143, 0xc, 0xf, false));
    return __builtin_amdgcn_readlane(x, 63);
}
typedef unsigned u32x2v __attribute__((ext_vector_type(2)));
template <int MODE>
__device__ __forceinline__ void vpass_step(const v4u (&cur)[16], v4u (&nxt)[16], const i32x4 (&idin)[4], i32x4 (&idout)[4], const float (&scc)[6], float (&scn)[6], const u32x2v xr, u32x2v& xrn, const __amdgpu_buffer_rsrc_t vrs,
                                           const bf16* Xf, const int* IDX, const float* AACC, const float* SU, const float* GT, bf16* Z, float alpha, LAS float* wl, int t, int tn, int tnn, int sl, int lane0, bool live = true) {
    int lane = lane0; asm volatile("" : "+v"(lane));
    const int g = lane >> 3, i = lane & 7;
#pragma unroll
    for (int q = 0; q < 4; ++q) idout[q] = *(const GAS i32x4*)(IDX + (size_t)tnn * 128 + g * 16 + q * 4);
    if (MODE == 7) { scn[0] = 0.5f; scn[1] = 0.25f; scn[2] = 1.f; scn[3] = 1.f; scn[4] = (float)tn; scn[5] = 1.f; } else
    { const size_t o0 = (size_t)tn * 128 + lane; scn[0] = AACC[o0]; scn[1] = AACC[o0 + 64]; scn[2] = SU[o0]; scn[3] = SU[o0 + 64]; scn[4] = GT[o0]; scn[5] = GT[o0 + 64]; }
    const bool hv = (lane & 32) != 0, valid = (((lane >> 5) ^ (lane >> 3)) & 1) == 0;
    const int col = sl * 128 + (hv ? 64 : 0) + ((lane >> 4) & 1) * 32 + (i >> 2) * 16 + (i & 3) * 4;
    if (MODE != 3) xrn = *(const GAS u32x2v*)(Xf + (size_t)tn * 2048 + col);
    __builtin_amdgcn_sched_barrier(0);
#pragma unroll
    for (int j = 0; j < 16; ++j) { if (MODE == 1) nxt[j] = (v4u){(unsigned)idin[j >> 2][j & 3], 0x38383838u, 0x38383838u, 0x38383838u}; else nxt[j] = __builtin_bit_cast(v4u, __builtin_amdgcn_raw_buffer_load_b128(vrs, (idin[j >> 2][j & 3] << 7) + i * 16, 0, 0)); }
    __builtin_amdgcn_sched_barrier(0);
    const float w0 = gelu_tanh_g(scc[0] * scc[2]) * scc[4], w1 = gelu_tanh_g(scc[1] * scc[3]) * scc[5];
    const int e8 = max(wave_max_bits(__builtin_bit_cast(int, fmaxf(fabsf(w0), fabsf(w1)))) >> 23, 8);
    const float S = __builtin_bit_cast(float, (261 - e8) << 23), invS = __builtin_bit_cast(float, (e8 - 7) << 23);
    wl[lane] = w0 * S; wl[64 + lane] = w1 * S;
    if (MODE == 2) { unsigned s_ = 0u;
#pragma unroll
        for (int j = 0; j < 16; ++j) s_ += cur[j].x ^ cur[j].y ^ cur[j].z ^ cur[j].w;
        if (s_ == 0x12345u) Z[(size_t)t * 2048 + sl * 128 + lane] = 1; }
    else {
        f32x4 w4[4];
#pragma unroll
        for (int q = 0; q < 4; ++q) w4[q] = *(const LAS f32x4*)(wl + g * 16 + q * 4);
        const int p8 = (lane & 3) * 8;
        const unsigned selp = 0x0c0c0c0cu & ~(0xffu << p8);
        const unsigned selLo = (lane & 4) ? 0x0c0c0c0cu : selp, selHi = (lane & 4) ? selp : 0x0c0c0c0cu;
        f32x4 D1 = {0.f, 0.f, 0.f, 0.f}, D2 = {0.f, 0.f, 0.f, 0.f};
#pragma unroll
        for (int j = 0; j < 16; ++j) {
            const unsigned tb = (unsigned)__builtin_amdgcn_cvt_pk_fp8_f32(w4[j >> 2][j & 3], 0.f, 0, false);
            const unsigned alo = __builtin_amdgcn_perm(0u, tb, selLo), ahi = __builtin_amdgcn_perm(0u, tb, selHi);
            const long A = (long)(((unsigned long)ahi << 32) | (unsigned long)alo);
            const long B1 = (long)(((unsigned long)cur[j].y << 32) | (unsigned long)cur[j].x), B2 = (long)(((unsigned long)cur[j].w << 32) | (unsigned long)cur[j].z);
            D1 = __builtin_amdgcn_mfma_f32_16x16x32_fp8_fp8(A, B1, D1, 0, 0, 0);
            D2 = __builtin_amdgcn_mfma_f32_16x16x32_fp8_fp8(A, B2, D2, 0, 0, 0);
        }
        f32x4 o;
#pragma unroll
        for (int r = 0; r < 4; ++r) { const float snd = hv ? D1[r] : D2[r], own = hv ? D2[r] : D1[r]; const unsigned xw = (r & 2) ? xr.y : xr.x; const float xv = (r & 1) ? bfhi(xw) : bflo(xw); o[r] = alpha * xv + (own + __shfl_xor(snd, 40)) * invS; }
        u32x2v ob; ob.x = pk2(o[0], o[1]); ob.y = pk2(o[2], o[3]);
        if (MODE == 3 || MODE == 4) { if (o[0] + o[1] + o[2] + o[3] == 1.2345f) *(GAS u32x2v*)(Z + (size_t)t * 2048 + col) = ob; } else
        if (MODE == 6) { if (valid && live) *(GAS u32x2v*)(Z + (size_t)(t & 127) * 2048 + col) = ob; } else
        if (valid && live) *(GAS u32x2v*)(Z + (size_t)t * 2048 + col) = ob;
    }
}
template <int MODE>
__device__ __forceinline__ void phase_vpass_sl(const unsigned char* V, const bf16* Xf, const int* IDX, const float* AACC, const float* SU, const float* GT, bf16* Z, float alpha, const XTopo tp, LAS unsigned char* lds, int wave, int lane_in) {
    const int lane0 = lane_in;
    LAS float* wl = (LAS float*)lds + wave * 128;
    for (int sl = tp.xi; sl < 16; sl += tp.nx) {
        const __amdgpu_buffer_rsrc_t vrs = __builtin_amdgcn_make_buffer_rsrc((void*)(V + (size_t)sl * 16384 * 128), 0, 16384 * 128, 0x00020000);
        v4u vqA[16], vqB[16]; i32x4 idA[4], idB[4]; float scA[6], scB[6]; u32x2v xrA = {0u, 0u}, xrB = {0u, 0u};
        {   int lane = lane0; asm volatile("" : "+v"(lane));
            const int g = lane >> 3, i = lane & 7, t0 = tp.wq, t1 = min(tp.wq + tp.nwq, NTOKF - 1);
#pragma unroll
            for (int q = 0; q < 4; ++q) { idA[q] = *(const GAS i32x4*)(IDX + (size_t)t0 * 128 + g * 16 + q * 4); idB[q] = *(const GAS i32x4*)(IDX + (size_t)t1 * 128 + g * 16 + q * 4); }
            const size_t o0 = (size_t)t0 * 128 + lane; scA[0] = AACC[o0]; scA[1] = AACC[o0 + 64]; scA[2] = SU[o0]; scA[3] = SU[o0 + 64]; scA[4] = GT[o0]; scA[5] = GT[o0 + 64];
            if (MODE != 3) xrA = *(const GAS u32x2v*)(Xf + (size_t)t0 * 2048 + sl * 128 + ((lane & 32) ? 64 : 0) + ((lane >> 4) & 1) * 32 + (i >> 2) * 16 + (i & 3) * 4);
            __builtin_amdgcn_sched_barrier(0);
#pragma unroll
            for (int j = 0; j < 16; ++j) { if (MODE == 1) vqA[j] = (v4u){(unsigned)idA[j >> 2][j & 3], 0x38383838u, 0x38383838u, 0x38383838u}; else vqA[j] = __builtin_bit_cast(v4u, __builtin_amdgcn_raw_buffer_load_b128(vrs, (idA[j >> 2][j & 3] << 7) + i * 16, 0, 0)); }
        }
#pragma unroll 1
        for (int t = tp.wq; t < NTOKF; t += 2 * tp.nwq) {
            const int t1 = min(t + tp.nwq, NTOKF - 1), t2 = min(t + 2 * tp.nwq, NTOKF - 1), t3 = min(t + 3 * tp.nwq, NTOKF - 1);
            vpass_step<MODE>(vqA, vqB, idB, idA, scA, scB, xrA, xrB, vrs, Xf, IDX, AACC, SU, GT, Z, alpha, wl, t, t1, t2, sl, lane0);
            vpass_step<MODE>(vqB, vqA, idA, idB, scB, scA, xrB, xrA, vrs, Xf, IDX, AACC, SU, GT, Z, alpha, wl, t1, t2, t3, sl, lane0, t + tp.nwq < NTOKF);
        }
    }
}
typedef short s16x4 __attribute__((ext_vector_type(4)));
typedef unsigned u32x2 __attribute__((ext_vector_type(2)));
template <int MODE>
__device__ __forceinline__ void phase_spatial(const bf16* UB, const bf16* VB, const float* VST, const float* lng, const float* lnb, const bf16* WSB, const float* wsf, const float* bs,
                                              bf16* UM, float* vs_out, LAS unsigned char* lds, int vcu, int G, int wave, int lane) {
    constexpr int PITCH = 136;
    LAS bf16* T = (LAS bf16*)lds;
    LAS bf16* WS = (LAS bf16*)(lds + 128 * PITCH * 2);
    const int tid = wave * 64 + lane;
    const int nbg = G >> 3, g = (nbg > 0) ? vcu / nbg : 0, jb = (nbg > 0) ? vcu % nbg : 0;
    if (MODE != 1 && nbg > 0 && g < 8) {
        for (int i = tid; i < 128 * 16; i += 512) { const int t = i >> 4, ch = i & 15; *(LAS v4u*)(WS + t * 128 + ((ch ^ (t & 15)) << 3)) = *(const GAS v4u*)(WSB + (size_t)(g * 128 + t) * 128 + ch * 8); }
        const int s_ = tid >> 2, cq_ = (tid & 3) * 32;
        v4u pvq[4]; float ps1 = 1.f, ps2 = 2.f;
        if (MODE == 2) pvq[0] = pvq[1] = pvq[2] = pvq[3] = (v4u){0x3f803f80u, 0x3f803f80u, 0x3f803f80u, 0x3f803f80u};
        else if (jb < 384) { const int ck = jb / 6, cb = g * 6 + jb % 6; const size_t r = (size_t)ck * 128 + s_;
            ps1 = VST[r * 2]; ps2 = VST[r * 2 + 1];
#pragma unroll
            for (int i = 0; i < 4; ++i) pvq[i] = *(const GAS v4u*)(VB + r * 6144 + cb * 128 + cq_ + i * 8); }
        for (int u = jb; u < 384; u += nbg) {
            const int ck = u / 6, cb = g * 6 + u % 6;
            const size_t row0 = (size_t)ck * 128; const int col0 = cb * 128;
            u32x2 uq[8]; float bsv[8];
            { const int fr = lane & 15, fq = lane >> 4, c0 = 16 * wave;
#pragma unroll
              for (int jt = 0; jt < 8; ++jt) { const int t = jt * 16 + fr; if (MODE == 3) uq[jt] = (u32x2){0x3f803f80u, 0x3f803f80u}; else uq[jt] = *(const GAS u32x2*)(UB + (row0 + t) * 6144 + col0 + c0 + 4 * fq); bsv[jt] = bs[g * 128 + t]; } }
            {
                const float mu = ps1 * (1.f / 6144.f); const float rstd = rsqrtf(ps2 * (1.f / 6144.f) - mu * mu + 1e-5f);
#pragma unroll
                for (int i = 0; i < 4; ++i) { const v4u q = pvq[i];
                    const float* gp = lng + col0 + cq_ + i * 8; const float* bp = lnb + col0 + cq_ + i * 8;
                    const f32x4 g0 = *(const GAS f32x4*)gp, g1 = *(const GAS f32x4*)(gp + 4), b0 = *(const GAS f32x4*)bp, b1 = *(const GAS f32x4*)(bp + 4);
                    v4u o;
                    o.x = pk2((bflo(q.x) - mu) * rstd * g0.x + b0.x, (bfhi(q.x) - mu) * rstd * g0.y + b0.y);
                    o.y = pk2((bflo(q.y) - mu) * rstd * g0.z + b0.z, (bfhi(q.y) - mu) * rstd * g0.w + b0.w);
                    o.z = pk2((bflo(q.z) - mu) * rstd * g1.x + b1.x, (bfhi(q.z) - mu) * rstd * g1.y + b1.y);
                    o.w = pk2((bflo(q.w) - mu) * rstd * g1.z + b1.z, (bfhi(q.w) - mu) * rstd * g1.w + b1.w);
                    *(LAS v4u*)(T + s_ * PITCH + cq_ + i * 8) = o; }
            }
            __syncthreads();
            {
                const int fr = lane & 15, fq = lane >> 4, qq = fr >> 2, pp = fr & 3, c0 = 16 * wave;
                if (MODE != 2 && u + nbg < 384) { const int un = u + nbg, ckn = un / 6, cbn = g * 6 + un % 6; const size_t r = (size_t)ckn * 128 + s_;
                    ps1 = VST[r * 2]; ps2 = VST[r * 2 + 1];
#pragma unroll
                    for (int i = 0; i < 4; ++i) pvq[i] = *(const GAS v4u*)(VB + r * 6144 + cbn * 128 + cq_ + i * 8); }
                bf16x8 af[4];
#pragma unroll
                for (int ks = 0; ks < 4; ++ks) {
                    const s16x4 r0 = __builtin_amdgcn_ds_read_tr16_b64_v4i16((LAS s16x4*)(T + (32 * ks + 8 * fq + qq) * PITCH + c0 + 4 * pp));
                    const s16x4 r1 = __builtin_amdgcn_ds_read_tr16_b64_v4i16((LAS s16x4*)(T + (32 * ks + 8 * fq + 4 + qq) * PITCH + c0 + 4 * pp));
                    af[ks] = (bf16x8){r0.x, r0.y, r0.z, r0.w, r1.x, r1.y, r1.z, r1.w};
                }
                f32x4 acc[8];
#pragma unroll
                for (int jt = 0; jt < 8; ++jt) {
                    acc[jt] = (f32x4){0.f, 0.f, 0.f, 0.f};
#pragma unroll
                    for (int ks = 0; ks < 4; ++ks) if (ks <= (jt >> 1)) { const bf16x8 bfr = *(const LAS bf16x8*)(WS + (jt * 16 + fr) * 128 + (((ks * 4 + fq) ^ fr) << 3)); acc[jt] = __builtin_amdgcn_mfma_f32_16x16x32_bf16(af[ks], bfr, acc[jt], 0, 0, 0); }
                }
#pragma unroll
                for (int jt = 0; jt < 8; ++jt) {
                    const int t = jt * 16 + fr; const size_t off = (row0 + t) * 6144 + col0 + c0 + 4 * fq;
                    u32x2 o; o.x = pk2(bflo(uq[jt].x) * (acc[jt][0] + bsv[jt]), bfhi(uq[jt].x) * (acc[jt][1] + bsv[jt])); o.y = pk2(bflo(uq[jt].y) * (acc[jt][2] + bsv[jt]), bfhi(uq[jt].y) * (acc[jt][3] + bsv[jt]));
                    if (MODE == 3) { if (o.x == 0x12345u) *(GAS u32x2*)(UM + off) = o; } else *(GAS u32x2*)(UM + off) = o;
                }
            }
            __syncthreads();
        }
    }
    if (MODE == 0 || MODE == 1) for (int it = vcu * 512 + tid; it < 128 * 768; it += G * 512) {
        const int sq = it / 768, c8 = (it % 768) * 8, gg = c8 / 768;
        const size_t r0 = 8192 + (size_t)sq * 4;
        const f32x4 g0 = *(const GAS f32x4*)(lng + c8), g1 = *(const GAS f32x4*)(lng + c8 + 4), b0 = *(const GAS f32x4*)(lnb + c8), b1 = *(const GAS f32x4*)(lnb + c8 + 4);
        v4u vq4[4], uq4[4]; float st1[4], st2[4], bsv4[4], wv[4][4];
#pragma unroll
        for (int s = 0; s < 4; ++s) { st1[s] = VST[(r0 + s) * 2]; st2[s] = VST[(r0 + s) * 2 + 1]; vq4[s] = *(const GAS v4u*)(VB + (r0 + s) * 6144 + c8); uq4[s] = *(const GAS v4u*)(UB + (r0 + s) * 6144 + c8); bsv4[s] = bs[gg * 128 + s];
#pragma unroll
            for (int s2 = 0; s2 < 4; ++s2) wv[s][s2] = (s2 <= s) ? wsf[(size_t)(gg * 128 + s) * 128 + s2] : 0.f; }
        float vn[4][8];
#pragma unroll
        for (int s = 0; s < 4; ++s) {
            const float mu = st1[s] * (1.f / 6144.f); const float rstd = rsqrtf(st2[s] * (1.f / 6144.f) - mu * mu + 1e-5f); const v4u q = vq4[s];
            vn[s][0] = (bflo(q.x) - mu) * rstd * g0.x + b0.x; vn[s][1] = (bfhi(q.x) - mu) * rstd * g0.y + b0.y; vn[s][2] = (bflo(q.y) - mu) * rstd * g0.z + b0.z; vn[s][3] = (bfhi(q.y) - mu) * rstd * g0.w + b0.w;
            vn[s][4] = (bflo(q.z) - mu) * rstd * g1.x + b1.x; vn[s][5] = (bfhi(q.z) - mu) * rstd * g1.y + b1.y; vn[s][6] = (bflo(q.w) - mu) * rstd * g1.z + b1.z; vn[s][7] = (bfhi(q.w) - mu) * rstd * g1.w + b1.w;
        }
#pragma unroll
        for (int s = 0; s < 4; ++s) { float* vo = vs_out + ((size_t)sq * 4 + s) * 6144 + c8;
            *(GAS f32x4*)vo = (f32x4){vn[s][0], vn[s][1], vn[s][2], vn[s][3]}; *(GAS f32x4*)(vo + 4) = (f32x4){vn[s][4], vn[s][5], vn[s][6], vn[s][7]}; }
#pragma unroll
        for (int t = 0; t < 4; ++t) {
            float mx[8];
#pragma unroll
            for (int e = 0; e < 8; ++e) mx[e] = bsv4[t];
#pragma unroll
            for (int s = 0; s < 4; ++s) if (s <= t) {
#pragma unroll
                for (int e = 0; e < 8; ++e) mx[e] += wv[t][s] * vn[s][e]; }
            const v4u uq = uq4[t];
            v4u o; o.x = pk2(bflo(uq.x) * mx[0], bfhi(uq.x) * mx[1]); o.y = pk2(bflo(uq.y) * mx[2], bfhi(uq.y) * mx[3]); o.z = pk2(bflo(uq.z) * mx[4], bfhi(uq.z) * mx[5]); o.w = pk2(bflo(uq.w) * mx[6], bfhi(uq.w) * mx[7]);
            *(GAS v4u*)(UM + (r0 + t) * 6144 + c8) = o;
        }
    }
}
__device__ __forceinline__ float wave_scan_add(float v, int lane) {
#pragma unroll
    for (int o = 1; o < 64; o <<= 1) { const float t = __shfl_up(v, o); if (lane >= o) v += t; }
    return v;
}
__device__ __forceinline__ float wave_scan_max(float v, int lane) {
#pragma unroll
    for (int o = 1; o < 64; o <<= 1) { const float t = __shfl_up(v, o); if (lane >= o) v = fmaxf(v, t); }
    return v;
}
__device__ __forceinline__ bf16x8 tr_frag2(const LAS bf16* p0, const LAS bf16* p1) {
    const s16x4 r0 = __builtin_amdgcn_ds_read_tr16_b64_v4i16((LAS s16x4*)p0);
    const s16x4 r1 = __builtin_amdgcn_ds_read_tr16_b64_v4i16((LAS s16x4*)p1);
    return (bf16x8){r0.x, r0.y, r0.z, r0.w, r1.x, r1.y, r1.z, r1.w};
}
__device__ __forceinline__ bf16x8 tr_frag(const LAS bf16* p0, int rowstep4) { return tr_frag2(p0, p0 + rowstep4); }
__device__ __forceinline__ int qk_off(int row, int chunk) { return row * 128 + ((chunk ^ (row & 15)) << 3); }
__device__ __forceinline__ int v_off(int row, int chunk) { return row * 256 + ((chunk ^ (row & 7)) << 3); }
__device__ __forceinline__ int p_off(int row, int chunk) { return row * 64 + ((chunk ^ ((row >> 1) & 7)) << 3); }

__device__ __forceinline__ void mlstm_prompt_seq(const bf16* QKVO, const float* GATES, const float* hn_gain, bf16* HN, float* Cp, float* np_, float* mp, int seq, int h, LAS unsigned char* lds, int wave, int lane) {
    LAS bf16* Qs = (LAS bf16*)lds;
    LAS bf16* Ks = (LAS bf16*)(lds + 16384);
    LAS bf16* Vs = (LAS bf16*)(lds + 32768);
    LAS bf16* Cd = (LAS bf16*)(lds + 65536) + wave * 4096;
    LAS unsigned char* hi = lds + RING_BYTES + 512;
    LAS bf16* Ps = (LAS bf16*)hi;
    LAS float* A_ = (LAS float*)(hi + 8192);
    LAS float* M_ = A_ + 64;
    LAS float* B_ = M_ + 64;
    LAS float* SC = B_ + 64;
    LAS float* X_ = SC + 4;
    LAS bf16* nd = (LAS bf16*)(X_ + 1024);
    LAS float* GN = X_ + 1024 + 64;
    const int tid = wave * 64 + lane, fr = lane & 15, fq = lane >> 4;
    const size_t row0 = (size_t)seq * 2048;
    for (int i = tid; i < 65536 / 16; i += 512) ((LAS v4u*)(lds + 65536))[i] = (v4u){0u, 0u, 0u, 0u};
    if (tid < 16) ((LAS v4u*)nd)[tid] = (v4u){0u, 0u, 0u, 0u};
    if (tid < 256) GN[tid] = hn_gain[h * 256 + tid];
    float nreg = 0.f;
    f32x4 Cacc[2][8];
#pragma unroll
    for (int it = 0; it < 2; ++it)
#pragma unroll
        for (int jd = 0; jd < 8; ++jd) Cacc[it][jd] = (f32x4){0.f, 0.f, 0.f, 0.f};
    float m = 0.f;
    const bf16x8 ones = (fr == 0) ? (bf16x8){0x3F80, 0x3F80, 0x3F80, 0x3F80, 0x3F80, 0x3F80, 0x3F80, 0x3F80} : (bf16x8){0, 0, 0, 0, 0, 0, 0, 0};
    const int srow = tid >> 3, sc16 = (tid & 7) * 16, sc32 = (tid & 7) * 32;
    v4u pq[2], pk[2], pv[4];
    {   const bf16* r = QKVO + (row0 + srow) * 6144;
#pragma unroll
        for (int i = 0; i < 2; ++i) { pq[i] = *(const GAS v4u*)(r + h * 128 + sc16 + i * 8); pk[i] = *(const GAS v4u*)(r + 1024 + h * 128 + sc16 + i * 8); }
#pragma unroll
        for (int i = 0; i < 4; ++i) pv[i] = *(const GAS v4u*)(r + 2048 + h * 256 + sc32 + i * 8); }
    float ig_n = 0.f, lf_n = 0.f;
    if (wave == 0) { ig_n = GATES[(row0 + lane) * 16 + h]; lf_n = GATES[(row0 + lane) * 16 + 8 + h]; }
    __syncthreads();
#pragma unroll 1
    for (int c = 0; c < 32; ++c) {
        const size_t rb = row0 + (size_t)c * 64;
        int fr_l = lane & 15, fq_l = lane >> 4; asm volatile("" : "+v"(fr_l), "+v"(fq_l));
        const int fr = fr_l, fq = fq_l;
#pragma unroll
        for (int i = 0; i < 2; ++i) { *(LAS v4u*)(Qs + qk_off(srow, (sc16 >> 3) + i)) = pq[i]; *(LAS v4u*)(Ks + qk_off(srow, (sc16 >> 3) + i)) = pk[i]; }
#pragma unroll
        for (int i = 0; i < 4; ++i) *(LAS v4u*)(Vs + v_off(srow, (sc32 >> 3) + i)) = pv[i];
        if (c + 1 < 32) { const bf16* r = QKVO + (rb + 64 + srow) * 6144;
#pragma unroll
            for (int i = 0; i < 2; ++i) { pq[i] = *(const GAS v4u*)(r + h * 128 + sc16 + i * 8); pk[i] = *(const GAS v4u*)(r + 1024 + h * 128 + sc16 + i * 8); }
#pragma unroll
            for (int i = 0; i < 4; ++i) pv[i] = *(const GAS v4u*)(r + 2048 + h * 256 + sc32 + i * 8); }
        if (wave == 0) {
            const float ig = ig_n, lf = lf_n;
            if (c + 1 < 32) { ig_n = GATES[(rb + 64 + lane) * 16 + h]; lf_n = GATES[(rb + 64 + lane) * 16 + 8 + h]; }
            const float b = wave_scan_add(lf, lane); const float a = ig - b; const float pm = wave_scan_max(a, lane);
            const float Mt = fmaxf(m, pm);
            A_[lane] = a; M_[lane] = Mt; B_[lane] = b;
            const float M63 = __shfl(Mt, 63), b63 = __shfl(b, 63);
            if (lane == 0) { SC[0] = __expf(m - M63); SC[1] = b63 + M63; SC[2] = m; }
            m = b63 + M63;
        }
        __syncthreads();
        f32x4 nacc[3][4];
#pragma unroll
        for (int it = 0; it < 3; ++it)
#pragma unroll
            for (int jt = 0; jt < 4; ++jt) nacc[it][jt] = (f32x4){0.f, 0.f, 0.f, 0.f};
#pragma unroll 1
        for (int ks = 0; ks < 4; ++ks) {
            bf16x8 ca[3];
#pragma unroll
            for (int it = 0; it < 2; ++it) ca[it] = tr_frag(Cd + (32 * ks + 8 * fq + (fr >> 2)) * 32 + 16 * it + 4 * (fr & 3), 4 * 32);
            ca[2] = (fr == 0) ? *(const LAS bf16x8*)(nd + 32 * ks + 8 * fq) : (bf16x8){0, 0, 0, 0, 0, 0, 0, 0};
#pragma unroll
            for (int jt = 0; jt < 4; ++jt) { const bf16x8 qb = *(const LAS bf16x8*)(Qs + qk_off(16 * jt + fr, 4 * ks + fq));
#pragma unroll
                for (int it = 0; it < 3; ++it) nacc[it][jt] = __builtin_amdgcn_mfma_f32_16x16x32_bf16(ca[it], qb, nacc[it][jt], 0, 0, 0); }
        }
#pragma unroll
        for (int jt = 0; jt < 4; ++jt) { const float mt = M_[16 * jt + fr]; const float wi = __expf(SC[2] - mt);
#pragma unroll
            for (int it = 0; it < 3; ++it) nacc[it][jt] = nacc[it][jt] * wi; }
        {
#pragma unroll 1
            for (int ti = wave; ti < 16; ti += 8) {
                int tt, st;
                if (ti < 10) { tt = (ti >= 6) ? 3 : (ti >= 3) ? 2 : (ti >= 1) ? 1 : 0; st = ti - (tt * (tt + 1)) / 2; }
                else { const int z = ti - 10; tt = (z >= 5) ? 2 : (z >= 3) ? 1 : 0; st = (z >= 5) ? 3 : (z >= 3) ? (z - 3 + 2) : (z + 1); }
                u32x2 o = (u32x2){0u, 0u};
                if (ti < 10) {
                    f32x4 sa = (f32x4){0.f, 0.f, 0.f, 0.f};
#pragma unroll
                    for (int ks = 0; ks < 4; ++ks) { const bf16x8 ka = *(const LAS bf16x8*)(Ks + qk_off(16 * st + fr, 4 * ks + fq)); const bf16x8 qb = *(const LAS bf16x8*)(Qs + qk_off(16 * tt + fr, 4 * ks + fq));
                        sa = __builtin_amdgcn_mfma_f32_16x16x32_bf16(ka, qb, sa, 0, 0, 0); }
                    const int t = 16 * tt + fr, s0 = 16 * st + 4 * fq; const float mt = M_[t];
                    float pvv[4];
#pragma unroll
                    for (int r = 0; r < 4; ++r) pvv[r] = (s0 + r <= t) ? sa[r] * __expf(A_[s0 + r] - mt) : 0.f;
                    o.x = pk2(pvv[0], pvv[1]); o.y = pk2(pvv[2], pvv[3]);
                }
                *(LAS u32x2*)(Ps + p_off(16 * tt + fr, 2 * st + (fq >> 1)) + 4 * (fq & 1)) = o;
            }
        }
        __syncthreads();
        {   const float M63 = M_[63]; const float wk = __expf(A_[srow] - M63);
#pragma unroll
            for (int i = 0; i < 2; ++i) { v4u q = *(LAS v4u*)(Ks + qk_off(srow, (sc16 >> 3) + i));
                q.x = pk2(bflo(q.x) * wk, bfhi(q.x) * wk); q.y = pk2(bflo(q.y) * wk, bfhi(q.y) * wk); q.z = pk2(bflo(q.z) * wk, bfhi(q.z) * wk); q.w = pk2(bflo(q.w) * wk, bfhi(q.w) * wk);
                *(LAS v4u*)(Ks + qk_off(srow, (sc16 >> 3) + i)) = q; } }
        bf16x8 va[2][2];
#pragma unroll
        for (int ks = 0; ks < 2; ++ks)
#pragma unroll
            for (int it = 0; it < 2; ++it) { const int r_ = 32 * ks + 8 * fq + (fr >> 2), ch_ = 4 * wave + 2 * it + ((fr & 3) >> 1), w_ = 4 * (fr & 1); va[ks][it] = tr_frag2(Vs + v_off(r_, ch_) + w_, Vs + v_off(r_ + 4, ch_) + w_); }
#pragma unroll
        for (int ks = 0; ks < 2; ++ks)
#pragma unroll
            for (int jt = 0; jt < 4; ++jt) { const bf16x8 pb = *(const LAS bf16x8*)(Ps + p_off(16 * jt + fr, 4 * ks + fq));
                nacc[0][jt] = __builtin_amdgcn_mfma_f32_16x16x32_bf16(va[ks][0], pb, nacc[0][jt], 0, 0, 0);
                nacc[1][jt] = __builtin_amdgcn_mfma_f32_16x16x32_bf16(va[ks][1], pb, nacc[1][jt], 0, 0, 0);
                nacc[2][jt] = __builtin_amdgcn_mfma_f32_16x16x32_bf16(ones, pb, nacc[2][jt], 0, 0, 0); }
        u32x2 oq[4][2];
#pragma unroll
        for (int jt = 0; jt < 4; ++jt)
#pragma unroll
            for (int it = 0; it < 2; ++it) oq[jt][it] = *(const GAS u32x2*)(QKVO + (rb + 16 * jt + fr) * 6144 + 4096 + h * 256 + 32 * wave + 16 * it + 4 * fq);
        float s1[4], s2[4];
#pragma unroll
        for (int jt = 0; jt < 4; ++jt) {
            const int t = 16 * jt + fr;
            const float den = __shfl(nacc[2][jt][0], fr);
            const float dd = fmaxf(fabsf(den), __expf(-(B_[t] + M_[t]))); const float inv = 1.f / dd;
            s1[jt] = 0.f; s2[jt] = 0.f;
#pragma unroll
            for (int it = 0; it < 2; ++it) { const u32x2 oq_ = oq[jt][it];
                const float og[4] = {bflo(oq_.x), bfhi(oq_.x), bflo(oq_.y), bfhi(oq_.y)};
#pragma unroll
                for (int r = 0; r < 4; ++r) { const float hv = nacc[it][jt][r] * inv * __builtin_amdgcn_rcpf(1.f + __expf(-og[r])); nacc[it][jt][r] = hv; s1[jt] += hv; s2[jt] += hv * hv; } }
            s1[jt] += __shfl_xor(s1[jt], 16); s1[jt] += __shfl_xor(s1[jt], 32); s2[jt] += __shfl_xor(s2[jt], 16); s2[jt] += __shfl_xor(s2[jt], 32);
            if (fq == 0) { X_[(wave * 64 + t) * 2] = s1[jt]; X_[(wave * 64 + t) * 2 + 1] = s2[jt]; }
        }
        __syncthreads();
#pragma unroll
        for (int jt = 0; jt < 4; ++jt) {
            const int t = 16 * jt + fr; float a1 = 0.f, a2 = 0.f;
#pragma unroll
            for (int w = 0; w < 8; ++w) { a1 += X_[(w * 64 + t) * 2]; a2 += X_[(w * 64 + t) * 2 + 1]; }
            const float mu = a1 * (1.f / 256.f); const float rstd = rsqrtf(a2 * (1.f / 256.f) - mu * mu + 1e-5f);
#pragma unroll
            for (int it = 0; it < 2; ++it) { const int e = 32 * wave + 16 * it + 4 * fq; const f32x4 gn = *(const LAS f32x4*)(GN + e);
                u32x2 o; o.x = pk2((nacc[it][jt][0] - mu) * rstd * gn.x, (nacc[it][jt][1] - mu) * rstd * gn.y); o.y = pk2((nacc[it][jt][2] - mu) * rstd * gn.z, (nacc[it][jt][3] - mu) * rstd * gn.w);
                *(GAS u32x2*)(HN + (rb + t) * 2048 + h * 256 + e) = o; }
        }
        {   const float decay = SC[0];
#pragma unroll
            for (int it = 0; it < 2; ++it)
#pragma unroll
                for (int jd = 0; jd < 8; ++jd) Cacc[it][jd] = Cacc[it][jd] * decay;
            if (tid < 128) { float sum = 0.f;
#pragma unroll 8
                for (int s2_ = 0; s2_ < 64; ++s2_) sum += bflo((unsigned)Ks[qk_off(s2_, tid >> 3) + (tid & 7)]);
                nreg = decay * nreg + sum; nd[tid] = (bf16)f2bf(nreg); }
#pragma unroll
            for (int ks = 0; ks < 2; ++ks)
#pragma unroll
                for (int jd = 0; jd < 8; ++jd) { asm volatile("" ::: "memory"); const int r_ = 32 * ks + 8 * fq + (fr >> 2), ch_ = 2 * jd + ((fr & 3) >> 1), w_ = 4 * (fr & 1); const bf16x8 kb = tr_frag2(Ks + qk_off(r_, ch_) + w_, Ks + qk_off(r_ + 4, ch_) + w_);
                    Cacc[0][jd] = __builtin_amdgcn_mfma_f32_16x16x32_bf16(va[ks][0], kb, Cacc[0][jd], 0, 0, 0);
                    Cacc[1][jd] = __builtin_amdgcn_mfma_f32_16x16x32_bf16(va[ks][1], kb, Cacc[1][jd], 0, 0, 0);
                }
#pragma unroll
            for (int jd = 0; jd < 8; ++jd) {
#pragma unroll
                for (int it = 0; it < 2; ++it) { u32x2 o; o.x = pk2(Cacc[it][jd][0], Cacc[it][jd][1]); o.y = pk2(Cacc[it][jd][2], Cacc[it][jd][3]); *(LAS u32x2*)(Cd + (16 * jd + fr) * 32 + 16 * it + 4 * fq) = o; }
            }
        }
        __syncthreads();
    }
    float* Co = Cp + (size_t)(seq * 8 + h) * 32768;
#pragma unroll
    for (int jd = 0; jd < 8; ++jd) {
#pragma unroll
        for (int it = 0; it < 2; ++it) *(GAS f32x4*)(Co + (size_t)(16 * jd + fr) * 256 + 32 * wave + 16 * it + 4 * fq) = Cacc[it][jd];
    }
    if (tid < 128) np_[(seq * 8 + h) * 128 + tid] = nreg;
    if (wave == 0 && lane == 0) mp[seq * 8 + h] = m;
}

__device__ __forceinline__ void mlstm_sample_unit(const bf16* QKVO, const float* GATES, const float* hn_gain, const float* C0, const float* n0, const float* m0,
                                                  bf16* HN, float* Cs, float* ns, float* ms, int u, LAS unsigned char* lds, int wave, int lane) {
    const int h = u & 7, tid = wave * 64 + lane; const size_t r0 = 8192 + (size_t)(u >> 3) * 4;
    LAS float* q = (LAS float*)lds;
    LAS float* k = q + 512;
    LAS float* v = k + 512;
    LAS float* Sm = v + 1024;
    LAS float* gv = Sm + 16;
    LAS float* nn = gv + 32;
    LAS float* part = nn + 128;
    LAS float* red = part + 8192;
    { const int t = tid >> 7, d = tid & 127; const bf16* r = QKVO + (r0 + t) * 6144; q[tid] = bflo((unsigned)r[h * 128 + d]); k[tid] = bflo((unsigned)r[1024 + h * 128 + d]);
#pragma unroll
      for (int i = 0; i < 2; ++i) { const int idx = tid + 512 * i, tv = idx >> 8, e = idx & 255; v[idx] = bflo((unsigned)QKVO[(r0 + tv) * 6144 + 2048 + h * 256 + e]); } }
    if (tid < 128) nn[tid] = n0[(size_t)u * 128 + tid];
    if (tid == 0) {
        const float mprev = m0[u]; float b = 0.f, pm = -INFINITY;
        for (int t = 0; t < 4; ++t) { const float ig = GATES[(r0 + t) * 16 + h], lf = GATES[(r0 + t) * 16 + 8 + h]; b += lf; const float a = ig - b; pm = fmaxf(pm, a); const float Mt = fmaxf(mprev, pm);
            gv[t] = a; gv[4 + t] = Mt; gv[8 + t] = b; gv[12 + t] = __expf(mprev - Mt); }
        const float M3 = gv[7], b3 = gv[11];
        gv[28] = __expf(mprev - M3); gv[29] = b3 + M3;
        for (int s = 0; s < 4; ++s) gv[20 + s] = __expf(gv[s] - M3);
    }
    __syncthreads();
    if (tid < 16) { const int t = tid >> 2, s = tid & 3; float r = 0.f; if (s <= t) { float dot = 0.f; for (int d = 0; d < 128; ++d) dot += q[t * 128 + d] * k[s * 128 + d]; r = dot * __expf(gv[s] - gv[4 + t]); } Sm[tid] = r; }
    else if (tid < 20) { const int t = tid - 16; float dot = 0.f; for (int d = 0; d < 128; ++d) dot += q[t * 128 + d] * nn[d]; gv[24 + t] = dot; }
    __syncthreads();
    if (tid < 4) { float den = gv[12 + tid] * gv[24 + tid]; for (int s = 0; s <= tid; ++s) den += Sm[tid * 4 + s]; gv[16 + tid] = fmaxf(fabsf(den), __expf(-(gv[8 + tid] + gv[4 + tid]))); }
    k[tid] *= gv[20 + (tid >> 7)];
    __syncthreads();
    {
        const int eq = tid & 63, dg = tid >> 6; const float decay = gv[28];
        f32x4 v4[4];
#pragma unroll
        for (int s = 0; s < 4; ++s) v4[s] = *(const LAS f32x4*)(v + s * 256 + 4 * eq);
        f32x4 acc[4];
#pragma unroll
        for (int t = 0; t < 4; ++t) acc[t] = (f32x4){0.f, 0.f, 0.f, 0.f};
        const float* cin = C0 + (size_t)u * 32768 + (size_t)(dg * 16) * 256 + 4 * eq; float* cout = Cs + (size_t)u * 32768 + (size_t)(dg * 16) * 256 + 4 * eq;
#pragma unroll
        for (int hb = 0; hb < 2; ++hb) {
            f32x4 cr[8];
#pragma unroll
            for (int dd = 0; dd < 8; ++dd) cr[dd] = __builtin_nontemporal_load((const GAS f32x4*)(cin + (hb * 8 + dd) * 256));
#pragma unroll
            for (int dd = 0; dd < 8; ++dd) { const int d = dg * 16 + hb * 8 + dd; const f32x4 c = cr[dd];
#pragma unroll
                for (int t = 0; t < 4; ++t) acc[t] += c * q[t * 128 + d];
                f32x4 cn = c * decay;
#pragma unroll
                for (int s = 0; s < 4; ++s) cn += v4[s] * k[s * 128 + d];
                __builtin_nontemporal_store(cn, (GAS f32x4*)(cout + (hb * 8 + dd) * 256)); }
        }
#pragma unroll
        for (int t = 0; t < 4; ++t) *(LAS f32x4*)(part + (dg * 4 + t) * 256 + 4 * eq) = acc[t];
    }
    __syncthreads();
    float hv[2];
    {   const int t = tid >> 7, e2 = (tid & 127) * 2;
        float s1 = 0.f, s2 = 0.f;
#pragma unroll
        for (int i = 0; i < 2; ++i) { const int e = e2 + i; float num2 = 0.f;
#pragma unroll
            for (int dg = 0; dg < 8; ++dg) num2 += part[(dg * 4 + t) * 256 + e];
            float num1 = 0.f; for (int s = 0; s <= t; ++s) num1 += Sm[t * 4 + s] * v[s * 256 + e];
            float x = (num1 + gv[12 + t] * num2) / gv[16 + t];
            const float o = bflo((unsigned)QKVO[(r0 + t) * 6144 + 4096 + h * 256 + e]);
            x *= 1.f / (1.f + __expf(-o)); hv[i] = x; s1 += x; s2 += x * x; }
        s1 = wave_sum_f(s1); s2 = wave_sum_f(s2);
        if (lane == 0) { red[wave * 2] = s1; red[wave * 2 + 1] = s2; }
    }
    __syncthreads();
    {   const int t = tid >> 7, e2 = (tid & 127) * 2;
        const float a1 = red[(2 * t) * 2] + red[(2 * t + 1) * 2], a2 = red[(2 * t) * 2 + 1] + red[(2 * t + 1) * 2 + 1];
        const float mu = a1 * (1.f / 256.f); const float rstd = rsqrtf(a2 * (1.f / 256.f) - mu * mu + 1e-5f);
        const unsigned o = pk2((hv[0] - mu) * rstd * hn_gain[h * 256 + e2], (hv[1] - mu) * rstd * hn_gain[h * 256 + e2 + 1]);
        *(GAS unsigned*)(HN + (r0 + t) * 2048 + h * 256 + e2) = o;
        if (tid < 128) { float a = gv[28] * nn[tid]; for (int s = 0; s < 4; ++s) a += k[s * 128 + tid]; ns[(size_t)u * 128 + tid] = a; }
        if (tid == 0) ms[u] = gv[29];
    }
    __syncthreads();
}

__device__ __forceinline__ void phase_mlstm(const Args& a, LAS unsigned char* lds, int G, int wave, int lane, int which) {
    const bf16* QKVO = (const bf16*)(a.ws + a.L.qkvo); const float* GATES = (const float*)(a.ws + a.L.gates); bf16* HN = (bf16*)(a.ws + a.L.qp);
    const int bx = blockIdx.x;
    constexpr size_t O_CP = 17825792, O_NP = O_CP + 1048576, O_MP = O_NP + 4096, O_CS = O_MP + 32, O_NS = O_CS + 33554432, O_MS = O_NS + 131072;
    if (bx < 32) { if (which & 1) mlstm_prompt_seq(QKVO, GATES, a.in[7], HN, a.out + O_CP, a.out + O_NP, a.out + O_MP, bx >> 3, bx & 7, lds, wave, lane); }
    else {
        if (which & 2) for (int u = bx - 32; u < 1024; u += G - 32) mlstm_sample_unit(QKVO, GATES, a.in[7], a.in[2], a.in[3], a.in[4], HN, a.out + O_CS, a.out + O_NS, a.out + O_MS, u, lds, wave, lane);
        if (which & 28) { __syncthreads(); side_convert(a, lds, (bx - 32) * NWAVES + wave, (G - 32) * NWAVES, wave, lane, (which & 4) ? 3 : ((which >> 3) & 3)); }
    }
}
struct MiniBf16S { bf16* O; int ldc, sclo, schi; __device__ __forceinline__ void operator()(int row, int col, f32x4 a) const { const float s = (col >= sclo && col < schi) ? 0.08838834764831845f : 1.f;
    u32x2 o; o.x = pk2(a[0] * s, a[1] * s); o.y = pk2(a[2] * s, a[3] * s); *(GAS u32x2*)(O + (size_t)row * ldc + col) = o; } };
struct MiniBf16 { bf16* O; int ldc; __device__ __forceinline__ void operator()(int row, int col, f32x4 a) const { u32x2 o; o.x = pk2(a[0], a[1]); o.y = pk2(a[2], a[3]); *(GAS u32x2*)(O + (size_t)row * ldc + col) = o; } };
struct MiniRes { const bf16* xb; bf16* Z; float alpha; __device__ __forceinline__ void operator()(int row, int col, f32x4 a) const {
    const u32x2 x = *(const GAS u32x2*)(xb + (size_t)row * 2048 + col); u32x2 o; o.x = pk2(bflo(x.x) * alpha + a[0], bfhi(x.x) * alpha + a[1]); o.y = pk2(bflo(x.y) * alpha + a[2], bfhi(x.y) * alpha + a[3]);
    *(GAS u32x2*)(Z + (size_t)row * 2048 + col) = o; } };
struct MiniGelu { bf16* U; bf16* V; const float* bias; float* VST; __device__ __forceinline__ void operator()(int row, int col, f32x4 a) const {
    const bool isv = col >= 6144; const f32x4 bv = *(const GAS f32x4*)(bias + col); float s1 = 0.f, s2 = 0.f;
#pragma unroll
    for (int e = 0; e < 4; ++e) { a[e] = pg8::gelu_tanh_f(a[e] + bv[e]); s1 += a[e]; s2 += a[e] * a[e]; }
    u32x2 o; o.x = pk2(a[0], a[1]); o.y = pk2(a[2], a[3]);
    *(GAS u32x2*)((isv ? V + (size_t)row * 6144 + (col - 6144) : U + (size_t)row * 6144 + col)) = o;
    if (isv) { s1 += __shfl_xor(s1, 16); s1 += __shfl_xor(s1, 32); s2 += __shfl_xor(s2, 16); s2 += __shfl_xor(s2, 32);
        if ((threadIdx.x & 48) == 0) { atomicAdd(VST + 2 * row, s1); atomicAdd(VST + 2 * row + 1, s2); } } } };
template <class Epi>
__device__ __forceinline__ void mini_gemm(const bf16* A, const bf16* Bt, int N, int K, const Epi& E, LAS unsigned char* lds, int vcu, int G, int wave, int lane) {
    const int tid = wave * 64 + lane, fr = lane & 15, fq = lane >> 4;
    const int srow = tid >> 4, sch = tid & 15;
    const int nct = N / 128, nunits = 16 * nct, nch = K / 128;
    const int wofs = srow * 256 + ((sch ^ (srow & 15)) << 4);
    const size_t bstep = (size_t)32 * K;
#define MG_LOAD(r, c) do { int cc_ = (c) + c0; if (cc_ >= nch) cc_ -= nch; r[0] = *(const GAS v4u*)(ag + (size_t)cc_ * 128); _Pragma("unroll") for (int p_ = 0; p_ < 4; ++p_) r[1 + p_] = *(const GAS v4u*)(bg + p_ * bstep + (size_t)cc_ * 128); } while (0)
#define MG_STORE(r, b) do { *(LAS v4u*)(lds + (b) * 40960 + wofs) = r[0]; _Pragma("unroll") for (int p_ = 0; p_ < 4; ++p_) *(LAS v4u*)(lds + (b) * 40960 + 8192 + p_ * 8192 + wofs) = r[1 + p_]; } while (0)
#define MG_COMPUTE(b) do { _Pragma("unroll") for (int ks_ = 0; ks_ < 4; ++ks_) { const int co_ = ((ks_ * 4 + fq) ^ fr) << 4; \
        const bf16x8 a0_ = *(const LAS bf16x8*)(lds + (b) * 40960 + fr * 256 + co_), a1_ = *(const LAS bf16x8*)(lds + (b) * 40960 + (16 + fr) * 256 + co_); \
        const bf16x8 b_ = *(const LAS bf16x8*)(lds + (b) * 40960 + 8192 + (wave * 16 + fr) * 256 + co_); \
        acc0 = __builtin_amdgcn_mfma_f32_16x16x32_bf16(b_, a0_, acc0, 0, 0, 0); acc1 = __builtin_amdgcn_mfma_f32_16x16x32_bf16(b_, a1_, acc1, 0, 0, 0); } } while (0)
    for (int u = vcu; u < nunits; u += G) {
        const int rt = u & 15, ct = u >> 4;
        const int row0 = 8192 + rt * 32, colB0 = ct * 128;
        const bf16* ag = A + (size_t)(row0 + srow) * K + sch * 8;
        const bf16* bg = Bt + (size_t)(colB0 + srow) * K + sch * 8;
        f32x4 acc0 = (f32x4){0.f, 0.f, 0.f, 0.f}, acc1 = acc0;
        const int c0 = (u * 5) % nch;
        v4u r0[5], r1[5], r2[5], r3[5];
        MG_LOAD(r0, 0); MG_LOAD(r1, 1); MG_LOAD(r2, 2); MG_LOAD(r3, 3);
        MG_STORE(r0, 0); __syncthreads();
#pragma unroll 1
        for (int c = 0; c < nch; c += 4) {
            MG_LOAD(r0, min(c + 4, nch - 1));
            MG_COMPUTE(0);
            MG_STORE(r1, 1); __syncthreads();
            MG_LOAD(r1, min(c + 5, nch - 1));
            MG_COMPUTE(1);
            MG_STORE(r2, 0); __syncthreads();
            MG_LOAD(r2, min(c + 6, nch - 1));
            MG_COMPUTE(0);
            MG_STORE(r3, 1); __syncthreads();
            MG_LOAD(r3, min(c + 7, nch - 1));
            MG_COMPUTE(1);
            MG_STORE(r0, 0);
            __syncthreads();
        }
        E(row0 + fr, colB0 + wave * 16 + 4 * fq, acc0); E(row0 + 16 + fr, colB0 + wave * 16 + 4 * fq, acc1);
    }
#undef MG_LOAD
#undef MG_STORE
#undef MG_COMPUTE
}
__global__ void __launch_bounds__(NWAVES * 64, 2) mk(Args args) {
    extern __shared__ __attribute__((aligned(16))) unsigned char lds_raw[];
    LAS unsigned char* lds = (LAS unsigned char*)lds_raw;
    volatile LAS unsigned* MISC = (volatile LAS unsigned*)(lds + MISC_OFF);
    const int tid = threadIdx.x, lane = tid & 63, wave = __builtin_amdgcn_readfirstlane(tid >> 6);
    const int G = gridDim.x, bx = blockIdx.x; const int vcu = (G % 8 == 0) ? (bx % 8) * (G / 8) + bx / 8 : bx;
    for (int u = tid; u < (LDS_BYTES - RING_BYTES) / 4; u += NWAVES * 64) ((LAS unsigned*)(lds + RING_BYTES))[u] = 0u;
    __syncthreads();
    unsigned char* ws = args.ws; const Lay& L = args.L;
    unsigned* ctl = (unsigned*)(ws + L.ctl);
    XcdBarrier bar = xcd_barrier_post(ctl + 4096 + args.li * XCD_BAR_WORDS, MISC + 8);
    const int lo = args.ph_lo, hi = args.ph_hi;
#ifndef PHMASK
#define PHMASK 0xFFFFFFFFu
#endif
#define IN(k) (((PHMASK >> (k)) & 1u) && lo <= (k) && (k) < hi)
#ifndef MLSTM_DUPSEL
#define MLSTM_DUPSEL 3
#endif
#ifndef TK_ABL
#define TK_ABL 0
#endif
#ifndef SP_ABL
#define SP_ABL 0
#endif
#ifndef UP_ABL
#define UP_ABL 0
#endif
#ifndef VP_ABL
#define VP_ABL 0
#endif
#ifndef DUPMASK
#define DUPMASK 0u
#endif
#define DUP(k) ((DUPMASK >> (k)) & 1u)
#define LANE() ({ int l_ = lane; asm volatile("" : "+v"(l_)); l_; })
#define SEAM(k) do { if (IN(k) && IN((k) + 1)) xcd_barrier(bar); } while (0)
#define GEMM_PHASE_FULL(EPI_T, E, Aptr, Btptr, Nn, Kk) do { pg8::Gemm g_{(const pg8::bf16_t*)(Aptr), (const pg8::bf16_t*)(Btptr), NTOKF, (Nn), (Kk)}; pg8::StaticOrder S_; S_.init(NTOKF, (Nn), G, bx); \
        pg8::gemm_phase<EPI_T, pg8::StaticOrder, true, true>(lds, g_, S_, E); } while (0)
#define GEMM_PHASE(EPI_T, E, Aptr, Btptr, Nn, Kk, MINI_E) do { pg8::Gemm g_{(const pg8::bf16_t*)(Aptr), (const pg8::bf16_t*)(Btptr), 8192, (Nn), (Kk)}; pg8::StaticOrder S_; S_.init(8192, (Nn), G, bx); \
        pg8::gemm_phase<EPI_T, pg8::StaticOrder, true, true>(lds, g_, S_, E); \
        mini_gemm((const bf16*)(Aptr), (const bf16*)(Btptr), (Nn), (Kk), MINI_E, lds, vcu, G, wave, LANE()); } while (0)

#define GEMM_PHASE_MINI(EPI_T, E, Aptr, Btptr, Nn, Kk, MINI_E) do { mini_gemm((const bf16*)(Aptr), (const bf16*)(Btptr), (Nn), (Kk), MINI_E, lds, vcu, G, wave, LANE()); } while (0)
#ifdef MINI_DUP
#define GEMM_PHASE_DUPSEL GEMM_PHASE_MINI
#else
#define GEMM_PHASE_DUPSEL GEMM_PHASE
#endif

    if (IN(0)) { { phase_prologue(args, lds, vcu, G, wave, LANE()); } if (DUP(0)) { xcd_barrier(bar); { phase_prologue(args, lds, vcu, G, wave, LANE()); } } } SEAM(0);
    if (IN(1)) { { pg8::EpiBf16S E{(pg8::bf16_t*)(ws + L.qkvo), 6144, 1024, 2048, 0.08838834764831845f}; GEMM_PHASE_FULL(pg8::EpiBf16S, E, ws + L.xb, ws + L.wina, 6144, 2048); } if (DUP(1)) { xcd_barrier(bar); { pg8::EpiBf16S E{(pg8::bf16_t*)(ws + L.qkvo), 6144, 1024, 2048, 0.08838834764831845f}; GEMM_PHASE_FULL(pg8::EpiBf16S, E, ws + L.xb, ws + L.wina, 6144, 2048); } } } SEAM(1);
    if (IN(2)) { { phase_mlstm(args, lds, G, wave, lane, 7); } if (DUP(2)) { xcd_barrier(bar); { phase_mlstm(args, lds, G, wave, lane, MLSTM_DUPSEL); } } } SEAM(2);
    if (IN(3)) { { pg8::EpiRes E{(const pg8::bf16_t*)(ws + L.xb), (pg8::bf16_t*)(ws + L.z), ALPHA_F}; GEMM_PHASE(pg8::EpiRes, E, ws + L.qp, ws + L.wouta, 2048, 2048, (MiniRes{(const bf16*)(ws + L.xb), (bf16*)(ws + L.z), ALPHA_F})); } if (DUP(3)) { xcd_barrier(bar); { pg8::EpiRes E{(const pg8::bf16_t*)(ws + L.xb), (pg8::bf16_t*)(ws + L.z), ALPHA_F}; GEMM_PHASE(pg8::EpiRes, E, ws + L.qp, ws + L.wouta, 2048, 2048, (MiniRes{(const bf16*)(ws + L.xb), (bf16*)(ws + L.z), ALPHA_F})); } } } SEAM(3);
    if (IN(4)) { { phase_ln<true>((const float*)(ws + L.z), args.in[16], args.in[17], (float*)nullptr, (bf16*)(ws + L.xb), ws + L.xq, (float*)(ws + L.sx), vcu, G, wave, LANE()); } if (DUP(4)) { xcd_barrier(bar); { phase_ln<true>((const float*)(ws + L.z), args.in[16], args.in[17], (float*)nullptr, (bf16*)(ws + L.xb), ws + L.xq, (float*)(ws + L.sx), vcu, G, wave, LANE()); } } } SEAM(4);
    if (IN(5)) { { pg8::EpiBf16S E{(pg8::bf16_t*)(ws + L.qp), 2048, 0, 0, 1.f}; GEMM_PHASE(pg8::EpiBf16S, E, ws + L.xb, ws + L.wq, 2048, 2048, (MiniBf16S{(bf16*)(ws + L.qp), 2048, 0, 0})); } if (DUP(5)) { xcd_barrier(bar); { pg8::EpiBf16S E{(pg8::bf16_t*)(ws + L.qp), 2048, 0, 0, 1.f}; GEMM_PHASE(pg8::EpiBf16S, E, ws + L.xb, ws + L.wq, 2048, 2048, (MiniBf16S{(bf16*)(ws + L.qp), 2048, 0, 0})); } } } SEAM(5);
#define RINV_U ((const float*)(ws + L.rinv))
#define RINV_V ((const float*)(ws + L.rinv) + 16384)
    if (IN(6)) { { phase_topk<0>((const bf16*)(ws + L.qp), (const bf16*)(ws + L.sk), (int*)(ws + L.idx), (float*)(ws + L.gt), (float*)(ws + L.ww), (float*)(ws + L.su), RINV_U, RINV_V, lds, vcu, G, wave, LANE()); } if (DUP(6)) { xcd_barrier(bar); { phase_topk<TK_ABL>((const bf16*)(ws + L.qp), (const bf16*)(ws + L.sk), (int*)(ws + L.um), (float*)(ws + L.um + 8388608), (float*)(ws + L.um + 16777216), (float*)(ws + L.um + 25165824), RINV_U, RINV_V, lds, vcu, G, wave, LANE()); } } } SEAM(6);
    if (IN(7)) { { phase_upass_sl<0>((const unsigned char*)(ws + L.ptu), (const unsigned char*)(ws + L.xq), (const float*)(ws + L.sx), (const int*)(ws + L.idx), (float*)(ws + L.ww), (float*)(ws + L.gt), (float*)(ws + L.su), RINV_U, RINV_V, xcd_topology(bar.bar, bar.x, MISC[10], wave), LANE()); } if (DUP(7)) { xcd_barrier(bar); { phase_upass_sl<UP_ABL>((const unsigned char*)(ws + L.ptu), (const unsigned char*)(ws + L.xq), (const float*)(ws + L.sx), (const int*)(ws + L.idx), (float*)(ws + L.um), (float*)(ws + L.gt), (float*)(ws + L.su), RINV_U, RINV_V, xcd_topology(bar.bar, bar.x, MISC[10], wave), LANE()); } } } SEAM(7);
    if (IN(8)) { { phase_vpass_sl<0>((const unsigned char*)(ws + L.ptv), (const bf16*)(ws + L.xb), (const int*)(ws + L.idx), (const float*)(ws + L.ww), (const float*)(ws + L.su), (const float*)(ws + L.gt), (bf16*)(ws + L.z), ALPHA_F, xcd_topology(bar.bar, bar.x, MISC[10], wave), lds, wave, LANE()); } if (DUP(8)) { xcd_barrier(bar); { phase_vpass_sl<VP_ABL>((const unsigned char*)(ws + L.ptv), (const bf16*)(ws + L.xb), (const int*)(ws + L.idx), (const float*)(ws + L.ww), (const float*)(ws + L.su), (const float*)(ws + L.gt), (bf16*)(ws + L.um), ALPHA_F, xcd_topology(bar.bar, bar.x, MISC[10], wave), lds, wave, LANE()); } } } SEAM(8);
    if (IN(9)) { { phase_ln<true>((const float*)(ws + L.z), args.in[18], args.in[19], (float*)nullptr, (bf16*)(ws + L.xb), (unsigned char*)nullptr, (float*)nullptr, vcu, G, wave, LANE()); } if (DUP(9)) { xcd_barrier(bar); { phase_ln<true>((const float*)(ws + L.z), args.in[18], args.in[19], (float*)nullptr, (bf16*)(ws + L.xb), (unsigned char*)nullptr, (float*)nullptr, vcu, G, wave, LANE()); } } } SEAM(9);
    if (IN(10)) { { pg8::EpiGelu E{(pg8::bf16_t*)(ws + L.ub), (pg8::bf16_t*)(ws + L.vb), args.in[10], (float*)(ws + L.vst)}; GEMM_PHASE_FULL(pg8::EpiGelu, E, ws + L.xb, ws + L.winb, 12288, 2048); } if (DUP(10)) { xcd_barrier(bar); { pg8::EpiGelu E{(pg8::bf16_t*)(ws + L.ub), (pg8::bf16_t*)(ws + L.vb), args.in[10], (float*)(ws + L.vst)}; GEMM_PHASE_FULL(pg8::EpiGelu, E, ws + L.xb, ws + L.winb, 12288, 2048); } } } SEAM(10);
    if (IN(11)) { { phase_spatial<0>((const bf16*)(ws + L.ub), (const bf16*)(ws + L.vb), (const float*)(ws + L.vst), args.in[11], args.in[12], (const bf16*)(ws + L.wsb), args.in[13], args.in[14],
                                (bf16*)(ws + L.um), args.out + OUT_VS, lds, vcu, G, wave, LANE()); } if (DUP(11)) { xcd_barrier(bar); { phase_spatial<SP_ABL>((const bf16*)(ws + L.ub), (const bf16*)(ws + L.vb), (const float*)(ws + L.vst), args.in[11], args.in[12], (const bf16*)(ws + L.wsb), args.in[13], args.in[14],
                                (bf16*)(ws + L.ptu), (float*)(ws + L.ptu1), lds, vcu, G, wave, LANE()); } } } SEAM(11);
    if (IN(12)) { { pg8::EpiRes E{(const pg8::bf16_t*)(ws + L.xb), (pg8::bf16_t*)(ws + L.z), ALPHA_F}; GEMM_PHASE(pg8::EpiRes, E, ws + L.um, ws + L.woutb, 2048, 6144, (MiniRes{(const bf16*)(ws + L.xb), (bf16*)(ws + L.z), ALPHA_F})); } if (DUP(12)) { xcd_barrier(bar); { pg8::EpiRes E{(const pg8::bf16_t*)(ws + L.xb), (pg8::bf16_t*)(ws + L.z), ALPHA_F}; GEMM_PHASE_DUPSEL(pg8::EpiRes, E, ws + L.um, ws + L.woutb, 2048, 6144, (MiniRes{(const bf16*)(ws + L.xb), (bf16*)(ws + L.z), ALPHA_F})); } } } SEAM(12);
    if (IN(13)) { { phase_ln<true>((const float*)(ws + L.z), args.in[16] + 2048, args.in[17] + 2048, (float*)nullptr, (bf16*)(ws + L.xb), ws + L.xq, (float*)(ws + L.sx), vcu, G, wave, LANE()); } if (DUP(13)) { xcd_barrier(bar); { phase_ln<true>((const float*)(ws + L.z), args.in[16] + 2048, args.in[17] + 2048, (float*)nullptr, (bf16*)(ws + L.xb), ws + L.xq, (float*)(ws + L.sx), vcu, G, wave, LANE()); } } } SEAM(13);
    if (IN(14)) { { pg8::EpiBf16S E{(pg8::bf16_t*)(ws + L.qp), 2048, 0, 0, 1.f}; GEMM_PHASE(pg8::EpiBf16S, E, ws + L.xb, (bf16*)(ws + L.wq) + (size_t)2048 * 2048, 2048, 2048, (MiniBf16S{(bf16*)(ws + L.qp), 2048, 0, 0})); } if (DUP(14)) { xcd_barrier(bar); { pg8::EpiBf16S E{(pg8::bf16_t*)(ws + L.qp), 2048, 0, 0, 1.f}; GEMM_PHASE(pg8::EpiBf16S, E, ws + L.xb, (bf16*)(ws + L.wq) + (size_t)2048 * 2048, 2048, 2048, (MiniBf16S{(bf16*)(ws + L.qp), 2048, 0, 0})); } } } SEAM(14);
#undef RINV_U
#undef RINV_V
#define RINV_U ((const float*)(ws + L.rinv) + 32768)
#define RINV_V ((const float*)(ws + L.rinv) + 49152)
    if (IN(15)) { { phase_topk<0>((const bf16*)(ws + L.qp), (const bf16*)(ws + L.sk) + (size_t)16 * 128 * 128, (int*)(ws + L.idx), (float*)(ws + L.gt), (float*)(ws + L.ww), (float*)(ws + L.su), RINV_U, RINV_V, lds, vcu, G, wave, LANE()); } if (DUP(15)) { xcd_barrier(bar); { phase_topk<TK_ABL>((const bf16*)(ws + L.qp), (const bf16*)(ws + L.sk) + (size_t)16 * 128 * 128, (int*)(ws + L.um), (float*)(ws + L.um + 8388608), (float*)(ws + L.um + 16777216), (float*)(ws + L.um + 25165824), RINV_U, RINV_V, lds, vcu, G, wave, LANE()); } } } SEAM(15);
    if (IN(16)) { { phase_upass_sl<0>((const unsigned char*)(ws + L.ptu1), (const unsigned char*)(ws + L.xq), (const float*)(ws + L.sx), (const int*)(ws + L.idx), (float*)(ws + L.ww), (float*)(ws + L.gt), (float*)(ws + L.su), RINV_U, RINV_V, xcd_topology(bar.bar, bar.x, MISC[10], wave), LANE()); } if (DUP(16)) { xcd_barrier(bar); { phase_upass_sl<UP_ABL>((const unsigned char*)(ws + L.ptu1), (const unsigned char*)(ws + L.xq), (const float*)(ws + L.sx), (const int*)(ws + L.idx), (float*)(ws + L.um), (float*)(ws + L.gt), (float*)(ws + L.su), RINV_U, RINV_V, xcd_topology(bar.bar, bar.x, MISC[10], wave), LANE()); } } } SEAM(16);
    if (IN(17)) { { phase_vpass_sl<0>((const unsigned char*)(ws + L.ptv1), (const bf16*)(ws + L.xb), (const int*)(ws + L.idx), (const float*)(ws + L.ww), (const float*)(ws + L.su), (const float*)(ws + L.gt), (bf16*)(ws + L.z), ALPHA_F, xcd_topology(bar.bar, bar.x, MISC[10], wave), lds, wave, LANE()); } if (DUP(17)) { xcd_barrier(bar); { phase_vpass_sl<VP_ABL>((const unsigned char*)(ws + L.ptv1), (const bf16*)(ws + L.xb), (const int*)(ws + L.idx), (const float*)(ws + L.ww), (const float*)(ws + L.su), (const float*)(ws + L.gt), (bf16*)(ws + L.um), ALPHA_F, xcd_topology(bar.bar, bar.x, MISC[10], wave), lds, wave, LANE()); } } } SEAM(17);
#ifdef XBAR_EXTRA
    if (IN(17) && IN(18)) { for (int e_ = 0; e_ < XBAR_EXTRA; ++e_) xcd_barrier(bar); }
#endif
    if (IN(18)) { phase_ln<true>((const float*)(ws + L.z), args.in[18] + 2048, args.in[19] + 2048, args.out, nullptr, (unsigned char*)nullptr, (float*)nullptr, vcu, G, wave, LANE()); }
#undef IN
#undef SEAM
#undef GEMM_PHASE
}

static int g_grid = 0;
static bool mk_init() {
    if (g_grid == 0) {
        int dev = 0, cus = 0;
        if (hipGetDevice(&dev) != hipSuccess || hipDeviceGetAttribute(&cus, hipDeviceAttributeMultiprocessorCount, dev) != hipSuccess) { g_grid = -1; return false; }
        if (hipFuncSetAttribute((const void*)mk, hipFuncAttributeMaxDynamicSharedMemorySize, LDS_BYTES) != hipSuccess) { g_grid = -1; return false; }
        (void)hipGetLastError();
        g_grid = cus;
    }
    return g_grid > 0;
}
static void mk_launch(const Args& a0, int lo, int hi, int li, hipStream_t st) {
    Args a = a0; a.ph_lo = lo; a.ph_hi = hi; a.li = li;
    hipLaunchKernelGGL(mk, dim3(g_grid), dim3(NWAVES * 64), LDS_BYTES, st, a);
}
extern "C" void kernel_launch(void* const* d_in, const int* in_sizes, int n_in, void* d_out, int out_size, void* d_ws, size_t ws_size, hipStream_t stream) {
    if (!mk_init()) return;
    constexpr unsigned long long MiB = 1ull << 20;
    Args a{};
    for (int i = 0; i < 24; ++i) a.in[i] = (const float*)d_in[i];
    a.out = (float*)d_out; a.ws = (unsigned char*)d_ws;
    Lay& L = a.L;
    L.ctl = 0; L.wina = 1 * MiB; L.wouta = 25 * MiB; L.winb = 33 * MiB; L.woutb = 81 * MiB; L.wq = 105 * MiB; L.sk = 121 * MiB; L.gates = 122 * MiB; L.vst = 123 * MiB; L.wsb = 124 * MiB;
    L.idx = 125 * MiB; L.gt = 130 * MiB; L.ww = 135 * MiB; L.ptu = 140 * MiB; L.ptv = 204 * MiB; L.xf0 = 268 * MiB; L.xf1 = 336 * MiB; L.z = 404 * MiB; L.xb = 472 * MiB; L.qp = 506 * MiB;
    L.qkvo = 540 * MiB; L.ub = 540 * MiB; L.vb = 642 * MiB; L.um = 744 * MiB; L.ptu1 = 846 * MiB; L.ptv1 = 910 * MiB; L.rinv = 974 * MiB; L.su = 975 * MiB; L.xq = 980 * MiB; L.sx = 997 * MiB;
    (void)hipMemsetAsync((unsigned char*)d_ws + L.ctl, 0, MiB, stream);
    mk_launch(a, 0, 19, 0, stream);
}
```

```cpp
#include <hip/hip_runtime.h>
#include <stdint.h>
#include <math.h>
#define DUPMASK 0u
#define MLSTM_DUPSEL 7
#define GAS __attribute__((address_space(1)))
#define LAS __attribute__((address_space(3)))
typedef unsigned short bf16;
typedef unsigned v4u __attribute__((ext_vector_type(4)));
typedef float f32x4 __attribute__((ext_vector_type(4)));
typedef short bf16x8 __attribute__((ext_vector_type(8)));
typedef GAS unsigned gu32;
typedef GAS unsigned long long gu64;
#define RLX_AGENT __ATOMIC_RELAXED, __HIP_MEMORY_SCOPE_AGENT
#define LDS_WAIT() asm volatile("s_waitcnt lgkmcnt(0)" ::: "memory")
#define VM_WAIT() asm volatile("s_waitcnt vmcnt(0)" ::: "memory")
__device__ __forceinline__ unsigned long long rt() { return __builtin_amdgcn_s_memrealtime(); }
__device__ __forceinline__ unsigned f2bf(float f) { unsigned u = __builtin_bit_cast(unsigned, f); return (u + 0x7fffu + ((u >> 16) & 1u)) >> 16; }
__device__ __forceinline__ unsigned pk2(float lo, float hi) { unsigned r; asm("v_cvt_pk_bf16_f32 %0, %1, %2" : "=v"(r) : "v"(lo), "v"(hi)); return r; }

#define XB_TMO      128
#define XB_XCNT(j)  (256  + 64 * (j))
#define XB_XSUB(j)  (1280 + 64 * (j))
#define XB_XGEN(j)  (2304 + 64 * (j))
#define XB_TOP      3328
#define XB_TOPGEN   3392
#define XCD_BAR_WORDS 3456
#define XB_SPIN_CAP (1u << 22)

__device__ __forceinline__ unsigned xb_ld(unsigned* p)              { return __hip_atomic_load(p, __ATOMIC_RELAXED, __HIP_MEMORY_SCOPE_AGENT); }
__device__ __forceinline__ unsigned xb_add(unsigned* p, unsigned v) { return __hip_atomic_fetch_add(p, v, __ATOMIC_RELAXED, __HIP_MEMORY_SCOPE_AGENT); }
__device__ __forceinline__ unsigned xb_xcc_id() { return (unsigned)__builtin_amdgcn_s_getreg((3 << 11) | 20) & 0xFu; }
#define XB_SPIN(cond, bar) do { unsigned _sp = 0; while (cond) { __builtin_amdgcn_s_sleep(1); \
    if ((++_sp & 255u) == 0u) { if (xb_ld(&(bar)[XB_TMO])) break; if (_sp > XB_SPIN_CAP) { atomicAdd(&(bar)[XB_TMO], 1u); break; } } } } while (0)

struct XcdBarrier {
    unsigned* bar; unsigned x;
    volatile LAS unsigned* st;
};

__device__ __forceinline__ XcdBarrier xcd_barrier_post(unsigned* bar, volatile LAS unsigned* st) {
    XcdBarrier b; b.bar = bar; b.x = xb_xcc_id(); b.st = st;
    if (threadIdx.x == 0) st[2] = xb_add(&bar[XB_XCNT(b.x)], 1u);
    return b;
}
__device__ __forceinline__ void xcd_barrier_complete(unsigned* bar, unsigned x, unsigned& nloc, unsigned& nx) {
    const unsigned G = gridDim.x * gridDim.y * gridDim.z;
    unsigned sum, cnt, mine, sp = 0u;
    for (;;) {
        sum = 0u; cnt = 0u; mine = 0u;
#pragma unroll
        for (unsigned j = 0; j < 16; ++j) { const unsigned c = xb_ld(&bar[XB_XCNT(j)]); sum += c; cnt += (c > 0u) ? 1u : 0u; mine = (j == x) ? c : mine; }
        if (sum == G) break;
        __builtin_amdgcn_s_sleep(1);
        if ((++sp & 255u) == 0u) { if (xb_ld(&bar[XB_TMO])) break; if (sp > XB_SPIN_CAP) { atomicAdd(&bar[XB_TMO], 1u); break; } }
    }
    nloc = mine > 0u ? mine : 1u; nx = cnt > 0u ? cnt : 1u;
}

__device__ __forceinline__ void xcd_barrier(const XcdBarrier& b) {
    asm volatile("s_waitcnt vmcnt(0)" ::: "memory");
    __syncthreads();
    if (threadIdx.x == 0) {
        unsigned* bar = b.bar;
        __builtin_amdgcn_s_waitcnt(0);
        unsigned nloc = b.st[0], nx = b.st[1];
        if (nloc == 0u) { xcd_barrier_complete(bar, b.x, nloc, nx); b.st[0] = nloc; b.st[1] = nx; }
        const unsigned old = xb_add(&bar[XB_XSUB(b.x)], 1u);
        const unsigned gen = old / nloc;
        if (old + 1u == (gen + 1u) * nloc) {
            __builtin_amdgcn_fence(__ATOMIC_RELEASE, "agent");
            asm volatile("s_waitcnt vmcnt(0)" ::: "memory");
            const unsigned og = xb_add(&bar[XB_TOP], 1u);
            const unsigned tg = og / nx;
            if (og + 1u == (tg + 1u) * nx) xb_add(&bar[XB_TOPGEN], 1u);
            else XB_SPIN(xb_ld(&bar[XB_TOPGEN]) == tg, bar);
            __builtin_amdgcn_fence(__ATOMIC_ACQUIRE, "agent");
            xb_add(&bar[XB_XGEN(b.x)], 1u);
            asm volatile("s_waitcnt vmcnt(0)" ::: "memory");
        } else {
            XB_SPIN(xb_ld(&bar[XB_XGEN(b.x)]) == gen, bar);
            __builtin_amdgcn_fence(__ATOMIC_ACQUIRE, "agent");
            asm volatile("s_waitcnt vmcnt(0)" ::: "memory");
        }
    }
    __syncthreads();
}

namespace pg8 {
#define PG8_LAS __attribute__((address_space(3)))
typedef unsigned short bf16_t;
typedef short bf16x8 __attribute__((ext_vector_type(8)));
typedef float f32x4 __attribute__((ext_vector_type(4)));
typedef unsigned u32x4 __attribute__((ext_vector_type(4)));
typedef unsigned pu32x2 __attribute__((ext_vector_type(2)));
constexpr int BM = 256, BK = 64, HALF = 128, HTB = HALF * BK * 2  , STAGE_BYTES = 8 * HTB, NXCD = 8, WGM = 8;

__host__ __device__ __forceinline__ int lds_byte(int r, int c) { const int st = (r >> 4) * 2 + (c >> 5), rr = r & 15, cc = c & 31, ob = rr * 64 + cc * 2; return st * 1024 + (ob ^ (((ob >> 9) & 1) << 5)); }
__host__ __device__ __forceinline__ void stage_rc(int b, int& R, int& C) { const int st = b / 1024, sb = b % 1024, swz = sb ^ (((sb >> 9) & 1) << 5); R = (st >> 1) * 16 + swz / 64; C = (st & 1) * 32 + (swz % 64) / 2; }
__host__ __device__ __forceinline__ int perm32(int rho) { const int n = rho >> 4, i = rho & 15; return 8 * (i >> 2) + 4 * n + (i & 3); }

struct Unit { int pm, pn; };
struct Gemm { const bf16_t* A; const bf16_t* Bt; int M, N, K; };

struct StaticOrder {
    int nM, nN, nwg, G, c;
    __host__ __device__ void init(int M, int N, int G_, int c_) { nM = M / BM; nN = N / BM; nwg = nM * nN; G = G_; c = c_; }
    __host__ __device__ bool next(int i, Unit& u) const {
        const long L = (long)i * G + c; if (L >= nwg) return false;
        int wgid = (int)L; { const int q = nwg / NXCD, r = nwg % NXCD, xcd = wgid % NXCD, off = wgid / NXCD; wgid = (xcd < r ? xcd * (q + 1) : r * (q + 1) + (xcd - r) * q) + off; }
        const int nig = WGM * nN, gid = wgid / nig, fm = gid * WGM, gsz = (nM - fm) < WGM ? (nM - fm) : WGM;
        u.pm = fm + ((wgid % nig) % gsz); u.pn = (wgid % nig) / gsz; return true;
    }
    __device__ __forceinline__ void a_ready(const Unit&) const {}
    __device__ __forceinline__ void done(const Unit&) const {}
};


__device__ __forceinline__ unsigned cvt_pk_bf16(float lo, float hi) { unsigned r; asm volatile("v_cvt_pk_bf16_f32 %0, %1, %2" : "=v"(r) : "v"(lo), "v"(hi)); return r; }
__device__ __forceinline__ float gelu_tanh_f(float x) { const float u = x + 0.044715f * x * x * x; const float e = __builtin_amdgcn_exp2f(u * -2.302208198f); return x * __builtin_amdgcn_rcpf(1.0f + e); }
struct EpiBf16S {
    static constexpr bool PERM = true, AFTER_DRAIN = false;
    bf16_t* O; int ldc; int sc_lo, sc_hi; float sc;
    __device__ __forceinline__ void operator()(const f32x4 (&acc)[2][2][4][2], const Unit& u, int wr, int wc, int fr, int fq) const {
        const int row0 = u.pm * BM + wr * 64 + fr; const int colt = u.pn * BM;
        const float s = (colt >= sc_lo && colt < sc_hi) ? sc : 1.f;
        const int col0 = colt + wc * 32 + 8 * fq;
#pragma unroll
        for (int ai = 0; ai < 2; ++ai)
#pragma unroll
            for (int m = 0; m < 4; ++m) { bf16_t* rowp = O + (size_t)(row0 + ai * HALF + m * 16) * ldc + col0;
#pragma unroll
                for (int bj = 0; bj < 2; ++bj) { const f32x4 v0 = acc[ai][bj][m][0] * s, v1 = acc[ai][bj][m][1] * s;
                    u32x4 w; w.x = cvt_pk_bf16(v0[0], v0[1]); w.y = cvt_pk_bf16(v0[2], v0[3]); w.z = cvt_pk_bf16(v1[0], v1[1]); w.w = cvt_pk_bf16(v1[2], v1[3]);
                    *(u32x4*)(rowp + bj * HALF) = w; } }
    }
};
struct EpiRes {
    static constexpr bool PERM = false, AFTER_DRAIN = false;
    const bf16_t* xb; bf16_t* Z; float alpha;
    __device__ __forceinline__ void operator()(const f32x4 (&acc)[2][2][4][2], const Unit& u, int wr, int wc, int fr, int fq) const {
        const int col0 = u.pn * BM + wc * 32 + 4 * fq;
#pragma unroll
        for (int ai = 0; ai < 2; ++ai)
#pragma unroll
            for (int m = 0; m < 4; ++m) { const int r = u.pm * BM + ai * HALF + wr * 64 + m * 16 + fr;
                const bf16_t* rp = xb + (size_t)r * 2048; bf16_t* zp = Z + (size_t)r * 2048;
#pragma unroll
                for (int bj = 0; bj < 2; ++bj)
#pragma unroll
                    for (int n = 0; n < 2; ++n) { const int c = col0 + bj * HALF + n * 16; const pu32x2 x = *(const pu32x2*)(rp + c); const f32x4 a = acc[ai][bj][m][n];
                        pu32x2 o; o.x = pk2(__builtin_bit_cast(float, x.x << 16) * alpha + a[0], __builtin_bit_cast(float, x.x & 0xffff0000u) * alpha + a[1]);
                        o.y = pk2(__builtin_bit_cast(float, x.y << 16) * alpha + a[2], __builtin_bit_cast(float, x.y & 0xffff0000u) * alpha + a[3]); *(pu32x2*)(zp + c) = o; } }
    }
};
struct EpiGelu {
    static constexpr bool PERM = true, AFTER_DRAIN = false;
    bf16_t* U; bf16_t* V; const float* bias; float* VST;
    __device__ __forceinline__ void operator()(const f32x4 (&acc)[2][2][4][2], const Unit& u, int wr, int wc, int fr, int fq) const {
        const int row0 = u.pm * BM + wr * 64 + fr; const bool isv = u.pn >= 24; const int colt = (isv ? u.pn - 24 : u.pn) * BM;
        bf16_t* base = isv ? V : U;
        const int col0 = colt + wc * 32 + 8 * fq, bcol0 = u.pn * BM + wc * 32 + 8 * fq;
        f32x4 bv[2][2];
#pragma unroll
        for (int bj = 0; bj < 2; ++bj)
#pragma unroll
            for (int n = 0; n < 2; ++n) bv[bj][n] = *(const f32x4*)(bias + bcol0 + bj * HALF + 4 * n);
#pragma unroll
        for (int ai = 0; ai < 2; ++ai)
#pragma unroll
            for (int m = 0; m < 4; ++m) { const int r = row0 + ai * HALF + m * 16; bf16_t* rowp = base + (size_t)r * 6144 + col0; float s1 = 0.f, s2 = 0.f;
#pragma unroll
                for (int bj = 0; bj < 2; ++bj) { f32x4 v0 = acc[ai][bj][m][0] + bv[bj][0], v1 = acc[ai][bj][m][1] + bv[bj][1];
#pragma unroll
                    for (int e = 0; e < 4; ++e) { v0[e] = gelu_tanh_f(v0[e]); v1[e] = gelu_tanh_f(v1[e]); s1 += v0[e] + v1[e]; s2 += v0[e] * v0[e] + v1[e] * v1[e]; }
                    u32x4 w; w.x = cvt_pk_bf16(v0[0], v0[1]); w.y = cvt_pk_bf16(v0[2], v0[3]); w.z = cvt_pk_bf16(v1[0], v1[1]); w.w = cvt_pk_bf16(v1[2], v1[3]);
                    *(u32x4*)(rowp + bj * HALF) = w; }
                if (isv) { s1 += __shfl_xor(s1, 16); s1 += __shfl_xor(s1, 32); s2 += __shfl_xor(s2, 16); s2 += __shfl_xor(s2, 32);
                    if (fq == 0) { atomicAdd(VST + 2 * r, s1); atomicAdd(VST + 2 * r + 1, s2); } } }
    }
};
template <class Epi, class Sched, bool ALIGN_EPI = false, bool SP2 = false>
__device__ __forceinline__ void gemm_phase(PG8_LAS unsigned char* lds, const Gemm g, const Sched& S, const Epi& E) {
    int tid_l = threadIdx.x; asm volatile("" : "+v"(tid_l));
    const int tid = tid_l, wid = __builtin_amdgcn_readfirstlane(tid >> 6), lane = tid & 63, wr = wid >> 2, wc = wid & 3, fr = lane & 15, fq = lane >> 4;
    const int K = g.K, nt = K / BK;
    unsigned voffA[2], voffB[2];
#pragma unroll
    for (int i = 0; i < 2; ++i) { int R, C; stage_rc(tid * 16 + i * 8192, R, C); const int Rb = Epi::PERM ? ((R & ~31) + perm32(R & 31)) : R;
        voffA[i] = (unsigned)(R * K + C) * 2u; voffB[i] = (unsigned)(Rb * K + C) * 2u; }
    const size_t kstep = (size_t)(BK * 2);
    const size_t hstep = (size_t)HALF * K * 2;
    const size_t tstep = 2 * hstep;
    const unsigned ldsw = (unsigned)wid * 1024u;
    const int aoff = lds_byte(wr * 64 + fr, fq * 8), boff = lds_byte(wc * 32 + fr, fq * 8);
#define PG8_SA(b, h) (((b) * 2 + (h)) * HTB)
#define PG8_SB(b, h) ((4 + (b) * 2 + (h)) * HTB)
#define PG8_STAGE(bufoff, gbase, voff) do { _Pragma("unroll") for (int _i = 0; _i < 2; ++_i) \
        __builtin_amdgcn_global_load_lds((const unsigned*)((const char*)(gbase) + (voff)[_i]), (PG8_LAS unsigned*)(lds + (bufoff) + ldsw + _i * 8192), 16, 0, 0); } while (0)
#define PG8_LDA(dst, b, h) do { _Pragma("unroll") for (int m = 0; m < 4; ++m) _Pragma("unroll") for (int k = 0; k < 2; ++k) dst[m][k] = *(const PG8_LAS bf16x8*)(lds + PG8_SA(b, h) + aoff + m * 2048 + k * 1024); } while (0)
#define PG8_LDB(dst, b, h) do { _Pragma("unroll") for (int n = 0; n < 2; ++n) _Pragma("unroll") for (int k = 0; k < 2; ++k) dst[n][k] = *(const PG8_LAS bf16x8*)(lds + PG8_SB(b, h) + boff + n * 2048 + k * 1024); } while (0)
#define PG8_MMA(ai, bj, At, Bt) do { __builtin_amdgcn_s_setprio(1); _Pragma("unroll") for (int m = 0; m < 4; ++m) _Pragma("unroll") for (int n = 0; n < 2; ++n) _Pragma("unroll") for (int k = 0; k < 2; ++k) \
        acc[ai][bj][m][n] = __builtin_amdgcn_mfma_f32_16x16x32_bf16(Bt[n][k], At[m][k], acc[ai][bj][m][n], 0, 0, 0); __builtin_amdgcn_s_setprio(0); } while (0)
#define PG8_WAIT_V(n) asm volatile("s_waitcnt vmcnt(" #n ")" ::: "memory")
#define PG8_WAIT_L(n) asm volatile("s_waitcnt lgkmcnt(" #n ")" ::: "memory")
#define PG8_BAR __builtin_amdgcn_s_barrier()
#define PG8_SCHED __builtin_amdgcn_sched_barrier(0)
    Unit cur, nxt; int ui = 0;
    if (!S.next(0, cur)) return;
    f32x4 acc[2][2][4][2];
#pragma unroll
    for (int a = 0; a < 2; ++a)
#pragma unroll
        for (int b = 0; b < 2; ++b)
#pragma unroll
            for (int m = 0; m < 4; ++m)
#pragma unroll
                for (int n = 0; n < 2; ++n) acc[a][b][m][n] = (f32x4){0.f, 0.f, 0.f, 0.f};
    bf16x8 At[4][2], B0[2][2], B1[2][2];
    const char* cA = (const char*)g.A + (size_t)cur.pm * tstep; const char* cB = (const char*)g.Bt + (size_t)cur.pn * tstep;
    S.a_ready(cur);
    if constexpr (SP2) {
        PG8_STAGE(PG8_SB(0, 0), cB, voffB); PG8_STAGE(PG8_SB(0, 1), cB + hstep, voffB); PG8_STAGE(PG8_SA(0, 0), cA, voffA); PG8_STAGE(PG8_SA(0, 1), cA + hstep, voffA);
        if (wr == 1) PG8_BAR;
        PG8_WAIT_V(2); PG8_BAR;
        PG8_STAGE(PG8_SB(1, 0), cB + kstep, voffB); PG8_STAGE(PG8_SA(1, 0), cA + kstep, voffA); PG8_STAGE(PG8_SB(1, 1), cB + hstep + kstep, voffB);
        PG8_WAIT_V(6); PG8_BAR;
    } else {
        PG8_STAGE(PG8_SB(0, 0), cB, voffB); PG8_STAGE(PG8_SA(0, 0), cA, voffA); PG8_STAGE(PG8_SB(0, 1), cB + hstep, voffB); PG8_STAGE(PG8_SA(0, 1), cA + hstep, voffA);
        if (wr == 1) PG8_BAR;
        PG8_WAIT_V(4); PG8_BAR;
        PG8_STAGE(PG8_SB(1, 0), cB + kstep, voffB); PG8_STAGE(PG8_SA(1, 0), cA + kstep, voffA); PG8_STAGE(PG8_SB(1, 1), cB + hstep + kstep, voffB);
        PG8_WAIT_V(6); PG8_BAR;
    }
    for (;;) {
        const bool has_next = S.next(ui + 1, nxt);
        const char* nA = has_next ? (const char*)g.A + (size_t)nxt.pm * tstep : cA; const char* nB = has_next ? (const char*)g.Bt + (size_t)nxt.pn * tstep : cB;
        for (int t = 0; t < nt; t += 2) {
            const bool last = (t == nt - 2);
            const char* a1 = cA + (size_t)(t + 1) * kstep;
            const char* a2 = last ? nA : cA + (size_t)(t + 2) * kstep; const char* b2 = last ? nB : cB + (size_t)(t + 2) * kstep;
            const char* a3 = a2 + kstep; const char* b3 = b2 + kstep;
            if (last && has_next) S.a_ready(nxt);
            if constexpr (SP2) {
            PG8_LDB(B0, 0, 0); PG8_LDB(B1, 0, 1); PG8_SCHED; PG8_LDA(At, 0, 0); PG8_STAGE(PG8_SA(1, 1), a1 + hstep, voffA);
            PG8_WAIT_V(8); PG8_WAIT_L(0); PG8_BAR; PG8_MMA(0, 0, At, B0); PG8_MMA(0, 1, At, B1); PG8_BAR; PG8_SCHED;
            PG8_LDA(At, 0, 1); PG8_STAGE(PG8_SB(0, 0), b2, voffB); PG8_STAGE(PG8_SB(0, 1), b2 + hstep, voffB); PG8_STAGE(PG8_SA(0, 0), a2, voffA);
            PG8_WAIT_V(8); PG8_WAIT_L(0); PG8_BAR; PG8_MMA(1, 0, At, B0); PG8_MMA(1, 1, At, B1); PG8_BAR; PG8_SCHED;
            PG8_LDB(B0, 1, 0); PG8_LDB(B1, 1, 1); PG8_SCHED; PG8_LDA(At, 1, 0); PG8_STAGE(PG8_SA(0, 1), a2 + hstep, voffA);
            PG8_WAIT_V(8); PG8_WAIT_L(0); PG8_BAR; PG8_MMA(0, 0, At, B0); PG8_MMA(0, 1, At, B1); PG8_BAR; PG8_SCHED;
            PG8_LDA(At, 1, 1); PG8_STAGE(PG8_SB(1, 0), b3, voffB); PG8_STAGE(PG8_SB(1, 1), b3 + hstep, voffB); PG8_STAGE(PG8_SA(1, 0), a3, voffA);
            PG8_WAIT_V(8); PG8_WAIT_L(0); PG8_BAR; PG8_MMA(1, 0, At, B0); PG8_MMA(1, 1, At, B1); PG8_BAR; PG8_SCHED;
            } else {
            PG8_LDB(B0, 0, 0); PG8_SCHED; PG8_LDA(At, 0, 0); PG8_STAGE(PG8_SA(1, 1), a1 + hstep, voffA);
            PG8_WAIT_L(8); PG8_BAR; PG8_WAIT_L(0); PG8_MMA(0, 0, At, B0); PG8_BAR; PG8_SCHED;
            PG8_LDB(B1, 0, 1); PG8_STAGE(PG8_SB(0, 0), b2, voffB);
            PG8_BAR; PG8_WAIT_L(0); PG8_MMA(0, 1, At, B1); PG8_BAR;
            PG8_LDA(At, 0, 1); PG8_STAGE(PG8_SA(0, 0), a2, voffA);
            PG8_BAR; PG8_WAIT_L(0); PG8_MMA(1, 0, At, B0); PG8_BAR; PG8_SCHED;
            PG8_STAGE(PG8_SB(0, 1), b2 + hstep, voffB);
            PG8_WAIT_V(6); PG8_BAR; PG8_MMA(1, 1, At, B1); PG8_BAR;
            PG8_LDB(B0, 1, 0); PG8_SCHED; PG8_LDA(At, 1, 0); PG8_STAGE(PG8_SA(0, 1), a2 + hstep, voffA);
            PG8_WAIT_L(8); PG8_BAR; PG8_WAIT_L(0); PG8_MMA(0, 0, At, B0); PG8_BAR; PG8_SCHED;
            PG8_LDB(B1, 1, 1); PG8_STAGE(PG8_SB(1, 0), b3, voffB);
            PG8_BAR; PG8_WAIT_L(0); PG8_MMA(0, 1, At, B1); PG8_BAR;
            PG8_LDA(At, 1, 1); PG8_STAGE(PG8_SA(1, 0), a3, voffA);
            PG8_BAR; PG8_WAIT_L(0); PG8_MMA(1, 0, At, B0); PG8_BAR; PG8_SCHED;
            PG8_STAGE(PG8_SB(1, 1), b3 + hstep, voffB);
            PG8_WAIT_V(6); PG8_BAR; PG8_MMA(1, 1, At, B1); PG8_BAR;
            }
        }
        if constexpr (ALIGN_EPI) { if (wr == 0) PG8_BAR; }
        if constexpr (!Epi::AFTER_DRAIN) { E(acc, cur, wr, wc, fr, fq); S.done(cur); }
        if (!has_next) break;
#pragma unroll
        for (int a = 0; a < 2; ++a)
#pragma unroll
            for (int b = 0; b < 2; ++b)
#pragma unroll
                for (int m = 0; m < 4; ++m)
#pragma unroll
                    for (int n = 0; n < 2; ++n) acc[a][b][m][n] = (f32x4){0.f, 0.f, 0.f, 0.f};
        cur = nxt; cA = nA; cB = nB; ++ui;
        if constexpr (ALIGN_EPI) { if (wr == 1) PG8_BAR; }
    }
    PG8_WAIT_V(0);
    if constexpr (!ALIGN_EPI) { if (wr == 0) PG8_BAR; }
    PG8_BAR;
    if constexpr (Epi::AFTER_DRAIN) { E.fused(acc, cur, wr, wc, fr, fq, lds, wid, lane); S.done(cur); }
#undef PG8_SA
#undef PG8_SB
#undef PG8_STAGE
#undef PG8_LDA
#undef PG8_LDB
#undef PG8_MMA
#undef PG8_WAIT_V
#undef PG8_WAIT_L
#undef PG8_BAR
#undef PG8_SCHED
}
}
constexpr int NWAVES = 8;
constexpr int LDS_BYTES = 147456;
constexpr int RING_BYTES = 131072;
constexpr int MISC_OFF = RING_BYTES + 320;
constexpr int NTOKF = 8704;
constexpr float ALPHA_F = 1.4142135623730951f;
constexpr size_t OUT_VS = 52565024;

struct Lay {
    unsigned long long ctl, wina, wouta, winb, woutb, wq, sk, gates, vst, idx, gt, ww, ptu, ptv, xf0, xf1, z, xb, qp, qkvo, ub, vb, um, wsb, ptu1, ptv1, rinv, su, xq, sx;
};
struct Args { const float* in[24]; float* out; unsigned char* ws; Lay L; int ph_lo, ph_hi, li, pad; };

__device__ __forceinline__ float wave_sum_f(float v) {
#pragma unroll
    for (int o = 1; o < 64; o <<= 1) v += __shfl_xor(v, o);
    return v;
}
__device__ __forceinline__ void p0_transpose_item(const float* W, int K, int ldw, int Nuse, bf16* WT, LAS float* scr, int item, int lane) {
    const int nblk = Nuse / 32, kb = item / nblk, nb = item % nblk, k0 = 64 * kb, n0 = 32 * nb;
    f32x4 ld[8];
#pragma unroll
    for (int i = 0; i < 8; ++i) ld[i] = __builtin_nontemporal_load((const GAS f32x4*)(W + (size_t)(k0 + 8 * i + (lane >> 3)) * ldw + n0 + (lane & 7) * 4));
#pragma unroll
    for (int i = 0; i < 8; ++i) { LAS float* d = scr + (8 * i + (lane >> 3)) * 33 + (lane & 7) * 4; d[0] = ld[i].x; d[1] = ld[i].y; d[2] = ld[i].z; d[3] = ld[i].w; }
    LDS_WAIT(); asm volatile("" ::: "memory");
    const int c = lane & 7;
#pragma unroll
    for (int j = 0; j < 4; ++j) { const int n = (lane >> 3) + 8 * j; const LAS float* s = scr + (8 * c) * 33 + n;
        v4u o; o.x = pk2(s[0 * 33], s[1 * 33]); o.y = pk2(s[2 * 33], s[3 * 33]); o.z = pk2(s[4 * 33], s[5 * 33]); o.w = pk2(s[6 * 33], s[7 * 33]);
        *(GAS v4u*)(WT + (size_t)(n0 + n) * K + k0 + 8 * c) = o; }
    LDS_WAIT(); asm volatile("" ::: "memory");
}
__device__ __forceinline__ void cvt_stream(const float* src, bf16* dst, size_t n8, int gw, int NGW, int lane) {
    for (size_t i = (size_t)gw * 64 + lane; i < n8; i += (size_t)NGW * 64) {
        const f32x4 a = *(const GAS f32x4*)(src + i * 8), b = *(const GAS f32x4*)(src + i * 8 + 4);
        v4u o; o.x = pk2(a.x, a.y); o.y = pk2(a.z, a.w); o.z = pk2(b.x, b.y); o.w = pk2(b.z, b.w);
        *(GAS v4u*)(dst + i * 8) = o;
    }
}
__device__ __forceinline__ void cvt_peer_table(const float* src, bf16* dst, int gw, int NGW, int lane) {
    const size_t n8 = (size_t)16384 * 2048 / 8;
    for (size_t i = (size_t)gw * 64 + lane; i < n8; i += (size_t)NGW * 64) {
        const f32x4 a = __builtin_nontemporal_load((const GAS f32x4*)(src + i * 8)), b = __builtin_nontemporal_load((const GAS f32x4*)(src + i * 8 + 4));
        v4u o; o.x = pk2(a.x, a.y); o.y = pk2(a.z, a.w); o.z = pk2(b.x, b.y); o.w = pk2(b.z, b.w);
        const size_t e = i >> 8; const int c8 = (int)(i & 255) * 8;
        *(GAS v4u*)(dst + ((size_t)(c8 >> 6) * 16384 + e) * 64 + (c8 & 63)) = o;
    }
}
__device__ __forceinline__ void cvt_peer_table_fp8(const float* src, unsigned char* dst, float* rinv, int gw, int NGW, int lane) {
    f32x4 nx[8];
    if (gw < 16384) {
#pragma unroll
        for (int j = 0; j < 8; ++j) nx[j] = __builtin_nontemporal_load((const GAS f32x4*)(src + (size_t)gw * 2048 + j * 256 + lane * 4)); }
    for (int e = gw; e < 16384; e += NGW) {
        f32x4 v[8]; float am = 0.f;
#pragma unroll
        for (int j = 0; j < 8; ++j) { v[j] = nx[j]; am = fmaxf(am, fmaxf(fmaxf(fabsf(v[j].x), fabsf(v[j].y)), fmaxf(fabsf(v[j].z), fabsf(v[j].w)))); }
        if (e + NGW < 16384) {
#pragma unroll
            for (int j = 0; j < 8; ++j) nx[j] = __builtin_nontemporal_load((const GAS f32x4*)(src + (size_t)(e + NGW) * 2048 + j * 256 + lane * 4)); }
#pragma unroll
        for (int o = 1; o < 64; o <<= 1) am = fmaxf(am, __shfl_xor(am, o));
        const float sc = (am > 0.f) ? exp2f(floorf(log2f(224.f / am))) : 1.f;
        if (lane == 0) rinv[e] = 1.f / sc;
#pragma unroll
        for (int j = 0; j < 8; ++j) { unsigned p = __builtin_amdgcn_cvt_pk_fp8_f32(v[j].x * sc, v[j].y * sc, 0u, false); p = __builtin_amdgcn_cvt_pk_fp8_f32(v[j].z * sc, v[j].w * sc, p, true);
            const int w = lane & 31, pw = ((((w >> 2) & 1) * 4 + (w & 3)) << 2) + ((w >> 4) & 1) * 2 + ((w >> 3) & 1);
            *(GAS unsigned*)(dst + ((size_t)(2 * j + (lane >> 5)) * 16384 + e) * 128 + pw * 4) = p; }
    }
}
__device__ __forceinline__ unsigned pack_i8x4(f32x4 v, float sc) { const int a = __float2int_rn(v.x * sc), b = __float2int_rn(v.y * sc), c = __float2int_rn(v.z * sc), d = __float2int_rn(v.w * sc);
    return (unsigned)(a & 0xFF) | ((unsigned)(b & 0xFF) << 8) | ((unsigned)(c & 0xFF) << 16) | ((unsigned)d << 24); }
__device__ __forceinline__ void cvt_peer_table_i8(const float* src, unsigned char* dst, float* rinv, int gw, int NGW, int lane) {
    f32x4 nx[8];
    if (gw < 16384) {
#pragma unroll
        for (int j = 0; j < 8; ++j) nx[j] = __builtin_nontemporal_load((const GAS f32x4*)(src + (size_t)gw * 2048 + j * 256 + lane * 4)); }
    for (int e = gw; e < 16384; e += NGW) {
        f32x4 v[8]; float am = 0.f;
#pragma unroll
        for (int j = 0; j < 8; ++j) { v[j] = nx[j]; am = fmaxf(am, fmaxf(fmaxf(fabsf(v[j].x), fabsf(v[j].y)), fmaxf(fabsf(v[j].z), fabsf(v[j].w)))); }
        if (e + NGW < 16384) {
#pragma unroll
            for (int j = 0; j < 8; ++j) nx[j] = __builtin_nontemporal_load((const GAS f32x4*)(src + (size_t)(e + NGW) * 2048 + j * 256 + lane * 4)); }
#pragma unroll
        for (int o = 1; o < 64; o <<= 1) am = fmaxf(am, __shfl_xor(am, o));
        const float sc = (am > 0.f) ? 127.f / am : 0.f;
        if (lane == 0) rinv[e] = am * (1.f / 127.f);
#pragma unroll
        for (int j = 0; j < 8; ++j) *(GAS unsigned*)(dst + ((size_t)(2 * j + (lane >> 5)) * 16384 + e) * 128 + (lane & 31) * 4) = pack_i8x4(v[j], sc);
    }
}
__device__ __forceinline__ const float* xrow_in(const Args& a, int r) { return r < 8192 ? a.in[0] + (size_t)r * 2048 : a.in[1] + (size_t)(r - 8192) * 2048; }

__device__ __forceinline__ void phase_prologue(const Args& a, LAS unsigned char* lds, int vcu, int G, int wave, int lane) {
    unsigned char* ws = a.ws;
    LAS float* scr = (LAS float*)(lds + wave * 16384);
    const int gw = vcu * NWAVES + wave, NGW = G * NWAVES;
    for (int it = gw; it < 32 * 192; it += NGW) p0_transpose_item(a.in[5], 2048, 6160, 6144, (bf16*)(ws + a.L.wina), scr, it, lane);
    __syncthreads();
    { LAS f32x4* wg = (LAS f32x4*)lds; const float* w = a.in[5];
      for (int i = threadIdx.x; i < 2048 * 4; i += NWAVES * 64) { const int k = i >> 2, q4 = i & 3; wg[(k >> 2) * 16 + ((((k & 3) * 4 + q4)) ^ ((k >> 2) & 15))] = *(const GAS f32x4*)(w + (size_t)k * 6160 + 6144 + q4 * 4); } }
    __syncthreads();
    const float* bg = a.in[6];
    for (int r = gw; r < NTOKF; r += NGW) {
        const float* xr = xrow_in(a, r);
        GAS unsigned long long* o8 = (GAS unsigned long long*)((bf16*)(ws + a.L.xb) + (size_t)r * 2048) + lane;
        float g[16];
#pragma unroll
        for (int q = 0; q < 16; ++q) g[q] = 0.f;
#pragma unroll 1
        for (int j = 0; j < 8; ++j) {
            const f32x4 xv = *(const GAS f32x4*)(xr + j * 256 + lane * 4);
            o8[64 * j] = (unsigned long long)pk2(xv.x, xv.y) | ((unsigned long long)pk2(xv.z, xv.w) << 32);
            const int kq = j * 64 + lane;
#pragma unroll
            for (int e = 0; e < 4; ++e) { const float x = xv[e];
#pragma unroll
                for (int q4 = 0; q4 < 4; ++q4) { const f32x4 w4 = ((const LAS f32x4*)lds)[kq * 16 + ((e * 4 + q4) ^ (kq & 15))]; g[q4 * 4 + 0] += x * w4.x; g[q4 * 4 + 1] += x * w4.y; g[q4 * 4 + 2] += x * w4.z; g[q4 * 4 + 3] += x * w4.w; } }
        }
        float mine = 0.f;
#pragma unroll
        for (int q = 0; q < 16; ++q) { const float s = wave_sum_f(g[q]); if (lane == q) mine = s; }
        if (lane < 16) { float v = mine + bg[lane]; if (lane >= 8) v = fminf(v, 0.f) - log1pf(expf(-fabsf(v))); ((float*)(ws + a.L.gates))[(size_t)r * 16 + lane] = v; }
    }
    __syncthreads();
}

__device__ __forceinline__ void side_convert(const Args& a, LAS unsigned char* lds, int gw, int NGW, int wave, int lane, int parts) {
    unsigned char* ws = a.ws;
    LAS float* scr = (LAS float*)(lds + wave * 16384);
    constexpr int I_OA = 32 * 64, I_B = 32 * 384, I_OB = 96 * 64, I_Q = 32 * 64;
    constexpr int NITEMS = I_OA + I_B + I_OB + 2 * I_Q;
    if (parts & 1) for (int it = gw; it < NITEMS; it += NGW) {
        int r = it;
        if (r < I_OA) { p0_transpose_item(a.in[8], 2048, 2048, 2048, (bf16*)(ws + a.L.wouta), scr, r, lane); continue; } r -= I_OA;
        if (r < I_B) { p0_transpose_item(a.in[9], 2048, 12288, 12288, (bf16*)(ws + a.L.winb), scr, r, lane); continue; } r -= I_B;
        if (r < I_OB) { p0_transpose_item(a.in[15], 6144, 2048, 2048, (bf16*)(ws + a.L.woutb), scr, r, lane); continue; } r -= I_OB;
        if (r < I_Q) { p0_transpose_item(a.in[20], 2048, 2048, 2048, (bf16*)(ws + a.L.wq), scr, r, lane); continue; } r -= I_Q;
        p0_transpose_item(a.in[20] + (size_t)2048 * 2048, 2048, 2048, 2048, (bf16*)(ws + a.L.wq) + (size_t)2048 * 2048, scr, r, lane);
    }
    if (parts & 2) { float* ri = (float*)(ws + a.L.rinv);
      cvt_peer_table_i8(a.in[22], ws + a.L.ptu, ri, gw, NGW, lane);
      cvt_peer_table_fp8(a.in[23], ws + a.L.ptv, ri + 16384, gw, NGW, lane);
      cvt_peer_table_i8(a.in[22] + (size_t)16384 * 2048, ws + a.L.ptu1, ri + 32768, gw, NGW, lane);
      cvt_peer_table_fp8(a.in[23] + (size_t)16384 * 2048, ws + a.L.ptv1, ri + 49152, gw, NGW, lane); }
    cvt_stream(a.in[21], (bf16*)(ws + a.L.sk), (size_t)2 * 16 * 128 * 128 / 8, gw, NGW, lane);
    { bf16* wsb = (bf16*)(ws + a.L.wsb); const float* wsf = a.in[13]; for (int i = gw * 64 + lane; i < 8 * 128 * 128; i += NGW * 64) { const int t = (i >> 7) & 127, s = i & 127; wsb[i] = (bf16)(s <= t ? f2bf(wsf[i]) : 0u); } }
    { float* vst = (float*)(ws + a.L.vst); for (int i = gw * 64 + lane; i < NTOKF * 2; i += NGW * 64) vst[i] = 0.f; }
}

template <bool ZBF>
__device__ __forceinline__ void phase_ln(const float* Z, const float* g, const float* b, float* Xf, bf16* Xb, unsigned char* Xq, float* sx, int vcu, int G, int wave, int lane) {
    const int gw = vcu * NWAVES + wave, NGW = G * NWAVES;
    f32x4 gv[8], bv[8];
#pragma unroll
    for (int j = 0; j < 8; ++j) { gv[j] = *(const GAS f32x4*)(g + j * 256 + lane * 4); bv[j] = *(const GAS f32x4*)(b + j * 256 + lane * 4); }
    for (int r = gw; r < NTOKF; r += NGW) {
        const float* zr = Z + (size_t)r * 2048;
        f32x4 v[8]; float s = 0.f;
#pragma unroll
        for (int j = 0; j < 8; ++j) {
            if (ZBF) { const unsigned long long q = *((const GAS unsigned long long*)((const bf16*)Z + (size_t)r * 2048) + 64 * j + lane); const unsigned lo = (unsigned)q, hi = (unsigned)(q >> 32);
                v[j] = (f32x4){__builtin_bit_cast(float, lo << 16), __builtin_bit_cast(float, lo & 0xffff0000u), __builtin_bit_cast(float, hi << 16), __builtin_bit_cast(float, hi & 0xffff0000u)}; }
            else v[j] = *(const GAS f32x4*)(zr + j * 256 + lane * 4);
            s += (v[j].x + v[j].y) + (v[j].z + v[j].w); }
        const float mean = wave_sum_f(s) * (1.f / 2048.f); float s2 = 0.f;
#pragma unroll
        for (int j = 0; j < 8; ++j) { v[j] = v[j] - mean; s2 += (v[j].x * v[j].x + v[j].y * v[j].y) + (v[j].z * v[j].z + v[j].w * v[j].w); }
        const float rstd = 1.f / sqrtf(wave_sum_f(s2) * (1.f / 2048.f) + 1e-5f);
#pragma unroll
        for (int j = 0; j < 8; ++j) { v[j] = v[j] * rstd * gv[j] + bv[j]; if (Xf) *(GAS f32x4*)(Xf + (size_t)r * 2048 + j * 256 + lane * 4) = v[j]; }
        if (Xq) {
            float am = 0.f;
#pragma unroll
            for (int j = 0; j < 8; ++j) am = fmaxf(am, fmaxf(fmaxf(fabsf(v[j].x), fabsf(v[j].y)), fmaxf(fabsf(v[j].z), fabsf(v[j].w))));
#pragma unroll
            for (int o = 1; o < 64; o <<= 1) am = fmaxf(am, __shfl_xor(am, o));
            const float sc = (am > 0.f) ? 127.f / am : 0.f;
            if (lane == 0) sx[r] = am * (1.f / 127.f);
#pragma unroll
            for (int j = 0; j < 8; ++j) *(GAS unsigned*)(Xq + (size_t)r * 2048 + j * 256 + lane * 4) = pack_i8x4(v[j], sc);
        }
        if (Xb) { GAS unsigned long long* o8 = (GAS unsigned long long*)(Xb + (size_t)r * 2048) + lane;
#pragma unroll
            for (int j = 0; j < 8; ++j) o8[64 * j] = (unsigned long long)pk2(v[j].x, v[j].y) | ((unsigned long long)pk2(v[j].z, v[j].w) << 32); }
    }
}
typedef __bf16 bf16x2_t __attribute__((ext_vector_type(2)));
typedef int i32x4 __attribute__((ext_vector_type(4)));
__device__ __forceinline__ unsigned fkey(float f) { const unsigned u = __builtin_bit_cast(unsigned, f); return (u & 0x80000000u) ? ~u : (u | 0x80000000u); }
__device__ __forceinline__ float keyf(unsigned k) { const unsigned u = (k & 0x80000000u) ? (k & 0x7fffffffu) : ~k; return __builtin_bit_cast(float, u); }
__device__ __forceinline__ float dot2bf(unsigned a, unsigned b, float c) { return __builtin_amdgcn_fdot2_f32_bf16(__builtin_bit_cast(bf16x2_t, a), __builtin_bit_cast(bf16x2_t, b), c, false); }
__device__ __forceinline__ float bflo(unsigned w) { return __builtin_bit_cast(float, w << 16); }
__device__ __forceinline__ float bfhi(unsigned w) { return __builtin_bit_cast(float, w & 0xffff0000u); }
__device__ __forceinline__ float gelu_tanh_g(float x) { const float u = x + 0.044715f * x * x * x; const float e = __builtin_amdgcn_exp2f(u * -2.302208198f); return x * __builtin_amdgcn_rcpf(1.0f + e); }
#define INS16(v, x) do { unsigned nw_ = (x); _Pragma("unroll") for (int k_ = 0; k_ < 16; ++k_) { const unsigned hi_ = max(v[k_], nw_); nw_ = min(v[k_], nw_); v[k_] = hi_; } } while (0)


#define CE_DESC(a, b) do { const unsigned hi_ = max(a, b), lo_ = min(a, b); a = hi_; b = lo_; } while (0)
__device__ __forceinline__ void sort16_desc(unsigned (&v)[16]) {
#pragma unroll
    for (int k = 2; k <= 16; k <<= 1)
#pragma unroll
        for (int j = k >> 1; j > 0; j >>= 1)
#pragma unroll
            for (int i = 0; i < 16; ++i) { const int l = i ^ j; if (l > i) { if ((i & k) == 0) CE_DESC(v[i], v[l]); else CE_DESC(v[l], v[i]); } }
}
__device__ __forceinline__ void merge_top16(unsigned (&a)[16], const unsigned (&b)[16]) {
#pragma unroll
    for (int i = 0; i < 16; ++i) a[i] = max(a[i], b[15 - i]);
#pragma unroll
    for (int sd = 8; sd >= 1; sd >>= 1)
#pragma unroll
        for (int i = 0; i < 16; ++i) if ((i & sd) == 0) CE_DESC(a[i], a[i + sd]);
}
static __device__ const unsigned char CAND_TAB[52] = {
    0, 1, 2, 3, 4, 5, 6, 7, 8, 9, 10, 11, 12, 13, 14, 15,
    16, 17, 18, 19, 20, 21, 22, 23,
    32, 33, 34, 35, 36,
    48, 49, 50, 51,
    64, 65, 66,
    80, 81,
    96, 97,
    112, 113,
    128, 144, 160, 176, 192, 208, 224, 240,
    255, 255 };

template <int MODE>
__device__ __forceinline__ void phase_topk(const bf16* QP, const bf16* SK, int* IDX, float* GT, float* AACC, float* SU, const float* rinvU, const float* rinvV, LAS unsigned char* lds, int vcu, int G, int wave, int lane) {
    LAS float* S = (LAS float*)lds;
    LAS unsigned char* NL = lds + 2 * 64 * 132 * 4;
    LAS float* FL = (LAS float*)(NL + 512 * 32);
    const int tid = wave * 64 + lane;
    for (int u = vcu; u < 136 * 8; u += G) {
        const int tt = u >> 3, h = u & 7;
        if (MODE != 1) {
            const int p = wave >> 2, rt = wave & 3, fr = lane & 15, fq = lane >> 4;
            const bf16* qrow = QP + (size_t)(tt * 64 + rt * 16 + fr) * 2048 + h * 256 + p * 128 + 8 * fq;
            bf16x8 af[4];
#pragma unroll
            for (int ks = 0; ks < 4; ++ks) af[ks] = *(const GAS bf16x8*)(qrow + ks * 32);
            const bf16* kbase = SK + (size_t)((h * 2 + p) * 128 + fr) * 128 + 8 * fq;
#pragma unroll 4
            for (int nt = 0; nt < 8; ++nt) {
                bf16x8 bfr[4];
#pragma unroll
                for (int ks = 0; ks < 4; ++ks) bfr[ks] = *(const GAS bf16x8*)(kbase + (size_t)nt * 16 * 128 + ks * 32);
                f32x4 acc = (f32x4){0.f, 0.f, 0.f, 0.f};
#pragma unroll
                for (int ks = 0; ks < 4; ++ks) acc = __builtin_amdgcn_mfma_f32_16x16x32_bf16(af[ks], bfr[ks], acc, 0, 0, 0);
                LAS float* sp = S + (size_t)(p * 64 + rt * 16 + fq * 4) * 132 + nt * 16 + fr;
                sp[0] = acc[0]; sp[132] = acc[1]; sp[264] = acc[2]; sp[396] = acc[3];
            }
        }
        __syncthreads();
        if (MODE != 2) {
            const int tl = lane >> 3, p = (lane >> 2) & 1, qr = lane & 3, t = wave * 8 + tl;
            unsigned own[16], oth_[16];
            const LAS f32x4* sp = (const LAS f32x4*)(S + (size_t)(p * 64 + t) * 132 + qr * 32);
#pragma unroll
            for (int c = 0; c < 4; ++c) { const f32x4 v = sp[c], w = sp[4 + c];
#pragma unroll
                for (int e = 0; e < 4; ++e) { own[c * 4 + e] = (fkey(v[e]) & ~127u) | (unsigned)(127 - (qr * 32 + c * 4 + e)); oth_[c * 4 + e] = (fkey(w[e]) & ~127u) | (unsigned)(127 - (qr * 32 + 16 + c * 4 + e)); } }
            sort16_desc(own); sort16_desc(oth_); merge_top16(own, oth_);
#pragma unroll
            for (int st = 1; st <= 2; st <<= 1) {
#pragma unroll
                for (int i = 0; i < 16; ++i) oth_[i] = (unsigned)__shfl_xor((int)own[i], st);
                merge_top16(own, oth_);
            }
            LAS unsigned char* nl = NL + tid * 32;
            LAS float* fl = FL + (tid >> 2) * 32;
#pragma unroll
            for (int i = 0; i < 16; ++i) { const unsigned oth = (unsigned)__shfl_xor((int)own[i], 4); const unsigned a0 = p ? oth : own[i], a1 = p ? own[i] : oth;
                if (qr == 0) { fl[i] = keyf(a0 & ~127u); fl[16 + i] = keyf(a1 & ~127u); }
                nl[i] = (unsigned char)(127u - (a0 & 127u)); nl[16 + i] = (unsigned char)(127u - (a1 & 127u)); }
            unsigned tv[16];
#pragma unroll
            for (int k = 0; k < 16; ++k) tv[k] = 0u;
#pragma unroll
            for (int m = 0; m < 13; ++m) { const unsigned c = CAND_TAB[m * 4 + qr]; unsigned key = 0u;
                if (c != 255u) { const float s = fl[c >> 4] + fl[16 + (c & 15u)]; key = (fkey(s) & ~255u) | (255u - c); }
                INS16(tv, key); }
#pragma unroll
            for (int st = 1; st <= 2; st <<= 1) {
#pragma unroll
                for (int i = 0; i < 16; ++i) oth_[i] = (unsigned)__shfl_xor((int)tv[i], st);
                merge_top16(tv, oth_);
            }
            float ev[16]; int ex[16]; float sum = 0.f; const float mx = keyf(tv[0] & ~255u);
#pragma unroll
            for (int k = 0; k < 16; ++k) { const unsigned c = 255u - (tv[k] & 255u); const int i = (int)(c >> 4), j = (int)(c & 15u);
                ex[k] = (int)nl[i] * 128 + (int)nl[16 + j]; ev[k] = __expf(keyf(tv[k] & ~255u) - mx); sum += ev[k]; }
            const float inv = 1.f / sum;
            if (MODE == 3) { if (ex[0] == 0x7fffffff) IDX[0] = (int)inv; }
            else if (p == 0 && qr == 0) {
                const size_t o = (size_t)(tt * 64 + t) * 128 + h * 16;
#pragma unroll
                for (int k4 = 0; k4 < 4; ++k4) { *(GAS i32x4*)(IDX + o + k4 * 4) = (i32x4){ex[k4 * 4], ex[k4 * 4 + 1], ex[k4 * 4 + 2], ex[k4 * 4 + 3]};
                    *(GAS f32x4*)(GT + o + k4 * 4) = (f32x4){ev[k4 * 4] * inv, ev[k4 * 4 + 1] * inv, ev[k4 * 4 + 2] * inv, ev[k4 * 4 + 3] * inv};
                    *(GAS f32x4*)(AACC + o + k4 * 4) = (f32x4){0.f, 0.f, 0.f, 0.f}; }
            }
        }
        __syncthreads();
    }
}

__device__ __forceinline__ void phase_upass(const bf16* U, const bf16* XBt, const int* IDX, const float* GT, float* WW, int vcu, int G, int wave, int lane) {
    const int gw = vcu * NWAVES + wave, NGW = G * NWAVES;
    for (int t = gw; t < NTOKF; t += NGW) {
        v4u xq[4];
#pragma unroll
        for (int j = 0; j < 4; ++j) xq[j] = *(const GAS v4u*)(XBt + (size_t)t * 2048 + j * 512 + lane * 8);
        const int ilo = IDX[(size_t)t * 128 + lane], ihi = IDX[(size_t)t * 128 + 64 + lane];
        float wlo = 0.f, whi = 0.f;
#pragma unroll 1
        for (int e0 = 0; e0 < 128; e0 += 4) {
            v4u uq[4][4];
#pragma unroll
            for (int ee = 0; ee < 4; ++ee) { const int e = e0 + ee; const int id = __builtin_amdgcn_readlane(e0 < 64 ? ilo : ihi, e & 63);
                const bf16* ur = U + (size_t)id * 2048 + lane * 8;
#pragma unroll
                for (int j = 0; j < 4; ++j) uq[ee][j] = *(const GAS v4u*)(ur + j * 512); }
#pragma unroll
            for (int ee = 0; ee < 4; ++ee) { float acc = 0.f;
#pragma unroll
                for (int j = 0; j < 4; ++j) { acc = dot2bf(uq[ee][j].x, xq[j].x, acc); acc = dot2bf(uq[ee][j].y, xq[j].y, acc); acc = dot2bf(uq[ee][j].z, xq[j].z, acc); acc = dot2bf(uq[ee][j].w, xq[j].w, acc); }
                acc = wave_sum_f(acc);
                const int e = e0 + ee;
                if (lane == (e & 63)) { if (e0 < 64) wlo = acc; else whi = acc; } }
        }
        WW[(size_t)t * 128 + lane] = gelu_tanh_g(wlo) * GT[(size_t)t * 128 + lane];
        WW[(size_t)t * 128 + 64 + lane] = gelu_tanh_g(whi) * GT[(size_t)t * 128 + 64 + lane];
    }
}

__device__ __forceinline__ void phase_vpass(const bf16* V, const float* Xf, const int* IDX, const float* WW, float* Z, float alpha, int vcu, int G, int wave, int lane) {
    const int gw = vcu * NWAVES + wave, NGW = G * NWAVES;
    for (int t = gw; t < NTOKF; t += NGW) {
        f32x4 acc[4][2];
#pragma unroll
        for (int j = 0; j < 4; ++j)
#pragma unroll
            for (int q = 0; q < 2; ++q) acc[j][q] = *(const GAS f32x4*)(Xf + (size_t)t * 2048 + j * 512 + lane * 8 + q * 4) * alpha;
        const int ilo = IDX[(size_t)t * 128 + lane], ihi = IDX[(size_t)t * 128 + 64 + lane];
        const float wlo = WW[(size_t)t * 128 + lane], whi = WW[(size_t)t * 128 + 64 + lane];
#pragma unroll 1
        for (int e0 = 0; e0 < 128; e0 += 4) {
            v4u vq[4][4]; float wv[4];
#pragma unroll
            for (int ee = 0; ee < 4; ++ee) { const int e = e0 + ee; const int id = __builtin_amdgcn_readlane(e0 < 64 ? ilo : ihi, e & 63);
                wv[ee] = __builtin_bit_cast(float, __builtin_amdgcn_readlane(__builtin_bit_cast(int, e0 < 64 ? wlo : whi), e & 63));
                const bf16* vr = V + (size_t)id * 2048 + lane * 8;
#pragma unroll
                for (int j = 0; j < 4; ++j) vq[ee][j] = *(const GAS v4u*)(vr + j * 512); }
#pragma unroll
            for (int ee = 0; ee < 4; ++ee)
#pragma unroll
                for (int j = 0; j < 4; ++j) { const v4u q = vq[ee][j]; const float w = wv[ee];
                    acc[j][0].x += w * bflo(q.x); acc[j][0].y += w * bfhi(q.x); acc[j][0].z += w * bflo(q.y); acc[j][0].w += w * bfhi(q.y);
                    acc[j][1].x += w * bflo(q.z); acc[j][1].y += w * bfhi(q.z); acc[j][1].z += w * bflo(q.w); acc[j][1].w += w * bfhi(q.w); }
        }
#pragma unroll
        for (int j = 0; j < 4; ++j)
#pragma unroll
            for (int q = 0; q < 2; ++q) *(GAS f32x4*)(Z + (size_t)t * 2048 + j * 512 + lane * 8 + q * 4) = acc[j][q];
    }
}

struct XTopo { int xi, nx, wq, nwq; };
__device__ __forceinline__ XTopo xcd_topology(unsigned* bar, unsigned x, unsigned rank, int wave) {
    XTopo t; int xi = 0, nx = 0, nloc = 1;
#pragma unroll
    for (unsigned j = 0; j < 16; ++j) { const unsigned c = xb_ld(&bar[XB_XCNT(j)]); if (c > 0u) { if (j < x) ++xi; ++nx; } if (j == x) nloc = (int)c; }
    if (nloc < 1) nloc = 1; if (nx < 1) nx = 1;
    t.xi = __builtin_amdgcn_readfirstlane(xi); t.nx = __builtin_amdgcn_readfirstlane(nx); t.wq = __builtin_amdgcn_readfirstlane((int)rank * NWAVES + wave); t.nwq = __builtin_amdgcn_readfirstlane(nloc * NWAVES); return t;
}
typedef float f32x2 __attribute__((ext_vector_type(2)));
template <int MODE>
__device__ __forceinline__ void upass_reduce_add(float (&acc)[16], float* ap, int lane) {
    const bool b2 = (lane & 4) != 0, b1 = (lane & 2) != 0, b0 = (lane & 1) != 0;
    float r8[8], r4[4], r2[2];
#pragma unroll
    for (int j = 0; j < 8; ++j) { const float keep = b2 ? acc[8 + j] : acc[j], send = b2 ? acc[j] : acc[8 + j]; r8[j] = keep + __shfl_xor(send, 4); }
#pragma unroll
    for (int j = 0; j < 4; ++j) { const float keep = b1 ? r8[4 + j] : r8[j], send = b1 ? r8[j] : r8[4 + j]; r4[j] = keep + __shfl_xor(send, 2); }
#pragma unroll
    for (int j = 0; j < 2; ++j) { const float keep = b0 ? r4[2 + j] : r4[j], send = b0 ? r4[j] : r4[2 + j]; r2[j] = keep + __shfl_xor(send, 1); }
    if (MODE == 1) { ap[0] = r2[0]; ap[64] = r2[1]; } else { unsafeAtomicAdd(ap, r2[0]); unsafeAtomicAdd(ap + 64, r2[1]); }
}
__device__ __forceinline__ float dot16_i8(const v4u q, const v4u x) {
    int a = __builtin_amdgcn_sdot4((int)q.x, (int)x.x, 0, false); a = __builtin_amdgcn_sdot4((int)q.y, (int)x.y, a, false);
    a = __builtin_amdgcn_sdot4((int)q.z, (int)x.z, a, false); a = __builtin_amdgcn_sdot4((int)q.w, (int)x.w, a, false);
    return (float)a;
}
__device__ __forceinline__ void unpack16bf(const v4u a, const v4u b, float (&xf)[16]) {
    xf[0] = bflo(a.x); xf[1] = bfhi(a.x); xf[2] = bflo(a.y); xf[3] = bfhi(a.y); xf[4] = bflo(a.z); xf[5] = bfhi(a.z); xf[6] = bflo(a.w); xf[7] = bfhi(a.w);
    xf[8] = bflo(b.x); xf[9] = bfhi(b.x); xf[10] = bflo(b.y); xf[11] = bfhi(b.y); xf[12] = bflo(b.z); xf[13] = bfhi(b.z); xf[14] = bflo(b.w); xf[15] = bfhi(b.w);
}
template <int MODE>
__device__ __forceinline__ void phase_upass_sl(const unsigned char* U, const unsigned char* XQ, const float* SX, const int* IDX, float* AACC, float* GT, float* SU, const float* rinvU, const float* rinvV, const XTopo tp, int lane0) {
#define UP_IDX(dst, tt) do { const int t_ = min((tt), NTOKF - 1); const int* ip_ = IDX + (size_t)t_ * 128 + (lane >> 3) * 8; dst[0] = *(const GAS i32x4*)ip_; dst[1] = *(const GAS i32x4*)(ip_ + 4); dst[2] = *(const GAS i32x4*)(ip_ + 64); dst[3] = *(const GAS i32x4*)(ip_ + 68); } while (0)
#define UP_SEL(id, s_) id[2 * ((s_) & 1) + ((s_) >> 3)][((s_) >> 1) & 3]
#define UP_GATHER8(dst, id, h) do { _Pragma("unroll") for (int j_ = 0; j_ < 8; ++j_) { if (MODE == 2) dst[j_] = (v4u){(unsigned)UP_SEL(id, 8 * (h) + j_), 0x38383838u, 0x38383838u, 0x38383838u}; else dst[j_] = __builtin_bit_cast(v4u, __builtin_amdgcn_raw_buffer_load_b128(urs, (UP_SEL(id, 8 * (h) + j_) << 7) + i * 16, 0, 0)); } } while (0)
#define UP_X(xa, xb, tt) do { const int t_ = min((tt), NTOKF - 1); xa = *(const GAS v4u*)(XQ + (size_t)t_ * 2048 + sl * 128 + (lane & 7) * 16); xb.x = __builtin_bit_cast(unsigned, SX[t_]); } while (0)
    for (int sl = tp.xi; sl < 16; sl += tp.nx) {
        int lane = lane0; asm volatile("" : "+v"(lane));
        const int g = lane >> 3, i = lane & 7;
        const __amdgpu_buffer_rsrc_t urs = __builtin_amdgcn_make_buffer_rsrc((void*)(U + (size_t)sl * 16384 * 128), 0, 16384 * 128, 0x00020000);
        i32x4 idn[4]; v4u qa[8], qb[8], xa, xb;
        UP_IDX(idn, tp.wq); UP_GATHER8(qa, idn, 0); UP_GATHER8(qb, idn, 1); UP_X(xa, xb, tp.wq); UP_IDX(idn, tp.wq + tp.nwq);
#pragma unroll 1
        for (int t = tp.wq; t < NTOKF; t += tp.nwq) {
            float acc[16]; const v4u xq_ = xa; const float sx_ = __builtin_bit_cast(float, xb.x);
#pragma unroll
            for (int j = 0; j < 8; ++j) acc[j] = dot16_i8(qa[j], xq_) * sx_;
            UP_GATHER8(qa, idn, 0);
#pragma unroll
            for (int j = 0; j < 8; ++j) acc[8 + j] = dot16_i8(qb[j], xq_) * sx_;
            UP_GATHER8(qb, idn, 1);
            UP_X(xa, xb, t + tp.nwq); UP_IDX(idn, t + 2 * tp.nwq);
            upass_reduce_add<MODE>(acc, AACC + (size_t)t * 128 + lane, lane);
            if (MODE == 0 && sl == tp.xi && ((t >> 8) % tp.nx) == tp.xi) {
                const size_t o_ = (size_t)t * 128 + lane; const int e0_ = IDX[o_], e1_ = IDX[o_ + 64];
                SU[o_] = rinvU[e0_]; SU[o_ + 64] = rinvU[e1_]; GT[o_] *= rinvV[e0_]; GT[o_ + 64] *= rinvV[e1_]; }
        }
    }
#undef UP_IDX
#undef UP_SEL
#undef UP_GATHER8
#undef UP_X
}
__device__ __forceinline__ void vpass_finish(const v4u (&vq)[16], const LAS float* wl, const float* Xf, float* Z, float alpha, int t, int sl, int lane) {
    const int g = lane >> 3, i = lane & 7;
    f32x4 w4[4];
#pragma unroll
    for (int q = 0; q < 4; ++q) w4[q] = *(const LAS f32x4*)(wl + g * 16 + q * 4);
    float acc[16];
#pragma unroll
    for (int c = 0; c < 16; ++c) acc[c] = 0.f;
#pragma unroll
    for (int j = 0; j < 16; ++j) { const float w = w4[j >> 2][j & 3]; const unsigned wd[4] = {vq[j].x, vq[j].y, vq[j].z, vq[j].w};
#pragma unroll
        for (int d = 0; d < 4; ++d) { const f32x2 lo = __builtin_amdgcn_cvt_pk_f32_fp8(wd[d], false), hi = __builtin_amdgcn_cvt_pk_f32_fp8(wd[d], true);
            acc[d * 4 + 0] += w * lo.x; acc[d * 4 + 1] += w * lo.y; acc[d * 4 + 2] += w * hi.x; acc[d * 4 + 3] += w * hi.y; } }
    const bool b3 = (lane & 8) != 0, b4 = (lane & 16) != 0, b5 = (lane & 32) != 0;
    float r8[8], r4[4], r2[2];
#pragma unroll
    for (int c = 0; c < 8; ++c) { const float keep = b3 ? acc[8 + c] : acc[c], send = b3 ? acc[c] : acc[8 + c]; r8[c] = keep + __shfl_xor(send, 8); }
#pragma unroll
    for (int c = 0; c < 4; ++c) { const float keep = b4 ? r8[4 + c] : r8[c], send = b4 ? r8[c] : r8[4 + c]; r4[c] = keep + __shfl_xor(send, 16); }
#pragma unroll
    for (int c = 0; c < 2; ++c) { const float keep = b5 ? r4[2 + c] : r4[c], send = b5 ? r4[c] : r4[2 + c]; r2[c] = keep + __shfl_xor(send, 32); }
    const int col = sl * 128 + i * 16 + (b3 ? 8 : 0) + (b4 ? 4 : 0) + (b5 ? 2 : 0);
    const f32x2 xr = *(const GAS f32x2*)(Xf + (size_t)t * 2048 + col);
    *(GAS f32x2*)(Z + (size_t)t * 2048 + col) = (f32x2){alpha * xr.x + r2[0], alpha * xr.y + r2[1]};
}
__device__ __forceinline__ int wave_max_bits(int x) {
    x = max(x, __builtin_amdgcn_update_dpp(x, x, 0x111, 0xf, 0xf, false));
    x = max(x, __builtin_amdgcn_update_dpp(x, x, 0x112, 0xf, 0xf, false));
    x = max(x, __builtin_amdgcn_update_dpp(x, x, 0x114, 0xf, 0xf, false));
    x = max(x, __builtin_amdgcn_update_dpp(x, x, 0x118, 0xf, 0xf, false));
    x = max(x, __builtin_amdgcn_update_dpp(x, x, 0x142, 0xa, 0xf, false));
    x = max(x, __builtin_amdgcn_update_dpp(x, x, 0x143, 0xc, 0xf, false));
    return __builtin_amdgcn_readlane(x, 63);
}
typedef unsigned u32x2v __attribute__((ext_vector_type(2)));
template <int MODE>
__device__ __forceinline__ void vpass_step(const v4u (&cur)[16], v4u (&nxt)[16], const i32x4 (&idin)[4], i32x4 (&idout)[4], const float (&scc)[6], float (&scn)[6], const u32x2v xr, u32x2v& xrn, const __amdgpu_buffer_rsrc_t vrs,
                                           const bf16* Xf, const int* IDX, const float* AACC, const float* SU, const float* GT, bf16* Z, float alpha, LAS float* wl, int t, int tn, int tnn, int sl, int lane0, bool live = true) {
    int lane = lane0; asm volatile("" : "+v"(lane));
    const int g = lane >> 3, i = lane & 7;
#pragma unroll
    for (int q = 0; q < 4; ++q) idout[q] = *(const GAS i32x4*)(IDX + (size_t)tnn * 128 + g * 16 + q * 4);
    if (MODE == 7) { scn[0] = 0.5f; scn[1] = 0.25f; scn[2] = 1.f; scn[3] = 1.f; scn[4] = (float)tn; scn[5] = 1.f; } else
    { const size_t o0 = (size_t)tn * 128 + lane; scn[0] = AACC[o0]; scn[1] = AACC[o0 + 64]; scn[2] = SU[o0]; scn[3] = SU[o0 + 64]; scn[4] = GT[o0]; scn[5] = GT[o0 + 64]; }
    const bool hv = (lane & 32) != 0, valid = (((lane >> 5) ^ (lane >> 3)) & 1) == 0;
    const int col = sl * 128 + (hv ? 64 : 0) + ((lane >> 4) & 1) * 32 + (i >> 2) * 16 + (i & 3) * 4;
    if (MODE != 3) xrn = *(const GAS u32x2v*)(Xf + (size_t)tn * 2048 + col);
    __builtin_amdgcn_sched_barrier(0);
#pragma unroll
    for (int j = 0; j < 16; ++j) { if (MODE == 1) nxt[j] = (v4u){(unsigned)idin[j >> 2][j & 3], 0x38383838u, 0x38383838u, 0x38383838u}; else nxt[j] = __builtin_bit_cast(v4u, __builtin_amdgcn_raw_buffer_load_b128(vrs, (idin[j >> 2][j & 3] << 7) + i * 16, 0, 0)); }
    __builtin_amdgcn_sched_barrier(0);
    const float w0 = gelu_tanh_g(scc[0] * scc[2]) * scc[4], w1 = gelu_tanh_g(scc[1] * scc[3]) * scc[5];
    const int e8 = max(wave_max_bits(__builtin_bit_cast(int, fmaxf(fabsf(w0), fabsf(w1)))) >> 23, 8);
    const float S = __builtin_bit_cast(float, (261 - e8) << 23), invS = __builtin_bit_cast(float, (e8 - 7) << 23);
    wl[lane] = w0 * S; wl[64 + lane] = w1 * S;
    if (MODE == 2) { unsigned s_ = 0u;
#pragma unroll
        for (int j = 0; j < 16; ++j) s_ += cur[j].x ^ cur[j].y ^ cur[j].z ^ cur[j].w;
        if (s_ == 0x12345u) Z[(size_t)t * 2048 + sl * 128 + lane] = 1; }
    else {
        f32x4 w4[4];
#pragma unroll
        for (int q = 0; q < 4; ++q) w4[q] = *(const LAS f32x4*)(wl + g * 16 + q * 4);
        const int p8 = (lane & 3) * 8;
        const unsigned selp = 0x0c0c0c0cu & ~(0xffu << p8);
        const unsigned selLo = (lane & 4) ? 0x0c0c0c0cu : selp, selHi = (lane & 4) ? selp : 0x0c0c0c0cu;
        f32x4 D1 = {0.f, 0.f, 0.f, 0.f}, D2 = {0.f, 0.f, 0.f, 0.f};
#pragma unroll
        for (int j = 0; j < 16; ++j) {
            const unsigned tb = (unsigned)__builtin_amdgcn_cvt_pk_fp8_f32(w4[j >> 2][j & 3], 0.f, 0, false);
            const unsigned alo = __builtin_amdgcn_perm(0u, tb, selLo), ahi = __builtin_amdgcn_perm(0u, tb, selHi);
            const long A = (long)(((unsigned long)ahi << 32) | (unsigned long)alo);
            const long B1 = (long)(((unsigned long)cur[j].y << 32) | (unsigned long)cur[j].x), B2 = (long)(((unsigned long)cur[j].w << 32) | (unsigned long)cur[j].z);
            D1 = __builtin_amdgcn_mfma_f32_16x16x32_fp8_fp8(A, B1, D1, 0, 0, 0);
            D2 = __builtin_amdgcn_mfma_f32_16x16x32_fp8_fp8(A, B2, D2, 0, 0, 0);
        }
        f32x4 o;
#pragma unroll
        for (int r = 0; r < 4; ++r) { const float snd = hv ? D1[r] : D2[r], own = hv ? D2[r] : D1[r]; const unsigned xw = (r & 2) ? xr.y : xr.x; const float xv = (r & 1) ? bfhi(xw) : bflo(xw); o[r] = alpha * xv + (own + __shfl_xor(snd, 40)) * invS; }
        u32x2v ob; ob.x = pk2(o[0], o[1]); ob.y = pk2(o[2], o[3]);
        if (MODE == 3 || MODE == 4) { if (o[0] + o[1] + o[2] + o[3] == 1.2345f) *(GAS u32x2v*)(Z + (size_t)t * 2048 + col) = ob; } else
        if (MODE == 6) { if (valid && live) *(GAS u32x2v*)(Z + (size_t)(t & 127) * 2048 + col) = ob; } else
        if (valid && live) *(GAS u32x2v*)(Z + (size_t)t * 2048 + col) = ob;
    }
}
template <int MODE>
__device__ __forceinline__ void phase_vpass_sl(const unsigned char* V, const bf16* Xf, const int* IDX, const float* AACC, const float* SU, const float* GT, bf16* Z, float alpha, const XTopo tp, LAS unsigned char* lds, int wave, int lane_in) {
    const int lane0 = lane_in;
    LAS float* wl = (LAS float*)lds + wave * 128;
    for (int sl = tp.xi; sl < 16; sl += tp.nx) {
        const __amdgpu_buffer_rsrc_t vrs = __builtin_amdgcn_make_buffer_rsrc((void*)(V + (size_t)sl * 16384 * 128), 0, 16384 * 128, 0x00020000);
        v4u vqA[16], vqB[16]; i32x4 idA[4], idB[4]; float scA[6], scB[6]; u32x2v xrA = {0u, 0u}, xrB = {0u, 0u};
        {   int lane = lane0; asm volatile("" : "+v"(lane));
            const int g = lane >> 3, i = lane & 7, t0 = tp.wq, t1 = min(tp.wq + tp.nwq, NTOKF - 1);
#pragma unroll
            for (int q = 0; q < 4; ++q) { idA[q] = *(const GAS i32x4*)(IDX + (size_t)t0 * 128 + g * 16 + q * 4); idB[q] = *(const GAS i32x4*)(IDX + (size_t)t1 * 128 + g * 16 + q * 4); }
            const size_t o0 = (size_t)t0 * 128 + lane; scA[0] = AACC[o0]; scA[1] = AACC[o0 + 64]; scA[2] = SU[o0]; scA[3] = SU[o0 + 64]; scA[4] = GT[o0]; scA[5] = GT[o0 + 64];
            if (MODE != 3) xrA = *(const GAS u32x2v*)(Xf + (size_t)t0 * 2048 + sl * 128 + ((lane & 32) ? 64 : 0) + ((lane >> 4) & 1) * 32 + (i >> 2) * 16 + (i & 3) * 4);
            __builtin_amdgcn_sched_barrier(0);
#pragma unroll
            for (int j = 0; j < 16; ++j) { if (MODE == 1) vqA[j] = (v4u){(unsigned)idA[j >> 2][j & 3], 0x38383838u, 0x38383838u, 0x38383838u}; else vqA[j] = __builtin_bit_cast(v4u, __builtin_amdgcn_raw_buffer_load_b128(vrs, (idA[j >> 2][j & 3] << 7) + i * 16, 0, 0)); }
        }
#pragma unroll 1
        for (int t = tp.wq; t < NTOKF; t += 2 * tp.nwq) {
            const int t1 = min(t + tp.nwq, NTOKF - 1), t2 = min(t + 2 * tp.nwq, NTOKF - 1), t3 = min(t + 3 * tp.nwq, NTOKF - 1);
            vpass_step<MODE>(vqA, vqB, idB, idA, scA, scB, xrA, xrB, vrs, Xf, IDX, AACC, SU, GT, Z, alpha, wl, t, t1, t2, sl, lane0);
            vpass_step<MODE>(vqB, vqA, idA, idB, scB, scA, xrB, xrA, vrs, Xf, IDX, AACC, SU, GT, Z, alpha, wl, t1, t2, t3, sl, lane0, t + tp.nwq < NTOKF);
        }
    }
}
typedef short s16x4 __attribute__((ext_vector_type(4)));
typedef unsigned u32x2 __attribute__((ext_vector_type(2)));
template <int MODE>
__device__ __forceinline__ void phase_spatial(const bf16* UB, const bf16* VB, const float* VST, const float* lng, const float* lnb, const bf16* WSB, const float* wsf, const float* bs,
                                              bf16* UM, float* vs_out, LAS unsigned char* lds, int vcu, int G, int wave, int lane) {
    constexpr int PITCH = 136;
    LAS bf16* T = (LAS bf16*)lds;
    LAS bf16* WS = (LAS bf16*)(lds + 128 * PITCH * 2);
    const int tid = wave * 64 + lane;
    const int nbg = G >> 3, g = (nbg > 0) ? vcu / nbg : 0, jb = (nbg > 0) ? vcu % nbg : 0;
    if (MODE != 1 && nbg > 0 && g < 8) {
        for (int i = tid; i < 128 * 16; i += 512) { const int t = i >> 4, ch = i & 15; *(LAS v4u*)(WS + t * 128 + ((ch ^ (t & 15)) << 3)) = *(const GAS v4u*)(WSB + (size_t)(g * 128 + t) * 128 + ch * 8); }
        const int s_ = tid >> 2, cq_ = (tid & 3) * 32;
        v4u pvq[4]; float ps1 = 1.f, ps2 = 2.f;
        if (MODE == 2) pvq[0] = pvq[1] = pvq[2] = pvq[3] = (v4u){0x3f803f80u, 0x3f803f80u, 0x3f803f80u, 0x3f803f80u};
        else if (jb < 384) { const int ck = jb / 6, cb = g * 6 + jb % 6; const size_t r = (size_t)ck * 128 + s_;
            ps1 = VST[r * 2]; ps2 = VST[r * 2 + 1];
#pragma unroll
            for (int i = 0; i < 4; ++i) pvq[i] = *(const GAS v4u*)(VB + r * 6144 + cb * 128 + cq_ + i * 8); }
        for (int u = jb; u < 384; u += nbg) {
            const int ck = u / 6, cb = g * 6 + u % 6;
            const size_t row0 = (size_t)ck * 128; const int col0 = cb * 128;
            u32x2 uq[8]; float bsv[8];
            { const int fr = lane & 15, fq = lane >> 4, c0 = 16 * wave;
#pragma unroll
              for (int jt = 0; jt < 8; ++jt) { const int t = jt * 16 + fr; if (MODE == 3) uq[jt] = (u32x2){0x3f803f80u, 0x3f803f80u}; else uq[jt] = *(const GAS u32x2*)(UB + (row0 + t) * 6144 + col0 + c0 + 4 * fq); bsv[jt] = bs[g * 128 + t]; } }
            {
                const float mu = ps1 * (1.f / 6144.f); const float rstd = rsqrtf(ps2 * (1.f / 6144.f) - mu * mu + 1e-5f);
#pragma unroll
                for (int i = 0; i < 4; ++i) { const v4u q = pvq[i];
                    const float* gp = lng + col0 + cq_ + i * 8; const float* bp = lnb + col0 + cq_ + i * 8;
                    const f32x4 g0 = *(const GAS f32x4*)gp, g1 = *(const GAS f32x4*)(gp + 4), b0 = *(const GAS f32x4*)bp, b1 = *(const GAS f32x4*)(bp + 4);
                    v4u o;
                    o.x = pk2((bflo(q.x) - mu) * rstd * g0.x + b0.x, (bfhi(q.x) - mu) * rstd * g0.y + b0.y);
                    o.y = pk2((bflo(q.y) - mu) * rstd * g0.z + b0.z, (bfhi(q.y) - mu) * rstd * g0.w + b0.w);
                    o.z = pk2((bflo(q.z) - mu) * rstd * g1.x + b1.x, (bfhi(q.z) - mu) * rstd * g1.y + b1.y);
                    o.w = pk2((bflo(q.w) - mu) * rstd * g1.z + b1.z, (bfhi(q.w) - mu) * rstd * g1.w + b1.w);
                    *(LAS v4u*)(T + s_ * PITCH + cq_ + i * 8) = o; }
            }
            __syncthreads();
            {
                const int fr = lane & 15, fq = lane >> 4, qq = fr >> 2, pp = fr & 3, c0 = 16 * wave;
                if (MODE != 2 && u + nbg < 384) { const int un = u + nbg, ckn = un / 6, cbn = g * 6 + un % 6; const size_t r = (size_t)ckn * 128 + s_;
                    ps1 = VST[r * 2]; ps2 = VST[r * 2 + 1];
#pragma unroll
                    for (int i = 0; i < 4; ++i) pvq[i] = *(const GAS v4u*)(VB + r * 6144 + cbn * 128 + cq_ + i * 8); }
                bf16x8 af[4];
#pragma unroll
                for (int ks = 0; ks < 4; ++ks) {
                    const s16x4 r0 = __builtin_amdgcn_ds_read_tr16_b64_v4i16((LAS s16x4*)(T + (32 * ks + 8 * fq + qq) * PITCH + c0 + 4 * pp));
                    const s16x4 r1 = __builtin_amdgcn_ds_read_tr16_b64_v4i16((LAS s16x4*)(T + (32 * ks + 8 * fq + 4 + qq) * PITCH + c0 + 4 * pp));
                    af[ks] = (bf16x8){r0.x, r0.y, r0.z, r0.w, r1.x, r1.y, r1.z, r1.w};
                }
                f32x4 acc[8];
#pragma unroll
                for (int jt = 0; jt < 8; ++jt) {
                    acc[jt] = (f32x4){0.f, 0.f, 0.f, 0.f};
#pragma unroll
                    for (int ks = 0; ks < 4; ++ks) if (ks <= (jt >> 1)) { const bf16x8 bfr = *(const LAS bf16x8*)(WS + (jt * 16 + fr) * 128 + (((ks * 4 + fq) ^ fr) << 3)); acc[jt] = __builtin_amdgcn_mfma_f32_16x16x32_bf16(af[ks], bfr, acc[jt], 0, 0, 0); }
                }
#pragma unroll
                for (int jt = 0; jt < 8; ++jt) {
                    const int t = jt * 16 + fr; const size_t off = (row0 + t) * 6144 + col0 + c0 + 4 * fq;
                    u32x2 o; o.x = pk2(bflo(uq[jt].x) * (acc[jt][0] + bsv[jt]), bfhi(uq[jt].x) * (acc[jt][1] + bsv[jt])); o.y = pk2(bflo(uq[jt].y) * (acc[jt][2] + bsv[jt]), bfhi(uq[jt].y) * (acc[jt][3] + bsv[jt]));
                    if (MODE == 3) { if (o.x == 0x12345u) *(GAS u32x2*)(UM + off) = o; } else *(GAS u32x2*)(UM + off) = o;
                }
            }
            __syncthreads();
        }
    }
    if (MODE == 0 || MODE == 1) for (int it = vcu * 512 + tid; it < 128 * 768; it += G * 512) {
        const int sq = it / 768, c8 = (it % 768) * 8, gg = c8 / 768;
        const size_t r0 = 8192 + (size_t)sq * 4;
        const f32x4 g0 = *(const GAS f32x4*)(lng + c8), g1 = *(const GAS f32x4*)(lng + c8 + 4), b0 = *(const GAS f32x4*)(lnb + c8), b1 = *(const GAS f32x4*)(lnb + c8 + 4);
        v4u vq4[4], uq4[4]; float st1[4], st2[4], bsv4[4], wv[4][4];
#pragma unroll
        for (int s = 0; s < 4; ++s) { st1[s] = VST[(r0 + s) * 2]; st2[s] = VST[(r0 + s) * 2 + 1]; vq4[s] = *(const GAS v4u*)(VB + (r0 + s) * 6144 + c8); uq4[s] = *(const GAS v4u*)(UB + (r0 + s) * 6144 + c8); bsv4[s] = bs[gg * 128 + s];
#pragma unroll
            for (int s2 = 0; s2 < 4; ++s2) wv[s][s2] = (s2 <= s) ? wsf[(size_t)(gg * 128 + s) * 128 + s2] : 0.f; }
        float vn[4][8];
#pragma unroll
        for (int s = 0; s < 4; ++s) {
            const float mu = st1[s] * (1.f / 6144.f); const float rstd = rsqrtf(st2[s] * (1.f / 6144.f) - mu * mu + 1e-5f); const v4u q = vq4[s];
            vn[s][0] = (bflo(q.x) - mu) * rstd * g0.x + b0.x; vn[s][1] = (bfhi(q.x) - mu) * rstd * g0.y + b0.y; vn[s][2] = (bflo(q.y) - mu) * rstd * g0.z + b0.z; vn[s][3] = (bfhi(q.y) - mu) * rstd * g0.w + b0.w;
            vn[s][4] = (bflo(q.z) - mu) * rstd * g1.x + b1.x; vn[s][5] = (bfhi(q.z) - mu) * rstd * g1.y + b1.y; vn[s][6] = (bflo(q.w) - mu) * rstd * g1.z + b1.z; vn[s][7] = (bfhi(q.w) - mu) * rstd * g1.w + b1.w;
        }
#pragma unroll
        for (int s = 0; s < 4; ++s) { float* vo = vs_out + ((size_t)sq * 4 + s) * 6144 + c8;
            *(GAS f32x4*)vo = (f32x4){vn[s][0], vn[s][1], vn[s][2], vn[s][3]}; *(GAS f32x4*)(vo + 4) = (f32x4){vn[s][4], vn[s][5], vn[s][6], vn[s][7]}; }
#pragma unroll
        for (int t = 0; t < 4; ++t) {
            float mx[8];
#pragma unroll
            for (int e = 0; e < 8; ++e) mx[e] = bsv4[t];
#pragma unroll
            for (int s = 0; s < 4; ++s) if (s <= t) {
#pragma unroll
                for (int e = 0; e < 8; ++e) mx[e] += wv[t][s] * vn[s][e]; }
            const v4u uq = uq4[t];
            v4u o; o.x = pk2(bflo(uq.x) * mx[0], bfhi(uq.x) * mx[1]); o.y = pk2(bflo(uq.y) * mx[2], bfhi(uq.y) * mx[3]); o.z = pk2(bflo(uq.z) * mx[4], bfhi(uq.z) * mx[5]); o.w = pk2(bflo(uq.w) * mx[6], bfhi(uq.w) * mx[7]);
            *(GAS v4u*)(UM + (r0 + t) * 6144 + c8) = o;
        }
    }
}
__device__ __forceinline__ float wave_scan_add(float v, int lane) {
#pragma unroll
    for (int o = 1; o < 64; o <<= 1) { const float t = __shfl_up(v, o); if (lane >= o) v += t; }
    return v;
}
__device__ __forceinline__ float wave_scan_max(float v, int lane) {
#pragma unroll
    for (int o = 1; o < 64; o <<= 1) { const float t = __shfl_up(v, o); if (lane >= o) v = fmaxf(v, t); }
    return v;
}
__device__ __forceinline__ bf16x8 tr_frag2(const LAS bf16* p0, const LAS bf16* p1) {
    const s16x4 r0 = __builtin_amdgcn_ds_read_tr16_b64_v4i16((LAS s16x4*)p0);
    const s16x4 r1 = __builtin_amdgcn_ds_read_tr16_b64_v4i16((LAS s16x4*)p1);
    return (bf16x8){r0.x, r0.y, r0.z, r0.w, r1.x, r1.y, r1.z, r1.w};
}
__device__ __forceinline__ bf16x8 tr_frag(const LAS bf16* p0, int rowstep4) { return tr_frag2(p0, p0 + rowstep4); }
__device__ __forceinline__ int qk_off(int row, int chunk) { return row * 128 + ((chunk ^ (row & 15)) << 3); }
__device__ __forceinline__ int v_off(int row, int chunk) { return row * 256 + ((chunk ^ (row & 7)) << 3); }
__device__ __forceinline__ int p_off(int row, int chunk) { return row * 64 + ((chunk ^ ((row >> 1) & 7)) << 3); }

__device__ __forceinline__ void mlstm_prompt_seq(const bf16* QKVO, const float* GATES, const float* hn_gain, bf16* HN, float* Cp, float* np_, float* mp, int seq, int h, LAS unsigned char* lds, int wave, int lane) {
    LAS bf16* Qs = (LAS bf16*)lds;
    LAS bf16* Ks = (LAS bf16*)(lds + 16384);
    LAS bf16* Vs = (LAS bf16*)(lds + 32768);
    LAS bf16* Cd = (LAS bf16*)(lds + 65536) + wave * 4096;
    LAS unsigned char* hi = lds + RING_BYTES + 512;
    LAS bf16* Ps = (LAS bf16*)hi;
    LAS float* A_ = (LAS float*)(hi + 8192);
    LAS float* M_ = A_ + 64;
    LAS float* B_ = M_ + 64;
    LAS float* SC = B_ + 64;
    LAS float* X_ = SC + 4;
    LAS bf16* nd = (LAS bf16*)(X_ + 1024);
    LAS float* GN = X_ + 1024 + 64;
    const int tid = wave * 64 + lane, fr = lane & 15, fq = lane >> 4;
    const size_t row0 = (size_t)seq * 2048;
    for (int i = tid; i < 65536 / 16; i += 512) ((LAS v4u*)(lds + 65536))[i] = (v4u){0u, 0u, 0u, 0u};
    if (tid < 16) ((LAS v4u*)nd)[tid] = (v4u){0u, 0u, 0u, 0u};
    if (tid < 256) GN[tid] = hn_gain[h * 256 + tid];
    float nreg = 0.f;
    f32x4 Cacc[2][8];
#pragma unroll
    for (int it = 0; it < 2; ++it)
#pragma unroll
        for (int jd = 0; jd < 8; ++jd) Cacc[it][jd] = (f32x4){0.f, 0.f, 0.f, 0.f};
    float m = 0.f;
    const bf16x8 ones = (fr == 0) ? (bf16x8){0x3F80, 0x3F80, 0x3F80, 0x3F80, 0x3F80, 0x3F80, 0x3F80, 0x3F80} : (bf16x8){0, 0, 0, 0, 0, 0, 0, 0};
    const int srow = tid >> 3, sc16 = (tid & 7) * 16, sc32 = (tid & 7) * 32;
    v4u pq[2], pk[2], pv[4];
    {   const bf16* r = QKVO + (row0 + srow) * 6144;
#pragma unroll
        for (int i = 0; i < 2; ++i) { pq[i] = *(const GAS v4u*)(r + h * 128 + sc16 + i * 8); pk[i] = *(const GAS v4u*)(r + 1024 + h * 128 + sc16 + i * 8); }
#pragma unroll
        for (int i = 0; i < 4; ++i) pv[i] = *(const GAS v4u*)(r + 2048 + h * 256 + sc32 + i * 8); }
    float ig_n = 0.f, lf_n = 0.f;
    if (wave == 0) { ig_n = GATES[(row0 + lane) * 16 + h]; lf_n = GATES[(row0 + lane) * 16 + 8 + h]; }
    __syncthreads();
#pragma unroll 1
    for (int c = 0; c < 32; ++c) {
        const size_t rb = row0 + (size_t)c * 64;
        int fr_l = lane & 15, fq_l = lane >> 4; asm volatile("" : "+v"(fr_l), "+v"(fq_l));
        const int fr = fr_l, fq = fq_l;
#pragma unroll
        for (int i = 0; i < 2; ++i) { *(LAS v4u*)(Qs + qk_off(srow, (sc16 >> 3) + i)) = pq[i]; *(LAS v4u*)(Ks + qk_off(srow, (sc16 >> 3) + i)) = pk[i]; }
#pragma unroll
        for (int i = 0; i < 4; ++i) *(LAS v4u*)(Vs + v_off(srow, (sc32 >> 3) + i)) = pv[i];
        if (c + 1 < 32) { const bf16* r = QKVO + (rb + 64 + srow) * 6144;
#pragma unroll
            for (int i = 0; i < 2; ++i) { pq[i] = *(const GAS v4u*)(r + h * 128 + sc16 + i * 8); pk[i] = *(const GAS v4u*)(r + 1024 + h * 128 + sc16 + i * 8); }
#pragma unroll
            for (int i = 0; i < 4; ++i) pv[i] = *(const GAS v4u*)(r + 2048 + h * 256 + sc32 + i * 8); }
        if (wave == 0) {
            const float ig = ig_n, lf = lf_n;
            if (c + 1 < 32) { ig_n = GATES[(rb + 64 + lane) * 16 + h]; lf_n = GATES[(rb + 64 + lane) * 16 + 8 + h]; }
            const float b = wave_scan_add(lf, lane); const float a = ig - b; const float pm = wave_scan_max(a, lane);
            const float Mt = fmaxf(m, pm);
            A_[lane] = a; M_[lane] = Mt; B_[lane] = b;
            const float M63 = __shfl(Mt, 63), b63 = __shfl(b, 63);
            if (lane == 0) { SC[0] = __expf(m - M63); SC[1] = b63 + M63; SC[2] = m; }
            m = b63 + M63;
        }
        __syncthreads();
        f32x4 nacc[3][4];
#pragma unroll
        for (int it = 0; it < 3; ++it)
#pragma unroll
            for (int jt = 0; jt < 4; ++jt) nacc[it][jt] = (f32x4){0.f, 0.f, 0.f, 0.f};
#pragma unroll 1
        for (int ks = 0; ks < 4; ++ks) {
            bf16x8 ca[3];
#pragma unroll
            for (int it = 0; it < 2; ++it) ca[it] = tr_frag(Cd + (32 * ks + 8 * fq + (fr >> 2)) * 32 + 16 * it + 4 * (fr & 3), 4 * 32);
            ca[2] = (fr == 0) ? *(const LAS bf16x8*)(nd + 32 * ks + 8 * fq) : (bf16x8){0, 0, 0, 0, 0, 0, 0, 0};
#pragma unroll
            for (int jt = 0; jt < 4; ++jt) { const bf16x8 qb = *(const LAS bf16x8*)(Qs + qk_off(16 * jt + fr, 4 * ks + fq));
#pragma unroll
                for (int it = 0; it < 3; ++it) nacc[it][jt] = __builtin_amdgcn_mfma_f32_16x16x32_bf16(ca[it], qb, nacc[it][jt], 0, 0, 0); }
        }
#pragma unroll
        for (int jt = 0; jt < 4; ++jt) { const float mt = M_[16 * jt + fr]; const float wi = __expf(SC[2] - mt);
#pragma unroll
            for (int it = 0; it < 3; ++it) nacc[it][jt] = nacc[it][jt] * wi; }
        {
#pragma unroll 1
            for (int ti = wave; ti < 16; ti += 8) {
                int tt, st;
                if (ti < 10) { tt = (ti >= 6) ? 3 : (ti >= 3) ? 2 : (ti >= 1) ? 1 : 0; st = ti - (tt * (tt + 1)) / 2; }
                else { const int z = ti - 10; tt = (z >= 5) ? 2 : (z >= 3) ? 1 : 0; st = (z >= 5) ? 3 : (z >= 3) ? (z - 3 + 2) : (z + 1); }
                u32x2 o = (u32x2){0u, 0u};
                if (ti < 10) {
                    f32x4 sa = (f32x4){0.f, 0.f, 0.f, 0.f};
#pragma unroll
                    for (int ks = 0; ks < 4; ++ks) { const bf16x8 ka = *(const LAS bf16x8*)(Ks + qk_off(16 * st + fr, 4 * ks + fq)); const bf16x8 qb = *(const LAS bf16x8*)(Qs + qk_off(16 * tt + fr, 4 * ks + fq));
                        sa = __builtin_amdgcn_mfma_f32_16x16x32_bf16(ka, qb, sa, 0, 0, 0); }
                    const int t = 16 * tt + fr, s0 = 16 * st + 4 * fq; const float mt = M_[t];
                    float pvv[4];
#pragma unroll
                    for (int r = 0; r < 4; ++r) pvv[r] = (s0 + r <= t) ? sa[r] * __expf(A_[s0 + r] - mt) : 0.f;
                    o.x = pk2(pvv[0], pvv[1]); o.y = pk2(pvv[2], pvv[3]);
                }
                *(LAS u32x2*)(Ps + p_off(16 * tt + fr, 2 * st + (fq >> 1)) + 4 * (fq & 1)) = o;
            }
        }
        __syncthreads();
        {   const float M63 = M_[63]; const float wk = __expf(A_[srow] - M63);
#pragma unroll
            for (int i = 0; i < 2; ++i) { v4u q = *(LAS v4u*)(Ks + qk_off(srow, (sc16 >> 3) + i));
                q.x = pk2(bflo(q.x) * wk, bfhi(q.x) * wk); q.y = pk2(bflo(q.y) * wk, bfhi(q.y) * wk); q.z = pk2(bflo(q.z) * wk, bfhi(q.z) * wk); q.w = pk2(bflo(q.w) * wk, bfhi(q.w) * wk);
                *(LAS v4u*)(Ks + qk_off(srow, (sc16 >> 3) + i)) = q; } }
        bf16x8 va[2][2];
#pragma unroll
        for (int ks = 0; ks < 2; ++ks)
#pragma unroll
            for (int it = 0; it < 2; ++it) { const int r_ = 32 * ks + 8 * fq + (fr >> 2), ch_ = 4 * wave + 2 * it + ((fr & 3) >> 1), w_ = 4 * (fr & 1); va[ks][it] = tr_frag2(Vs + v_off(r_, ch_) + w_, Vs + v_off(r_ + 4, ch_) + w_); }
#pragma unroll
        for (int ks = 0; ks < 2; ++ks)
#pragma unroll
            for (int jt = 0; jt < 4; ++jt) { const bf16x8 pb = *(const LAS bf16x8*)(Ps + p_off(16 * jt + fr, 4 * ks + fq));
                nacc[0][jt] = __builtin_amdgcn_mfma_f32_16x16x32_bf16(va[ks][0], pb, nacc[0][jt], 0, 0, 0);
                nacc[1][jt] = __builtin_amdgcn_mfma_f32_16x16x32_bf16(va[ks][1], pb, nacc[1][jt], 0, 0, 0);
                nacc[2][jt] = __builtin_amdgcn_mfma_f32_16x16x32_bf16(ones, pb, nacc[2][jt], 0, 0, 0); }
        u32x2 oq[4][2];
#pragma unroll
        for (int jt = 0; jt < 4; ++jt)
#pragma unroll
            for (int it = 0; it < 2; ++it) oq[jt][it] = *(const GAS u32x2*)(QKVO + (rb + 16 * jt + fr) * 6144 + 4096 + h * 256 + 32 * wave + 16 * it + 4 * fq);
        float s1[4], s2[4];
#pragma unroll
        for (int jt = 0; jt < 4; ++jt) {
            const int t = 16 * jt + fr;
            const float den = __shfl(nacc[2][jt][0], fr);
            const float dd = fmaxf(fabsf(den), __expf(-(B_[t] + M_[t]))); const float inv = 1.f / dd;
            s1[jt] = 0.f; s2[jt] = 0.f;
#pragma unroll
            for (int it = 0; it < 2; ++it) { const u32x2 oq_ = oq[jt][it];
                const float og[4] = {bflo(oq_.x), bfhi(oq_.x), bflo(oq_.y), bfhi(oq_.y)};
#pragma unroll
                for (int r = 0; r < 4; ++r) { const float hv = nacc[it][jt][r] * inv * __builtin_amdgcn_rcpf(1.f + __expf(-og[r])); nacc[it][jt][r] = hv; s1[jt] += hv; s2[jt] += hv * hv; } }
            s1[jt] += __shfl_xor(s1[jt], 16); s1[jt] += __shfl_xor(s1[jt], 32); s2[jt] += __shfl_xor(s2[jt], 16); s2[jt] += __shfl_xor(s2[jt], 32);
            if (fq == 0) { X_[(wave * 64 + t) * 2] = s1[jt]; X_[(wave * 64 + t) * 2 + 1] = s2[jt]; }
        }
        __syncthreads();
#pragma unroll
        for (int jt = 0; jt < 4; ++jt) {
            const int t = 16 * jt + fr; float a1 = 0.f, a2 = 0.f;
#pragma unroll
            for (int w = 0; w < 8; ++w) { a1 += X_[(w * 64 + t) * 2]; a2 += X_[(w * 64 + t) * 2 + 1]; }
            const float mu = a1 * (1.f / 256.f); const float rstd = rsqrtf(a2 * (1.f / 256.f) - mu * mu + 1e-5f);
#pragma unroll
            for (int it = 0; it < 2; ++it) { const int e = 32 * wave + 16 * it + 4 * fq; const f32x4 gn = *(const LAS f32x4*)(GN + e);
                u32x2 o; o.x = pk2((nacc[it][jt][0] - mu) * rstd * gn.x, (nacc[it][jt][1] - mu) * rstd * gn.y); o.y = pk2((nacc[it][jt][2] - mu) * rstd * gn.z, (nacc[it][jt][3] - mu) * rstd * gn.w);
                *(GAS u32x2*)(HN + (rb + t) * 2048 + h * 256 + e) = o; }
        }
        {   const float decay = SC[0];
#pragma unroll
            for (int it = 0; it < 2; ++it)
#pragma unroll
                for (int jd = 0; jd < 8; ++jd) Cacc[it][jd] = Cacc[it][jd] * decay;
            if (tid < 128) { float sum = 0.f;
#pragma unroll 8
                for (int s2_ = 0; s2_ < 64; ++s2_) sum += bflo((unsigned)Ks[qk_off(s2_, tid >> 3) + (tid & 7)]);
                nreg = decay * nreg + sum; nd[tid] = (bf16)f2bf(nreg); }
#pragma unroll
            for (int ks = 0; ks < 2; ++ks)
#pragma unroll
                for (int jd = 0; jd < 8; ++jd) { asm volatile("" ::: "memory"); const int r_ = 32 * ks + 8 * fq + (fr >> 2), ch_ = 2 * jd + ((fr & 3) >> 1), w_ = 4 * (fr & 1); const bf16x8 kb = tr_frag2(Ks + qk_off(r_, ch_) + w_, Ks + qk_off(r_ + 4, ch_) + w_);
                    Cacc[0][jd] = __builtin_amdgcn_mfma_f32_16x16x32_bf16(va[ks][0], kb, Cacc[0][jd], 0, 0, 0);
                    Cacc[1][jd] = __builtin_amdgcn_mfma_f32_16x16x32_bf16(va[ks][1], kb, Cacc[1][jd], 0, 0, 0);
                }
#pragma unroll
            for (int jd = 0; jd < 8; ++jd) {
#pragma unroll
                for (int it = 0; it < 2; ++it) { u32x2 o; o.x = pk2(Cacc[it][jd][0], Cacc[it][jd][1]); o.y = pk2(Cacc[it][jd][2], Cacc[it][jd][3]); *(LAS u32x2*)(Cd + (16 * jd + fr) * 32 + 16 * it + 4 * fq) = o; }
            }
        }
        __syncthreads();
    }
    float* Co = Cp + (size_t)(seq * 8 + h) * 32768;
#pragma unroll
    for (int jd = 0; jd < 8; ++jd) {
#pragma unroll
        for (int it = 0; it < 2; ++it) *(GAS f32x4*)(Co + (size_t)(16 * jd + fr) * 256 + 32 * wave + 16 * it + 4 * fq) = Cacc[it][jd];
    }
    if (tid < 128) np_[(seq * 8 + h) * 128 + tid] = nreg;
    if (wave == 0 && lane == 0) mp[seq * 8 + h] = m;
}

__device__ __forceinline__ void mlstm_sample_unit(const bf16* QKVO, const float* GATES, const float* hn_gain, const float* C0, const float* n0, const float* m0,
                                                  bf16* HN, float* Cs, float* ns, float* ms, int u, LAS unsigned char* lds, int wave, int lane) {
    const int h = u & 7, tid = wave * 64 + lane; const size_t r0 = 8192 + (size_t)(u >> 3) * 4;
    LAS float* q = (LAS float*)lds;
    LAS float* k = q + 512;
    LAS float* v = k + 512;
    LAS float* Sm = v + 1024;
    LAS float* gv = Sm + 16;
    LAS float* nn = gv + 32;
    LAS float* part = nn + 128;
    LAS float* red = part + 8192;
    { const int t = tid >> 7, d = tid & 127; const bf16* r = QKVO + (r0 + t) * 6144; q[tid] = bflo((unsigned)r[h * 128 + d]); k[tid] = bflo((unsigned)r[1024 + h * 128 + d]);
#pragma unroll
      for (int i = 0; i < 2; ++i) { const int idx = tid + 512 * i, tv = idx >> 8, e = idx & 255; v[idx] = bflo((unsigned)QKVO[(r0 + tv) * 6144 + 2048 + h * 256 + e]); } }
    if (tid < 128) nn[tid] = n0[(size_t)u * 128 + tid];
    if (tid == 0) {
        const float mprev = m0[u]; float b = 0.f, pm = -INFINITY;
        for (int t = 0; t < 4; ++t) { const float ig = GATES[(r0 + t) * 16 + h], lf = GATES[(r0 + t) * 16 + 8 + h]; b += lf; const float a = ig - b; pm = fmaxf(pm, a); const float Mt = fmaxf(mprev, pm);
            gv[t] = a; gv[4 + t] = Mt; gv[8 + t] = b; gv[12 + t] = __expf(mprev - Mt); }
        const float M3 = gv[7], b3 = gv[11];
        gv[28] = __expf(mprev - M3); gv[29] = b3 + M3;
        for (int s = 0; s < 4; ++s) gv[20 + s] = __expf(gv[s] - M3);
    }
    __syncthreads();
    if (tid < 16) { const int t = tid >> 2, s = tid & 3; float r = 0.f; if (s <= t) { float dot = 0.f; for (int d = 0; d < 128; ++d) dot += q[t * 128 + d] * k[s * 128 + d]; r = dot * __expf(gv[s] - gv[4 + t]); } Sm[tid] = r; }
    else if (tid < 20) { const int t = tid - 16; float dot = 0.f; for (int d = 0; d < 128; ++d) dot += q[t * 128 + d] * nn[d]; gv[24 + t] = dot; }
    __syncthreads();
    if (tid < 4) { float den = gv[12 + tid] * gv[24 + tid]; for (int s = 0; s <= tid; ++s) den += Sm[tid * 4 + s]; gv[16 + tid] = fmaxf(fabsf(den), __expf(-(gv[8 + tid] + gv[4 + tid]))); }
    k[tid] *= gv[20 + (tid >> 7)];
    __syncthreads();
    {
        const int eq = tid & 63, dg = tid >> 6; const float decay = gv[28];
        f32x4 v4[4];
#pragma unroll
        for (int s = 0; s < 4; ++s) v4[s] = *(const LAS f32x4*)(v + s * 256 + 4 * eq);
        f32x4 acc[4];
#pragma unroll
        for (int t = 0; t < 4; ++t) acc[t] = (f32x4){0.f, 0.f, 0.f, 0.f};
        const float* cin = C0 + (size_t)u * 32768 + (size_t)(dg * 16) * 256 + 4 * eq; float* cout = Cs + (size_t)u * 32768 + (size_t)(dg * 16) * 256 + 4 * eq;
#pragma unroll
        for (int hb = 0; hb < 2; ++hb) {
            f32x4 cr[8];
#pragma unroll
            for (int dd = 0; dd < 8; ++dd) cr[dd] = __builtin_nontemporal_load((const GAS f32x4*)(cin + (hb * 8 + dd) * 256));
#pragma unroll
            for (int dd = 0; dd < 8; ++dd) { const int d = dg * 16 + hb * 8 + dd; const f32x4 c = cr[dd];
#pragma unroll
                for (int t = 0; t < 4; ++t) acc[t] += c * q[t * 128 + d];
                f32x4 cn = c * decay;
#pragma unroll
                for (int s = 0; s < 4; ++s) cn += v4[s] * k[s * 128 + d];
                __builtin_nontemporal_store(cn, (GAS f32x4*)(cout + (hb * 8 + dd) * 256)); }
        }
#pragma unroll
        for (int t = 0; t < 4; ++t) *(LAS f32x4*)(part + (dg * 4 + t) * 256 + 4 * eq) = acc[t];
    }
    __syncthreads();
    float hv[2];
    {   const int t = tid >> 7, e2 = (tid & 127) * 2;
        float s1 = 0.f, s2 = 0.f;
#pragma unroll
        for (int i = 0; i < 2; ++i) { const int e = e2 + i; float num2 = 0.f;
#pragma unroll
            for (int dg = 0; dg < 8; ++dg) num2 += part[(dg * 4 + t) * 256 + e];
            float num1 = 0.f; for (int s = 0; s <= t; ++s) num1 += Sm[t * 4 + s] * v[s * 256 + e];
            float x = (num1 + gv[12 + t] * num2) / gv[16 + t];
            const float o = bflo((unsigned)QKVO[(r0 + t) * 6144 + 4096 + h * 256 + e]);
            x *= 1.f / (1.f + __expf(-o)); hv[i] = x; s1 += x; s2 += x * x; }
        s1 = wave_sum_f(s1); s2 = wave_sum_f(s2);
        if (lane == 0) { red[wave * 2] = s1; red[wave * 2 + 1] = s2; }
    }
    __syncthreads();
    {   const int t = tid >> 7, e2 = (tid & 127) * 2;
        const float a1 = red[(2 * t) * 2] + red[(2 * t + 1) * 2], a2 = red[(2 * t) * 2 + 1] + red[(2 * t + 1) * 2 + 1];
        const float mu = a1 * (1.f / 256.f); const float rstd = rsqrtf(a2 * (1.f / 256.f) - mu * mu + 1e-5f);
        const unsigned o = pk2((hv[0] - mu) * rstd * hn_gain[h * 256 + e2], (hv[1] - mu) * rstd * hn_gain[h * 256 + e2 + 1]);
        *(GAS unsigned*)(HN + (r0 + t) * 2048 + h * 256 + e2) = o;
        if (tid < 128) { float a = gv[28] * nn[tid]; for (int s = 0; s < 4; ++s) a += k[s * 128 + tid]; ns[(size_t)u * 128 + tid] = a; }
        if (tid == 0) ms[u] = gv[29];
    }
    __syncthreads();
}

__device__ __forceinline__ void phase_mlstm(const Args& a, LAS unsigned char* lds, int G, int wave, int lane, int which) {
    const bf16* QKVO = (const bf16*)(a.ws + a.L.qkvo); const float* GATES = (const float*)(a.ws + a.L.gates); bf16* HN = (bf16*)(a.ws + a.L.qp);
    const int bx = blockIdx.x;
    constexpr size_t O_CP = 17825792, O_NP = O_CP + 1048576, O_MP = O_NP + 4096, O_CS = O_MP + 32, O_NS = O_CS + 33554432, O_MS = O_NS + 131072;
    if (bx < 32) { if (which & 1) mlstm_prompt_seq(QKVO, GATES, a.in[7], HN, a.out + O_CP, a.out + O_NP, a.out + O_MP, bx >> 3, bx & 7, lds, wave, lane); }
    else {
        if (which & 2) for (int u = bx - 32; u < 1024; u += G - 32) mlstm_sample_unit(QKVO, GATES, a.in[7], a.in[2], a.in[3], a.in[4], HN, a.out + O_CS, a.out + O_NS, a.out + O_MS, u, lds, wave, lane);
        if (which & 28) { __syncthreads(); side_convert(a, lds, (bx - 32) * NWAVES + wave, (G - 32) * NWAVES, wave, lane, (which & 4) ? 3 : ((which >> 3) & 3)); }
    }
}
struct MiniBf16S { bf16* O; int ldc, sclo, schi; __device__ __forceinline__ void operator()(int row, int col, f32x4 a) const { const float s = (col >= sclo && col < schi) ? 0.08838834764831845f : 1.f;
    u32x2 o; o.x = pk2(a[0] * s, a[1] * s); o.y = pk2(a[2] * s, a[3] * s); *(GAS u32x2*)(O + (size_t)row * ldc + col) = o; } };
struct MiniBf16 { bf16* O; int ldc; __device__ __forceinline__ void operator()(int row, int col, f32x4 a) const { u32x2 o; o.x = pk2(a[0], a[1]); o.y = pk2(a[2], a[3]); *(GAS u32x2*)(O + (size_t)row * ldc + col) = o; } };
struct MiniRes { const bf16* xb; bf16* Z; float alpha; __device__ __forceinline__ void operator()(int row, int col, f32x4 a) const {
    const u32x2 x = *(const GAS u32x2*)(xb + (size_t)row * 2048 + col); u32x2 o; o.x = pk2(bflo(x.x) * alpha + a[0], bfhi(x.x) * alpha + a[1]); o.y = pk2(bflo(x.y) * alpha + a[2], bfhi(x.y) * alpha + a[3]);
    *(GAS u32x2*)(Z + (size_t)row * 2048 + col) = o; } };
struct MiniGelu { bf16* U; bf16* V; const float* bias; float* VST; __device__ __forceinline__ void operator()(int row, int col, f32x4 a) const {
    const bool isv = col >= 6144; const f32x4 bv = *(const GAS f32x4*)(bias + col); float s1 = 0.f, s2 = 0.f;
#pragma unroll
    for (int e = 0; e < 4; ++e) { a[e] = pg8::gelu_tanh_f(a[e] + bv[e]); s1 += a[e]; s2 += a[e] * a[e]; }
    u32x2 o; o.x = pk2(a[0], a[1]); o.y = pk2(a[2], a[3]);
    *(GAS u32x2*)((isv ? V + (size_t)row * 6144 + (col - 6144) : U + (size_t)row * 6144 + col)) = o;
    if (isv) { s1 += __shfl_xor(s1, 16); s1 += __shfl_xor(s1, 32); s2 += __shfl_xor(s2, 16); s2 += __shfl_xor(s2, 32);
        if ((threadIdx.x & 48) == 0) { atomicAdd(VST + 2 * row, s1); atomicAdd(VST + 2 * row + 1, s2); } } } };
template <class Epi, int MABL = 0>
__device__ __forceinline__ void mini_gemm(const bf16* A, const bf16* Bt, int N, int K, const Epi& E, LAS unsigned char* lds, int vcu, int G, int wave, int lane) {
    const int tid = wave * 64 + lane, fr = lane & 15, fq = lane >> 4;
    const int srow = tid >> 4, q16 = (tid & 15) ^ (srow & 15);
    const int nct = N / 128, nunits = 16 * nct, nch = K / 128;
    const size_t bstep = (size_t)32 * K;
    LAS unsigned char* lw = lds + wave * 1024;
#define MG_DMA(c, st) do { if (MABL != 2) { const int cc_ = min((c), nch - 1); __builtin_amdgcn_global_load_lds((const unsigned*)(ag + (size_t)cc_ * 128), (LAS unsigned*)(lw + (st)), 16, 0, 0); \
        _Pragma("unroll") for (int p_ = 0; p_ < 4; ++p_) __builtin_amdgcn_global_load_lds((const unsigned*)(bg + p_ * bstep + (size_t)cc_ * 128), (LAS unsigned*)(lw + (st) + 8192 + p_ * 8192), 16, 0, 0); } } while (0)
#define MG_COMPUTE(st) do { if (MABL == 1) break; bf16x8 a0_[4], a1_[4], b_[4]; _Pragma("unroll") for (int ks_ = 0; ks_ < 4; ++ks_) { const int co_ = ((ks_ * 4 + fq) ^ fr) << 4; \
        a0_[ks_] = *(const LAS bf16x8*)(lds + (st) + fr * 256 + co_); a1_[ks_] = *(const LAS bf16x8*)(lds + (st) + (16 + fr) * 256 + co_); b_[ks_] = *(const LAS bf16x8*)(lds + (st) + 8192 + (wave * 16 + fr) * 256 + co_); } \
        _Pragma("unroll") for (int ks_ = 0; ks_ < 4; ++ks_) { acc0 = __builtin_amdgcn_mfma_f32_16x16x32_bf16(b_[ks_], a0_[ks_], acc0, 0, 0, 0); acc1 = __builtin_amdgcn_mfma_f32_16x16x32_bf16(b_[ks_], a1_[ks_], acc1, 0, 0, 0); } } while (0)
    for (int u = vcu; u < nunits; u += G) {
        const int rt = u & 15, ct = u >> 4;
        const int row0 = 8192 + rt * 32, colB0 = ct * 128;
        const bf16* ag = A + (size_t)(row0 + srow) * K + q16 * 8;
        const bf16* bg = Bt + (size_t)(colB0 + srow) * K + q16 * 8;
        f32x4 acc0 = (f32x4){0.f, 0.f, 0.f, 0.f}, acc1 = acc0;
        MG_DMA(0, 0); MG_DMA(1, 40960);
        int st = 0, st2 = 81920;
#pragma unroll 1
        for (int c = 0; c < nch; ++c) {
            asm volatile("s_waitcnt vmcnt(5)" ::: "memory");
            __builtin_amdgcn_s_barrier();
            asm volatile("" ::: "memory");
            MG_DMA(c + 2, st2);
            MG_COMPUTE(st);
            st = (st == 81920) ? 0 : st + 40960; st2 = (st2 == 81920) ? 0 : st2 + 40960;
        }
        asm volatile("s_waitcnt vmcnt(0)" ::: "memory");
        __syncthreads();
        if (MABL == 0 || (acc0[0] + acc1[1] == 1.2345f)) { E(row0 + fr, colB0 + wave * 16 + 4 * fq, acc0); E(row0 + 16 + fr, colB0 + wave * 16 + 4 * fq, acc1); }
    }
#undef MG_DMA
#undef MG_COMPUTE
}
__global__ void __launch_bounds__(NWAVES * 64, 2) mk(Args args) {
    extern __shared__ __attribute__((aligned(16))) unsigned char lds_raw[];
    LAS unsigned char* lds = (LAS unsigned char*)lds_raw;
    volatile LAS unsigned* MISC = (volatile LAS unsigned*)(lds + MISC_OFF);
    const int tid = threadIdx.x, lane = tid & 63, wave = __builtin_amdgcn_readfirstlane(tid >> 6);
    const int G = gridDim.x, bx = blockIdx.x; const int vcu = (G % 8 == 0) ? (bx % 8) * (G / 8) + bx / 8 : bx;
    for (int u = tid; u < (LDS_BYTES - RING_BYTES) / 4; u += NWAVES * 64) ((LAS unsigned*)(lds + RING_BYTES))[u] = 0u;
    __syncthreads();
    unsigned char* ws = args.ws; const Lay& L = args.L;
    unsigned* ctl = (unsigned*)(ws + L.ctl);
    XcdBarrier bar = xcd_barrier_post(ctl + 4096 + args.li * XCD_BAR_WORDS, MISC + 8);
    const int lo = args.ph_lo, hi = args.ph_hi;
#ifndef PHMASK
#define PHMASK 0xFFFFFFFFu
#endif
#define IN(k) (((PHMASK >> (k)) & 1u) && lo <= (k) && (k) < hi)
#ifndef MLSTM_DUPSEL
#define MLSTM_DUPSEL 3
#endif
#ifndef TK_ABL
#define TK_ABL 0
#endif
#ifndef SP_ABL
#define SP_ABL 0
#endif
#ifndef UP_ABL
#define UP_ABL 0
#endif
#ifndef VP_ABL
#define VP_ABL 0
#endif
#ifndef DUPMASK
#define DUPMASK 0u
#endif
#define DUP(k) ((DUPMASK >> (k)) & 1u)
#define LANE() ({ int l_ = lane; asm volatile("" : "+v"(l_)); l_; })
#define SEAM(k) do { if (IN(k) && IN((k) + 1)) xcd_barrier(bar); } while (0)
#define GEMM_PHASE_FULL(EPI_T, E, Aptr, Btptr, Nn, Kk) do { pg8::Gemm g_{(const pg8::bf16_t*)(Aptr), (const pg8::bf16_t*)(Btptr), NTOKF, (Nn), (Kk)}; pg8::StaticOrder S_; S_.init(NTOKF, (Nn), G, bx); \
        pg8::gemm_phase<EPI_T, pg8::StaticOrder, true, true>(lds, g_, S_, E); } while (0)
#define GEMM_PHASE(EPI_T, E, Aptr, Btptr, Nn, Kk, MINI_E) do { pg8::Gemm g_{(const pg8::bf16_t*)(Aptr), (const pg8::bf16_t*)(Btptr), 8192, (Nn), (Kk)}; pg8::StaticOrder S_; S_.init(8192, (Nn), G, bx); \
        pg8::gemm_phase<EPI_T, pg8::StaticOrder, true, true>(lds, g_, S_, E); \
        mini_gemm((const bf16*)(Aptr), (const bf16*)(Btptr), (Nn), (Kk), MINI_E, lds, vcu, G, wave, LANE()); } while (0)

#ifndef MINI_ABL
#define MINI_ABL 0
#endif
#define GEMM_PHASE_MINI(EPI_T, E, Aptr, Btptr, Nn, Kk, MINI_E) do { mini_gemm<decltype(MINI_E), MINI_ABL>((const bf16*)(Aptr), (const bf16*)(Btptr), (Nn), (Kk), MINI_E, lds, vcu, G, wave, LANE()); } while (0)
#ifdef MINI_DUP
#define GEMM_PHASE_DUPSEL GEMM_PHASE_MINI
#else
#define GEMM_PHASE_DUPSEL GEMM_PHASE
#endif

    if (IN(0)) { { phase_prologue(args, lds, vcu, G, wave, LANE()); } if (DUP(0)) { xcd_barrier(bar); { phase_prologue(args, lds, vcu, G, wave, LANE()); } } } SEAM(0);
    if (IN(1)) { { pg8::EpiBf16S E{(pg8::bf16_t*)(ws + L.qkvo), 6144, 1024, 2048, 0.08838834764831845f}; GEMM_PHASE_FULL(pg8::EpiBf16S, E, ws + L.xb, ws + L.wina, 6144, 2048); } if (DUP(1)) { xcd_barrier(bar); { pg8::EpiBf16S E{(pg8::bf16_t*)(ws + L.qkvo), 6144, 1024, 2048, 0.08838834764831845f}; GEMM_PHASE_FULL(pg8::EpiBf16S, E, ws + L.xb, ws + L.wina, 6144, 2048); } } } SEAM(1);
    if (IN(2)) { { phase_mlstm(args, lds, G, wave, lane, 7); } if (DUP(2)) { xcd_barrier(bar); { phase_mlstm(args, lds, G, wave, lane, MLSTM_DUPSEL); } } } SEAM(2);
    if (IN(3)) { { pg8::EpiRes E{(const pg8::bf16_t*)(ws + L.xb), (pg8::bf16_t*)(ws + L.z), ALPHA_F}; GEMM_PHASE(pg8::EpiRes, E, ws + L.qp, ws + L.wouta, 2048, 2048, (MiniRes{(const bf16*)(ws + L.xb), (bf16*)(ws + L.z), ALPHA_F})); } if (DUP(3)) { xcd_barrier(bar); { pg8::EpiRes E{(const pg8::bf16_t*)(ws + L.xb), (pg8::bf16_t*)(ws + L.z), ALPHA_F}; GEMM_PHASE(pg8::EpiRes, E, ws + L.qp, ws + L.wouta, 2048, 2048, (MiniRes{(const bf16*)(ws + L.xb), (bf16*)(ws + L.z), ALPHA_F})); } } } SEAM(3);
    if (IN(4)) { { phase_ln<true>((const float*)(ws + L.z), args.in[16], args.in[17], (float*)nullptr, (bf16*)(ws + L.xb), ws + L.xq, (float*)(ws + L.sx), vcu, G, wave, LANE()); } if (DUP(4)) { xcd_barrier(bar); { phase_ln<true>((const float*)(ws + L.z), args.in[16], args.in[17], (float*)nullptr, (bf16*)(ws + L.xb), ws + L.xq, (float*)(ws + L.sx), vcu, G, wave, LANE()); } } } SEAM(4);
    if (IN(5)) { { pg8::EpiBf16S E{(pg8::bf16_t*)(ws + L.qp), 2048, 0, 0, 1.f}; GEMM_PHASE(pg8::EpiBf16S, E, ws + L.xb, ws + L.wq, 2048, 2048, (MiniBf16S{(bf16*)(ws + L.qp), 2048, 0, 0})); } if (DUP(5)) { xcd_barrier(bar); { pg8::EpiBf16S E{(pg8::bf16_t*)(ws + L.qp), 2048, 0, 0, 1.f}; GEMM_PHASE(pg8::EpiBf16S, E, ws + L.xb, ws + L.wq, 2048, 2048, (MiniBf16S{(bf16*)(ws + L.qp), 2048, 0, 0})); } } } SEAM(5);
#define RINV_U ((const float*)(ws + L.rinv))
#define RINV_V ((const float*)(ws + L.rinv) + 16384)
    if (IN(6)) { { phase_topk<0>((const bf16*)(ws + L.qp), (const bf16*)(ws + L.sk), (int*)(ws + L.idx), (float*)(ws + L.gt), (float*)(ws + L.ww), (float*)(ws + L.su), RINV_U, RINV_V, lds, vcu, G, wave, LANE()); } if (DUP(6)) { xcd_barrier(bar); { phase_topk<TK_ABL>((const bf16*)(ws + L.qp), (const bf16*)(ws + L.sk), (int*)(ws + L.um), (float*)(ws + L.um + 8388608), (float*)(ws + L.um + 16777216), (float*)(ws + L.um + 25165824), RINV_U, RINV_V, lds, vcu, G, wave, LANE()); } } } SEAM(6);
    if (IN(7)) { { phase_upass_sl<0>((const unsigned char*)(ws + L.ptu), (const unsigned char*)(ws + L.xq), (const float*)(ws + L.sx), (const int*)(ws + L.idx), (float*)(ws + L.ww), (float*)(ws + L.gt), (float*)(ws + L.su), RINV_U, RINV_V, xcd_topology(bar.bar, bar.x, MISC[10], wave), LANE()); } if (DUP(7)) { xcd_barrier(bar); { phase_upass_sl<UP_ABL>((const unsigned char*)(ws + L.ptu), (const unsigned char*)(ws + L.xq), (const float*)(ws + L.sx), (const int*)(ws + L.idx), (float*)(ws + L.um), (float*)(ws + L.gt), (float*)(ws + L.su), RINV_U, RINV_V, xcd_topology(bar.bar, bar.x, MISC[10], wave), LANE()); } } } SEAM(7);
    if (IN(8)) { { phase_vpass_sl<0>((const unsigned char*)(ws + L.ptv), (const bf16*)(ws + L.xb), (const int*)(ws + L.idx), (const float*)(ws + L.ww), (const float*)(ws + L.su), (const float*)(ws + L.gt), (bf16*)(ws + L.z), ALPHA_F, xcd_topology(bar.bar, bar.x, MISC[10], wave), lds, wave, LANE()); } if (DUP(8)) { xcd_barrier(bar); { phase_vpass_sl<VP_ABL>((const unsigned char*)(ws + L.ptv), (const bf16*)(ws + L.xb), (const int*)(ws + L.idx), (const float*)(ws + L.ww), (const float*)(ws + L.su), (const float*)(ws + L.gt), (bf16*)(ws + L.um), ALPHA_F, xcd_topology(bar.bar, bar.x, MISC[10], wave), lds, wave, LANE()); } } } SEAM(8);
    if (IN(9)) { { phase_ln<true>((const float*)(ws + L.z), args.in[18], args.in[19], (float*)nullptr, (bf16*)(ws + L.xb), (unsigned char*)nullptr, (float*)nullptr, vcu, G, wave, LANE()); } if (DUP(9)) { xcd_barrier(bar); { phase_ln<true>((const float*)(ws + L.z), args.in[18], args.in[19], (float*)nullptr, (bf16*)(ws + L.xb), (unsigned char*)nullptr, (float*)nullptr, vcu, G, wave, LANE()); } } } SEAM(9);
    if (IN(10)) { { pg8::EpiGelu E{(pg8::bf16_t*)(ws + L.ub), (pg8::bf16_t*)(ws + L.vb), args.in[10], (float*)(ws + L.vst)}; GEMM_PHASE_FULL(pg8::EpiGelu, E, ws + L.xb, ws + L.winb, 12288, 2048); } if (DUP(10)) { xcd_barrier(bar); { pg8::EpiGelu E{(pg8::bf16_t*)(ws + L.ub), (pg8::bf16_t*)(ws + L.vb), args.in[10], (float*)(ws + L.vst)}; GEMM_PHASE_FULL(pg8::EpiGelu, E, ws + L.xb, ws + L.winb, 12288, 2048); } } } SEAM(10);
    if (IN(11)) { { phase_spatial<0>((const bf16*)(ws + L.ub), (const bf16*)(ws + L.vb), (const float*)(ws + L.vst), args.in[11], args.in[12], (const bf16*)(ws + L.wsb), args.in[13], args.in[14],
                                (bf16*)(ws + L.um), args.out + OUT_VS, lds, vcu, G, wave, LANE()); } if (DUP(11)) { xcd_barrier(bar); { phase_spatial<SP_ABL>((const bf16*)(ws + L.ub), (const bf16*)(ws + L.vb), (const float*)(ws + L.vst), args.in[11], args.in[12], (const bf16*)(ws + L.wsb), args.in[13], args.in[14],
                                (bf16*)(ws + L.ptu), (float*)(ws + L.ptu1), lds, vcu, G, wave, LANE()); } } } SEAM(11);
    if (IN(12)) { { pg8::EpiRes E{(const pg8::bf16_t*)(ws + L.xb), (pg8::bf16_t*)(ws + L.z), ALPHA_F}; GEMM_PHASE(pg8::EpiRes, E, ws + L.um, ws + L.woutb, 2048, 6144, (MiniRes{(const bf16*)(ws + L.xb), (bf16*)(ws + L.z), ALPHA_F})); } if (DUP(12)) { xcd_barrier(bar); { pg8::EpiRes E{(const pg8::bf16_t*)(ws + L.xb), (pg8::bf16_t*)(ws + L.z), ALPHA_F}; GEMM_PHASE_DUPSEL(pg8::EpiRes, E, ws + L.um, ws + L.woutb, 2048, 6144, (MiniRes{(const bf16*)(ws + L.xb), (bf16*)(ws + L.z), ALPHA_F})); } } } SEAM(12);
    if (IN(13)) { { phase_ln<true>((const float*)(ws + L.z), args.in[16] + 2048, args.in[17] + 2048, (float*)nullptr, (bf16*)(ws + L.xb), ws + L.xq, (float*)(ws + L.sx), vcu, G, wave, LANE()); } if (DUP(13)) { xcd_barrier(bar); { phase_ln<true>((const float*)(ws + L.z), args.in[16] + 2048, args.in[17] + 2048, (float*)nullptr, (bf16*)(ws + L.xb), ws + L.xq, (float*)(ws + L.sx), vcu, G, wave, LANE()); } } } SEAM(13);
    if (IN(14)) { { pg8::EpiBf16S E{(pg8::bf16_t*)(ws + L.qp), 2048, 0, 0, 1.f}; GEMM_PHASE(pg8::EpiBf16S, E, ws + L.xb, (bf16*)(ws + L.wq) + (size_t)2048 * 2048, 2048, 2048, (MiniBf16S{(bf16*)(ws + L.qp), 2048, 0, 0})); } if (DUP(14)) { xcd_barrier(bar); { pg8::EpiBf16S E{(pg8::bf16_t*)(ws + L.qp), 2048, 0, 0, 1.f}; GEMM_PHASE(pg8::EpiBf16S, E, ws + L.xb, (bf16*)(ws + L.wq) + (size_t)2048 * 2048, 2048, 2048, (MiniBf16S{(bf16*)(ws + L.qp), 2048, 0, 0})); } } } SEAM(14);
#undef RINV_U
#undef RINV_V
#define RINV_U ((const float*)(ws + L.rinv) + 32768)
#define RINV_V ((const float*)(ws + L.rinv) + 49152)
    if (IN(15)) { { phase_topk<0>((const bf16*)(ws + L.qp), (const bf16*)(ws + L.sk) + (size_t)16 * 128 * 128, (int*)(ws + L.idx), (float*)(ws + L.gt), (float*)(ws + L.ww), (float*)(ws + L.su), RINV_U, RINV_V, lds, vcu, G, wave, LANE()); } if (DUP(15)) { xcd_barrier(bar); { phase_topk<TK_ABL>((const bf16*)(ws + L.qp), (const bf16*)(ws + L.sk) + (size_t)16 * 128 * 128, (int*)(ws + L.um), (float*)(ws + L.um + 8388608), (float*)(ws + L.um + 16777216), (float*)(ws + L.um + 25165824), RINV_U, RINV_V, lds, vcu, G, wave, LANE()); } } } SEAM(15);
    if (IN(16)) { { phase_upass_sl<0>((const unsigned char*)(ws + L.ptu1), (const unsigned char*)(ws + L.xq), (const float*)(ws + L.sx), (const int*)(ws + L.idx), (float*)(ws + L.ww), (float*)(ws + L.gt), (float*)(ws + L.su), RINV_U, RINV_V, xcd_topology(bar.bar, bar.x, MISC[10], wave), LANE()); } if (DUP(16)) { xcd_barrier(bar); { phase_upass_sl<UP_ABL>((const unsigned char*)(ws + L.ptu1), (const unsigned char*)(ws + L.xq), (const float*)(ws + L.sx), (const int*)(ws + L.idx), (float*)(ws + L.um), (float*)(ws + L.gt), (float*)(ws + L.su), RINV_U, RINV_V, xcd_topology(bar.bar, bar.x, MISC[10], wave), LANE()); } } } SEAM(16);
    if (IN(17)) { { phase_vpass_sl<0>((const unsigned char*)(ws + L.ptv1), (const bf16*)(ws + L.xb), (const int*)(ws + L.idx), (const float*)(ws + L.ww), (const float*)(ws + L.su), (const float*)(ws + L.gt), (bf16*)(ws + L.z), ALPHA_F, xcd_topology(bar.bar, bar.x, MISC[10], wave), lds, wave, LANE()); } if (DUP(17)) { xcd_barrier(bar); { phase_vpass_sl<VP_ABL>((const unsigned char*)(ws + L.ptv1), (const bf16*)(ws + L.xb), (const int*)(ws + L.idx), (const float*)(ws + L.ww), (const float*)(ws + L.su), (const float*)(ws + L.gt), (bf16*)(ws + L.um), ALPHA_F, xcd_topology(bar.bar, bar.x, MISC[10], wave), lds, wave, LANE()); } } } SEAM(17);
#ifdef XBAR_EXTRA
    if (IN(17) && IN(18)) { for (int e_ = 0; e_ < XBAR_EXTRA; ++e_) xcd_barrier(bar); }
#endif
    if (IN(18)) { phase_ln<true>((const float*)(ws + L.z), args.in[18] + 2048, args.in[19] + 2048, args.out, nullptr, (unsigned char*)nullptr, (float*)nullptr, vcu, G, wave, LANE()); }
#undef IN
#undef SEAM
#undef GEMM_PHASE
}

static int g_grid = 0;
static bool mk_init() {
    if (g_grid == 0) {
        int dev = 0, cus = 0;
        if (hipGetDevice(&dev) != hipSuccess || hipDeviceGetAttribute(&cus, hipDeviceAttributeMultiprocessorCount, dev) != hipSuccess) { g_grid = -1; return false; }
        if (hipFuncSetAttribute((const void*)mk, hipFuncAttributeMaxDynamicSharedMemorySize, LDS_BYTES) != hipSuccess) { g_grid = -1; return false; }
        (void)hipGetLastError();
        g_grid = cus;
    }
    return g_grid > 0;
}
static void mk_launch(const Args& a0, int lo, int hi, int li, hipStream_t st) {
    Args a = a0; a.ph_lo = lo; a.ph_hi = hi; a.li = li;
    hipLaunchKernelGGL(mk, dim3(g_grid), dim3(NWAVES * 64), LDS_BYTES, st, a);
}
extern "C" void kernel_launch(void* const* d_in, const int* in_sizes, int n_in, void* d_out, int out_size, void* d_ws, size_t ws_size, hipStream_t stream) {
    if (!mk_init()) return;
    constexpr unsigned long long MiB = 1ull << 20;
    Args a{};
    for (int i = 0; i < 24; ++i) a.in[i] = (const float*)d_in[i];
    a.out = (float*)d_out; a.ws = (unsigned char*)d_ws;
    Lay& L = a.L;
    L.ctl = 0; L.wina = 1 * MiB; L.wouta = 25 * MiB; L.winb = 33 * MiB; L.woutb = 81 * MiB; L.wq = 105 * MiB; L.sk = 121 * MiB; L.gates = 122 * MiB; L.vst = 123 * MiB; L.wsb = 124 * MiB;
    L.idx = 125 * MiB; L.gt = 130 * MiB; L.ww = 135 * MiB; L.ptu = 140 * MiB; L.ptv = 204 * MiB; L.xf0 = 268 * MiB; L.xf1 = 336 * MiB; L.z = 404 * MiB; L.xb = 472 * MiB; L.qp = 506 * MiB;
    L.qkvo = 540 * MiB; L.ub = 540 * MiB; L.vb = 642 * MiB; L.um = 744 * MiB; L.ptu1 = 846 * MiB; L.ptv1 = 910 * MiB; L.rinv = 974 * MiB; L.su = 975 * MiB; L.xq = 980 * MiB; L.sx = 997 * MiB;
    (void)hipMemsetAsync((unsigned char*)d_ws + L.ctl, 0, MiB, stream);
    mk_launch(a, 0, 19, 0, stream);
}
```

```cpp
#include <hip/hip_runtime.h>
#include <stdint.h>
#include <math.h>
#define DUPMASK 0u
#define MLSTM_DUPSEL 7
#define GAS __attribute__((address_space(1)))
#define LAS __attribute__((address_space(3)))
typedef unsigned short bf16;
typedef unsigned v4u __attribute__((ext_vector_type(4)));
typedef float f32x4 __attribute__((ext_vector_type(4)));
typedef short bf16x8 __attribute__((ext_vector_type(8)));
typedef GAS unsigned gu32;
typedef GAS unsigned long long gu64;
#define RLX_AGENT __ATOMIC_RELAXED, __HIP_MEMORY_SCOPE_AGENT
#define LDS_WAIT() asm volatile("s_waitcnt lgkmcnt(0)" ::: "memory")
#define VM_WAIT() asm volatile("s_waitcnt vmcnt(0)" ::: "memory")
__device__ __forceinline__ unsigned long long rt() { return __builtin_amdgcn_s_memrealtime(); }
__device__ __forceinline__ unsigned f2bf(float f) { unsigned u = __builtin_bit_cast(unsigned, f); return (u + 0x7fffu + ((u >> 16) & 1u)) >> 16; }
__device__ __forceinline__ unsigned pk2(float lo, float hi) { unsigned r; asm("v_cvt_pk_bf16_f32 %0, %1, %2" : "=v"(r) : "v"(lo), "v"(hi)); return r; }

#define XB_TMO      128
#define XB_XCNT(j)  (256  + 64 * (j))
#define XB_XSUB(j)  (1280 + 64 * (j))
#define XB_XGEN(j)  (2304 + 64 * (j))
#define XB_TOP      3328
#define XB_TOPGEN   3392
#define XCD_BAR_WORDS 3456
#define XB_SPIN_CAP (1u << 22)

__device__ __forceinline__ unsigned xb_ld(unsigned* p)              { return __hip_atomic_load(p, __ATOMIC_RELAXED, __HIP_MEMORY_SCOPE_AGENT); }
__device__ __forceinline__ unsigned xb_add(unsigned* p, unsigned v) { return __hip_atomic_fetch_add(p, v, __ATOMIC_RELAXED, __HIP_MEMORY_SCOPE_AGENT); }
__device__ __forceinline__ unsigned xb_xcc_id() { return (unsigned)__builtin_amdgcn_s_getreg((3 << 11) | 20) & 0xFu; }
#define XB_SPIN(cond, bar) do { unsigned _sp = 0; while (cond) { __builtin_amdgcn_s_sleep(1); \
    if ((++_sp & 255u) == 0u) { if (xb_ld(&(bar)[XB_TMO])) break; if (_sp > XB_SPIN_CAP) { atomicAdd(&(bar)[XB_TMO], 1u); break; } } } } while (0)

struct XcdBarrier {
    unsigned* bar; unsigned x;
    volatile LAS unsigned* st;
};

__device__ __forceinline__ XcdBarrier xcd_barrier_post(unsigned* bar, volatile LAS unsigned* st) {
    XcdBarrier b; b.bar = bar; b.x = xb_xcc_id(); b.st = st;
    if (threadIdx.x == 0) st[2] = xb_add(&bar[XB_XCNT(b.x)], 1u);
    return b;
}
__device__ __forceinline__ void xcd_barrier_complete(unsigned* bar, unsigned x, unsigned& nloc, unsigned& nx) {
    const unsigned G = gridDim.x * gridDim.y * gridDim.z;
    unsigned sum, cnt, mine, sp = 0u;
    for (;;) {
        sum = 0u; cnt = 0u; mine = 0u;
#pragma unroll
        for (unsigned j = 0; j < 16; ++j) { const unsigned c = xb_ld(&bar[XB_XCNT(j)]); sum += c; cnt += (c > 0u) ? 1u : 0u; mine = (j == x) ? c : mine; }
        if (sum == G) break;
        __builtin_amdgcn_s_sleep(1);
        if ((++sp & 255u) == 0u) { if (xb_ld(&bar[XB_TMO])) break; if (sp > XB_SPIN_CAP) { atomicAdd(&bar[XB_TMO], 1u); break; } }
    }
    nloc = mine > 0u ? mine : 1u; nx = cnt > 0u ? cnt : 1u;
}

__device__ __forceinline__ void xcd_barrier(const XcdBarrier& b) {
    asm volatile("s_waitcnt vmcnt(0)" ::: "memory");
    __syncthreads();
    if (threadIdx.x == 0) {
        unsigned* bar = b.bar;
        __builtin_amdgcn_s_waitcnt(0);
        unsigned nloc = b.st[0], nx = b.st[1];
        if (nloc == 0u) { xcd_barrier_complete(bar, b.x, nloc, nx); b.st[0] = nloc; b.st[1] = nx; }
        const unsigned old = xb_add(&bar[XB_XSUB(b.x)], 1u);
        const unsigned gen = old / nloc;
        if (old + 1u == (gen + 1u) * nloc) {
            __builtin_amdgcn_fence(__ATOMIC_RELEASE, "agent");
            asm volatile("s_waitcnt vmcnt(0)" ::: "memory");
            const unsigned og = xb_add(&bar[XB_TOP], 1u);
            const unsigned tg = og / nx;
            if (og + 1u == (tg + 1u) * nx) xb_add(&bar[XB_TOPGEN], 1u);
            else XB_SPIN(xb_ld(&bar[XB_TOPGEN]) == tg, bar);
            __builtin_amdgcn_fence(__ATOMIC_ACQUIRE, "agent");
            xb_add(&bar[XB_XGEN(b.x)], 1u);
            asm volatile("s_waitcnt vmcnt(0)" ::: "memory");
        } else {
            XB_SPIN(xb_ld(&bar[XB_XGEN(b.x)]) == gen, bar);
            __builtin_amdgcn_fence(__ATOMIC_ACQUIRE, "agent");
            asm volatile("s_waitcnt vmcnt(0)" ::: "memory");
        }
    }
    __syncthreads();
}

namespace pg8 {
#define PG8_LAS __attribute__((address_space(3)))
typedef unsigned short bf16_t;
typedef short bf16x8 __attribute__((ext_vector_type(8)));
typedef float f32x4 __attribute__((ext_vector_type(4)));
typedef unsigned u32x4 __attribute__((ext_vector_type(4)));
typedef unsigned pu32x2 __attribute__((ext_vector_type(2)));
constexpr int BM = 256, BK = 64, HALF = 128, HTB = HALF * BK * 2  , STAGE_BYTES = 8 * HTB, NXCD = 8, WGM = 8;

__host__ __device__ __forceinline__ int lds_byte(int r, int c) { const int st = (r >> 4) * 2 + (c >> 5), rr = r & 15, cc = c & 31, ob = rr * 64 + cc * 2; return st * 1024 + (ob ^ (((ob >> 9) & 1) << 5)); }
__host__ __device__ __forceinline__ void stage_rc(int b, int& R, int& C) { const int st = b / 1024, sb = b % 1024, swz = sb ^ (((sb >> 9) & 1) << 5); R = (st >> 1) * 16 + swz / 64; C = (st & 1) * 32 + (swz % 64) / 2; }
__host__ __device__ __forceinline__ int perm32(int rho) { const int n = rho >> 4, i = rho & 15; return 8 * (i >> 2) + 4 * n + (i & 3); }

struct Unit { int pm, pn; };
struct Gemm { const bf16_t* A; const bf16_t* Bt; int M, N, K; };

struct StaticOrder {
    int nM, nN, nwg, G, c;
    __host__ __device__ void init(int M, int N, int G_, int c_) { nM = M / BM; nN = N / BM; nwg = nM * nN; G = G_; c = c_; }
    __host__ __device__ bool next(int i, Unit& u) const {
        const long L = (long)i * G + c; if (L >= nwg) return false;
        int wgid = (int)L; { const int q = nwg / NXCD, r = nwg % NXCD, xcd = wgid % NXCD, off = wgid / NXCD; wgid = (xcd < r ? xcd * (q + 1) : r * (q + 1) + (xcd - r) * q) + off; }
        const int nig = WGM * nN, gid = wgid / nig, fm = gid * WGM, gsz = (nM - fm) < WGM ? (nM - fm) : WGM;
        u.pm = fm + ((wgid % nig) % gsz); u.pn = (wgid % nig) / gsz; return true;
    }
    __device__ __forceinline__ void a_ready(const Unit&) const {}
    __device__ __forceinline__ void done(const Unit&) const {}
};


__device__ __forceinline__ unsigned cvt_pk_bf16(float lo, float hi) { unsigned r; asm volatile("v_cvt_pk_bf16_f32 %0, %1, %2" : "=v"(r) : "v"(lo), "v"(hi)); return r; }
__device__ __forceinline__ float gelu_tanh_f(float x) { const float u = x + 0.044715f * x * x * x; const float e = __builtin_amdgcn_exp2f(u * -2.302208198f); return x * __builtin_amdgcn_rcpf(1.0f + e); }
struct EpiBf16S {
    static constexpr bool PERM = true, AFTER_DRAIN = false;
    bf16_t* O; int ldc; int sc_lo, sc_hi; float sc;
    __device__ __forceinline__ void operator()(const f32x4 (&acc)[2][2][4][2], const Unit& u, int wr, int wc, int fr, int fq) const {
        const int row0 = u.pm * BM + wr * 64 + fr; const int colt = u.pn * BM;
        const float s = (colt >= sc_lo && colt < sc_hi) ? sc : 1.f;
        const int col0 = colt + wc * 32 + 8 * fq;
#pragma unroll
        for (int ai = 0; ai < 2; ++ai)
#pragma unroll
            for (int m = 0; m < 4; ++m) { bf16_t* rowp = O + (size_t)(row0 + ai * HALF + m * 16) * ldc + col0;
#pragma unroll
                for (int bj = 0; bj < 2; ++bj) { const f32x4 v0 = acc[ai][bj][m][0] * s, v1 = acc[ai][bj][m][1] * s;
                    u32x4 w; w.x = cvt_pk_bf16(v0[0], v0[1]); w.y = cvt_pk_bf16(v0[2], v0[3]); w.z = cvt_pk_bf16(v1[0], v1[1]); w.w = cvt_pk_bf16(v1[2], v1[3]);
                    *(u32x4*)(rowp + bj * HALF) = w; } }
    }
};
struct EpiRes {
    static constexpr bool PERM = false, AFTER_DRAIN = false;
    const bf16_t* xb; bf16_t* Z; float alpha;
    __device__ __forceinline__ void operator()(const f32x4 (&acc)[2][2][4][2], const Unit& u, int wr, int wc, int fr, int fq) const {
        const int col0 = u.pn * BM + wc * 32 + 4 * fq;
#pragma unroll
        for (int ai = 0; ai < 2; ++ai)
#pragma unroll
            for (int m = 0; m < 4; ++m) { const int r = u.pm * BM + ai * HALF + wr * 64 + m * 16 + fr;
                const bf16_t* rp = xb + (size_t)r * 2048; bf16_t* zp = Z + (size_t)r * 2048;
#pragma unroll
                for (int bj = 0; bj < 2; ++bj)
#pragma unroll
                    for (int n = 0; n < 2; ++n) { const int c = col0 + bj * HALF + n * 16; const pu32x2 x = *(const pu32x2*)(rp + c); const f32x4 a = acc[ai][bj][m][n];
                        pu32x2 o; o.x = pk2(__builtin_bit_cast(float, x.x << 16) * alpha + a[0], __builtin_bit_cast(float, x.x & 0xffff0000u) * alpha + a[1]);
                        o.y = pk2(__builtin_bit_cast(float, x.y << 16) * alpha + a[2], __builtin_bit_cast(float, x.y & 0xffff0000u) * alpha + a[3]); *(pu32x2*)(zp + c) = o; } }
    }
};
struct EpiGelu {
    static constexpr bool PERM = true, AFTER_DRAIN = false;
    bf16_t* U; bf16_t* V; const float* bias; float* VST;
    __device__ __forceinline__ void operator()(const f32x4 (&acc)[2][2][4][2], const Unit& u, int wr, int wc, int fr, int fq) const {
        const int row0 = u.pm * BM + wr * 64 + fr; const bool isv = u.pn >= 24; const int colt = (isv ? u.pn - 24 : u.pn) * BM;
        bf16_t* base = isv ? V : U;
        const int col0 = colt + wc * 32 + 8 * fq, bcol0 = u.pn * BM + wc * 32 + 8 * fq;
        f32x4 bv[2][2];
#pragma unroll
        for (int bj = 0; bj < 2; ++bj)
#pragma unroll
            for (int n = 0; n < 2; ++n) bv[bj][n] = *(const f32x4*)(bias + bcol0 + bj * HALF + 4 * n);
#pragma unroll
        for (int ai = 0; ai < 2; ++ai)
#pragma unroll
            for (int m = 0; m < 4; ++m) { const int r = row0 + ai * HALF + m * 16; bf16_t* rowp = base + (size_t)r * 6144 + col0; float s1 = 0.f, s2 = 0.f;
#pragma unroll
                for (int bj = 0; bj < 2; ++bj) { f32x4 v0 = acc[ai][bj][m][0] + bv[bj][0], v1 = acc[ai][bj][m][1] + bv[bj][1];
#pragma unroll
                    for (int e = 0; e < 4; ++e) { v0[e] = gelu_tanh_f(v0[e]); v1[e] = gelu_tanh_f(v1[e]); s1 += v0[e] + v1[e]; s2 += v0[e] * v0[e] + v1[e] * v1[e]; }
                    u32x4 w; w.x = cvt_pk_bf16(v0[0], v0[1]); w.y = cvt_pk_bf16(v0[2], v0[3]); w.z = cvt_pk_bf16(v1[0], v1[1]); w.w = cvt_pk_bf16(v1[2], v1[3]);
                    *(u32x4*)(rowp + bj * HALF) = w; }
                if (isv) { s1 += __shfl_xor(s1, 16); s1 += __shfl_xor(s1, 32); s2 += __shfl_xor(s2, 16); s2 += __shfl_xor(s2, 32);
                    if (fq == 0) { atomicAdd(VST + 2 * r, s1); atomicAdd(VST + 2 * r + 1, s2); } } }
    }
};
template <class Epi, class Sched, bool ALIGN_EPI = false, bool SP2 = false>
__device__ __forceinline__ void gemm_phase(PG8_LAS unsigned char* lds, const Gemm g, const Sched& S, const Epi& E) {
    int tid_l = threadIdx.x; asm volatile("" : "+v"(tid_l));
    const int tid = tid_l, wid = __builtin_amdgcn_readfirstlane(tid >> 6), lane = tid & 63, wr = wid >> 2, wc = wid & 3, fr = lane & 15, fq = lane >> 4;
    const int K = g.K, nt = K / BK;
    unsigned voffA[2], voffB[2];
#pragma unroll
    for (int i = 0; i < 2; ++i) { int R, C; stage_rc(tid * 16 + i * 8192, R, C); const int Rb = Epi::PERM ? ((R & ~31) + perm32(R & 31)) : R;
        voffA[i] = (unsigned)(R * K + C) * 2u; voffB[i] = (unsigned)(Rb * K + C) * 2u; }
    const size_t kstep = (size_t)(BK * 2);
    const size_t hstep = (size_t)HALF * K * 2;
    const size_t tstep = 2 * hstep;
    const unsigned ldsw = (unsigned)wid * 1024u;
    const int aoff = lds_byte(wr * 64 + fr, fq * 8), boff = lds_byte(wc * 32 + fr, fq * 8);
#define PG8_SA(b, h) (((b) * 2 + (h)) * HTB)
#define PG8_SB(b, h) ((4 + (b) * 2 + (h)) * HTB)
#define PG8_STAGE(bufoff, gbase, voff) do { _Pragma("unroll") for (int _i = 0; _i < 2; ++_i) \
        __builtin_amdgcn_global_load_lds((const unsigned*)((const char*)(gbase) + (voff)[_i]), (PG8_LAS unsigned*)(lds + (bufoff) + ldsw + _i * 8192), 16, 0, 0); } while (0)
#define PG8_LDA(dst, b, h) do { _Pragma("unroll") for (int m = 0; m < 4; ++m) _Pragma("unroll") for (int k = 0; k < 2; ++k) dst[m][k] = *(const PG8_LAS bf16x8*)(lds + PG8_SA(b, h) + aoff + m * 2048 + k * 1024); } while (0)
#define PG8_LDB(dst, b, h) do { _Pragma("unroll") for (int n = 0; n < 2; ++n) _Pragma("unroll") for (int k = 0; k < 2; ++k) dst[n][k] = *(const PG8_LAS bf16x8*)(lds + PG8_SB(b, h) + boff + n * 2048 + k * 1024); } while (0)
#define PG8_MMA(ai, bj, At, Bt) do { __builtin_amdgcn_s_setprio(1); _Pragma("unroll") for (int m = 0; m < 4; ++m) _Pragma("unroll") for (int n = 0; n < 2; ++n) _Pragma("unroll") for (int k = 0; k < 2; ++k) \
        acc[ai][bj][m][n] = __builtin_amdgcn_mfma_f32_16x16x32_bf16(Bt[n][k], At[m][k], acc[ai][bj][m][n], 0, 0, 0); __builtin_amdgcn_s_setprio(0); } while (0)
#define PG8_WAIT_V(n) asm volatile("s_waitcnt vmcnt(" #n ")" ::: "memory")
#define PG8_WAIT_L(n) asm volatile("s_waitcnt lgkmcnt(" #n ")" ::: "memory")
#define PG8_BAR __builtin_amdgcn_s_barrier()
#define PG8_SCHED __builtin_amdgcn_sched_barrier(0)
    Unit cur, nxt; int ui = 0;
    if (!S.next(0, cur)) return;
    f32x4 acc[2][2][4][2];
#pragma unroll
    for (int a = 0; a < 2; ++a)
#pragma unroll
        for (int b = 0; b < 2; ++b)
#pragma unroll
            for (int m = 0; m < 4; ++m)
#pragma unroll
                for (int n = 0; n < 2; ++n) acc[a][b][m][n] = (f32x4){0.f, 0.f, 0.f, 0.f};
    bf16x8 At[4][2], B0[2][2], B1[2][2];
    const char* cA = (const char*)g.A + (size_t)cur.pm * tstep; const char* cB = (const char*)g.Bt + (size_t)cur.pn * tstep;
    S.a_ready(cur);
    if constexpr (SP2) {
        PG8_STAGE(PG8_SB(0, 0), cB, voffB); PG8_STAGE(PG8_SB(0, 1), cB + hstep, voffB); PG8_STAGE(PG8_SA(0, 0), cA, voffA); PG8_STAGE(PG8_SA(0, 1), cA + hstep, voffA);
        if (wr == 1) PG8_BAR;
        PG8_WAIT_V(2); PG8_BAR;
        PG8_STAGE(PG8_SB(1, 0), cB + kstep, voffB); PG8_STAGE(PG8_SA(1, 0), cA + kstep, voffA); PG8_STAGE(PG8_SB(1, 1), cB + hstep + kstep, voffB);
        PG8_WAIT_V(6); PG8_BAR;
    } else {
        PG8_STAGE(PG8_SB(0, 0), cB, voffB); PG8_STAGE(PG8_SA(0, 0), cA, voffA); PG8_STAGE(PG8_SB(0, 1), cB + hstep, voffB); PG8_STAGE(PG8_SA(0, 1), cA + hstep, voffA);
        if (wr == 1) PG8_BAR;
        PG8_WAIT_V(4); PG8_BAR;
        PG8_STAGE(PG8_SB(1, 0), cB + kstep, voffB); PG8_STAGE(PG8_SA(1, 0), cA + kstep, voffA); PG8_STAGE(PG8_SB(1, 1), cB + hstep + kstep, voffB);
        PG8_WAIT_V(6); PG8_BAR;
    }
    for (;;) {
        const bool has_next = S.next(ui + 1, nxt);
        const char* nA = has_next ? (const char*)g.A + (size_t)nxt.pm * tstep : cA; const char* nB = has_next ? (const char*)g.Bt + (size_t)nxt.pn * tstep : cB;
        for (int t = 0; t < nt; t += 2) {
            const bool last = (t == nt - 2);
            const char* a1 = cA + (size_t)(t + 1) * kstep;
            const char* a2 = last ? nA : cA + (size_t)(t + 2) * kstep; const char* b2 = last ? nB : cB + (size_t)(t + 2) * kstep;
            const char* a3 = a2 + kstep; const char* b3 = b2 + kstep;
            if (last && has_next) S.a_ready(nxt);
            if constexpr (SP2) {
            PG8_LDB(B0, 0, 0); PG8_LDB(B1, 0, 1); PG8_SCHED; PG8_LDA(At, 0, 0); PG8_STAGE(PG8_SA(1, 1), a1 + hstep, voffA);
            PG8_WAIT_V(8); PG8_WAIT_L(0); PG8_BAR; PG8_MMA(0, 0, At, B0); PG8_MMA(0, 1, At, B1); PG8_BAR; PG8_SCHED;
            PG8_LDA(At, 0, 1); PG8_STAGE(PG8_SB(0, 0), b2, voffB); PG8_STAGE(PG8_SB(0, 1), b2 + hstep, voffB); PG8_STAGE(PG8_SA(0, 0), a2, voffA);
            PG8_WAIT_V(8); PG8_WAIT_L(0); PG8_BAR; PG8_MMA(1, 0, At, B0); PG8_MMA(1, 1, At, B1); PG8_BAR; PG8_SCHED;
            PG8_LDB(B0, 1, 0); PG8_LDB(B1, 1, 1); PG8_SCHED; PG8_LDA(At, 1, 0); PG8_STAGE(PG8_SA(0, 1), a2 + hstep, voffA);
            PG8_WAIT_V(8); PG8_WAIT_L(0); PG8_BAR; PG8_MMA(0, 0, At, B0); PG8_MMA(0, 1, At, B1); PG8_BAR; PG8_SCHED;
            PG8_LDA(At, 1, 1); PG8_STAGE(PG8_SB(1, 0), b3, voffB); PG8_STAGE(PG8_SB(1, 1), b3 + hstep, voffB); PG8_STAGE(PG8_SA(1, 0), a3, voffA);
            PG8_WAIT_V(8); PG8_WAIT_L(0); PG8_BAR; PG8_MMA(1, 0, At, B0); PG8_MMA(1, 1, At, B1); PG8_BAR; PG8_SCHED;
            } else {
            PG8_LDB(B0, 0, 0); PG8_SCHED; PG8_LDA(At, 0, 0); PG8_STAGE(PG8_SA(1, 1), a1 + hstep, voffA);
            PG8_WAIT_L(8); PG8_BAR; PG8_WAIT_L(0); PG8_MMA(0, 0, At, B0); PG8_BAR; PG8_SCHED;
            PG8_LDB(B1, 0, 1); PG8_STAGE(PG8_SB(0, 0), b2, voffB);
            PG8_BAR; PG8_WAIT_L(0); PG8_MMA(0, 1, At, B1); PG8_BAR;
            PG8_LDA(At, 0, 1); PG8_STAGE(PG8_SA(0, 0), a2, voffA);
            PG8_BAR; PG8_WAIT_L(0); PG8_MMA(1, 0, At, B0); PG8_BAR; PG8_SCHED;
            PG8_STAGE(PG8_SB(0, 1), b2 + hstep, voffB);
            PG8_WAIT_V(6); PG8_BAR; PG8_MMA(1, 1, At, B1); PG8_BAR;
            PG8_LDB(B0, 1, 0); PG8_SCHED; PG8_LDA(At, 1, 0); PG8_STAGE(PG8_SA(0, 1), a2 + hstep, voffA);
            PG8_WAIT_L(8); PG8_BAR; PG8_WAIT_L(0); PG8_MMA(0, 0, At, B0); PG8_BAR; PG8_SCHED;
            PG8_LDB(B1, 1, 1); PG8_STAGE(PG8_SB(1, 0), b3, voffB);
            PG8_BAR; PG8_WAIT_L(0); PG8_MMA(0, 1, At, B1); PG8_BAR;
            PG8_LDA(At, 1, 1); PG8_STAGE(PG8_SA(1, 0), a3, voffA);
            PG8_BAR; PG8_WAIT_L(0); PG8_MMA(1, 0, At, B0); PG8_BAR; PG8_SCHED;
            PG8_STAGE(PG8_SB(1, 1), b3 + hstep, voffB);
            PG8_WAIT_V(6); PG8_BAR; PG8_MMA(1, 1, At, B1); PG8_BAR;
            }
        }
        if constexpr (ALIGN_EPI) { if (wr == 0) PG8_BAR; }
        if constexpr (!Epi::AFTER_DRAIN) { E(acc, cur, wr, wc, fr, fq); S.done(cur); }
        if (!has_next) break;
#pragma unroll
        for (int a = 0; a < 2; ++a)
#pragma unroll
            for (int b = 0; b < 2; ++b)
#pragma unroll
                for (int m = 0; m < 4; ++m)
#pragma unroll
                    for (int n = 0; n < 2; ++n) acc[a][b][m][n] = (f32x4){0.f, 0.f, 0.f, 0.f};
        cur = nxt; cA = nA; cB = nB; ++ui;
        if constexpr (ALIGN_EPI) { if (wr == 1) PG8_BAR; }
    }
    PG8_WAIT_V(0);
    if constexpr (!ALIGN_EPI) { if (wr == 0) PG8_BAR; }
    PG8_BAR;
    if constexpr (Epi::AFTER_DRAIN) { E.fused(acc, cur, wr, wc, fr, fq, lds, wid, lane); S.done(cur); }
#undef PG8_SA
#undef PG8_SB
#undef PG8_STAGE
#undef PG8_LDA
#undef PG8_LDB
#undef PG8_MMA
#undef PG8_WAIT_V
#undef PG8_WAIT_L
#undef PG8_BAR
#undef PG8_SCHED
}
}
constexpr int NWAVES = 8;
constexpr int LDS_BYTES = 147456;
constexpr int RING_BYTES = 131072;
constexpr int MISC_OFF = RING_BYTES + 320;
constexpr int NTOKF = 8704;
constexpr float ALPHA_F = 1.4142135623730951f;
constexpr size_t OUT_VS = 52565024;

struct Lay {
    unsigned long long ctl, wina, wouta, winb, woutb, wq, sk, gates, vst, idx, gt, ww, ptu, ptv, xf0, xf1, z, xb, qp, qkvo, ub, vb, um, wsb, ptu1, ptv1, rinv, su, xq, sx;
};
struct Args { const float* in[24]; float* out; unsigned char* ws; Lay L; int ph_lo, ph_hi, li, pad; };

__device__ __forceinline__ float wave_sum_f(float v) {
#pragma unroll
    for (int o = 1; o < 64; o <<= 1) v += __shfl_xor(v, o);
    return v;
}
__device__ __forceinline__ void p0_transpose_item(const float* W, int K, int ldw, int Nuse, bf16* WT, LAS float* scr, int item, int lane) {
    const int nblk = Nuse / 32, kb = item / nblk, nb = item % nblk, k0 = 64 * kb, n0 = 32 * nb;
    f32x4 ld[8];
#pragma unroll
    for (int i = 0; i < 8; ++i) ld[i] = __builtin_nontemporal_load((const GAS f32x4*)(W + (size_t)(k0 + 8 * i + (lane >> 3)) * ldw + n0 + (lane & 7) * 4));
#pragma unroll
    for (int i = 0; i < 8; ++i) { LAS float* d = scr + (8 * i + (lane >> 3)) * 33 + (lane & 7) * 4; d[0] = ld[i].x; d[1] = ld[i].y; d[2] = ld[i].z; d[3] = ld[i].w; }
    LDS_WAIT(); asm volatile("" ::: "memory");
    const int c = lane & 7;
#pragma unroll
    for (int j = 0; j < 4; ++j) { const int n = (lane >> 3) + 8 * j; const LAS float* s = scr + (8 * c) * 33 + n;
        v4u o; o.x = pk2(s[0 * 33], s[1 * 33]); o.y = pk2(s[2 * 33], s[3 * 33]); o.z = pk2(s[4 * 33], s[5 * 33]); o.w = pk2(s[6 * 33], s[7 * 33]);
        *(GAS v4u*)(WT + (size_t)(n0 + n) * K + k0 + 8 * c) = o; }
    LDS_WAIT(); asm volatile("" ::: "memory");
}
__device__ __forceinline__ void cvt_stream(const float* src, bf16* dst, size_t n8, int gw, int NGW, int lane) {
    for (size_t i = (size_t)gw * 64 + lane; i < n8; i += (size_t)NGW * 64) {
        const f32x4 a = *(const GAS f32x4*)(src + i * 8), b = *(const GAS f32x4*)(src + i * 8 + 4);
        v4u o; o.x = pk2(a.x, a.y); o.y = pk2(a.z, a.w); o.z = pk2(b.x, b.y); o.w = pk2(b.z, b.w);
        *(GAS v4u*)(dst + i * 8) = o;
    }
}
__device__ __forceinline__ void cvt_peer_table(const float* src, bf16* dst, int gw, int NGW, int lane) {
    const size_t n8 = (size_t)16384 * 2048 / 8;
    for (size_t i = (size_t)gw * 64 + lane; i < n8; i += (size_t)NGW * 64) {
        const f32x4 a = __builtin_nontemporal_load((const GAS f32x4*)(src + i * 8)), b = __builtin_nontemporal_load((const GAS f32x4*)(src + i * 8 + 4));
        v4u o; o.x = pk2(a.x, a.y); o.y = pk2(a.z, a.w); o.z = pk2(b.x, b.y); o.w = pk2(b.z, b.w);
        const size_t e = i >> 8; const int c8 = (int)(i & 255) * 8;
        *(GAS v4u*)(dst + ((size_t)(c8 >> 6) * 16384 + e) * 64 + (c8 & 63)) = o;
    }
}
__device__ __forceinline__ void cvt_peer_table_fp8(const float* src, unsigned char* dst, float* rinv, int gw, int NGW, int lane) {
    f32x4 nx[8];
    if (gw < 16384) {
#pragma unroll
        for (int j = 0; j < 8; ++j) nx[j] = __builtin_nontemporal_load((const GAS f32x4*)(src + (size_t)gw * 2048 + j * 256 + lane * 4)); }
    for (int e = gw; e < 16384; e += NGW) {
        f32x4 v[8]; float am = 0.f;
#pragma unroll
        for (int j = 0; j < 8; ++j) { v[j] = nx[j]; am = fmaxf(am, fmaxf(fmaxf(fabsf(v[j].x), fabsf(v[j].y)), fmaxf(fabsf(v[j].z), fabsf(v[j].w)))); }
        if (e + NGW < 16384) {
#pragma unroll
            for (int j = 0; j < 8; ++j) nx[j] = __builtin_nontemporal_load((const GAS f32x4*)(src + (size_t)(e + NGW) * 2048 + j * 256 + lane * 4)); }
#pragma unroll
        for (int o = 1; o < 64; o <<= 1) am = fmaxf(am, __shfl_xor(am, o));
        const float sc = (am > 0.f) ? exp2f(floorf(log2f(224.f / am))) : 1.f;
        if (lane == 0) rinv[e] = 1.f / sc;
#pragma unroll
        for (int j = 0; j < 8; ++j) { unsigned p = __builtin_amdgcn_cvt_pk_fp8_f32(v[j].x * sc, v[j].y * sc, 0u, false); p = __builtin_amdgcn_cvt_pk_fp8_f32(v[j].z * sc, v[j].w * sc, p, true);
            const int w = lane & 31, pw = ((((w >> 2) & 1) * 4 + (w & 3)) << 2) + ((w >> 4) & 1) * 2 + ((w >> 3) & 1);
            *(GAS unsigned*)(dst + ((size_t)(2 * j + (lane >> 5)) * 16384 + e) * 128 + pw * 4) = p; }
    }
}
__device__ __forceinline__ unsigned pack_i8x4(f32x4 v, float sc) { const int a = __float2int_rn(v.x * sc), b = __float2int_rn(v.y * sc), c = __float2int_rn(v.z * sc), d = __float2int_rn(v.w * sc);
    return (unsigned)(a & 0xFF) | ((unsigned)(b & 0xFF) << 8) | ((unsigned)(c & 0xFF) << 16) | ((unsigned)d << 24); }
__device__ __forceinline__ void cvt_peer_table_i8(const float* src, unsigned char* dst, float* rinv, int gw, int NGW, int lane) {
    f32x4 nx[8];
    if (gw < 16384) {
#pragma unroll
        for (int j = 0; j < 8; ++j) nx[j] = __builtin_nontemporal_load((const GAS f32x4*)(src + (size_t)gw * 2048 + j * 256 + lane * 4)); }
    for (int e = gw; e < 16384; e += NGW) {
        f32x4 v[8]; float am = 0.f;
#pragma unroll
        for (int j = 0; j < 8; ++j) { v[j] = nx[j]; am = fmaxf(am, fmaxf(fmaxf(fabsf(v[j].x), fabsf(v[j].y)), fmaxf(fabsf(v[j].z), fabsf(v[j].w)))); }
        if (e + NGW < 16384) {
#pragma unroll
            for (int j = 0; j < 8; ++j) nx[j] = __builtin_nontemporal_load((const GAS f32x4*)(src + (size_t)(e + NGW) * 2048 + j * 256 + lane * 4)); }
#pragma unroll
        for (int o = 1; o < 64; o <<= 1) am = fmaxf(am, __shfl_xor(am, o));
        const float sc = (am > 0.f) ? 127.f / am : 0.f;
        if (lane == 0) rinv[e] = am * (1.f / 127.f);
#pragma unroll
        for (int j = 0; j < 8; ++j) *(GAS unsigned*)(dst + ((size_t)(2 * j + (lane >> 5)) * 16384 + e) * 128 + (lane & 31) * 4) = pack_i8x4(v[j], sc);
    }
}
__device__ __forceinline__ const float* xrow_in(const Args& a, int r) { return r < 8192 ? a.in[0] + (size_t)r * 2048 : a.in[1] + (size_t)(r - 8192) * 2048; }

__device__ __forceinline__ void phase_prologue(const Args& a, LAS unsigned char* lds, int vcu, int G, int wave, int lane) {
    unsigned char* ws = a.ws;
    LAS float* scr = (LAS float*)(lds + wave * 16384);
    const int gw = vcu * NWAVES + wave, NGW = G * NWAVES;
    for (int it = gw; it < 32 * 192; it += NGW) p0_transpose_item(a.in[5], 2048, 6160, 6144, (bf16*)(ws + a.L.wina), scr, it, lane);
    __syncthreads();
    { LAS f32x4* wg = (LAS f32x4*)lds; const float* w = a.in[5];
      for (int i = threadIdx.x; i < 2048 * 4; i += NWAVES * 64) { const int k = i >> 2, q4 = i & 3; wg[(k >> 2) * 16 + ((((k & 3) * 4 + q4)) ^ ((k >> 2) & 15))] = *(const GAS f32x4*)(w + (size_t)k * 6160 + 6144 + q4 * 4); } }
    __syncthreads();
    const float* bg = a.in[6];
    for (int r = gw; r < NTOKF; r += NGW) {
        const float* xr = xrow_in(a, r);
        GAS unsigned long long* o8 = (GAS unsigned long long*)((bf16*)(ws + a.L.xb) + (size_t)r * 2048) + lane;
        float g[16];
#pragma unroll
        for (int q = 0; q < 16; ++q) g[q] = 0.f;
#pragma unroll 1
        for (int j = 0; j < 8; ++j) {
            const f32x4 xv = *(const GAS f32x4*)(xr + j * 256 + lane * 4);
            o8[64 * j] = (unsigned long long)pk2(xv.x, xv.y) | ((unsigned long long)pk2(xv.z, xv.w) << 32);
            const int kq = j * 64 + lane;
#pragma unroll
            for (int e = 0; e < 4; ++e) { const float x = xv[e];
#pragma unroll
                for (int q4 = 0; q4 < 4; ++q4) { const f32x4 w4 = ((const LAS f32x4*)lds)[kq * 16 + ((e * 4 + q4) ^ (kq & 15))]; g[q4 * 4 + 0] += x * w4.x; g[q4 * 4 + 1] += x * w4.y; g[q4 * 4 + 2] += x * w4.z; g[q4 * 4 + 3] += x * w4.w; } }
        }
        float mine = 0.f;
#pragma unroll
        for (int q = 0; q < 16; ++q) { const float s = wave_sum_f(g[q]); if (lane == q) mine = s; }
        if (lane < 16) { float v = mine + bg[lane]; if (lane >= 8) v = fminf(v, 0.f) - log1pf(expf(-fabsf(v))); ((float*)(ws + a.L.gates))[(size_t)r * 16 + lane] = v; }
    }
    __syncthreads();
}

__device__ __forceinline__ void side_convert(const Args& a, LAS unsigned char* lds, int gw, int NGW, int wave, int lane, int parts) {
    unsigned char* ws = a.ws;
    LAS float* scr = (LAS float*)(lds + wave * 16384);
    constexpr int I_OA = 32 * 64, I_B = 32 * 384, I_OB = 96 * 64, I_Q = 32 * 64;
    constexpr int NITEMS = I_OA + I_B + I_OB + 2 * I_Q;
    if (parts & 1) for (int it = gw; it < NITEMS; it += NGW) {
        int r = it;
        if (r < I_OA) { p0_transpose_item(a.in[8], 2048, 2048, 2048, (bf16*)(ws + a.L.wouta), scr, r, lane); continue; } r -= I_OA;
        if (r < I_B) { p0_transpose_item(a.in[9], 2048, 12288, 12288, (bf16*)(ws + a.L.winb), scr, r, lane); continue; } r -= I_B;
        if (r < I_OB) { p0_transpose_item(a.in[15], 6144, 2048, 2048, (bf16*)(ws + a.L.woutb), scr, r, lane); continue; } r -= I_OB;
        if (r < I_Q) { p0_transpose_item(a.in[20], 2048, 2048, 2048, (bf16*)(ws + a.L.wq), scr, r, lane); continue; } r -= I_Q;
        p0_transpose_item(a.in[20] + (size_t)2048 * 2048, 2048, 2048, 2048, (bf16*)(ws + a.L.wq) + (size_t)2048 * 2048, scr, r, lane);
    }
    if (parts & 2) { float* ri = (float*)(ws + a.L.rinv);
      cvt_peer_table_i8(a.in[22], ws + a.L.ptu, ri, gw, NGW, lane);
      cvt_peer_table_fp8(a.in[23], ws + a.L.ptv, ri + 16384, gw, NGW, lane);
      cvt_peer_table_i8(a.in[22] + (size_t)16384 * 2048, ws + a.L.ptu1, ri + 32768, gw, NGW, lane);
      cvt_peer_table_fp8(a.in[23] + (size_t)16384 * 2048, ws + a.L.ptv1, ri + 49152, gw, NGW, lane); }
    cvt_stream(a.in[21], (bf16*)(ws + a.L.sk), (size_t)2 * 16 * 128 * 128 / 8, gw, NGW, lane);
    { bf16* wsb = (bf16*)(ws + a.L.wsb); const float* wsf = a.in[13]; for (int i = gw * 64 + lane; i < 8 * 128 * 128; i += NGW * 64) { const int t = (i >> 7) & 127, s = i & 127; wsb[i] = (bf16)(s <= t ? f2bf(wsf[i]) : 0u); } }
    { float* vst = (float*)(ws + a.L.vst); for (int i = gw * 64 + lane; i < NTOKF * 2; i += NGW * 64) vst[i] = 0.f; }
}

template <bool ZBF>
__device__ __forceinline__ void phase_ln(const float* Z, const float* g, const float* b, float* Xf, bf16* Xb, unsigned char* Xq, float* sx, bf16* XS, int vcu, int G, int wave, int lane) {
    const int gw = vcu * NWAVES + wave, NGW = G * NWAVES;
    f32x4 gv[8], bv[8];
#pragma unroll
    for (int j = 0; j < 8; ++j) { gv[j] = *(const GAS f32x4*)(g + j * 256 + lane * 4); bv[j] = *(const GAS f32x4*)(b + j * 256 + lane * 4); }
    for (int r = gw; r < NTOKF; r += NGW) {
        const float* zr = Z + (size_t)r * 2048;
        f32x4 v[8]; float s = 0.f;
#pragma unroll
        for (int j = 0; j < 8; ++j) {
            if (!ZBF) { const unsigned long long q = *((const GAS unsigned long long*)((const bf16*)Z + (size_t)r * 2048) + 64 * j + lane); const unsigned lo = (unsigned)q, hi = (unsigned)(q >> 32);
                v[j] = (f32x4){__builtin_bit_cast(float, lo << 16), __builtin_bit_cast(float, lo & 0xffff0000u), __builtin_bit_cast(float, hi << 16), __builtin_bit_cast(float, hi & 0xffff0000u)}; }
            else { const unsigned long long q = *((const GAS unsigned long long*)((const bf16*)Z + ((size_t)(2 * j + (lane >> 5)) * NTOKF + r) * 128) + (lane & 31)); const unsigned lo = (unsigned)q, hi = (unsigned)(q >> 32);
                v[j] = (f32x4){__builtin_bit_cast(float, lo << 16), __builtin_bit_cast(float, lo & 0xffff0000u), __builtin_bit_cast(float, hi << 16), __builtin_bit_cast(float, hi & 0xffff0000u)}; }
            s += (v[j].x + v[j].y) + (v[j].z + v[j].w); }
        const float mean = wave_sum_f(s) * (1.f / 2048.f); float s2 = 0.f;
#pragma unroll
        for (int j = 0; j < 8; ++j) { v[j] = v[j] - mean; s2 += (v[j].x * v[j].x + v[j].y * v[j].y) + (v[j].z * v[j].z + v[j].w * v[j].w); }
        const float rstd = 1.f / sqrtf(wave_sum_f(s2) * (1.f / 2048.f) + 1e-5f);
#pragma unroll
        for (int j = 0; j < 8; ++j) { v[j] = v[j] * rstd * gv[j] + bv[j]; if (Xf) *(GAS f32x4*)(Xf + (size_t)r * 2048 + j * 256 + lane * 4) = v[j]; }
        if (Xq) {
            float am = 0.f;
#pragma unroll
            for (int j = 0; j < 8; ++j) am = fmaxf(am, fmaxf(fmaxf(fabsf(v[j].x), fabsf(v[j].y)), fmaxf(fabsf(v[j].z), fabsf(v[j].w))));
#pragma unroll
            for (int o = 1; o < 64; o <<= 1) am = fmaxf(am, __shfl_xor(am, o));
            const float sc = (am > 0.f) ? 127.f / am : 0.f;
            if (lane == 0) sx[r] = am * (1.f / 127.f);
#pragma unroll
            for (int j = 0; j < 8; ++j) *(GAS unsigned*)(Xq + (size_t)r * 2048 + j * 256 + lane * 4) = pack_i8x4(v[j], sc);
        }
        if (Xb) { GAS unsigned long long* o8 = (GAS unsigned long long*)(Xb + (size_t)r * 2048) + lane;
#pragma unroll
            for (int j = 0; j < 8; ++j) { const unsigned long long w = (unsigned long long)pk2(v[j].x, v[j].y) | ((unsigned long long)pk2(v[j].z, v[j].w) << 32); o8[64 * j] = w;
                if (XS) *((GAS unsigned long long*)(XS + ((size_t)(2 * j + (lane >> 5)) * NTOKF + r) * 128) + (lane & 31)) = w; } }
    }
}
typedef __bf16 bf16x2_t __attribute__((ext_vector_type(2)));
typedef int i32x4 __attribute__((ext_vector_type(4)));
__device__ __forceinline__ unsigned fkey(float f) { const unsigned u = __builtin_bit_cast(unsigned, f); return (u & 0x80000000u) ? ~u : (u | 0x80000000u); }
__device__ __forceinline__ float keyf(unsigned k) { const unsigned u = (k & 0x80000000u) ? (k & 0x7fffffffu) : ~k; return __builtin_bit_cast(float, u); }
__device__ __forceinline__ float dot2bf(unsigned a, unsigned b, float c) { return __builtin_amdgcn_fdot2_f32_bf16(__builtin_bit_cast(bf16x2_t, a), __builtin_bit_cast(bf16x2_t, b), c, false); }
__device__ __forceinline__ float bflo(unsigned w) { return __builtin_bit_cast(float, w << 16); }
__device__ __forceinline__ float bfhi(unsigned w) { return __builtin_bit_cast(float, w & 0xffff0000u); }
__device__ __forceinline__ float gelu_tanh_g(float x) { const float u = x + 0.044715f * x * x * x; const float e = __builtin_amdgcn_exp2f(u * -2.302208198f); return x * __builtin_amdgcn_rcpf(1.0f + e); }
#define INS16(v, x) do { unsigned nw_ = (x); _Pragma("unroll") for (int k_ = 0; k_ < 16; ++k_) { const unsigned hi_ = max(v[k_], nw_); nw_ = min(v[k_], nw_); v[k_] = hi_; } } while (0)


#define CE_DESC(a, b) do { const unsigned hi_ = max(a, b), lo_ = min(a, b); a = hi_; b = lo_; } while (0)
__device__ __forceinline__ void sort16_desc(unsigned (&v)[16]) {
#pragma unroll
    for (int k = 2; k <= 16; k <<= 1)
#pragma unroll
        for (int j = k >> 1; j > 0; j >>= 1)
#pragma unroll
            for (int i = 0; i < 16; ++i) { const int l = i ^ j; if (l > i) { if ((i & k) == 0) CE_DESC(v[i], v[l]); else CE_DESC(v[l], v[i]); } }
}
__device__ __forceinline__ void merge_top16(unsigned (&a)[16], const unsigned (&b)[16]) {
#pragma unroll
    for (int i = 0; i < 16; ++i) a[i] = max(a[i], b[15 - i]);
#pragma unroll
    for (int sd = 8; sd >= 1; sd >>= 1)
#pragma unroll
        for (int i = 0; i < 16; ++i) if ((i & sd) == 0) CE_DESC(a[i], a[i + sd]);
}
static __device__ const unsigned char CAND_TAB[52] = {
    0, 1, 2, 3, 4, 5, 6, 7, 8, 9, 10, 11, 12, 13, 14, 15,
    16, 17, 18, 19, 20, 21, 22, 23,
    32, 33, 34, 35, 36,
    48, 49, 50, 51,
    64, 65, 66,
    80, 81,
    96, 97,
    112, 113,
    128, 144, 160, 176, 192, 208, 224, 240,
    255, 255 };

template <int MODE>
__device__ __forceinline__ void phase_topk(const bf16* QP, const bf16* SK, int* IDX, float* GT, float* AACC, float* SU, const float* rinvU, const float* rinvV, LAS unsigned char* lds, int vcu, int G, int wave, int lane) {
    LAS float* S = (LAS float*)lds;
    LAS unsigned char* NL = lds + 2 * 64 * 132 * 4;
    LAS float* FL = (LAS float*)(NL + 512 * 32);
    const int tid = wave * 64 + lane;
    for (int u = vcu; u < 136 * 8; u += G) {
        const int tt = u >> 3, h = u & 7;
        if (MODE != 1) {
            const int p = wave >> 2, rt = wave & 3, fr = lane & 15, fq = lane >> 4;
            const bf16* qrow = QP + (size_t)(tt * 64 + rt * 16 + fr) * 2048 + h * 256 + p * 128 + 8 * fq;
            bf16x8 af[4];
#pragma unroll
            for (int ks = 0; ks < 4; ++ks) af[ks] = *(const GAS bf16x8*)(qrow + ks * 32);
            const bf16* kbase = SK + (size_t)((h * 2 + p) * 128 + fr) * 128 + 8 * fq;
#pragma unroll 4
            for (int nt = 0; nt < 8; ++nt) {
                bf16x8 bfr[4];
#pragma unroll
                for (int ks = 0; ks < 4; ++ks) bfr[ks] = *(const GAS bf16x8*)(kbase + (size_t)nt * 16 * 128 + ks * 32);
                f32x4 acc = (f32x4){0.f, 0.f, 0.f, 0.f};
#pragma unroll
                for (int ks = 0; ks < 4; ++ks) acc = __builtin_amdgcn_mfma_f32_16x16x32_bf16(af[ks], bfr[ks], acc, 0, 0, 0);
                LAS float* sp = S + (size_t)(p * 64 + rt * 16 + fq * 4) * 132 + nt * 16 + fr;
                sp[0] = acc[0]; sp[132] = acc[1]; sp[264] = acc[2]; sp[396] = acc[3];
            }
        }
        __syncthreads();
        if (MODE != 2) {
            const int tl = lane >> 3, p = (lane >> 2) & 1, qr = lane & 3, t = wave * 8 + tl;
            unsigned own[16], oth_[16];
            const LAS f32x4* sp = (const LAS f32x4*)(S + (size_t)(p * 64 + t) * 132 + qr * 32);
#pragma unroll
            for (int c = 0; c < 4; ++c) { const f32x4 v = sp[c], w = sp[4 + c];
#pragma unroll
                for (int e = 0; e < 4; ++e) { own[c * 4 + e] = (fkey(v[e]) & ~127u) | (unsigned)(127 - (qr * 32 + c * 4 + e)); oth_[c * 4 + e] = (fkey(w[e]) & ~127u) | (unsigned)(127 - (qr * 32 + 16 + c * 4 + e)); } }
            sort16_desc(own); sort16_desc(oth_); merge_top16(own, oth_);
#pragma unroll
            for (int st = 1; st <= 2; st <<= 1) {
#pragma unroll
                for (int i = 0; i < 16; ++i) oth_[i] = (unsigned)__shfl_xor((int)own[i], st);
                merge_top16(own, oth_);
            }
            LAS unsigned char* nl = NL + tid * 32;
            LAS float* fl = FL + (tid >> 2) * 32;
#pragma unroll
            for (int i = 0; i < 16; ++i) { const unsigned oth = (unsigned)__shfl_xor((int)own[i], 4); const unsigned a0 = p ? oth : own[i], a1 = p ? own[i] : oth;
                if (qr == 0) { fl[i] = keyf(a0 & ~127u); fl[16 + i] = keyf(a1 & ~127u); }
                nl[i] = (unsigned char)(127u - (a0 & 127u)); nl[16 + i] = (unsigned char)(127u - (a1 & 127u)); }
            unsigned tv[16];
#pragma unroll
            for (int k = 0; k < 16; ++k) tv[k] = 0u;
#pragma unroll
            for (int m = 0; m < 13; ++m) { const unsigned c = CAND_TAB[m * 4 + qr]; unsigned key = 0u;
                if (c != 255u) { const float s = fl[c >> 4] + fl[16 + (c & 15u)]; key = (fkey(s) & ~255u) | (255u - c); }
                INS16(tv, key); }
#pragma unroll
            for (int st = 1; st <= 2; st <<= 1) {
#pragma unroll
                for (int i = 0; i < 16; ++i) oth_[i] = (unsigned)__shfl_xor((int)tv[i], st);
                merge_top16(tv, oth_);
            }
            float ev[16]; int ex[16]; float sum = 0.f; const float mx = keyf(tv[0] & ~255u);
#pragma unroll
            for (int k = 0; k < 16; ++k) { const unsigned c = 255u - (tv[k] & 255u); const int i = (int)(c >> 4), j = (int)(c & 15u);
                ex[k] = (int)nl[i] * 128 + (int)nl[16 + j]; ev[k] = __expf(keyf(tv[k] & ~255u) - mx); sum += ev[k]; }
            const float inv = 1.f / sum;
            if (MODE == 3) { if (ex[0] == 0x7fffffff) IDX[0] = (int)inv; }
            else if (p == 0 && qr == 0) {
                const size_t o = (size_t)(tt * 64 + t) * 128 + h * 16;
#pragma unroll
                for (int k4 = 0; k4 < 4; ++k4) { *(GAS i32x4*)(IDX + o + k4 * 4) = (i32x4){ex[k4 * 4], ex[k4 * 4 + 1], ex[k4 * 4 + 2], ex[k4 * 4 + 3]};
                    *(GAS f32x4*)(GT + o + k4 * 4) = (f32x4){ev[k4 * 4] * inv, ev[k4 * 4 + 1] * inv, ev[k4 * 4 + 2] * inv, ev[k4 * 4 + 3] * inv};
                    *(GAS f32x4*)(AACC + o + k4 * 4) = (f32x4){0.f, 0.f, 0.f, 0.f}; }
            }
        }
        __syncthreads();
    }
}

__device__ __forceinline__ void phase_upass(const bf16* U, const bf16* XBt, const int* IDX, const float* GT, float* WW, int vcu, int G, int wave, int lane) {
    const int gw = vcu * NWAVES + wave, NGW = G * NWAVES;
    for (int t = gw; t < NTOKF; t += NGW) {
        v4u xq[4];
#pragma unroll
        for (int j = 0; j < 4; ++j) xq[j] = *(const GAS v4u*)(XBt + (size_t)t * 2048 + j * 512 + lane * 8);
        const int ilo = IDX[(size_t)t * 128 + lane], ihi = IDX[(size_t)t * 128 + 64 + lane];
        float wlo = 0.f, whi = 0.f;
#pragma unroll 1
        for (int e0 = 0; e0 < 128; e0 += 4) {
            v4u uq[4][4];
#pragma unroll
            for (int ee = 0; ee < 4; ++ee) { const int e = e0 + ee; const int id = __builtin_amdgcn_readlane(e0 < 64 ? ilo : ihi, e & 63);
                const bf16* ur = U + (size_t)id * 2048 + lane * 8;
#pragma unroll
                for (int j = 0; j < 4; ++j) uq[ee][j] = *(const GAS v4u*)(ur + j * 512); }
#pragma unroll
            for (int ee = 0; ee < 4; ++ee) { float acc = 0.f;
#pragma unroll
                for (int j = 0; j < 4; ++j) { acc = dot2bf(uq[ee][j].x, xq[j].x, acc); acc = dot2bf(uq[ee][j].y, xq[j].y, acc); acc = dot2bf(uq[ee][j].z, xq[j].z, acc); acc = dot2bf(uq[ee][j].w, xq[j].w, acc); }
                acc = wave_sum_f(acc);
                const int e = e0 + ee;
                if (lane == (e & 63)) { if (e0 < 64) wlo = acc; else whi = acc; } }
        }
        WW[(size_t)t * 128 + lane] = gelu_tanh_g(wlo) * GT[(size_t)t * 128 + lane];
        WW[(size_t)t * 128 + 64 + lane] = gelu_tanh_g(whi) * GT[(size_t)t * 128 + 64 + lane];
    }
}

__device__ __forceinline__ void phase_vpass(const bf16* V, const float* Xf, const int* IDX, const float* WW, float* Z, float alpha, int vcu, int G, int wave, int lane) {
    const int gw = vcu * NWAVES + wave, NGW = G * NWAVES;
    for (int t = gw; t < NTOKF; t += NGW) {
        f32x4 acc[4][2];
#pragma unroll
        for (int j = 0; j < 4; ++j)
#pragma unroll
            for (int q = 0; q < 2; ++q) acc[j][q] = *(const GAS f32x4*)(Xf + (size_t)t * 2048 + j * 512 + lane * 8 + q * 4) * alpha;
        const int ilo = IDX[(size_t)t * 128 + lane], ihi = IDX[(size_t)t * 128 + 64 + lane];
        const float wlo = WW[(size_t)t * 128 + lane], whi = WW[(size_t)t * 128 + 64 + lane];
#pragma unroll 1
        for (int e0 = 0; e0 < 128; e0 += 4) {
            v4u vq[4][4]; float wv[4];
#pragma unroll
            for (int ee = 0; ee < 4; ++ee) { const int e = e0 + ee; const int id = __builtin_amdgcn_readlane(e0 < 64 ? ilo : ihi, e & 63);
                wv[ee] = __builtin_bit_cast(float, __builtin_amdgcn_readlane(__builtin_bit_cast(int, e0 < 64 ? wlo : whi), e & 63));
                const bf16* vr = V + (size_t)id * 2048 + lane * 8;
#pragma unroll
                for (int j = 0; j < 4; ++j) vq[ee][j] = *(const GAS v4u*)(vr + j * 512); }
#pragma unroll
            for (int ee = 0; ee < 4; ++ee)
#pragma unroll
                for (int j = 0; j < 4; ++j) { const v4u q = vq[ee][j]; const float w = wv[ee];
                    acc[j][0].x += w * bflo(q.x); acc[j][0].y += w * bfhi(q.x); acc[j][0].z += w * bflo(q.y); acc[j][0].w += w * bfhi(q.y);
                    acc[j][1].x += w * bflo(q.z); acc[j][1].y += w * bfhi(q.z); acc[j][1].z += w * bflo(q.w); acc[j][1].w += w * bfhi(q.w); }
        }
#pragma unroll
        for (int j = 0; j < 4; ++j)
#pragma unroll
            for (int q = 0; q < 2; ++q) *(GAS f32x4*)(Z + (size_t)t * 2048 + j * 512 + lane * 8 + q * 4) = acc[j][q];
    }
}

struct XTopo { int xi, nx, wq, nwq; };
__device__ __forceinline__ XTopo xcd_topology(unsigned* bar, unsigned x, unsigned rank, int wave) {
    XTopo t; int xi = 0, nx = 0, nloc = 1;
#pragma unroll
    for (unsigned j = 0; j < 16; ++j) { const unsigned c = xb_ld(&bar[XB_XCNT(j)]); if (c > 0u) { if (j < x) ++xi; ++nx; } if (j == x) nloc = (int)c; }
    if (nloc < 1) nloc = 1; if (nx < 1) nx = 1;
    t.xi = __builtin_amdgcn_readfirstlane(xi); t.nx = __builtin_amdgcn_readfirstlane(nx); t.wq = __builtin_amdgcn_readfirstlane((int)rank * NWAVES + wave); t.nwq = __builtin_amdgcn_readfirstlane(nloc * NWAVES); return t;
}
typedef float f32x2 __attribute__((ext_vector_type(2)));
template <int MODE>
__device__ __forceinline__ void upass_reduce_add(float (&acc)[16], float* ap, int lane) {
    const bool b2 = (lane & 4) != 0, b1 = (lane & 2) != 0, b0 = (lane & 1) != 0;
    float r8[8], r4[4], r2[2];
#pragma unroll
    for (int j = 0; j < 8; ++j) { const float keep = b2 ? acc[8 + j] : acc[j], send = b2 ? acc[j] : acc[8 + j]; r8[j] = keep + __shfl_xor(send, 4); }
#pragma unroll
    for (int j = 0; j < 4; ++j) { const float keep = b1 ? r8[4 + j] : r8[j], send = b1 ? r8[j] : r8[4 + j]; r4[j] = keep + __shfl_xor(send, 2); }
#pragma unroll
    for (int j = 0; j < 2; ++j) { const float keep = b0 ? r4[2 + j] : r4[j], send = b0 ? r4[j] : r4[2 + j]; r2[j] = keep + __shfl_xor(send, 1); }
    if (MODE == 1) { ap[0] = r2[0]; ap[64] = r2[1]; } else { unsafeAtomicAdd(ap, r2[0]); unsafeAtomicAdd(ap + 64, r2[1]); }
}
__device__ __forceinline__ float dot16_i8(const v4u q, const v4u x) {
    int a = __builtin_amdgcn_sdot4((int)q.x, (int)x.x, 0, false); a = __builtin_amdgcn_sdot4((int)q.y, (int)x.y, a, false);
    a = __builtin_amdgcn_sdot4((int)q.z, (int)x.z, a, false); a = __builtin_amdgcn_sdot4((int)q.w, (int)x.w, a, false);
    return (float)a;
}
__device__ __forceinline__ void unpack16bf(const v4u a, const v4u b, float (&xf)[16]) {
    xf[0] = bflo(a.x); xf[1] = bfhi(a.x); xf[2] = bflo(a.y); xf[3] = bfhi(a.y); xf[4] = bflo(a.z); xf[5] = bfhi(a.z); xf[6] = bflo(a.w); xf[7] = bfhi(a.w);
    xf[8] = bflo(b.x); xf[9] = bfhi(b.x); xf[10] = bflo(b.y); xf[11] = bfhi(b.y); xf[12] = bflo(b.z); xf[13] = bfhi(b.z); xf[14] = bflo(b.w); xf[15] = bfhi(b.w);
}
template <int MODE>
__device__ __forceinline__ void phase_upass_sl(const unsigned char* U, const unsigned char* XQ, const float* SX, const int* IDX, float* AACC, float* GT, float* SU, const float* rinvU, const float* rinvV, const XTopo tp, int lane0) {
#define UP_IDX(dst, tt) do { const int t_ = min((tt), NTOKF - 1); const int* ip_ = IDX + (size_t)t_ * 128 + (lane >> 3) * 8; dst[0] = *(const GAS i32x4*)ip_; dst[1] = *(const GAS i32x4*)(ip_ + 4); dst[2] = *(const GAS i32x4*)(ip_ + 64); dst[3] = *(const GAS i32x4*)(ip_ + 68); } while (0)
#define UP_SEL(id, s_) id[2 * ((s_) & 1) + ((s_) >> 3)][((s_) >> 1) & 3]
#define UP_GATHER8(dst, id, h) do { _Pragma("unroll") for (int j_ = 0; j_ < 8; ++j_) { if (MODE == 2) dst[j_] = (v4u){(unsigned)UP_SEL(id, 8 * (h) + j_), 0x38383838u, 0x38383838u, 0x38383838u}; else dst[j_] = __builtin_bit_cast(v4u, __builtin_amdgcn_raw_buffer_load_b128(urs, (UP_SEL(id, 8 * (h) + j_) << 7) + i * 16, 0, 0)); } } while (0)
#define UP_X(xa, xb, tt) do { const int t_ = min((tt), NTOKF - 1); xa = *(const GAS v4u*)(XQ + (size_t)t_ * 2048 + sl * 128 + (lane & 7) * 16); xb.x = __builtin_bit_cast(unsigned, SX[t_]); } while (0)
    if (MODE == 0) {
        int lane = lane0; asm volatile("" : "+v"(lane));
        for (int t = tp.wq; t < NTOKF; t += tp.nwq) if (((t >> 8) % tp.nx) == tp.xi) {
            const size_t o_ = (size_t)t * 128 + lane; const int e0_ = IDX[o_], e1_ = IDX[o_ + 64];
            SU[o_] = rinvU[e0_]; SU[o_ + 64] = rinvU[e1_]; GT[o_] *= rinvV[e0_]; GT[o_ + 64] *= rinvV[e1_]; }
    }
    for (int sl = tp.xi; sl < 16; sl += tp.nx) {
        int lane = lane0; asm volatile("" : "+v"(lane));
        const int g = lane >> 3, i = lane & 7;
        const __amdgpu_buffer_rsrc_t urs = __builtin_amdgcn_make_buffer_rsrc((void*)(U + (size_t)sl * 16384 * 128), 0, 16384 * 128, 0x00020000);
        i32x4 idP[4], idQ[4]; v4u qa[8], qb[8], xP, sP, xQ, sQ;
#define UP_STEP(tt, xc, sc, idc, xn, sn, idnw) do { const int ts_ = (tt); \
            UP_X(xn, sn, ts_ + tp.nwq); UP_IDX(idnw, ts_ + 2 * tp.nwq); \
            __builtin_amdgcn_sched_barrier(0); \
            float acc[16]; const float sx_ = (ts_ < NTOKF) ? __builtin_bit_cast(float, sc.x) : 0.f;     \
            _Pragma("unroll") for (int j = 0; j < 8; ++j) acc[j] = dot16_i8(qa[j], xc) * sx_; \
            UP_GATHER8(qa, idc, 0); \
            __builtin_amdgcn_sched_barrier(0); \
            _Pragma("unroll") for (int j = 0; j < 8; ++j) acc[8 + j] = dot16_i8(qb[j], xc) * sx_; \
            UP_GATHER8(qb, idc, 1); \
            __builtin_amdgcn_sched_barrier(0); \
            upass_reduce_add<MODE>(acc, AACC + (size_t)min(ts_, NTOKF - 1) * 128 + lane, lane); } while (0)
        { i32x4 id0[4]; UP_IDX(id0, tp.wq); UP_X(xP, sP, tp.wq); UP_IDX(idP, tp.wq + tp.nwq);
          __builtin_amdgcn_sched_barrier(0);
          UP_GATHER8(qa, id0, 0); UP_GATHER8(qb, id0, 1);
          __builtin_amdgcn_s_waitcnt(0x0F70); }
#pragma unroll 1
        for (int t = tp.wq; t < NTOKF; t += 2 * tp.nwq) {
            UP_STEP(t, xP, sP, idP, xQ, sQ, idQ);
            UP_STEP(t + tp.nwq, xQ, sQ, idQ, xP, sP, idP);
        }
    }
#undef UP_STEP
#undef UP_IDX
#undef UP_SEL
#undef UP_GATHER8
#undef UP_X
}
__device__ __forceinline__ void vpass_finish(const v4u (&vq)[16], const LAS float* wl, const float* Xf, float* Z, float alpha, int t, int sl, int lane) {
    const int g = lane >> 3, i = lane & 7;
    f32x4 w4[4];
#pragma unroll
    for (int q = 0; q < 4; ++q) w4[q] = *(const LAS f32x4*)(wl + g * 16 + q * 4);
    float acc[16];
#pragma unroll
    for (int c = 0; c < 16; ++c) acc[c] = 0.f;
#pragma unroll
    for (int j = 0; j < 16; ++j) { const float w = w4[j >> 2][j & 3]; const unsigned wd[4] = {vq[j].x, vq[j].y, vq[j].z, vq[j].w};
#pragma unroll
        for (int d = 0; d < 4; ++d) { const f32x2 lo = __builtin_amdgcn_cvt_pk_f32_fp8(wd[d], false), hi = __builtin_amdgcn_cvt_pk_f32_fp8(wd[d], true);
            acc[d * 4 + 0] += w * lo.x; acc[d * 4 + 1] += w * lo.y; acc[d * 4 + 2] += w * hi.x; acc[d * 4 + 3] += w * hi.y; } }
    const bool b3 = (lane & 8) != 0, b4 = (lane & 16) != 0, b5 = (lane & 32) != 0;
    float r8[8], r4[4], r2[2];
#pragma unroll
    for (int c = 0; c < 8; ++c) { const float keep = b3 ? acc[8 + c] : acc[c], send = b3 ? acc[c] : acc[8 + c]; r8[c] = keep + __shfl_xor(send, 8); }
#pragma unroll
    for (int c = 0; c < 4; ++c) { const float keep = b4 ? r8[4 + c] : r8[c], send = b4 ? r8[c] : r8[4 + c]; r4[c] = keep + __shfl_xor(send, 16); }
#pragma unroll
    for (int c = 0; c < 2; ++c) { const float keep = b5 ? r4[2 + c] : r4[c], send = b5 ? r4[c] : r4[2 + c]; r2[c] = keep + __shfl_xor(send, 32); }
    const int col = sl * 128 + i * 16 + (b3 ? 8 : 0) + (b4 ? 4 : 0) + (b5 ? 2 : 0);
    const f32x2 xr = *(const GAS f32x2*)(Xf + (size_t)t * 2048 + col);
    *(GAS f32x2*)(Z + (size_t)t * 2048 + col) = (f32x2){alpha * xr.x + r2[0], alpha * xr.y + r2[1]};
}
__device__ __forceinline__ int wave_max_bits(int x) {
    x = max(x, __builtin_amdgcn_update_dpp(x, x, 0x111, 0xf, 0xf, false));
    x = max(x, __builtin_amdgcn_update_dpp(x, x, 0x112, 0xf, 0xf, false));
    x = max(x, __builtin_amdgcn_update_dpp(x, x, 0x114, 0xf, 0xf, false));
    x = max(x, __builtin_amdgcn_update_dpp(x, x, 0x118, 0xf, 0xf, false));
    x = max(x, __builtin_amdgcn_update_dpp(x, x, 0x142, 0xa, 0xf, false));
    x = max(x, __builtin_amdgcn_update_dpp(x, x, 0x143, 0xc, 0xf, false));
    return __builtin_amdgcn_readlane(x, 63);
}
typedef unsigned u32x2v __attribute__((ext_vector_type(2)));
template <int MODE>
__device__ __forceinline__ void vpass_step(const v4u (&cur)[16], v4u (&nxt)[16], const i32x4 (&idin)[4], i32x4 (&idout)[4], const float (&scc)[6], float (&scn)[6], const u32x2v xr, u32x2v& xrn, const __amdgpu_buffer_rsrc_t vrs,
                                           const bf16* Xf, const int* IDX, const float* AACC, const float* SU, const float* GT, bf16* Z, float alpha, LAS float* wl, int t, int tn, int tnn, int sl, int lane0, bool live = true) {
    int lane = lane0; asm volatile("" : "+v"(lane));
    const int g = lane >> 3, i = lane & 7;
#pragma unroll
    for (int q = 0; q < 4; ++q) idout[q] = *(const GAS i32x4*)(IDX + (size_t)tnn * 128 + g * 16 + q * 4);
    if (MODE == 7) { scn[0] = 0.5f; scn[1] = 0.25f; scn[2] = 1.f; scn[3] = 1.f; scn[4] = (float)tn; scn[5] = 1.f; } else
    { const size_t o0 = (size_t)tn * 128 + lane; scn[0] = AACC[o0]; scn[1] = AACC[o0 + 64]; scn[2] = SU[o0]; scn[3] = SU[o0 + 64]; scn[4] = GT[o0]; scn[5] = GT[o0 + 64]; }
    const bool hv = (lane & 32) != 0, valid = (((lane >> 5) ^ (lane >> 3)) & 1) == 0;
    const int col = (hv ? 64 : 0) + ((lane >> 4) & 1) * 32 + (i >> 2) * 16 + (i & 3) * 4;
    if (MODE != 3) xrn = *(const GAS u32x2v*)(Xf + (size_t)tn * 2048 + sl * 128 + col);
    __builtin_amdgcn_sched_barrier(0);
#pragma unroll
    for (int j = 0; j < 16; ++j) { if (MODE == 1) nxt[j] = (v4u){(unsigned)idin[j >> 2][j & 3], 0x38383838u, 0x38383838u, 0x38383838u}; else nxt[j] = __builtin_bit_cast(v4u, __builtin_amdgcn_raw_buffer_load_b128(vrs, (idin[j >> 2][j & 3] << 7) + i * 16, 0, 0)); }
    __builtin_amdgcn_sched_barrier(0);
    const float w0 = gelu_tanh_g(scc[0] * scc[2]) * scc[4], w1 = gelu_tanh_g(scc[1] * scc[3]) * scc[5];
    const int e8 = max(wave_max_bits(__builtin_bit_cast(int, fmaxf(fabsf(w0), fabsf(w1)))) >> 23, 8);
    const float S = __builtin_bit_cast(float, (261 - e8) << 23), invS = __builtin_bit_cast(float, (e8 - 7) << 23);
    wl[lane] = w0 * S; wl[64 + lane] = w1 * S;
    if (MODE == 2) { unsigned s_ = 0u;
#pragma unroll
        for (int j = 0; j < 16; ++j) s_ += cur[j].x ^ cur[j].y ^ cur[j].z ^ cur[j].w;
        if (s_ == 0x12345u) Z[((size_t)sl * NTOKF + t) * 128 + lane] = 1; }
    else {
        f32x4 w4[4];
#pragma unroll
        for (int q = 0; q < 4; ++q) w4[q] = *(const LAS f32x4*)(wl + g * 16 + q * 4);
        const int p8 = (lane & 3) * 8;
        const unsigned selp = 0x0c0c0c0cu & ~(0xffu << p8);
        const unsigned selLo = (lane & 4) ? 0x0c0c0c0cu : selp, selHi = (lane & 4) ? selp : 0x0c0c0c0cu;
        f32x4 D1 = {0.f, 0.f, 0.f, 0.f}, D2 = {0.f, 0.f, 0.f, 0.f};
#pragma unroll
        for (int j = 0; j < 16; ++j) {
            const unsigned tb = (unsigned)__builtin_amdgcn_cvt_pk_fp8_f32(w4[j >> 2][j & 3], 0.f, 0, false);
            const unsigned alo = __builtin_amdgcn_perm(0u, tb, selLo), ahi = __builtin_amdgcn_perm(0u, tb, selHi);
            const long A = (long)(((unsigned long)ahi << 32) | (unsigned long)alo);
            const long B1 = (long)(((unsigned long)cur[j].y << 32) | (unsigned long)cur[j].x), B2 = (long)(((unsigned long)cur[j].w << 32) | (unsigned long)cur[j].z);
            D1 = __builtin_amdgcn_mfma_f32_16x16x32_fp8_fp8(A, B1, D1, 0, 0, 0);
            D2 = __builtin_amdgcn_mfma_f32_16x16x32_fp8_fp8(A, B2, D2, 0, 0, 0);
        }
        f32x4 o;
#pragma unroll
        for (int r = 0; r < 4; ++r) { const float snd = hv ? D1[r] : D2[r], own = hv ? D2[r] : D1[r]; const unsigned xw = (r & 2) ? xr.y : xr.x; const float xv = (r & 1) ? bfhi(xw) : bflo(xw); o[r] = alpha * xv + (own + __shfl_xor(snd, 40)) * invS; }
        u32x2v ob; ob.x = pk2(o[0], o[1]); ob.y = pk2(o[2], o[3]);
        if (MODE == 3 || MODE == 4) { if (o[0] + o[1] + o[2] + o[3] == 1.2345f) *(GAS u32x2v*)(Z + ((size_t)sl * NTOKF + t) * 128 + col) = ob; } else
        if (valid && live) *(GAS u32x2v*)(Z + ((size_t)sl * NTOKF + t) * 128 + col) = ob;
    }
}
template <int MODE>
__device__ __forceinline__ void phase_vpass_sl(const unsigned char* V, const bf16* Xf, const int* IDX, const float* AACC, const float* SU, const float* GT, bf16* Z, float alpha, const XTopo tp, LAS unsigned char* lds, int wave, int lane_in) {
    const int lane0 = lane_in;
    LAS float* wl = (LAS float*)lds + wave * 128;
    for (int sl = tp.xi; sl < 16; sl += tp.nx) {
        const __amdgpu_buffer_rsrc_t vrs = __builtin_amdgcn_make_buffer_rsrc((void*)(V + (size_t)sl * 16384 * 128), 0, 16384 * 128, 0x00020000);
        v4u vqA[16], vqB[16]; i32x4 idA[4], idB[4]; float scA[6], scB[6]; u32x2v xrA = {0u, 0u}, xrB = {0u, 0u};
        {   int lane = lane0; asm volatile("" : "+v"(lane));
            const int g = lane >> 3, i = lane & 7, t0 = tp.wq, t1 = min(tp.wq + tp.nwq, NTOKF - 1);
#pragma unroll
            for (int q = 0; q < 4; ++q) { idA[q] = *(const GAS i32x4*)(IDX + (size_t)t0 * 128 + g * 16 + q * 4); idB[q] = *(const GAS i32x4*)(IDX + (size_t)t1 * 128 + g * 16 + q * 4); }
            const size_t o0 = (size_t)t0 * 128 + lane; scA[0] = AACC[o0]; scA[1] = AACC[o0 + 64]; scA[2] = SU[o0]; scA[3] = SU[o0 + 64]; scA[4] = GT[o0]; scA[5] = GT[o0 + 64];
            if (MODE != 3) xrA = *(const GAS u32x2v*)(Xf + (size_t)t0 * 2048 + sl * 128 + ((lane & 32) ? 64 : 0) + ((lane >> 4) & 1) * 32 + (i >> 2) * 16 + (i & 3) * 4);
            __builtin_amdgcn_sched_barrier(0);
#pragma unroll
            for (int j = 0; j < 16; ++j) { if (MODE == 1) vqA[j] = (v4u){(unsigned)idA[j >> 2][j & 3], 0x38383838u, 0x38383838u, 0x38383838u}; else vqA[j] = __builtin_bit_cast(v4u, __builtin_amdgcn_raw_buffer_load_b128(vrs, (idA[j >> 2][j & 3] << 7) + i * 16, 0, 0)); }
        }
#pragma unroll 1
        for (int t = tp.wq; t < NTOKF; t += 2 * tp.nwq) {
            const int t1 = min(t + tp.nwq, NTOKF - 1), t2 = min(t + 2 * tp.nwq, NTOKF - 1), t3 = min(t + 3 * tp.nwq, NTOKF - 1);
            vpass_step<MODE>(vqA, vqB, idB, idA, scA, scB, xrA, xrB, vrs, Xf, IDX, AACC, SU, GT, Z, alpha, wl, t, t1, t2, sl, lane0);
            vpass_step<MODE>(vqB, vqA, idA, idB, scB, scA, xrB, xrA, vrs, Xf, IDX, AACC, SU, GT, Z, alpha, wl, t1, t2, t3, sl, lane0, t + tp.nwq < NTOKF);
        }
    }
}
typedef short s16x4 __attribute__((ext_vector_type(4)));
typedef unsigned u32x2 __attribute__((ext_vector_type(2)));
template <int MODE>
__device__ __forceinline__ void phase_spatial(const bf16* UB, const bf16* VB, const float* VST, const float* lng, const float* lnb, const bf16* WSB, const float* wsf, const float* bs,
                                              bf16* UM, float* vs_out, LAS unsigned char* lds, int vcu, int G, int wave, int lane) {
    constexpr int PITCH = 136;
    LAS bf16* T = (LAS bf16*)lds;
    LAS bf16* WS = (LAS bf16*)(lds + 128 * PITCH * 2);
    const int tid = wave * 64 + lane;
    const int nbg = G >> 3, g = (nbg > 0) ? vcu / nbg : 0, jb = (nbg > 0) ? vcu % nbg : 0;
    if (MODE != 1 && nbg > 0 && g < 8) {
        for (int i = tid; i < 128 * 16; i += 512) { const int t = i >> 4, ch = i & 15; *(LAS v4u*)(WS + t * 128 + ((ch ^ (t & 15)) << 3)) = *(const GAS v4u*)(WSB + (size_t)(g * 128 + t) * 128 + ch * 8); }
        const int s_ = tid >> 2, cq_ = (tid & 3) * 32;
        v4u pvq[4]; float ps1 = 1.f, ps2 = 2.f;
        if (MODE == 2) pvq[0] = pvq[1] = pvq[2] = pvq[3] = (v4u){0x3f803f80u, 0x3f803f80u, 0x3f803f80u, 0x3f803f80u};
        else if (jb < 384) { const int ck = jb / 6, cb = g * 6 + jb % 6; const size_t r = (size_t)ck * 128 + s_;
            ps1 = VST[r * 2]; ps2 = VST[r * 2 + 1];
#pragma unroll
            for (int i = 0; i < 4; ++i) pvq[i] = *(const GAS v4u*)(VB + r * 6144 + cb * 128 + cq_ + i * 8); }
        for (int u = jb; u < 384; u += nbg) {
            const int ck = u / 6, cb = g * 6 + u % 6;
            const size_t row0 = (size_t)ck * 128; const int col0 = cb * 128;
            u32x2 uq[8]; float bsv[8];
            { const int fr = lane & 15, fq = lane >> 4, c0 = 16 * wave;
#pragma unroll
              for (int jt = 0; jt < 8; ++jt) { const int t = jt * 16 + fr; if (MODE == 3) uq[jt] = (u32x2){0x3f803f80u, 0x3f803f80u}; else uq[jt] = *(const GAS u32x2*)(UB + (row0 + t) * 6144 + col0 + c0 + 4 * fq); bsv[jt] = bs[g * 128 + t]; } }
            {
                const float mu = ps1 * (1.f / 6144.f); const float rstd = rsqrtf(ps2 * (1.f / 6144.f) - mu * mu + 1e-5f);
#pragma unroll
                for (int i = 0; i < 4; ++i) { const v4u q = pvq[i];
                    const float* gp = lng + col0 + cq_ + i * 8; const float* bp = lnb + col0 + cq_ + i * 8;
                    const f32x4 g0 = *(const GAS f32x4*)gp, g1 = *(const GAS f32x4*)(gp + 4), b0 = *(const GAS f32x4*)bp, b1 = *(const GAS f32x4*)(bp + 4);
                    v4u o;
                    o.x = pk2((bflo(q.x) - mu) * rstd * g0.x + b0.x, (bfhi(q.x) - mu) * rstd * g0.y + b0.y);
                    o.y = pk2((bflo(q.y) - mu) * rstd * g0.z + b0.z, (bfhi(q.y) - mu) * rstd * g0.w + b0.w);
                    o.z = pk2((bflo(q.z) - mu) * rstd * g1.x + b1.x, (bfhi(q.z) - mu) * rstd * g1.y + b1.y);
                    o.w = pk2((bflo(q.w) - mu) * rstd * g1.z + b1.z, (bfhi(q.w) - mu) * rstd * g1.w + b1.w);
                    *(LAS v4u*)(T + s_ * PITCH + cq_ + i * 8) = o; }
            }
            __syncthreads();
            {
                const int fr = lane & 15, fq = lane >> 4, qq = fr >> 2, pp = fr & 3, c0 = 16 * wave;
                if (MODE != 2 && u + nbg < 384) { const int un = u + nbg, ckn = un / 6, cbn = g * 6 + un % 6; const size_t r = (size_t)ckn * 128 + s_;
                    ps1 = VST[r * 2]; ps2 = VST[r * 2 + 1];
#pragma unroll
                    for (int i = 0; i < 4; ++i) pvq[i] = *(const GAS v4u*)(VB + r * 6144 + cbn * 128 + cq_ + i * 8); }
                bf16x8 af[4];
#pragma unroll
                for (int ks = 0; ks < 4; ++ks) {
                    const s16x4 r0 = __builtin_amdgcn_ds_read_tr16_b64_v4i16((LAS s16x4*)(T + (32 * ks + 8 * fq + qq) * PITCH + c0 + 4 * pp));
                    const s16x4 r1 = __builtin_amdgcn_ds_read_tr16_b64_v4i16((LAS s16x4*)(T + (32 * ks + 8 * fq + 4 + qq) * PITCH + c0 + 4 * pp));
                    af[ks] = (bf16x8){r0.x, r0.y, r0.z, r0.w, r1.x, r1.y, r1.z, r1.w};
                }
                f32x4 acc[8];
#pragma unroll
                for (int jt = 0; jt < 8; ++jt) {
                    acc[jt] = (f32x4){0.f, 0.f, 0.f, 0.f};
#pragma unroll
                    for (int ks = 0; ks < 4; ++ks) if (ks <= (jt >> 1)) { const bf16x8 bfr = *(const LAS bf16x8*)(WS + (jt * 16 + fr) * 128 + (((ks * 4 + fq) ^ fr) << 3)); acc[jt] = __builtin_amdgcn_mfma_f32_16x16x32_bf16(af[ks], bfr, acc[jt], 0, 0, 0); }
                }
#pragma unroll
                for (int jt = 0; jt < 8; ++jt) {
                    const int t = jt * 16 + fr; const size_t off = (row0 + t) * 6144 + col0 + c0 + 4 * fq;
                    u32x2 o; o.x = pk2(bflo(uq[jt].x) * (acc[jt][0] + bsv[jt]), bfhi(uq[jt].x) * (acc[jt][1] + bsv[jt])); o.y = pk2(bflo(uq[jt].y) * (acc[jt][2] + bsv[jt]), bfhi(uq[jt].y) * (acc[jt][3] + bsv[jt]));
                    if (MODE == 3) { if (o.x == 0x12345u) *(GAS u32x2*)(UM + off) = o; } else *(GAS u32x2*)(UM + off) = o;
                }
            }
            __syncthreads();
        }
    }
    if (MODE == 0 || MODE == 1) for (int it = vcu * 512 + tid; it < 128 * 768; it += G * 512) {
        const int sq = it / 768, c8 = (it % 768) * 8, gg = c8 / 768;
        const size_t r0 = 8192 + (size_t)sq * 4;
        const f32x4 g0 = *(const GAS f32x4*)(lng + c8), g1 = *(const GAS f32x4*)(lng + c8 + 4), b0 = *(const GAS f32x4*)(lnb + c8), b1 = *(const GAS f32x4*)(lnb + c8 + 4);
        v4u vq4[4], uq4[4]; float st1[4], st2[4], bsv4[4], wv[4][4];
#pragma unroll
        for (int s = 0; s < 4; ++s) { st1[s] = VST[(r0 + s) * 2]; st2[s] = VST[(r0 + s) * 2 + 1]; vq4[s] = *(const GAS v4u*)(VB + (r0 + s) * 6144 + c8); uq4[s] = *(const GAS v4u*)(UB + (r0 + s) * 6144 + c8); bsv4[s] = bs[gg * 128 + s];
#pragma unroll
            for (int s2 = 0; s2 < 4; ++s2) wv[s][s2] = (s2 <= s) ? wsf[(size_t)(gg * 128 + s) * 128 + s2] : 0.f; }
        float vn[4][8];
#pragma unroll
        for (int s = 0; s < 4; ++s) {
            const float mu = st1[s] * (1.f / 6144.f); const float rstd = rsqrtf(st2[s] * (1.f / 6144.f) - mu * mu + 1e-5f); const v4u q = vq4[s];
            vn[s][0] = (bflo(q.x) - mu) * rstd * g0.x + b0.x; vn[s][1] = (bfhi(q.x) - mu) * rstd * g0.y + b0.y; vn[s][2] = (bflo(q.y) - mu) * rstd * g0.z + b0.z; vn[s][3] = (bfhi(q.y) - mu) * rstd * g0.w + b0.w;
            vn[s][4] = (bflo(q.z) - mu) * rstd * g1.x + b1.x; vn[s][5] = (bfhi(q.z) - mu) * rstd * g1.y + b1.y; vn[s][6] = (bflo(q.w) - mu) * rstd * g1.z + b1.z; vn[s][7] = (bfhi(q.w) - mu) * rstd * g1.w + b1.w;
        }
#pragma unroll
        for (int s = 0; s < 4; ++s) { float* vo = vs_out + ((size_t)sq * 4 + s) * 6144 + c8;
            *(GAS f32x4*)vo = (f32x4){vn[s][0], vn[s][1], vn[s][2], vn[s][3]}; *(GAS f32x4*)(vo + 4) = (f32x4){vn[s][4], vn[s][5], vn[s][6], vn[s][7]}; }
#pragma unroll
        for (int t = 0; t < 4; ++t) {
            float mx[8];
#pragma unroll
            for (int e = 0; e < 8; ++e) mx[e] = bsv4[t];
#pragma unroll
            for (int s = 0; s < 4; ++s) if (s <= t) {
#pragma unroll
                for (int e = 0; e < 8; ++e) mx[e] += wv[t][s] * vn[s][e]; }
            const v4u uq = uq4[t];
            v4u o; o.x = pk2(bflo(uq.x) * mx[0], bfhi(uq.x) * mx[1]); o.y = pk2(bflo(uq.y) * mx[2], bfhi(uq.y) * mx[3]); o.z = pk2(bflo(uq.z) * mx[4], bfhi(uq.z) * mx[5]); o.w = pk2(bflo(uq.w) * mx[6], bfhi(uq.w) * mx[7]);
            *(GAS v4u*)(UM + (r0 + t) * 6144 + c8) = o;
        }
    }
}
__device__ __forceinline__ float wave_scan_add(float v, int lane) {
#pragma unroll
    for (int o = 1; o < 64; o <<= 1) { const float t = __shfl_up(v, o); if (lane >= o) v += t; }
    return v;
}
__device__ __forceinline__ float wave_scan_max(float v, int lane) {
#pragma unroll
    for (int o = 1; o < 64; o <<= 1) { const float t = __shfl_up(v, o); if (lane >= o) v = fmaxf(v, t); }
    return v;
}
__device__ __forceinline__ bf16x8 tr_frag2(const LAS bf16* p0, const LAS bf16* p1) {
    const s16x4 r0 = __builtin_amdgcn_ds_read_tr16_b64_v4i16((LAS s16x4*)p0);
    const s16x4 r1 = __builtin_amdgcn_ds_read_tr16_b64_v4i16((LAS s16x4*)p1);
    return (bf16x8){r0.x, r0.y, r0.z, r0.w, r1.x, r1.y, r1.z, r1.w};
}
__device__ __forceinline__ bf16x8 tr_frag(const LAS bf16* p0, int rowstep4) { return tr_frag2(p0, p0 + rowstep4); }
__device__ __forceinline__ int qk_off(int row, int chunk) { return row * 128 + ((chunk ^ (row & 15)) << 3); }
__device__ __forceinline__ int v_off(int row, int chunk) { return row * 256 + ((chunk ^ (row & 7)) << 3); }
__device__ __forceinline__ int p_off(int row, int chunk) { return row * 64 + ((chunk ^ ((row >> 1) & 7)) << 3); }

__device__ __forceinline__ void mlstm_prompt_seq(const bf16* QKVO, const float* GATES, const float* hn_gain, bf16* HN, float* Cp, float* np_, float* mp, int seq, int h, LAS unsigned char* lds, int wave, int lane) {
    LAS bf16* Qs = (LAS bf16*)lds;
    LAS bf16* Ks = (LAS bf16*)(lds + 16384);
    LAS bf16* Vs = (LAS bf16*)(lds + 32768);
    LAS bf16* Cd = (LAS bf16*)(lds + 65536) + wave * 4096;
    LAS unsigned char* hi = lds + RING_BYTES + 512;
    LAS bf16* Ps = (LAS bf16*)hi;
    LAS float* A_ = (LAS float*)(hi + 8192);
    LAS float* M_ = A_ + 64;
    LAS float* B_ = M_ + 64;
    LAS float* SC = B_ + 64;
    LAS float* X_ = SC + 4;
    LAS bf16* nd = (LAS bf16*)(X_ + 1024);
    LAS float* GN = X_ + 1024 + 64;
    const int tid = wave * 64 + lane, fr = lane & 15, fq = lane >> 4;
    const size_t row0 = (size_t)seq * 2048;
    for (int i = tid; i < 65536 / 16; i += 512) ((LAS v4u*)(lds + 65536))[i] = (v4u){0u, 0u, 0u, 0u};
    if (tid < 16) ((LAS v4u*)nd)[tid] = (v4u){0u, 0u, 0u, 0u};
    if (tid < 256) GN[tid] = hn_gain[h * 256 + tid];
    float nreg = 0.f;
    f32x4 Cacc[2][8];
#pragma unroll
    for (int it = 0; it < 2; ++it)
#pragma unroll
        for (int jd = 0; jd < 8; ++jd) Cacc[it][jd] = (f32x4){0.f, 0.f, 0.f, 0.f};
    float m = 0.f;
    const bf16x8 ones = (fr == 0) ? (bf16x8){0x3F80, 0x3F80, 0x3F80, 0x3F80, 0x3F80, 0x3F80, 0x3F80, 0x3F80} : (bf16x8){0, 0, 0, 0, 0, 0, 0, 0};
    const int srow = tid >> 3, sc16 = (tid & 7) * 16, sc32 = (tid & 7) * 32;
    v4u pq[2], pk[2], pv[4];
    {   const bf16* r = QKVO + (row0 + srow) * 6144;
#pragma unroll
        for (int i = 0; i < 2; ++i) { pq[i] = *(const GAS v4u*)(r + h * 128 + sc16 + i * 8); pk[i] = *(const GAS v4u*)(r + 1024 + h * 128 + sc16 + i * 8); }
#pragma unroll
        for (int i = 0; i < 4; ++i) pv[i] = *(const GAS v4u*)(r + 2048 + h * 256 + sc32 + i * 8); }
    float ig_n = 0.f, lf_n = 0.f;
    if (wave == 0) { ig_n = GATES[(row0 + lane) * 16 + h]; lf_n = GATES[(row0 + lane) * 16 + 8 + h]; }
    __syncthreads();
#pragma unroll 1
    for (int c = 0; c < 32; ++c) {
        const size_t rb = row0 + (size_t)c * 64;
        int fr_l = lane & 15, fq_l = lane >> 4; asm volatile("" : "+v"(fr_l), "+v"(fq_l));
        const int fr = fr_l, fq = fq_l;
#pragma unroll
        for (int i = 0; i < 2; ++i) { *(LAS v4u*)(Qs + qk_off(srow, (sc16 >> 3) + i)) = pq[i]; *(LAS v4u*)(Ks + qk_off(srow, (sc16 >> 3) + i)) = pk[i]; }
#pragma unroll
        for (int i = 0; i < 4; ++i) *(LAS v4u*)(Vs + v_off(srow, (sc32 >> 3) + i)) = pv[i];
        if (c + 1 < 32) { const bf16* r = QKVO + (rb + 64 + srow) * 6144;
#pragma unroll
            for (int i = 0; i < 2; ++i) { pq[i] = *(const GAS v4u*)(r + h * 128 + sc16 + i * 8); pk[i] = *(const GAS v4u*)(r + 1024 + h * 128 + sc16 + i * 8); }
#pragma unroll
            for (int i = 0; i < 4; ++i) pv[i] = *(const GAS v4u*)(r + 2048 + h * 256 + sc32 + i * 8); }
        if (wave == 0) {
            const float ig = ig_n, lf = lf_n;
            if (c + 1 < 32) { ig_n = GATES[(rb + 64 + lane) * 16 + h]; lf_n = GATES[(rb + 64 + lane) * 16 + 8 + h]; }
            const float b = wave_scan_add(lf, lane); const float a = ig - b; const float pm = wave_scan_max(a, lane);
            const float Mt = fmaxf(m, pm);
            A_[lane] = a; M_[lane] = Mt; B_[lane] = b;
            const float M63 = __shfl(Mt, 63), b63 = __shfl(b, 63);
            if (lane == 0) { SC[0] = __expf(m - M63); SC[1] = b63 + M63; SC[2] = m; }
            m = b63 + M63;
        }
        __syncthreads();
        f32x4 nacc[3][4];
#pragma unroll
        for (int it = 0; it < 3; ++it)
#pragma unroll
            for (int jt = 0; jt < 4; ++jt) nacc[it][jt] = (f32x4){0.f, 0.f, 0.f, 0.f};
#pragma unroll 1
        for (int ks = 0; ks < 4; ++ks) {
            bf16x8 ca[3];
#pragma unroll
            for (int it = 0; it < 2; ++it) ca[it] = tr_frag(Cd + (32 * ks + 8 * fq + (fr >> 2)) * 32 + 16 * it + 4 * (fr & 3), 4 * 32);
            ca[2] = (fr == 0) ? *(const LAS bf16x8*)(nd + 32 * ks + 8 * fq) : (bf16x8){0, 0, 0, 0, 0, 0, 0, 0};
#pragma unroll
            for (int jt = 0; jt < 4; ++jt) { const bf16x8 qb = *(const LAS bf16x8*)(Qs + qk_off(16 * jt + fr, 4 * ks + fq));
#pragma unroll
                for (int it = 0; it < 3; ++it) nacc[it][jt] = __builtin_amdgcn_mfma_f32_16x16x32_bf16(ca[it], qb, nacc[it][jt], 0, 0, 0); }
        }
#pragma unroll
        for (int jt = 0; jt < 4; ++jt) { const float mt = M_[16 * jt + fr]; const float wi = __expf(SC[2] - mt);
#pragma unroll
            for (int it = 0; it < 3; ++it) nacc[it][jt] = nacc[it][jt] * wi; }
        {
#pragma unroll 1
            for (int ti = wave; ti < 16; ti += 8) {
                int tt, st;
                if (ti < 10) { tt = (ti >= 6) ? 3 : (ti >= 3) ? 2 : (ti >= 1) ? 1 : 0; st = ti - (tt * (tt + 1)) / 2; }
                else { const int z = ti - 10; tt = (z >= 5) ? 2 : (z >= 3) ? 1 : 0; st = (z >= 5) ? 3 : (z >= 3) ? (z - 3 + 2) : (z + 1); }
                u32x2 o = (u32x2){0u, 0u};
                if (ti < 10) {
                    f32x4 sa = (f32x4){0.f, 0.f, 0.f, 0.f};
#pragma unroll
                    for (int ks = 0; ks < 4; ++ks) { const bf16x8 ka = *(const LAS bf16x8*)(Ks + qk_off(16 * st + fr, 4 * ks + fq)); const bf16x8 qb = *(const LAS bf16x8*)(Qs + qk_off(16 * tt + fr, 4 * ks + fq));
                        sa = __builtin_amdgcn_mfma_f32_16x16x32_bf16(ka, qb, sa, 0, 0, 0); }
                    const int t = 16 * tt + fr, s0 = 16 * st + 4 * fq; const float mt = M_[t];
                    float pvv[4];
#pragma unroll
                    for (int r = 0; r < 4; ++r) pvv[r] = (s0 + r <= t) ? sa[r] * __expf(A_[s0 + r] - mt) : 0.f;
                    o.x = pk2(pvv[0], pvv[1]); o.y = pk2(pvv[2], pvv[3]);
                }
                *(LAS u32x2*)(Ps + p_off(16 * tt + fr, 2 * st + (fq >> 1)) + 4 * (fq & 1)) = o;
            }
        }
        __syncthreads();
        {   const float M63 = M_[63]; const float wk = __expf(A_[srow] - M63);
#pragma unroll
            for (int i = 0; i < 2; ++i) { v4u q = *(LAS v4u*)(Ks + qk_off(srow, (sc16 >> 3) + i));
                q.x = pk2(bflo(q.x) * wk, bfhi(q.x) * wk); q.y = pk2(bflo(q.y) * wk, bfhi(q.y) * wk); q.z = pk2(bflo(q.z) * wk, bfhi(q.z) * wk); q.w = pk2(bflo(q.w) * wk, bfhi(q.w) * wk);
                *(LAS v4u*)(Ks + qk_off(srow, (sc16 >> 3) + i)) = q; } }
        bf16x8 va[2][2];
#pragma unroll
        for (int ks = 0; ks < 2; ++ks)
#pragma unroll
            for (int it = 0; it < 2; ++it) { const int r_ = 32 * ks + 8 * fq + (fr >> 2), ch_ = 4 * wave + 2 * it + ((fr & 3) >> 1), w_ = 4 * (fr & 1); va[ks][it] = tr_frag2(Vs + v_off(r_, ch_) + w_, Vs + v_off(r_ + 4, ch_) + w_); }
#pragma unroll
        for (int ks = 0; ks < 2; ++ks)
#pragma unroll
            for (int jt = 0; jt < 4; ++jt) { const bf16x8 pb = *(const LAS bf16x8*)(Ps + p_off(16 * jt + fr, 4 * ks + fq));
                nacc[0][jt] = __builtin_amdgcn_mfma_f32_16x16x32_bf16(va[ks][0], pb, nacc[0][jt], 0, 0, 0);
                nacc[1][jt] = __builtin_amdgcn_mfma_f32_16x16x32_bf16(va[ks][1], pb, nacc[1][jt], 0, 0, 0);
                nacc[2][jt] = __builtin_amdgcn_mfma_f32_16x16x32_bf16(ones, pb, nacc[2][jt], 0, 0, 0); }
        u32x2 oq[4][2];
#pragma unroll
        for (int jt = 0; jt < 4; ++jt)
#pragma unroll
            for (int it = 0; it < 2; ++it) oq[jt][it] = *(const GAS u32x2*)(QKVO + (rb + 16 * jt + fr) * 6144 + 4096 + h * 256 + 32 * wave + 16 * it + 4 * fq);
        float s1[4], s2[4];
#pragma unroll
        for (int jt = 0; jt < 4; ++jt) {
            const int t = 16 * jt + fr;
            const float den = __shfl(nacc[2][jt][0], fr);
            const float dd = fmaxf(fabsf(den), __expf(-(B_[t] + M_[t]))); const float inv = 1.f / dd;
            s1[jt] = 0.f; s2[jt] = 0.f;
#pragma unroll
            for (int it = 0; it < 2; ++it) { const u32x2 oq_ = oq[jt][it];
                const float og[4] = {bflo(oq_.x), bfhi(oq_.x), bflo(oq_.y), bfhi(oq_.y)};
#pragma unroll
                for (int r = 0; r < 4; ++r) { const float hv = nacc[it][jt][r] * inv * __builtin_amdgcn_rcpf(1.f + __expf(-og[r])); nacc[it][jt][r] = hv; s1[jt] += hv; s2[jt] += hv * hv; } }
            s1[jt] += __shfl_xor(s1[jt], 16); s1[jt] += __shfl_xor(s1[jt], 32); s2[jt] += __shfl_xor(s2[jt], 16); s2[jt] += __shfl_xor(s2[jt], 32);
            if (fq == 0) { X_[(wave * 64 + t) * 2] = s1[jt]; X_[(wave * 64 + t) * 2 + 1] = s2[jt]; }
        }
        __syncthreads();
#pragma unroll
        for (int jt = 0; jt < 4; ++jt) {
            const int t = 16 * jt + fr; float a1 = 0.f, a2 = 0.f;
#pragma unroll
            for (int w = 0; w < 8; ++w) { a1 += X_[(w * 64 + t) * 2]; a2 += X_[(w * 64 + t) * 2 + 1]; }
            const float mu = a1 * (1.f / 256.f); const float rstd = rsqrtf(a2 * (1.f / 256.f) - mu * mu + 1e-5f);
#pragma unroll
            for (int it = 0; it < 2; ++it) { const int e = 32 * wave + 16 * it + 4 * fq; const f32x4 gn = *(const LAS f32x4*)(GN + e);
                u32x2 o; o.x = pk2((nacc[it][jt][0] - mu) * rstd * gn.x, (nacc[it][jt][1] - mu) * rstd * gn.y); o.y = pk2((nacc[it][jt][2] - mu) * rstd * gn.z, (nacc[it][jt][3] - mu) * rstd * gn.w);
                *(GAS u32x2*)(HN + (rb + t) * 2048 + h * 256 + e) = o; }
        }
        {   const float decay = SC[0];
#pragma unroll
            for (int it = 0; it < 2; ++it)
#pragma unroll
                for (int jd = 0; jd < 8; ++jd) Cacc[it][jd] = Cacc[it][jd] * decay;
            if (tid < 128) { float sum = 0.f;
#pragma unroll 8
                for (int s2_ = 0; s2_ < 64; ++s2_) sum += bflo((unsigned)Ks[qk_off(s2_, tid >> 3) + (tid & 7)]);
                nreg = decay * nreg + sum; nd[tid] = (bf16)f2bf(nreg); }
#pragma unroll
            for (int ks = 0; ks < 2; ++ks)
#pragma unroll
                for (int jd = 0; jd < 8; ++jd) { asm volatile("" ::: "memory"); const int r_ = 32 * ks + 8 * fq + (fr >> 2), ch_ = 2 * jd + ((fr & 3) >> 1), w_ = 4 * (fr & 1); const bf16x8 kb = tr_frag2(Ks + qk_off(r_, ch_) + w_, Ks + qk_off(r_ + 4, ch_) + w_);
                    Cacc[0][jd] = __builtin_amdgcn_mfma_f32_16x16x32_bf16(va[ks][0], kb, Cacc[0][jd], 0, 0, 0);
                    Cacc[1][jd] = __builtin_amdgcn_mfma_f32_16x16x32_bf16(va[ks][1], kb, Cacc[1][jd], 0, 0, 0);
                }
#pragma unroll
            for (int jd = 0; jd < 8; ++jd) {
#pragma unroll
                for (int it = 0; it < 2; ++it) { u32x2 o; o.x = pk2(Cacc[it][jd][0], Cacc[it][jd][1]); o.y = pk2(Cacc[it][jd][2], Cacc[it][jd][3]); *(LAS u32x2*)(Cd + (16 * jd + fr) * 32 + 16 * it + 4 * fq) = o; }
            }
        }
        __syncthreads();
    }
    float* Co = Cp + (size_t)(seq * 8 + h) * 32768;
#pragma unroll
    for (int jd = 0; jd < 8; ++jd) {
#pragma unroll
        for (int it = 0; it < 2; ++it) *(GAS f32x4*)(Co + (size_t)(16 * jd + fr) * 256 + 32 * wave + 16 * it + 4 * fq) = Cacc[it][jd];
    }
    if (tid < 128) np_[(seq * 8 + h) * 128 + tid] = nreg;
    if (wave == 0 && lane == 0) mp[seq * 8 + h] = m;
}

__device__ __forceinline__ void mlstm_sample_unit(const bf16* QKVO, const float* GATES, const float* hn_gain, const float* C0, const float* n0, const float* m0,
                                                  bf16* HN, float* Cs, float* ns, float* ms, int u, LAS unsigned char* lds, int wave, int lane) {
    const int h = u & 7, tid = wave * 64 + lane; const size_t r0 = 8192 + (size_t)(u >> 3) * 4;
    LAS float* q = (LAS float*)lds;
    LAS float* k = q + 512;
    LAS float* v = k + 512;
    LAS float* Sm = v + 1024;
    LAS float* gv = Sm + 16;
    LAS float* nn = gv + 32;
    LAS float* part = nn + 128;
    LAS float* red = part + 8192;
    { const int t = tid >> 7, d = tid & 127; const bf16* r = QKVO + (r0 + t) * 6144; q[tid] = bflo((unsigned)r[h * 128 + d]); k[tid] = bflo((unsigned)r[1024 + h * 128 + d]);
#pragma unroll
      for (int i = 0; i < 2; ++i) { const int idx = tid + 512 * i, tv = idx >> 8, e = idx & 255; v[idx] = bflo((unsigned)QKVO[(r0 + tv) * 6144 + 2048 + h * 256 + e]); } }
    if (tid < 128) nn[tid] = n0[(size_t)u * 128 + tid];
    if (tid == 0) {
        const float mprev = m0[u]; float b = 0.f, pm = -INFINITY;
        for (int t = 0; t < 4; ++t) { const float ig = GATES[(r0 + t) * 16 + h], lf = GATES[(r0 + t) * 16 + 8 + h]; b += lf; const float a = ig - b; pm = fmaxf(pm, a); const float Mt = fmaxf(mprev, pm);
            gv[t] = a; gv[4 + t] = Mt; gv[8 + t] = b; gv[12 + t] = __expf(mprev - Mt); }
        const float M3 = gv[7], b3 = gv[11];
        gv[28] = __expf(mprev - M3); gv[29] = b3 + M3;
        for (int s = 0; s < 4; ++s) gv[20 + s] = __expf(gv[s] - M3);
    }
    __syncthreads();
    if (tid < 16) { const int t = tid >> 2, s = tid & 3; float r = 0.f; if (s <= t) { float dot = 0.f; for (int d = 0; d < 128; ++d) dot += q[t * 128 + d] * k[s * 128 + d]; r = dot * __expf(gv[s] - gv[4 + t]); } Sm[tid] = r; }
    else if (tid < 20) { const int t = tid - 16; float dot = 0.f; for (int d = 0; d < 128; ++d) dot += q[t * 128 + d] * nn[d]; gv[24 + t] = dot; }
    __syncthreads();
    if (tid < 4) { float den = gv[12 + tid] * gv[24 + tid]; for (int s = 0; s <= tid; ++s) den += Sm[tid * 4 + s]; gv[16 + tid] = fmaxf(fabsf(den), __expf(-(gv[8 + tid] + gv[4 + tid]))); }
    k[tid] *= gv[20 + (tid >> 7)];
    __syncthreads();
    {
        const int eq = tid & 63, dg = tid >> 6; const float decay = gv[28];
        f32x4 v4[4];
#pragma unroll
        for (int s = 0; s < 4; ++s) v4[s] = *(const LAS f32x4*)(v + s * 256 + 4 * eq);
        f32x4 acc[4];
#pragma unroll
        for (int t = 0; t < 4; ++t) acc[t] = (f32x4){0.f, 0.f, 0.f, 0.f};
        const float* cin = C0 + (size_t)u * 32768 + (size_t)(dg * 16) * 256 + 4 * eq; float* cout = Cs + (size_t)u * 32768 + (size_t)(dg * 16) * 256 + 4 * eq;
#pragma unroll
        for (int hb = 0; hb < 2; ++hb) {
            f32x4 cr[8];
#pragma unroll
            for (int dd = 0; dd < 8; ++dd) cr[dd] = __builtin_nontemporal_load((const GAS f32x4*)(cin + (hb * 8 + dd) * 256));
#pragma unroll
            for (int dd = 0; dd < 8; ++dd) { const int d = dg * 16 + hb * 8 + dd; const f32x4 c = cr[dd];
#pragma unroll
                for (int t = 0; t < 4; ++t) acc[t] += c * q[t * 128 + d];
                f32x4 cn = c * decay;
#pragma unroll
                for (int s = 0; s < 4; ++s) cn += v4[s] * k[s * 128 + d];
                __builtin_nontemporal_store(cn, (GAS f32x4*)(cout + (hb * 8 + dd) * 256)); }
        }
#pragma unroll
        for (int t = 0; t < 4; ++t) *(LAS f32x4*)(part + (dg * 4 + t) * 256 + 4 * eq) = acc[t];
    }
    __syncthreads();
    float hv[2];
    {   const int t = tid >> 7, e2 = (tid & 127) * 2;
        float s1 = 0.f, s2 = 0.f;
#pragma unroll
        for (int i = 0; i < 2; ++i) { const int e = e2 + i; float num2 = 0.f;
#pragma unroll
            for (int dg = 0; dg < 8; ++dg) num2 += part[(dg * 4 + t) * 256 + e];
            float num1 = 0.f; for (int s = 0; s <= t; ++s) num1 += Sm[t * 4 + s] * v[s * 256 + e];
            float x = (num1 + gv[12 + t] * num2) / gv[16 + t];
            const float o = bflo((unsigned)QKVO[(r0 + t) * 6144 + 4096 + h * 256 + e]);
            x *= 1.f / (1.f + __expf(-o)); hv[i] = x; s1 += x; s2 += x * x; }
        s1 = wave_sum_f(s1); s2 = wave_sum_f(s2);
        if (lane == 0) { red[wave * 2] = s1; red[wave * 2 + 1] = s2; }
    }
    __syncthreads();
    {   const int t = tid >> 7, e2 = (tid & 127) * 2;
        const float a1 = red[(2 * t) * 2] + red[(2 * t + 1) * 2], a2 = red[(2 * t) * 2 + 1] + red[(2 * t + 1) * 2 + 1];
        const float mu = a1 * (1.f / 256.f); const float rstd = rsqrtf(a2 * (1.f / 256.f) - mu * mu + 1e-5f);
        const unsigned o = pk2((hv[0] - mu) * rstd * hn_gain[h * 256 + e2], (hv[1] - mu) * rstd * hn_gain[h * 256 + e2 + 1]);
        *(GAS unsigned*)(HN + (r0 + t) * 2048 + h * 256 + e2) = o;
        if (tid < 128) { float a = gv[28] * nn[tid]; for (int s = 0; s < 4; ++s) a += k[s * 128 + tid]; ns[(size_t)u * 128 + tid] = a; }
        if (tid == 0) ms[u] = gv[29];
    }
    __syncthreads();
}

__device__ __forceinline__ void phase_mlstm(const Args& a, LAS unsigned char* lds, int G, int wave, int lane, int which) {
    const bf16* QKVO = (const bf16*)(a.ws + a.L.qkvo); const float* GATES = (const float*)(a.ws + a.L.gates); bf16* HN = (bf16*)(a.ws + a.L.qp);
    const int bx = blockIdx.x;
    constexpr size_t O_CP = 17825792, O_NP = O_CP + 1048576, O_MP = O_NP + 4096, O_CS = O_MP + 32, O_NS = O_CS + 33554432, O_MS = O_NS + 131072;
    if (bx < 32) { if (which & 1) mlstm_prompt_seq(QKVO, GATES, a.in[7], HN, a.out + O_CP, a.out + O_NP, a.out + O_MP, bx >> 3, bx & 7, lds, wave, lane); }
    else {
        if (which & 2) for (int u = bx - 32; u < 1024; u += G - 32) mlstm_sample_unit(QKVO, GATES, a.in[7], a.in[2], a.in[3], a.in[4], HN, a.out + O_CS, a.out + O_NS, a.out + O_MS, u, lds, wave, lane);
        if (which & 28) { __syncthreads(); side_convert(a, lds, (bx - 32) * NWAVES + wave, (G - 32) * NWAVES, wave, lane, (which & 4) ? 3 : ((which >> 3) & 3)); }
    }
}
struct MiniBf16S { bf16* O; int ldc, sclo, schi; __device__ __forceinline__ void operator()(int row, int col, f32x4 a) const { const float s = (col >= sclo && col < schi) ? 0.08838834764831845f : 1.f;
    u32x2 o; o.x = pk2(a[0] * s, a[1] * s); o.y = pk2(a[2] * s, a[3] * s); *(GAS u32x2*)(O + (size_t)row * ldc + col) = o; } };
struct MiniBf16 { bf16* O; int ldc; __device__ __forceinline__ void operator()(int row, int col, f32x4 a) const { u32x2 o; o.x = pk2(a[0], a[1]); o.y = pk2(a[2], a[3]); *(GAS u32x2*)(O + (size_t)row * ldc + col) = o; } };
struct MiniRes { const bf16* xb; bf16* Z; float alpha; __device__ __forceinline__ void operator()(int row, int col, f32x4 a) const {
    const u32x2 x = *(const GAS u32x2*)(xb + (size_t)row * 2048 + col); u32x2 o; o.x = pk2(bflo(x.x) * alpha + a[0], bfhi(x.x) * alpha + a[1]); o.y = pk2(bflo(x.y) * alpha + a[2], bfhi(x.y) * alpha + a[3]);
    *(GAS u32x2*)(Z + (size_t)row * 2048 + col) = o; } };
struct MiniGelu { bf16* U; bf16* V; const float* bias; float* VST; __device__ __forceinline__ void operator()(int row, int col, f32x4 a) const {
    const bool isv = col >= 6144; const f32x4 bv = *(const GAS f32x4*)(bias + col); float s1 = 0.f, s2 = 0.f;
#pragma unroll
    for (int e = 0; e < 4; ++e) { a[e] = pg8::gelu_tanh_f(a[e] + bv[e]); s1 += a[e]; s2 += a[e] * a[e]; }
    u32x2 o; o.x = pk2(a[0], a[1]); o.y = pk2(a[2], a[3]);
    *(GAS u32x2*)((isv ? V + (size_t)row * 6144 + (col - 6144) : U + (size_t)row * 6144 + col)) = o;
    if (isv) { s1 += __shfl_xor(s1, 16); s1 += __shfl_xor(s1, 32); s2 += __shfl_xor(s2, 16); s2 += __shfl_xor(s2, 32);
        if ((threadIdx.x & 48) == 0) { atomicAdd(VST + 2 * row, s1); atomicAdd(VST + 2 * row + 1, s2); } } } };
template <class Epi, int MABL = 0>
__device__ __forceinline__ void mini_gemm(const bf16* A, const bf16* Bt, int N, int K, const Epi& E, LAS unsigned char* lds, int vcu, int G, int wave, int lane) {
    const int tid = wave * 64 + lane, fr = lane & 15, fq = lane >> 4;
    const int srow = tid >> 4, q16 = (tid & 15) ^ (srow & 15);
    const int nct = N / 128, nunits = 16 * nct, nch = K / 128;
    const size_t bstep = (size_t)32 * K;
    LAS unsigned char* lw = lds + wave * 1024;
#define MG_DMA(c, st) do { if (MABL != 2) { const int cc_ = min((c), nch - 1); __builtin_amdgcn_global_load_lds((const unsigned*)(ag + (size_t)cc_ * 128), (LAS unsigned*)(lw + (st)), 16, 0, 0); \
        _Pragma("unroll") for (int p_ = 0; p_ < 4; ++p_) __builtin_amdgcn_global_load_lds((const unsigned*)(bg + p_ * bstep + (size_t)cc_ * 128), (LAS unsigned*)(lw + (st) + 8192 + p_ * 8192), 16, 0, 0); } } while (0)
#define MG_COMPUTE(st) do { if (MABL == 1) break; bf16x8 a0_[4], a1_[4], b_[4]; _Pragma("unroll") for (int ks_ = 0; ks_ < 4; ++ks_) { const int co_ = ((ks_ * 4 + fq) ^ fr) << 4; \
        a0_[ks_] = *(const LAS bf16x8*)(lds + (st) + fr * 256 + co_); a1_[ks_] = *(const LAS bf16x8*)(lds + (st) + (16 + fr) * 256 + co_); b_[ks_] = *(const LAS bf16x8*)(lds + (st) + 8192 + (wave * 16 + fr) * 256 + co_); } \
        _Pragma("unroll") for (int ks_ = 0; ks_ < 4; ++ks_) { acc0 = __builtin_amdgcn_mfma_f32_16x16x32_bf16(b_[ks_], a0_[ks_], acc0, 0, 0, 0); acc1 = __builtin_amdgcn_mfma_f32_16x16x32_bf16(b_[ks_], a1_[ks_], acc1, 0, 0, 0); } } while (0)
    for (int u = vcu; u < nunits; u += G) {
        const int rt = u & 15, ct = u >> 4;
        const int row0 = 8192 + rt * 32, colB0 = ct * 128;
        const bf16* ag = A + (size_t)(row0 + srow) * K + q16 * 8;
        const bf16* bg = Bt + (size_t)(colB0 + srow) * K + q16 * 8;
        f32x4 acc0 = (f32x4){0.f, 0.f, 0.f, 0.f}, acc1 = acc0;
        MG_DMA(0, 0); MG_DMA(1, 40960);
        int st = 0, st2 = 81920;
#pragma unroll 1
        for (int c = 0; c < nch; ++c) {
            asm volatile("s_waitcnt vmcnt(5)" ::: "memory");
            __builtin_amdgcn_s_barrier();
            asm volatile("" ::: "memory");
            MG_DMA(c + 2, st2);
            MG_COMPUTE(st);
            st = (st == 81920) ? 0 : st + 40960; st2 = (st2 == 81920) ? 0 : st2 + 40960;
        }
        asm volatile("s_waitcnt vmcnt(0)" ::: "memory");
        __syncthreads();
        if (MABL == 0 || (acc0[0] + acc1[1] == 1.2345f)) { E(row0 + fr, colB0 + wave * 16 + 4 * fq, acc0); E(row0 + 16 + fr, colB0 + wave * 16 + 4 * fq, acc1); }
    }
#undef MG_DMA
#undef MG_COMPUTE
}
__global__ void __launch_bounds__(NWAVES * 64, 2) mk(Args args) {
    extern __shared__ __attribute__((aligned(16))) unsigned char lds_raw[];
    LAS unsigned char* lds = (LAS unsigned char*)lds_raw;
    volatile LAS unsigned* MISC = (volatile LAS unsigned*)(lds + MISC_OFF);
    const int tid = threadIdx.x, lane = tid & 63, wave = __builtin_amdgcn_readfirstlane(tid >> 6);
    const int G = gridDim.x, bx = blockIdx.x; const int vcu = (G % 8 == 0) ? (bx % 8) * (G / 8) + bx / 8 : bx;
    for (int u = tid; u < (LDS_BYTES - RING_BYTES) / 4; u += NWAVES * 64) ((LAS unsigned*)(lds + RING_BYTES))[u] = 0u;
    __syncthreads();
    unsigned char* ws = args.ws; const Lay& L = args.L;
    unsigned* ctl = (unsigned*)(ws + L.ctl);
    XcdBarrier bar = xcd_barrier_post(ctl + 4096 + args.li * XCD_BAR_WORDS, MISC + 8);
    const int lo = args.ph_lo, hi = args.ph_hi;
#ifndef PHMASK
#define PHMASK 0xFFFFFFFFu
#endif
#define IN(k) (((PHMASK >> (k)) & 1u) && lo <= (k) && (k) < hi)
#ifndef MLSTM_DUPSEL
#define MLSTM_DUPSEL 3
#endif
#ifndef TK_ABL
#define TK_ABL 0
#endif
#ifndef SP_ABL
#define SP_ABL 0
#endif
#ifndef UP_ABL
#define UP_ABL 0
#endif
#ifndef VP_ABL
#define VP_ABL 0
#endif
#ifndef DUPMASK
#define DUPMASK 0u
#endif
#define DUP(k) ((DUPMASK >> (k)) & 1u)
#define LANE() ({ int l_ = lane; asm volatile("" : "+v"(l_)); l_; })
#define SEAM(k) do { if (IN(k) && IN((k) + 1)) xcd_barrier(bar); } while (0)
#define GEMM_PHASE_FULL(EPI_T, E, Aptr, Btptr, Nn, Kk) do { pg8::Gemm g_{(const pg8::bf16_t*)(Aptr), (const pg8::bf16_t*)(Btptr), NTOKF, (Nn), (Kk)}; pg8::StaticOrder S_; S_.init(NTOKF, (Nn), G, bx); \
        pg8::gemm_phase<EPI_T, pg8::StaticOrder, true, true>(lds, g_, S_, E); } while (0)
#define GEMM_PHASE(EPI_T, E, Aptr, Btptr, Nn, Kk, MINI_E) do { pg8::Gemm g_{(const pg8::bf16_t*)(Aptr), (const pg8::bf16_t*)(Btptr), 8192, (Nn), (Kk)}; pg8::StaticOrder S_; S_.init(8192, (Nn), G, bx); \
        pg8::gemm_phase<EPI_T, pg8::StaticOrder, true, true>(lds, g_, S_, E); \
        mini_gemm((const bf16*)(Aptr), (const bf16*)(Btptr), (Nn), (Kk), MINI_E, lds, vcu, G, wave, LANE()); } while (0)

#ifndef MINI_ABL
#define MINI_ABL 0
#endif
#define GEMM_PHASE_MINI(EPI_T, E, Aptr, Btptr, Nn, Kk, MINI_E) do { mini_gemm<decltype(MINI_E), MINI_ABL>((const bf16*)(Aptr), (const bf16*)(Btptr), (Nn), (Kk), MINI_E, lds, vcu, G, wave, LANE()); } while (0)
#ifdef MINI_DUP
#define GEMM_PHASE_DUPSEL GEMM_PHASE_MINI
#else
#define GEMM_PHASE_DUPSEL GEMM_PHASE
#endif

    if (IN(0)) { { phase_prologue(args, lds, vcu, G, wave, LANE()); } if (DUP(0)) { xcd_barrier(bar); { phase_prologue(args, lds, vcu, G, wave, LANE()); } } } SEAM(0);
    if (IN(1)) { { pg8::EpiBf16S E{(pg8::bf16_t*)(ws + L.qkvo), 6144, 1024, 2048, 0.08838834764831845f}; GEMM_PHASE(pg8::EpiBf16S, E, ws + L.xb, ws + L.wina, 6144, 2048, (MiniBf16S{(bf16*)(ws + L.qkvo), 6144, 1024, 2048})); } if (DUP(1)) { xcd_barrier(bar); { pg8::EpiBf16S E{(pg8::bf16_t*)(ws + L.qkvo), 6144, 1024, 2048, 0.08838834764831845f}; GEMM_PHASE(pg8::EpiBf16S, E, ws + L.xb, ws + L.wina, 6144, 2048, (MiniBf16S{(bf16*)(ws + L.qkvo), 6144, 1024, 2048})); } } } SEAM(1);
    if (IN(2)) { { phase_mlstm(args, lds, G, wave, lane, 7); } if (DUP(2)) { xcd_barrier(bar); { phase_mlstm(args, lds, G, wave, lane, MLSTM_DUPSEL); } } } SEAM(2);
    if (IN(3)) { { pg8::EpiRes E{(const pg8::bf16_t*)(ws + L.xb), (pg8::bf16_t*)(ws + L.z), ALPHA_F}; GEMM_PHASE(pg8::EpiRes, E, ws + L.qp, ws + L.wouta, 2048, 2048, (MiniRes{(const bf16*)(ws + L.xb), (bf16*)(ws + L.z), ALPHA_F})); } if (DUP(3)) { xcd_barrier(bar); { pg8::EpiRes E{(const pg8::bf16_t*)(ws + L.xb), (pg8::bf16_t*)(ws + L.z), ALPHA_F}; GEMM_PHASE(pg8::EpiRes, E, ws + L.qp, ws + L.wouta, 2048, 2048, (MiniRes{(const bf16*)(ws + L.xb), (bf16*)(ws + L.z), ALPHA_F})); } } } SEAM(3);
    if (IN(4)) { { phase_ln<false>((const float*)(ws + L.z), args.in[16], args.in[17], (float*)nullptr, (bf16*)(ws + L.xb), ws + L.xq, (float*)(ws + L.sx), (bf16*)nullptr, vcu, G, wave, LANE()); } if (DUP(4)) { xcd_barrier(bar); { phase_ln<false>((const float*)(ws + L.z), args.in[16], args.in[17], (float*)nullptr, (bf16*)(ws + L.xb), ws + L.xq, (float*)(ws + L.sx), (bf16*)nullptr, vcu, G, wave, LANE()); } } } SEAM(4);
    if (IN(5)) { { pg8::EpiBf16S E{(pg8::bf16_t*)(ws + L.qp), 2048, 0, 0, 1.f}; GEMM_PHASE(pg8::EpiBf16S, E, ws + L.xb, ws + L.wq, 2048, 2048, (MiniBf16S{(bf16*)(ws + L.qp), 2048, 0, 0})); } if (DUP(5)) { xcd_barrier(bar); { pg8::EpiBf16S E{(pg8::bf16_t*)(ws + L.qp), 2048, 0, 0, 1.f}; GEMM_PHASE(pg8::EpiBf16S, E, ws + L.xb, ws + L.wq, 2048, 2048, (MiniBf16S{(bf16*)(ws + L.qp), 2048, 0, 0})); } } } SEAM(5);
#define RINV_U ((const float*)(ws + L.rinv))
#define RINV_V ((const float*)(ws + L.rinv) + 16384)
    if (IN(6)) { { phase_topk<0>((const bf16*)(ws + L.qp), (const bf16*)(ws + L.sk), (int*)(ws + L.idx), (float*)(ws + L.gt), (float*)(ws + L.ww), (float*)(ws + L.su), RINV_U, RINV_V, lds, vcu, G, wave, LANE()); } if (DUP(6)) { xcd_barrier(bar); { phase_topk<TK_ABL>((const bf16*)(ws + L.qp), (const bf16*)(ws + L.sk), (int*)(ws + L.um), (float*)(ws + L.um + 8388608), (float*)(ws + L.um + 16777216), (float*)(ws + L.um + 25165824), RINV_U, RINV_V, lds, vcu, G, wave, LANE()); } } } SEAM(6);
    if (IN(7)) { { phase_upass_sl<0>((const unsigned char*)(ws + L.ptu), (const unsigned char*)(ws + L.xq), (const float*)(ws + L.sx), (const int*)(ws + L.idx), (float*)(ws + L.ww), (float*)(ws + L.gt), (float*)(ws + L.su), RINV_U, RINV_V, xcd_topology(bar.bar, bar.x, MISC[10], wave), LANE()); } if (DUP(7)) { xcd_barrier(bar); { phase_upass_sl<UP_ABL>((const unsigned char*)(ws + L.ptu), (const unsigned char*)(ws + L.xq), (const float*)(ws + L.sx), (const int*)(ws + L.idx), (float*)(ws + L.um), (float*)(ws + L.gt), (float*)(ws + L.su), RINV_U, RINV_V, xcd_topology(bar.bar, bar.x, MISC[10], wave), LANE()); } } } SEAM(7);
    if (IN(8)) { { phase_vpass_sl<0>((const unsigned char*)(ws + L.ptv), (const bf16*)(ws + L.xb), (const int*)(ws + L.idx), (const float*)(ws + L.ww), (const float*)(ws + L.su), (const float*)(ws + L.gt), (bf16*)(ws + L.z), ALPHA_F, xcd_topology(bar.bar, bar.x, MISC[10], wave), lds, wave, LANE()); } if (DUP(8)) { xcd_barrier(bar); { phase_vpass_sl<VP_ABL>((const unsigned char*)(ws + L.ptv), (const bf16*)(ws + L.xb), (const int*)(ws + L.idx), (const float*)(ws + L.ww), (const float*)(ws + L.su), (const float*)(ws + L.gt), (bf16*)(ws + L.um), ALPHA_F, xcd_topology(bar.bar, bar.x, MISC[10], wave), lds, wave, LANE()); } } } SEAM(8);
    if (IN(9)) { { phase_ln<true>((const float*)(ws + L.z), args.in[18], args.in[19], (float*)nullptr, (bf16*)(ws + L.xb), (unsigned char*)nullptr, (float*)nullptr, (bf16*)nullptr, vcu, G, wave, LANE()); } if (DUP(9)) { xcd_barrier(bar); { phase_ln<true>((const float*)(ws + L.z), args.in[18], args.in[19], (float*)nullptr, (bf16*)(ws + L.xb), (unsigned char*)nullptr, (float*)nullptr, (bf16*)nullptr, vcu, G, wave, LANE()); } } } SEAM(9);
    if (IN(10)) { { pg8::EpiGelu E{(pg8::bf16_t*)(ws + L.ub), (pg8::bf16_t*)(ws + L.vb), args.in[10], (float*)(ws + L.vst)}; GEMM_PHASE_FULL(pg8::EpiGelu, E, ws + L.xb, ws + L.winb, 12288, 2048); } if (DUP(10)) { xcd_barrier(bar); { pg8::EpiGelu E{(pg8::bf16_t*)(ws + L.ub), (pg8::bf16_t*)(ws + L.vb), args.in[10], (float*)(ws + L.vst)}; GEMM_PHASE_FULL(pg8::EpiGelu, E, ws + L.xb, ws + L.winb, 12288, 2048); } } } SEAM(10);
    if (IN(11)) { { phase_spatial<0>((const bf16*)(ws + L.ub), (const bf16*)(ws + L.vb), (const float*)(ws + L.vst), args.in[11], args.in[12], (const bf16*)(ws + L.wsb), args.in[13], args.in[14],
                                (bf16*)(ws + L.um), args.out + OUT_VS, lds, vcu, G, wave, LANE()); } if (DUP(11)) { xcd_barrier(bar); { phase_spatial<SP_ABL>((const bf16*)(ws + L.ub), (const bf16*)(ws + L.vb), (const float*)(ws + L.vst), args.in[11], args.in[12], (const bf16*)(ws + L.wsb), args.in[13], args.in[14],
                                (bf16*)(ws + L.ptu), (float*)(ws + L.ptu1), lds, vcu, G, wave, LANE()); } } } SEAM(11);
    if (IN(12)) { { pg8::EpiRes E{(const pg8::bf16_t*)(ws + L.xb), (pg8::bf16_t*)(ws + L.z), ALPHA_F}; GEMM_PHASE(pg8::EpiRes, E, ws + L.um, ws + L.woutb, 2048, 6144, (MiniRes{(const bf16*)(ws + L.xb), (bf16*)(ws + L.z), ALPHA_F})); } if (DUP(12)) { xcd_barrier(bar); { pg8::EpiRes E{(const pg8::bf16_t*)(ws + L.xb), (pg8::bf16_t*)(ws + L.z), ALPHA_F}; GEMM_PHASE_DUPSEL(pg8::EpiRes, E, ws + L.um, ws + L.woutb, 2048, 6144, (MiniRes{(const bf16*)(ws + L.xb), (bf16*)(ws + L.z), ALPHA_F})); } } } SEAM(12);
    if (IN(13)) { { phase_ln<false>((const float*)(ws + L.z), args.in[16] + 2048, args.in[17] + 2048, (float*)nullptr, (bf16*)(ws + L.xb), ws + L.xq, (float*)(ws + L.sx), (bf16*)nullptr, vcu, G, wave, LANE()); } if (DUP(13)) { xcd_barrier(bar); { phase_ln<false>((const float*)(ws + L.z), args.in[16] + 2048, args.in[17] + 2048, (float*)nullptr, (bf16*)(ws + L.xb), ws + L.xq, (float*)(ws + L.sx), (bf16*)nullptr, vcu, G, wave, LANE()); } } } SEAM(13);
    if (IN(14)) { { pg8::EpiBf16S E{(pg8::bf16_t*)(ws + L.qp), 2048, 0, 0, 1.f}; GEMM_PHASE(pg8::EpiBf16S, E, ws + L.xb, (bf16*)(ws + L.wq) + (size_t)2048 * 2048, 2048, 2048, (MiniBf16S{(bf16*)(ws + L.qp), 2048, 0, 0})); } if (DUP(14)) { xcd_barrier(bar); { pg8::EpiBf16S E{(pg8::bf16_t*)(ws + L.qp), 2048, 0, 0, 1.f}; GEMM_PHASE(pg8::EpiBf16S, E, ws + L.xb, (bf16*)(ws + L.wq) + (size_t)2048 * 2048, 2048, 2048, (MiniBf16S{(bf16*)(ws + L.qp), 2048, 0, 0})); } } } SEAM(14);
#undef RINV_U
#undef RINV_V
#define RINV_U ((const float*)(ws + L.rinv) + 32768)
#define RINV_V ((const float*)(ws + L.rinv) + 49152)
    if (IN(15)) { { phase_topk<0>((const bf16*)(ws + L.qp), (const bf16*)(ws + L.sk) + (size_t)16 * 128 * 128, (int*)(ws + L.idx), (float*)(ws + L.gt), (float*)(ws + L.ww), (float*)(ws + L.su), RINV_U, RINV_V, lds, vcu, G, wave, LANE()); } if (DUP(15)) { xcd_barrier(bar); { phase_topk<TK_ABL>((const bf16*)(ws + L.qp), (const bf16*)(ws + L.sk) + (size_t)16 * 128 * 128, (int*)(ws + L.um), (float*)(ws + L.um + 8388608), (float*)(ws + L.um + 16777216), (float*)(ws + L.um + 25165824), RINV_U, RINV_V, lds, vcu, G, wave, LANE()); } } } SEAM(15);
    if (IN(16)) { { phase_upass_sl<0>((const unsigned char*)(ws + L.ptu1), (const unsigned char*)(ws + L.xq), (const float*)(ws + L.sx), (const int*)(ws + L.idx), (float*)(ws + L.ww), (float*)(ws + L.gt), (float*)(ws + L.su), RINV_U, RINV_V, xcd_topology(bar.bar, bar.x, MISC[10], wave), LANE()); } if (DUP(16)) { xcd_barrier(bar); { phase_upass_sl<UP_ABL>((const unsigned char*)(ws + L.ptu1), (const unsigned char*)(ws + L.xq), (const float*)(ws + L.sx), (const int*)(ws + L.idx), (float*)(ws + L.um), (float*)(ws + L.gt), (float*)(ws + L.su), RINV_U, RINV_V, xcd_topology(bar.bar, bar.x, MISC[10], wave), LANE()); } } } SEAM(16);
    if (IN(17)) { { phase_vpass_sl<0>((const unsigned char*)(ws + L.ptv1), (const bf16*)(ws + L.xb), (const int*)(ws + L.idx), (const float*)(ws + L.ww), (const float*)(ws + L.su), (const float*)(ws + L.gt), (bf16*)(ws + L.z), ALPHA_F, xcd_topology(bar.bar, bar.x, MISC[10], wave), lds, wave, LANE()); } if (DUP(17)) { xcd_barrier(bar); { phase_vpass_sl<VP_ABL>((const unsigned char*)(ws + L.ptv1), (const bf16*)(ws + L.xb), (const int*)(ws + L.idx), (const float*)(ws + L.ww), (const float*)(ws + L.su), (const float*)(ws + L.gt), (bf16*)(ws + L.um), ALPHA_F, xcd_topology(bar.bar, bar.x, MISC[10], wave), lds, wave, LANE()); } } } SEAM(17);
#ifdef XBAR_EXTRA
    if (IN(17) && IN(18)) { for (int e_ = 0; e_ < XBAR_EXTRA; ++e_) xcd_barrier(bar); }
#endif
    if (IN(18)) { phase_ln<true>((const float*)(ws + L.z), args.in[18] + 2048, args.in[19] + 2048, args.out, nullptr, (unsigned char*)nullptr, (float*)nullptr, (bf16*)nullptr, vcu, G, wave, LANE()); }
#undef IN
#undef SEAM
#undef GEMM_PHASE
}

static int g_grid = 0;
static bool mk_init() {
    if (g_grid == 0) {
        int dev = 0, cus = 0;
        if (hipGetDevice(&dev) != hipSuccess || hipDeviceGetAttribute(&cus, hipDeviceAttributeMultiprocessorCount, dev) != hipSuccess) { g_grid = -1; return false; }
        if (hipFuncSetAttribute((const void*)mk, hipFuncAttributeMaxDynamicSharedMemorySize, LDS_BYTES) != hipSuccess) { g_grid = -1; return false; }
        (void)hipGetLastError();
        g_grid = cus;
    }
    return g_grid > 0;
}
static void mk_launch(const Args& a0, int lo, int hi, int li, hipStream_t st) {
    Args a = a0; a.ph_lo = lo; a.ph_hi = hi; a.li = li;
    hipLaunchKernelGGL(mk, dim3(g_grid), dim3(NWAVES * 64), LDS_BYTES, st, a);
}
extern "C" void kernel_launch(void* const* d_in, const int* in_sizes, int n_in, void* d_out, int out_size, void* d_ws, size_t ws_size, hipStream_t stream) {
    if (!mk_init()) return;
    constexpr unsigned long long MiB = 1ull << 20;
    Args a{};
    for (int i = 0; i < 24; ++i) a.in[i] = (const float*)d_in[i];
    a.out = (float*)d_out; a.ws = (unsigned char*)d_ws;
    Lay& L = a.L;
    L.ctl = 0; L.wina = 1 * MiB; L.wouta = 25 * MiB; L.winb = 33 * MiB; L.woutb = 81 * MiB; L.wq = 105 * MiB; L.sk = 121 * MiB; L.gates = 122 * MiB; L.vst = 123 * MiB; L.wsb = 124 * MiB;
    L.idx = 125 * MiB; L.gt = 130 * MiB; L.ww = 135 * MiB; L.ptu = 140 * MiB; L.ptv = 204 * MiB; L.xf0 = 268 * MiB; L.xf1 = 336 * MiB; L.z = 404 * MiB; L.xb = 472 * MiB; L.qp = 506 * MiB;
    L.qkvo = 540 * MiB; L.ub = 540 * MiB; L.vb = 642 * MiB; L.um = 744 * MiB; L.ptu1 = 846 * MiB; L.ptv1 = 910 * MiB; L.rinv = 974 * MiB; L.su = 975 * MiB; L.xq = 980 * MiB; L.sx = 997 * MiB;
    (void)hipMemsetAsync((unsigned char*)d_ws + L.ctl, 0, MiB, stream);
    mk_launch(a, 0, 19, 0, stream);
}
```
